# Optimizing an MI355X kernel written in HIP

```python
import math
import jax, jax.numpy as jnp
from jax import lax
import numpy as np

D_MODEL = 1024
BATCH = 8
SEQ = 2048
DEPTH = 1

A_HEADS = 8
A_LAT = 128
A_HEAD_DIM = 64
IDX_HEADS = 8
IDX_DIM = 64
TOPK_MAX = 256
B_HEADS = 8
B_KV_HEADS = 2
B_HEAD_DIM = 64
WINDOW = 128
BLOCK = 128
N_BUCKETS = 32
MAX_DISTANCE = 128
N_BIAS_HEADS = A_HEADS + B_HEADS
N_GROUPS = 4
EXPERTS_PER_GROUP = 8
N_EXPERTS = N_GROUPS * EXPERTS_PER_GROUP
EXPERT_TOPK = 2
D_EXPERT = 256
ALPHA = (2 * DEPTH) ** 0.25
BETA = (8 * DEPTH) ** -0.25
LN_EPS = 1e-5
RMS_EPS = 1e-6

IN_WIDTHS = (A_HEADS * A_LAT, A_LAT, IDX_HEADS * IDX_DIM, IDX_DIM, IDX_HEADS,
             B_HEADS * B_HEAD_DIM, B_KV_HEADS * B_HEAD_DIM, B_KV_HEADS * B_HEAD_DIM, D_MODEL, D_MODEL)
IN_WIDTH = (A_HEADS * A_LAT + A_LAT + IDX_HEADS * IDX_DIM + IDX_DIM + IDX_HEADS
            + B_HEADS * B_HEAD_DIM + 2 * B_KV_HEADS * B_HEAD_DIM + 2 * D_MODEL)

kernel_name = "hybrid_dsa_swa_sink_hmoe_deepnorm"


def _split_points():
    return [int(v) for v in np.cumsum(IN_WIDTHS)[:-1]]


def layer_norm(x, g, b):
    xf = x.astype(jnp.float32)
    mu = xf.mean(-1, keepdims=True)
    var = jnp.square(xf - mu).mean(-1, keepdims=True)
    return ((xf - mu) * lax.rsqrt(var + LN_EPS) * g.astype(jnp.float32) + b.astype(jnp.float32)).astype(x.dtype)


def rms_norm(x, g):
    xf = x.astype(jnp.float32)
    ms = jnp.square(xf).mean(-1, keepdims=True)
    return (xf * lax.rsqrt(ms + RMS_EPS) * g.astype(jnp.float32)).astype(x.dtype)


def t5_bucket(dist):
    n = jnp.maximum(dist, 0)
    max_exact = N_BUCKETS // 2
    nf = jnp.maximum(n, 1).astype(jnp.float32)
    large = max_exact + (jnp.log(nf / max_exact) / math.log(MAX_DISTANCE / max_exact)
                         * (N_BUCKETS - max_exact)).astype(jnp.int32)
    large = jnp.minimum(large, N_BUCKETS - 1)
    return jnp.where(n < max_exact, n, large).astype(jnp.int32)


def dsa_branch(q_lat, c_kv, q_idx, k_idx, w_idx, w_uv, bias_tab):
    bsz, L = c_kv.shape[:2]
    k_sel = min(TOPK_MAX, L // 4)
    n_blk = L // BLOCK
    key_pos = jnp.arange(L, dtype=jnp.int32)
    idx_scale = IDX_DIM ** -0.5
    w_scale = IDX_HEADS ** -0.5
    att_scale = A_LAT ** -0.5
    bias_a = bias_tab[:, :A_HEADS]
    gather = jax.vmap(lambda kv_b, i_b: kv_b[i_b])

    def to_blocks(a):
        return jnp.moveaxis(a.reshape((bsz, n_blk, BLOCK) + a.shape[2:]), 1, 0)

    def one_block(args):
        blk, qa, qi, wi = args
        q_pos = blk * BLOCK + jnp.arange(BLOCK, dtype=jnp.int32)
        s = jnp.einsum('bthd,bsd->bths', qi, k_idx) * idx_scale
        score = jnp.einsum('bths,bth->bts', jax.nn.relu(s), wi * w_scale).astype(jnp.float32)
        causal = key_pos[None, :] <= q_pos[:, None]
        score = jnp.where(causal[None], score, -jnp.inf)
        _, sel = lax.top_k(score, k_sel)
        kv = gather(c_kv, sel)
        dist = q_pos[None, :, None] - sel
        valid = dist >= 0
        bias = jnp.moveaxis(bias_a[t5_bucket(dist)], -1, 2).astype(jnp.float32)
        logits = jnp.einsum('bthc,btkc->bthk', qa, kv).astype(jnp.float32) * att_scale + bias
        logits = jnp.where(valid[:, :, None, :], logits, -jnp.inf)
        p = jax.nn.softmax(logits, axis=-1).astype(kv.dtype)
        o = jnp.einsum('bthk,btkc->bthc', p, kv)
        return jnp.einsum('bthc,hcd->bthd', o, w_uv)

    out = lax.map(one_block, (jnp.arange(n_blk, dtype=jnp.int32), to_blocks(q_lat),
                              to_blocks(q_idx), to_blocks(w_idx)))
    return jnp.moveaxis(out, 0, 1).reshape(bsz, L, A_HEADS * A_HEAD_DIM)


def swa_branch(q, k, v, sinks, bias_tab):
    bsz, L = q.shape[:2]
    n_blk = L // BLOCK
    grp = B_HEADS // B_KV_HEADS
    qb = q.reshape(bsz, n_blk, BLOCK, B_KV_HEADS, grp, B_HEAD_DIM)

    def band(a):
        a = jnp.pad(a, ((0, 0), (BLOCK, 0), (0, 0), (0, 0)))
        a = a.reshape(bsz, n_blk + 1, BLOCK, B_KV_HEADS, B_HEAD_DIM)
        return jnp.concatenate([a[:, :-1], a[:, 1:]], axis=2)

    kb, vb = band(k), band(v)
    t_loc = jnp.arange(BLOCK, dtype=jnp.int32)[:, None]
    s_loc = jnp.arange(2 * BLOCK, dtype=jnp.int32)[None, :]
    dist = t_loc + BLOCK - s_loc
    in_window = (dist >= 0) & (dist < WINDOW)
    blk_ids = jnp.arange(n_blk, dtype=jnp.int32)[:, None, None]
    mask = in_window[None] & ((blk_ids > 0) | (s_loc >= BLOCK)[None])
    bias = bias_tab[:, A_HEADS:][t5_bucket(dist)].astype(jnp.float32)
    bias = jnp.transpose(bias, (2, 0, 1)).reshape(B_KV_HEADS, grp, BLOCK, 2 * BLOCK)
    logits = jnp.einsum('bntkgd,bnskd->bnkgts', qb, kb).astype(jnp.float32) * (B_HEAD_DIM ** -0.5) + bias
    logits = jnp.where(mask[None, :, None, None], logits, -jnp.inf)
    sink = sinks.astype(jnp.float32).reshape(1, 1, B_KV_HEADS, grp, 1, 1)
    m = jnp.maximum(logits.max(-1, keepdims=True), sink)
    p = jnp.exp(logits - m)
    p = (p / (p.sum(-1, keepdims=True) + jnp.exp(sink - m))).astype(v.dtype)
    o = jnp.einsum('bnkgts,bnskd->bntkgd', p, vb)
    return o.reshape(bsz, L, B_HEADS * B_HEAD_DIM)


def hier_moe(x, w_group, b_group, w_router, b_router, w_gate, w_up, w_down):
    bsz, L, d = x.shape
    xt = x.reshape(-1, d)
    g_logits = (xt @ w_group).astype(jnp.float32) + b_group.astype(jnp.float32)
    g_prob = jax.nn.softmax(g_logits, axis=-1)
    g_sel = jnp.argmax(g_logits, axis=-1).astype(jnp.int32)
    g_w = jnp.take_along_axis(g_prob, g_sel[:, None], axis=-1)
    e_logits = ((xt @ w_router).astype(jnp.float32) + b_router.astype(jnp.float32))
    e_logits = e_logits.reshape(-1, N_GROUPS, EXPERTS_PER_GROUP)
    e_logits = jnp.take_along_axis(e_logits, g_sel[:, None, None], axis=1)[:, 0]
    e_prob = jax.nn.softmax(e_logits, axis=-1)
    top_p, top_i = lax.top_k(e_prob, EXPERT_TOPK)
    top_w = g_w * top_p / top_p.sum(-1, keepdims=True)
    expert_id = g_sel[:, None] * EXPERTS_PER_GROUP + top_i
    combine = (jax.nn.one_hot(expert_id, N_EXPERTS, dtype=jnp.float32) * top_w[..., None]).sum(1)
    combine = combine.astype(x.dtype)
    out = jnp.zeros_like(xt)
    for e in range(N_EXPERTS):
        h = jax.nn.silu(xt @ w_gate[e]) * (xt @ w_up[e])
        out = out + combine[:, e:e + 1] * (h @ w_down[e])
    return out.reshape(bsz, L, d)


def setup_inputs(seed: int = 0) -> dict:
    key = jax.random.key(seed)
    ks = jax.random.split(key, 20)
    f32 = jnp.float32

    def nrm(k, shape, scale):
        return jax.random.normal(k, shape, f32) * scale

    a_width = A_HEADS * A_HEAD_DIM
    b_width = B_HEADS * B_HEAD_DIM
    return {
        "x": nrm(ks[0], (BATCH, SEQ, D_MODEL), 1.0),
        "w_in": nrm(ks[1], (DEPTH, D_MODEL, IN_WIDTH), D_MODEL ** -0.5),
        "kv_norm_g": 1.0 + nrm(ks[2], (DEPTH, A_LAT), 0.02),
        "w_uv": nrm(ks[3], (DEPTH, A_HEADS, A_LAT, A_HEAD_DIM), A_LAT ** -0.5),
        "w_branch_a": nrm(ks[4], (DEPTH, a_width, D_MODEL), a_width ** -0.5),
        "sinks": nrm(ks[5], (DEPTH, B_HEADS), 0.5),
        "w_branch_b": nrm(ks[6], (DEPTH, b_width, D_MODEL), b_width ** -0.5),
        "w_out": nrm(ks[7], (DEPTH, D_MODEL, D_MODEL), BETA * D_MODEL ** -0.5),
        "rel_bias": nrm(ks[8], (N_BUCKETS, N_BIAS_HEADS), 0.5),
        "ln1_g": 1.0 + nrm(ks[9], (DEPTH, D_MODEL), 0.02),
        "ln1_b": nrm(ks[10], (DEPTH, D_MODEL), 0.02),
        "w_group": nrm(ks[11], (DEPTH, D_MODEL, N_GROUPS), D_MODEL ** -0.5),
        "b_group": nrm(ks[12], (DEPTH, N_GROUPS), 0.01),
        "w_router": nrm(ks[13], (DEPTH, D_MODEL, N_EXPERTS), D_MODEL ** -0.5),
        "b_router": nrm(ks[14], (DEPTH, N_EXPERTS), 0.01),
        "w_gate": nrm(ks[15], (DEPTH, N_EXPERTS, D_MODEL, D_EXPERT), D_MODEL ** -0.5),
        "w_up": nrm(ks[16], (DEPTH, N_EXPERTS, D_MODEL, D_EXPERT), D_MODEL ** -0.5),
        "w_down": nrm(ks[17], (DEPTH, N_EXPERTS, D_EXPERT, D_MODEL), BETA * D_EXPERT ** -0.5),
        "ln2_g": 1.0 + nrm(ks[18], (DEPTH, D_MODEL), 0.02),
        "ln2_b": nrm(ks[19], (DEPTH, D_MODEL), 0.02),
    }


def reference(x, w_in, kv_norm_g, w_uv, w_branch_a, sinks, w_branch_b, w_out, rel_bias,
              ln1_g, ln1_b, w_group, b_group, w_router, b_router, w_gate, w_up, w_down,
              ln2_g, ln2_b):
    bsz, L, _ = x.shape
    splits = _split_points()
    for layer in range(DEPTH):
        proj = x @ w_in[layer]
        (q_lat, c_kv, q_idx, k_idx, w_idx, q_b, k_b, v_b, gate_a, gate_b) = jnp.split(proj, splits, axis=-1)
        c_kv = rms_norm(c_kv, kv_norm_g[layer])
        y_a = dsa_branch(q_lat.reshape(bsz, L, A_HEADS, A_LAT), c_kv,
                         q_idx.reshape(bsz, L, IDX_HEADS, IDX_DIM), k_idx, w_idx,
                         w_uv[layer], rel_bias)
        y_b = swa_branch(q_b.reshape(bsz, L, B_HEADS, B_HEAD_DIM),
                         k_b.reshape(bsz, L, B_KV_HEADS, B_HEAD_DIM),
                         v_b.reshape(bsz, L, B_KV_HEADS, B_HEAD_DIM),
                         sinks[layer], rel_bias)
        merged = (jax.nn.sigmoid(gate_a) * (y_a @ w_branch_a[layer])
                  + jax.nn.sigmoid(gate_b) * (y_b @ w_branch_b[layer]))
        x = layer_norm(ALPHA * x + merged @ w_out[layer], ln1_g[layer], ln1_b[layer])
        ffn = hier_moe(x, w_group[layer], b_group[layer], w_router[layer], b_router[layer],
                       w_gate[layer], w_up[layer], w_down[layer])
        x = layer_norm(ALPHA * x + ffn, ln2_g[layer], ln2_b[layer])
    return x
```

```cpp
#include <hip/hip_runtime.h>
#include <cstdio>
#include <cstdint>

#ifndef MK_N_LAUNCHES
#define MK_N_LAUNCHES 1
#endif

constexpr int D = 1024, BATCH = 8, SEQ = 2048, NTOK = BATCH * SEQ;
constexpr int A_HEADS = 8, A_LAT = 128, IDX_HEADS = 8, IDX_DIM = 64, KSEL = 256;
constexpr int B_HEADS = 8, B_HD = 64, WINDOW = 128;
constexpr int NEXP = 32, EPG = 8, NGRP = 4, DEXP = 256;
constexpr int IN_WIDTH = 4552, NPROJ = 4608;
constexpr float ALPHA = 1.189207115002721f;
constexpr float LN_EPS = 1e-5f, RMS_EPS = 1e-6f;
constexpr float ATT_SCALE = 0.08838834764831845f;
constexpr float IDXW_SCALE = 0.125f * 0.35355339059327373f;
constexpr int NPHASE = 10;

constexpr size_t MiB = 1u << 20;
constexpr size_t WS_CTL = 0, CTL_ZERO_BYTES = 1 * MiB;
constexpr size_t WS_WIN = 1 * MiB;
constexpr size_t WS_SEL = 1 * MiB;
constexpr size_t WS_WC = 10 * MiB;
constexpr size_t WS_WB = 12 * MiB;
constexpr size_t WS_WO = 13 * MiB;
constexpr size_t WS_WIDX = 15 * MiB;
constexpr size_t WS_BIAS = 16 * MiB;
constexpr size_t WS_PE = 16 * MiB + 64 * 1024;
constexpr size_t WS_PW = 16 * MiB + 256 * 1024;
constexpr size_t WS_WGU = 17 * MiB;
constexpr size_t WS_WD = 49 * MiB;
constexpr size_t WS_XB = 65 * MiB;
constexpr size_t WS_QLAT = 97 * MiB;
constexpr size_t WS_CKV = 129 * MiB;
constexpr size_t WS_KIDX = 133 * MiB;
constexpr size_t WS_QIDX = 135 * MiB;
constexpr size_t WS_QB = 151 * MiB;
constexpr size_t WS_KB = 167 * MiB;
constexpr size_t WS_VB = 171 * MiB;
constexpr size_t WS_GA = 175 * MiB;
constexpr size_t WS_GB = 207 * MiB;
constexpr size_t WS_CKVRAW = 239 * MiB;
constexpr size_t WS_LIST = 247 * MiB;
constexpr size_t WS_SLOT = 129 * MiB;
constexpr size_t WS_END = 252 * MiB;
constexpr int CW_CNT = 64;
constexpr int CW_BAR = 4096;

constexpr int NWAVES = 8, NTHR = 512;
constexpr int LDS_BYTES = 155648;
constexpr int MISC_OFF = 131072 + 320;

#define GAS __attribute__((address_space(1)))
#define LAS __attribute__((address_space(3)))
typedef unsigned short bf16;
typedef unsigned v4u __attribute__((ext_vector_type(4)));
typedef unsigned v2u __attribute__((ext_vector_type(2)));
typedef float f32x4 __attribute__((ext_vector_type(4)));

__device__ __forceinline__ float bf2f(unsigned v) { return __builtin_bit_cast(float, v << 16); }
__device__ __forceinline__ float bflo(unsigned v) { return __builtin_bit_cast(float, v << 16); }
__device__ __forceinline__ float bfhi(unsigned v) { return __builtin_bit_cast(float, v & 0xffff0000u); }
__device__ __forceinline__ unsigned f2bf(float f) { unsigned u = __builtin_bit_cast(unsigned, f); return (u + 0x7fffu + ((u >> 16) & 1u)) >> 16; }
__device__ __forceinline__ unsigned cvt_pk(float lo, float hi) { unsigned r; asm volatile("v_cvt_pk_bf16_f32 %0, %1, %2" : "=v"(r) : "v"(lo), "v"(hi)); return r; }
__device__ __forceinline__ unsigned pk2(float lo, float hi) { return f2bf(lo) | (f2bf(hi) << 16); }
__device__ __forceinline__ float wave_sum(float v) {
#pragma unroll
    for (int o = 1; o < 64; o <<= 1) v += __shfl_xor(v, o);
    return v;
}
__device__ __forceinline__ float wave_max(float v) {
#pragma unroll
    for (int o = 1; o < 64; o <<= 1) v = fmaxf(v, __shfl_xor(v, o));
    return v;
}

typedef unsigned u2v __attribute__((ext_vector_type(2)));
#define DPP_I(v, ctrl) __builtin_amdgcn_update_dpp(0, (v), (ctrl), 0xf, 0xf, true)
#define DPP_F(v, ctrl) __builtin_bit_cast(float, __builtin_amdgcn_update_dpp(0, __builtin_bit_cast(int, (v)), (ctrl), 0xf, 0xf, true))
__device__ __forceinline__ void swap16(unsigned a, unsigned& x, unsigned& y) { unsigned b = a; asm volatile("" : "+v"(b)); auto r = __builtin_amdgcn_permlane16_swap(a, b, false, false); x = r[0]; y = r[1]; }
__device__ __forceinline__ void swap32(unsigned a, unsigned& x, unsigned& y) { unsigned b = a; asm volatile("" : "+v"(b)); auto r = __builtin_amdgcn_permlane32_swap(a, b, false, false); x = r[0]; y = r[1]; }
__device__ __forceinline__ float x16_sum(float v) { unsigned x, y; swap16(__builtin_bit_cast(unsigned, v), x, y); return __builtin_bit_cast(float, x) + __builtin_bit_cast(float, y); }
__device__ __forceinline__ float x16_max(float v) { unsigned x, y; swap16(__builtin_bit_cast(unsigned, v), x, y); return fmaxf(__builtin_bit_cast(float, x), __builtin_bit_cast(float, y)); }
__device__ __forceinline__ float x16_min(float v) { unsigned x, y; swap16(__builtin_bit_cast(unsigned, v), x, y); return fminf(__builtin_bit_cast(float, x), __builtin_bit_cast(float, y)); }
__device__ __forceinline__ int x16_sumi(int v) { unsigned x, y; swap16((unsigned)v, x, y); return (int)(x + y); }
__device__ __forceinline__ float x32_sum(float v) { unsigned x, y; swap32(__builtin_bit_cast(unsigned, v), x, y); return __builtin_bit_cast(float, x) + __builtin_bit_cast(float, y); }
__device__ __forceinline__ float x32_max(float v) { unsigned x, y; swap32(__builtin_bit_cast(unsigned, v), x, y); return fmaxf(__builtin_bit_cast(float, x), __builtin_bit_cast(float, y)); }

#define XB_TMO      128
#define XB_XCNT(j)  (256  + 64 * (j))
#define XB_XSUB(j)  (1280 + 64 * (j))
#define XB_XGEN(j)  (2304 + 64 * (j))
#define XB_TOP      3328
#define XB_TOPGEN   3392
#define XCD_BAR_WORDS 3456
#define XB_SPIN_CAP (1u << 22)

__device__ __forceinline__ unsigned xb_ld(unsigned* p)              { return __hip_atomic_load(p, __ATOMIC_RELAXED, __HIP_MEMORY_SCOPE_AGENT); }
__device__ __forceinline__ unsigned xb_add(unsigned* p, unsigned v) { return __hip_atomic_fetch_add(p, v, __ATOMIC_RELAXED, __HIP_MEMORY_SCOPE_AGENT); }
__device__ __forceinline__ unsigned xb_xcc_id() { return (unsigned)__builtin_amdgcn_s_getreg((3 << 11) | 20) & 0xFu; }
#define XB_SPIN(cond, bar) do { unsigned _sp = 0; while (cond) { __builtin_amdgcn_s_sleep(1); \
    if ((++_sp & 255u) == 0u) { if (xb_ld(&(bar)[XB_TMO])) break; if (_sp > XB_SPIN_CAP) { atomicAdd(&(bar)[XB_TMO], 1u); break; } } } } while (0)

struct XcdBarrier { unsigned* bar; unsigned x; volatile LAS unsigned* st; };

__device__ __forceinline__ XcdBarrier xcd_barrier_post(unsigned* bar, volatile LAS unsigned* st) {
    XcdBarrier b; b.bar = bar; b.x = xb_xcc_id(); b.st = st;
    if (threadIdx.x == 0) (void)xb_add(&bar[XB_XCNT(b.x)], 1u);
    return b;
}
__device__ __forceinline__ void xcd_barrier_complete(unsigned* bar, unsigned x, unsigned& nloc, unsigned& nx) {
    const unsigned G = gridDim.x * gridDim.y * gridDim.z;
    unsigned sum, cnt, mine, sp = 0u;
    for (;;) {
        sum = 0u; cnt = 0u; mine = 0u;
#pragma unroll
        for (unsigned j = 0; j < 16; ++j) { const unsigned c = xb_ld(&bar[XB_XCNT(j)]); sum += c; cnt += (c > 0u) ? 1u : 0u; mine = (j == x) ? c : mine; }
        if (sum == G) break;
        __builtin_amdgcn_s_sleep(1);
        if ((++sp & 255u) == 0u) { if (xb_ld(&bar[XB_TMO])) break; if (sp > XB_SPIN_CAP) { atomicAdd(&bar[XB_TMO], 1u); break; } }
    }
    nloc = mine > 0u ? mine : 1u; nx = cnt > 0u ? cnt : 1u;
}
__device__ __forceinline__ void xcd_barrier(const XcdBarrier& b) {
    asm volatile("s_waitcnt vmcnt(0)" ::: "memory");
    __syncthreads();
    if (threadIdx.x == 0) {
        unsigned* bar = b.bar;
        __builtin_amdgcn_s_waitcnt(0);
        unsigned nloc = b.st[0], nx = b.st[1];
        if (nloc == 0u) { xcd_barrier_complete(bar, b.x, nloc, nx); b.st[0] = nloc; b.st[1] = nx; }
        const unsigned old = xb_add(&bar[XB_XSUB(b.x)], 1u);
        const unsigned gen = old / nloc;
        if (old + 1u == (gen + 1u) * nloc) {
            __builtin_amdgcn_fence(__ATOMIC_RELEASE, "agent");
            asm volatile("s_waitcnt vmcnt(0)" ::: "memory");
            const unsigned og = xb_add(&bar[XB_TOP], 1u);
            const unsigned tg = og / nx;
            if (og + 1u == (tg + 1u) * nx) xb_add(&bar[XB_TOPGEN], 1u);
            else XB_SPIN(xb_ld(&bar[XB_TOPGEN]) == tg, bar);
            __builtin_amdgcn_fence(__ATOMIC_ACQUIRE, "agent");
            xb_add(&bar[XB_XGEN(b.x)], 1u);
            asm volatile("s_waitcnt vmcnt(0)" ::: "memory");
        } else {
            XB_SPIN(xb_ld(&bar[XB_XGEN(b.x)]) == gen, bar);
            __builtin_amdgcn_fence(__ATOMIC_ACQUIRE, "agent");
            asm volatile("s_waitcnt vmcnt(0)" ::: "memory");
        }
    }
    __syncthreads();
}

struct Ctx {
    const float *x, *w_in, *kv_g, *w_uv, *w_a, *sinks, *w_b, *w_out, *rel_bias, *ln1_g, *ln1_b, *w_group, *b_group, *w_router, *b_router, *w_gate, *w_up, *w_down, *ln2_g, *ln2_b;
    float* out;
    unsigned char* ws;
    unsigned* ctl;
    __device__ __forceinline__ bf16* P(size_t off) const { return (bf16*)(ws + off); }
    LAS unsigned char* lds;
    int tid, lane, wave, bid, G;
};

__device__ __forceinline__ int proj_src_col(int j) {
    if (j < 1024) return j;
    if (j < 1152) return j;
    if (j < 1216) return 1664 + (j - 1152);
    if (j < 1224) return 1728 + (j - 1216);
    if (j < 1280) return -1;
    if (j < 1792) return 1152 + (j - 1280);
    if (j < 2304) return 1736 + (j - 1792);
    if (j < 2432) return 2248 + (j - 2304);
    if (j < 2560) return 2376 + (j - 2432);
    if (j < 3584) return 2504 + (j - 2560);
    return 3528 + (j - 3584);
}
__device__ __forceinline__ float sigmoidf_(float v) { return 1.0f / (1.0f + __expf(-v)); }

template <class Src> __device__ __forceinline__ void transpose_item(const Ctx& c, LAS float* scr, const Src& src, bf16* dst, int dstK, int k0, int n0) {
    const int lane = c.lane;
    f32x4 tv[8]; const int kr = lane >> 3, n4 = (lane & 7) * 4;
#pragma unroll
    for (int i = 0; i < 8; ++i) tv[i] = src.v4(k0 + 8 * i + kr, n0 + n4);
#pragma unroll
    for (int i = 0; i < 8; ++i) { LAS float* d = scr + (8 * i + kr) * 33 + n4; d[0] = tv[i].x; d[1] = tv[i].y; d[2] = tv[i].z; d[3] = tv[i].w; }
    asm volatile("s_waitcnt lgkmcnt(0)" ::: "memory");
    const int cc = lane & 7;
#pragma unroll
    for (int j = 0; j < 4; ++j) { const int n = (lane >> 3) + 8 * j; const LAS float* q = scr + (8 * cc) * 33 + n;
        v4u o; o.x = pk2(q[0 * 33], q[1 * 33]); o.y = pk2(q[2 * 33], q[3 * 33]); o.z = pk2(q[4 * 33], q[5 * 33]); o.w = pk2(q[6 * 33], q[7 * 33]);
        *(v4u*)(dst + (size_t)(n0 + n) * dstK + k0 + 8 * cc) = o; }
    asm volatile("s_waitcnt lgkmcnt(0)" ::: "memory");
}
struct SrcWin { const float* w; __device__ __forceinline__ f32x4 v4(int k, int n) const { const int s = proj_src_col(n); return s < 0 ? (f32x4){0.f, 0.f, 0.f, 0.f} : *(const f32x4*)(w + (size_t)k * IN_WIDTH + s); } };
struct SrcPlain { const float* w; int N; __device__ __forceinline__ f32x4 v4(int k, int n) const { return *(const f32x4*)(w + (size_t)k * N + n); } };
struct SrcShift { const float* w; int N; int shift; __device__ __forceinline__ f32x4 v4(int k, int n) const { return *(const f32x4*)(w + (size_t)k * N + n + shift); } };

__device__ __forceinline__ float t5_bias_bucket(int dist) {
    if (dist < 16) return (float)dist;
    int b = 16 + (int)(logf((float)dist / 16.0f) / logf(8.0f) * 16.0f);
    return (float)(b < 31 ? b : 31);
}
constexpr int P0_EXPERT_ITEMS = 32 * 256 + 32 * 128;
__device__ __forceinline__ void p0_expert_item(const Ctx& c, LAS float* scr, int r) {
    constexpr int I_GU = 32 * 256;
    if (r < I_GU) { const int e = r / 256, q = r % 256, n0 = (q / 16) * 32, half = (n0 >> 7) & 1, col0 = (n0 >> 8) * 128 + (n0 & 127);
        if (half) { SrcShift s_{c.w_up + (size_t)e * 1024 * 256, DEXP, col0 - n0}; transpose_item(c, scr, s_, (bf16*)(c.ws + WS_WGU) + (size_t)e * 512 * 1024, 1024, (q % 16) * 64, n0); }
        else { SrcShift s_{c.w_gate + (size_t)e * 1024 * 256, DEXP, col0 - n0}; transpose_item(c, scr, s_, (bf16*)(c.ws + WS_WGU) + (size_t)e * 512 * 1024, 1024, (q % 16) * 64, n0); }
        return; }
    r -= I_GU;
    { const int e = r / 128, q = r % 128; SrcPlain s_{c.w_down + (size_t)e * 256 * 1024, 1024};
        transpose_item(c, scr, s_, (bf16*)(c.ws + WS_WD) + (size_t)e * 1024 * 256, 256, (q % 4) * 64, (q / 4) * 32); }
}
constexpr size_t WS_WRT = 16 * MiB + 512 * 1024;
__device__ __forceinline__ void p0_prologue(const Ctx& c) {
    { const size_t n8 = (size_t)NTOK * D / 8; const f32x4* xs = (const f32x4*)c.x; v4u* xd = (v4u*)((bf16*)(c.ws + WS_XB));
      const size_t st = (size_t)c.G * NTHR;
      size_t i = (size_t)c.bid * NTHR + c.tid;
      for (; i + 3 * st < n8; i += 4 * st) { f32x4 a[4], b[4];
#pragma unroll
          for (int u = 0; u < 4; ++u) { a[u] = xs[2 * (i + u * st)]; b[u] = xs[2 * (i + u * st) + 1]; }
#pragma unroll
          for (int u = 0; u < 4; ++u) { v4u o; o.x = pk2(a[u].x, a[u].y); o.y = pk2(a[u].z, a[u].w); o.z = pk2(b[u].x, b[u].y); o.w = pk2(b[u].z, b[u].w); xd[i + u * st] = o; } }
      for (; i < n8; i += st) { const f32x4 a = xs[2 * i], b = xs[2 * i + 1]; v4u o; o.x = pk2(a.x, a.y); o.y = pk2(a.z, a.w); o.z = pk2(b.x, b.y); o.w = pk2(b.z, b.w); xd[i] = o; } }
    { LAS float* scr = (LAS float*)(c.lds + c.wave * 8704);
      constexpr int I_WIN = 16 * 144, I_WB = 8 * 32, I_WO = 16 * 32, I_ALL = I_WIN + I_WB + I_WO;
      for (int it = c.bid * NWAVES + c.wave; it < I_ALL; it += c.G * NWAVES) {
        int r = it;
        if (r < I_WIN) { SrcWin s_{c.w_in}; transpose_item(c, scr, s_, (bf16*)(c.ws + WS_WIN), 1024, (r % 16) * 64, (r / 16) * 32); continue; } r -= I_WIN;
        if (r < I_WB) { SrcPlain s_{c.w_b, 1024}; transpose_item(c, scr, s_, (bf16*)(c.ws + WS_WB), 512, (r % 8) * 64, (r / 8) * 32); continue; } r -= I_WB;
        { SrcPlain s_{c.w_out, 1024}; transpose_item(c, scr, s_, (bf16*)(c.ws + WS_WO), 1024, (r % 16) * 64, (r / 16) * 32); }
      } }
    __syncthreads();
    { LAS float* tile = (LAS float*)c.lds; LAS float* Us = tile + 64 * 65; LAS float* As = Us + 64 * 65;
      for (int tI = c.bid; tI < 256; tI += c.G) { const int k0 = (tI & 15) * 64, n0 = (tI >> 4) * 64, h = k0 >> 7;
        const int r = c.tid >> 6, cc = c.tid & 63;
#pragma unroll
        for (int pI = 0; pI < 8; ++pI) { const int kk = pI * 8 + r; Us[kk * 65 + cc] = c.w_uv[(size_t)(k0 + kk) * 64 + cc]; As[kk * 65 + cc] = c.w_a[(size_t)(h * 64 + kk) * 1024 + n0 + cc]; }
        __syncthreads();
#pragma unroll
        for (int pI = 0; pI < 8; ++pI) { const int kk = pI * 8 + r; float a = 0.f;
#pragma unroll 16
            for (int d = 0; d < 64; ++d) a += Us[kk * 65 + d] * As[d * 65 + cc];
            tile[kk * 65 + cc] = a; }
        __syncthreads();
        const int nl = c.tid >> 3, kc = c.tid & 7; v4u o;
        o.x = pk2(tile[(8 * kc + 0) * 65 + nl], tile[(8 * kc + 1) * 65 + nl]); o.y = pk2(tile[(8 * kc + 2) * 65 + nl], tile[(8 * kc + 3) * 65 + nl]);
        o.z = pk2(tile[(8 * kc + 4) * 65 + nl], tile[(8 * kc + 5) * 65 + nl]); o.w = pk2(tile[(8 * kc + 6) * 65 + nl], tile[(8 * kc + 7) * 65 + nl]);
        *(v4u*)((bf16*)(c.ws + WS_WC) + (size_t)(n0 + nl) * 1024 + k0 + 8 * kc) = o;
        __syncthreads(); } }
    for (int i = c.bid * NTHR + c.tid; i < 48 * 1024; i += c.G * NTHR) { const int o = i >> 10, k = i & 1023;
        const float v = o < 32 ? c.w_router[(size_t)k * 32 + o] : (o < 36 ? c.w_group[(size_t)k * 4 + (o - 32)] : 0.f);
        const unsigned hi = f2bf(v); const float rem = v - bf2f(hi);
        ((bf16*)(c.ws + WS_WRT))[i] = (bf16)hi; ((bf16*)(c.ws + WS_WRT))[48 * 1024 + i] = (bf16)f2bf(rem); }
    if (c.bid == 0) { for (int i = c.tid; i < 129 * 8; i += NTHR) { const int d = i >> 3, h = i & 7; const int b = (int)t5_bias_bucket(d);
            ((float*)(c.ws + WS_BIAS))[i] = c.rel_bias[b * 16 + h]; ((float*)(c.ws + WS_BIAS) + 129 * 8)[i] = c.rel_bias[b * 16 + 8 + h]; } }
}


__device__ __forceinline__ void p_rmsnorm(const Ctx& c) {
    const int gw = c.bid * NWAVES + c.wave, NGW = c.G * NWAVES, l15 = c.lane & 15, g4 = c.lane >> 4;
    const f32x4 g0 = *(const f32x4*)(c.kv_g + 8 * l15), g1 = *(const f32x4*)(c.kv_g + 8 * l15 + 4);
    for (int r = 4 * gw + g4; r < NTOK; r += 4 * NGW) {
        const float* src = (const float*)(c.ws + WS_CKVRAW) + (size_t)r * 128 + 8 * l15;
        const f32x4 a = *(const f32x4*)src, b = *(const f32x4*)(src + 4);
        float ss = (a.x * a.x + a.y * a.y) + (a.z * a.z + a.w * a.w) + (b.x * b.x + b.y * b.y) + (b.z * b.z + b.w * b.w);
        ss += DPP_F(ss, 0xB1); ss += DPP_F(ss, 0x4E); ss += DPP_F(ss, 0x141); ss += DPP_F(ss, 0x140);
        const float rs = 1.0f / sqrtf(ss * (1.0f / 128.0f) + RMS_EPS);
        v4u o; o.x = pk2(a.x * rs * g0.x, a.y * rs * g0.y); o.y = pk2(a.z * rs * g0.z, a.w * rs * g0.w); o.z = pk2(b.x * rs * g1.x, b.y * rs * g1.y); o.w = pk2(b.z * rs * g1.z, b.w * rs * g1.w);
        *(v4u*)((bf16*)(c.ws + WS_CKV) + (size_t)r * 128 + 8 * l15) = o;
    }
}


typedef float f32x16 __attribute__((ext_vector_type(16)));
typedef short s16x8 __attribute__((ext_vector_type(8)));
__device__ __forceinline__ float half_min(float v) {
    v = fminf(v, DPP_F(v, 0xB1)); v = fminf(v, DPP_F(v, 0x4E)); v = fminf(v, DPP_F(v, 0x141)); v = fminf(v, DPP_F(v, 0x140)); return x16_min(v); }
__device__ __forceinline__ float half_max(float v) {
    v = fmaxf(v, DPP_F(v, 0xB1)); v = fmaxf(v, DPP_F(v, 0x4E)); v = fmaxf(v, DPP_F(v, 0x141)); v = fmaxf(v, DPP_F(v, 0x140)); return x16_max(v); }
__device__ __forceinline__ int half_sum(int v) {
    v += DPP_I(v, 0xB1); v += DPP_I(v, 0x4E); v += DPP_I(v, 0x141); v += DPP_I(v, 0x140); return x16_sumi(v); }
__device__ __forceinline__ void p2_unit(const Ctx& c, int b, int blk) {
    LAS unsigned char* kst = c.lds;
    const int lane = c.lane, wv = c.wave, r = lane & 31, hh = lane >> 5, g4 = lane >> 4, c16 = lane & 15;
    const int t0 = blk * 16 + 2 * wv, n0 = b * SEQ + t0, ntile = blk + 1, nst = (ntile + 15) >> 4;
    const unsigned char* ksrc = c.ws + WS_KIDX + (size_t)(b * 128) * 2048;
#define P2_ISSUE(st) do { _Pragma("unroll") for (int _j = 0; _j < 4; ++_j) \
        __builtin_amdgcn_global_load_lds((const unsigned*)(ksrc + (size_t)(st) * 32768 + (_j * 512 + c.tid) * 16), (LAS unsigned*)(kst + ((st) & 1) * 32768 + (_j * 512 + wv * 64) * 16), 16, 0, 0); } while (0)
    P2_ISSUE(0);
    s16x8 af[2];
    { const bf16* qp = (const bf16*)(c.ws + WS_QIDX) + (size_t)(n0 + (c16 >> 3)) * 512 + (c16 & 7) * 64 + 8 * g4;
      af[0] = *(const s16x8*)qp; af[1] = *(const s16x8*)(qp + 32); }
    const f32x4 wq = *(const f32x4*)((const float*)(c.ws + WS_WIDX) + (size_t)(n0 + hh) * 8 + 4 * (g4 & 1));
    asm volatile("" :: "v"(af[0]), "v"(af[1]), "v"(wq));
    float sc0[64];
#pragma unroll
    for (int i = 0; i < 64; ++i) sc0[i] = -INFINITY;
    const int lim0 = 2 * wv + hh;
#pragma unroll
    for (int st = 0; st < 8; ++st) {
        if (st < nst) {
            if (st + 1 < nst) { P2_ISSUE(st + 1); asm volatile("s_waitcnt vmcnt(4)" ::: "memory"); }
            else asm volatile("s_waitcnt vmcnt(0)" ::: "memory");
            __builtin_amdgcn_s_barrier();
            const LAS unsigned char* kb_ = kst + (st & 1) * 32768 + lane * 16;
#pragma unroll
            for (int tp = 0; tp < 8; ++tp) {
                const int tile = st * 16 + 2 * tp;
                if (tile < ntile) {
                    float sv[2];
#pragma unroll
                    for (int u2 = 0; u2 < 2; ++u2) {
                        const s16x8 b0 = *(const LAS s16x8*)(kb_ + (2 * tp + u2) * 2048), b1 = *(const LAS s16x8*)(kb_ + (2 * tp + u2) * 2048 + 1024);
                        f32x4 acc = {0.f, 0.f, 0.f, 0.f};
                        acc = __builtin_amdgcn_mfma_f32_16x16x32_bf16(af[0], b0, acc, 0, 0, 0);
                        acc = __builtin_amdgcn_mfma_f32_16x16x32_bf16(af[1], b1, acc, 0, 0, 0);
                        float v = wq.x * fmaxf(acc[0], 0.f) + wq.y * fmaxf(acc[1], 0.f) + wq.z * fmaxf(acc[2], 0.f) + wq.w * fmaxf(acc[3], 0.f);
                        v = x16_sum(v) + 0.0f;
                        const int tl = tile + u2;
                        if (tl == blk) v = (c16 <= lim0) ? v : -INFINITY;
                        if (tl > blk) v = -INFINITY;
                        sv[u2] = v;
                    }
                    sc0[st * 8 + tp] = (g4 & 1) ? sv[1] : sv[0];
                    if (tp & 1) __builtin_amdgcn_sched_barrier(0);
                }
            }
            asm volatile("s_waitcnt lgkmcnt(0)" ::: "memory");
            __builtin_amdgcn_s_barrier();
        }
    }
#undef P2_ISSUE
    const int nreg = (ntile + 1) >> 1;
    float thr0 = -INFINITY; int quota0 = 0;
    if (blk >= 16) {
        float mn0 = INFINITY, mx0 = -INFINITY; int cp = 0, cn = 0;
#pragma unroll
        for (int g = 0; g < 4; ++g) if (nreg > 16 * g) {
#pragma unroll
            for (int i = 16 * g; i < 16 * g + 16; ++i) { mx0 = fmaxf(mx0, sc0[i]); mn0 = fminf(mn0, sc0[i] == -INFINITY ? INFINITY : sc0[i]); cp += (sc0[i] > 0.f) ? 1 : 0; cn += (sc0[i] >= 0.f) ? 1 : 0; } }
        mn0 = half_min(mn0); mx0 = half_max(mx0); cp = half_sum(cp); cn = half_sum(cn);
        float lo0, hi0; int chi0, clo0; bool done0 = false;
        if (cp <= KSEL && cn >= KSEL) { done0 = true; thr0 = 0.f; quota0 = KSEL - cp; lo0 = hi0 = 0.f; chi0 = 0; clo0 = KSEL + 1; }
        else if (cp > KSEL) { lo0 = 0.f; clo0 = cn; hi0 = mx0 + fabsf(mx0) * 1e-6f + 1e-30f; chi0 = 0; }
        else { lo0 = mn0; clo0 = t0 + hh + 1; hi0 = 0.f; chi0 = cn; }
        for (int it = 0; it < 200; ++it) {
            if (__builtin_amdgcn_ballot_w64(!done0) == 0ull) break;
            const float half_ = 0.5f * (lo0 + hi0);
            float mid0 = half_;
            if (!(it & 1)) { const float fr_ = ((float)(clo0 - KSEL) + 0.5f) / (float)(clo0 - chi0); const float mi = lo0 + (hi0 - lo0) * fr_; mid0 = (mi > lo0 && mi < hi0) ? mi : half_; }
            unsigned sa = 0u, sb = 0u; int nproc = 0;
#pragma unroll
            for (int g = 0; g < 4; ++g) if (nreg > 16 * g) { nproc += 16;
#pragma unroll
                for (int i = 16 * g; i < 16 * g + 16; ++i) { const unsigned tb_ = __builtin_bit_cast(unsigned, sc0[i] - mid0);
                    if (g < 2) sa = __builtin_amdgcn_alignbit(sa, tb_, 31); else sb = __builtin_amdgcn_alignbit(sb, tb_, 31); } }
            int c0 = half_sum(nproc - __builtin_popcount(sa) - __builtin_popcount(sb));
            if (!done0) { if (c0 == KSEL) { done0 = true; thr0 = mid0; quota0 = KSEL; } else if (mid0 <= lo0 || mid0 >= hi0) { done0 = true; thr0 = lo0; quota0 = KSEL - chi0; } else if (c0 > KSEL) { lo0 = mid0; clo0 = c0; } else { hi0 = mid0; chi0 = c0; } }
        }
        if (!done0) { thr0 = lo0; quota0 = KSEL - chi0; }
    }
    unsigned short* selp0 = (unsigned short*)(c.ws + WS_SEL) + (size_t)(n0 + hh) * KSEL;
    int base0 = 0, eq0 = 0; const unsigned ltm = (1u << r) - 1u;
#pragma unroll
    for (int g = 0; g < 4; ++g) if (nreg > 16 * g) {
#pragma unroll
        for (int i = 16 * g; i < 16 * g + 16; ++i) {
            bool sel_ = sc0[i] > thr0; const bool pe = sc0[i] == thr0; const unsigned long long me = __builtin_amdgcn_ballot_w64(pe);
            if (me) { const unsigned mh = hh ? (unsigned)(me >> 32) : (unsigned)me; sel_ = sel_ || (pe && (eq0 + __builtin_popcount(mh & ltm) < quota0)); eq0 += __builtin_popcount(mh); }
            const unsigned long long ms = __builtin_amdgcn_ballot_w64(sel_); const unsigned mh2 = hh ? (unsigned)(ms >> 32) : (unsigned)ms;
            const int pos = base0 + __builtin_popcount(mh2 & ltm); if (sel_ && pos < KSEL) selp0[pos] = (unsigned short)(32 * i + r); base0 += __builtin_popcount(mh2);
        } }
}
__device__ __forceinline__ void p2_indexer_topk(const Ctx& c) {
    for (int pu = c.bid; pu < 256; pu += c.G) {
        const int b = pu >> 5, j = pu & 31;
#pragma unroll 1
        for (int q = 0; q < 4; ++q) p2_unit(c, b, q == 0 ? j : (q == 1 ? 63 - j : (q == 2 ? 64 + j : 127 - j)));
    }
}


typedef short s16x4 __attribute__((ext_vector_type(4)));
constexpr int DSA_WS_OFF = 131072 + 2048;
constexpr int DSA_BIAS_OFF = 131072 + 2048 + 10240;
__device__ __forceinline__ void p3a_dsa(const Ctx& c) {
    const int lane = c.lane, wv = c.wave, l15 = lane & 15, g4 = lane >> 4;
    LAS unsigned char* kvb = c.lds + wv * 16384;
    LAS unsigned char* wsb = c.lds + DSA_WS_OFF + wv * 1280;
    LAS float* biasL = (LAS float*)(c.lds + DSA_BIAS_OFF);
    for (int i = c.tid; i < 129 * 8; i += NTHR) biasL[i] = ((const float*)(c.ws + WS_BIAS))[i];
    __syncthreads();
    const int prow = (l15 & 3) | ((l15 & 4) << 1) | ((l15 & 8) >> 1);
    const int rowx = ((prow & 3) << 2) | (prow >> 2);
    const unsigned qk_off = (unsigned)(256 * prow + 16 * (g4 ^ (rowx & 3))), qk_sx = (unsigned)(rowx >> 2);
    const int grow = 8 * (g4 & 1) + 4 * (g4 >> 1);
    const int trow = grow + (l15 >> 2), trx = ((trow & 3) << 2) | ((trow >> 2) & 3);
    const unsigned tr_off = (unsigned)(256 * trow + 16 * (((lane & 3) >> 1) ^ (trx & 1)) + 8 * (lane & 1)), tr_mx = (unsigned)(trx >> 1);
    const bf16* ckv = (const bf16*)(c.ws + WS_CKV);
    const float bfar = biasL[128 * 8 + (l15 & 7)];
    float bmax = 0.f;
    for (int d = 0; d <= 128; ++d) bmax = fmaxf(bmax, fabsf(biasL[d * 8 + (l15 & 7)]));
    const float kvmax = 11.313708499f * 1.004f * wave_max(fmaxf(fabsf(c.kv_g[2 * lane]), fabsf(c.kv_g[2 * lane + 1])));
    unsigned trm[8];
#pragma unroll
    for (int m = 0; m < 8; ++m) trm[m] = tr_off + 32u * ((unsigned)m ^ tr_mx);
    const int gw = c.bid * NWAVES + wv, NGW = c.G * NWAVES;
    if (wv < 4) for (int eit = gw; eit < P0_EXPERT_ITEMS; eit += NGW) p0_expert_item(c, (LAS float*)kvb, eit);
    asm volatile("s_waitcnt lgkmcnt(0)" ::: "memory");
#define DSA_LOADQ(n_, raw_, qf_) do { raw_ = *(const v2u*)((const unsigned short*)(c.ws + WS_SEL) + (size_t)(n_) * KSEL + 4 * lane); \
        const s16x8* qp_ = (const s16x8*)((const bf16*)(c.ws + WS_QLAT) + (size_t)(n_) * 1024 + (l15 & 7) * 128 + 8 * g4); \
        _Pragma("unroll") for (int s_ = 0; s_ < 4; ++s_) qf_[s_] = qp_[4 * s_]; } while (0)
#define DSA_PREP(n_, raw_, qf_, sl_, t_, cnt_, nch_, nfar_, mref_) do { t_ = (n_) & 2047; cnt_ = (t_ + 1 < KSEL) ? t_ + 1 : KSEL; nch_ = (cnt_ + 31) >> 5; \
        { const int i0 = 4 * lane, lim = t_ - 128; \
          raw_.x = (i0 < cnt_ ? (raw_.x & 0xffffu) : 0u) | (i0 + 1 < cnt_ ? (raw_.x & 0xffff0000u) : 0u); raw_.y = (i0 + 2 < cnt_ ? (raw_.y & 0xffffu) : 0u) | (i0 + 3 < cnt_ ? (raw_.y & 0xffff0000u) : 0u); \
          *(LAS v2u*)(wsb + (sl_) * 512 + 8 * lane) = raw_; \
          const int e0 = (i0 < cnt_ && (int)(raw_.x & 0xffffu) <= lim) ? 1 : 0, e1 = (i0 + 1 < cnt_ && (int)(raw_.x >> 16) <= lim) ? 1 : 0, e2 = (i0 + 2 < cnt_ && (int)(raw_.y & 0xffffu) <= lim) ? 1 : 0, e3 = (i0 + 3 < cnt_ && (int)(raw_.y >> 16) <= lim) ? 1 : 0; \
          int nf = e0 + e1 + e2 + e3; nf += DPP_I(nf, 0xB1); nf += DPP_I(nf, 0x4E); nf += DPP_I(nf, 0x141); nf += DPP_I(nf, 0x140); nf = x16_sumi(nf); { unsigned xa, xb; swap32((unsigned)nf, xa, xb); nf = (int)(xa + xb); } \
          nfar_ = __builtin_amdgcn_readfirstlane(nf) >> 5; } \
        { float q2 = 0.f; \
          _Pragma("unroll") for (int s_ = 0; s_ < 4; ++s_) { if (l15 >= 8) qf_[s_] = (s16x8){0, 0, 0, 0, 0, 0, 0, 0}; \
              _Pragma("unroll") for (int e = 0; e < 8; ++e) { const float qv = bf2f((unsigned)(unsigned short)qf_[s_][e]); q2 += qv * qv; } } \
          q2 = x16_sum(q2); q2 = x32_sum(q2); mref_ = sqrtf(q2) * kvmax + bmax; } } while (0)
#define DSA_ISSUE(ch_, bi_, k8_, sl_, n_, t_, cnt_, nfar_) do { const bf16* ckb_ = ckv + (size_t)((n_) >> 11) * SEQ * 128; \
            _Pragma("unroll") for (int u = 0; u < 8; ++u) { const unsigned kw = u < 2 ? k8_.x : (u < 4 ? k8_.y : (u < 6 ? k8_.z : k8_.w)); const unsigned key = (u & 1) ? (kw >> 16) : (kw & 0xffffu); \
                const int chl = l15 ^ ((g4 << 2) | (u & 3)); \
                __builtin_amdgcn_global_load_lds((const unsigned*)((const char*)ckb_ + (size_t)(unsigned)(key * 256u + (unsigned)chl * 16u)), (LAS unsigned*)(kvb + (bi_) * 8192 + u * 1024), 16, 0, 0); } \
            if ((ch_) >= (nfar_) && lane < 32) { const int kap = 32 * (ch_) + 8 * (lane & 3) + (lane >> 2); const int key = *(const LAS unsigned short*)(wsb + (sl_) * 512 + 2 * kap); int dd = (t_) - key; dd = dd > 128 ? 128 : dd; dd = kap < (cnt_) ? dd : 255; \
                *(LAS unsigned short*)(wsb + 1024 + (bi_) * 64 + 2 * lane) = (unsigned short)dd; } } while (0)
    const bool mixq = (NGW == SEQ);
#define DSA_QIDX(i_) (mixq ? ((i_) * SEQ + ((gw + 293 * (i_)) & (SEQ - 1))) : (gw + (i_) * NGW))
    const int nq = mixq ? BATCH : (NTOK - gw + NGW - 1) / NGW;
    int qi = 0, n = DSA_QIDX(0), sl = 0, b0 = 0, t = 0, cnt = 0, nch = 0, nfar = 0; float Mref = 0.f;
    s16x8 qf[4]; v2u rawn; s16x8 qfn[4];
    if (nq > 0) { v2u raw0; DSA_LOADQ(n, raw0, qf); DSA_PREP(n, raw0, qf, 0, t, cnt, nch, nfar, Mref);
        asm volatile("s_waitcnt lgkmcnt(0)" ::: "memory");
        const v4u k80 = *(const LAS v4u*)(wsb + (8 * g4) * 2); DSA_ISSUE(0, 0, k80, 0, n, t, cnt, nfar); }
    for (; qi < nq; ++qi) {
        const bool has_next = qi + 1 < nq; const int nn = has_next ? DSA_QIDX(qi + 1) : n;
        if (has_next) DSA_LOADQ(nn, rawn, qfn);
        int tn = 0, cntn = 0, nchn = 0, nfarn = 0; float Mrefn = 0.f;
        f32x4 O[8];
#pragma unroll
        for (int m = 0; m < 8; ++m) O[m] = (f32x4){0.f, 0.f, 0.f, 0.f};
        float l_run = 0.f;
        v4u k8n = *(const LAS v4u*)(wsb + sl * 512 + (32 * (nch > 1 ? 1 : 0) + 8 * g4) * 2);
        for (int ch = 0; ch < nch; ++ch) {
            const int bi = (b0 + ch) & 1;
            asm volatile("s_waitcnt lgkmcnt(0)" ::: "memory");
            if (ch + 1 < nch) { const v4u k8 = k8n; k8n = *(const LAS v4u*)(wsb + sl * 512 + (32 * (ch + 2 < 8 ? ch + 2 : 7) + 8 * g4) * 2);
                DSA_ISSUE(ch + 1, bi ^ 1, k8, sl, n, t, cnt, nfar); asm volatile("s_waitcnt vmcnt(8)" ::: "memory"); }
            else if (has_next) { DSA_PREP(nn, rawn, qfn, sl ^ 1, tn, cntn, nchn, nfarn, Mrefn);
                asm volatile("s_waitcnt lgkmcnt(0)" ::: "memory");
                const v4u k8 = *(const LAS v4u*)(wsb + (sl ^ 1) * 512 + (8 * g4) * 2);
                DSA_ISSUE(0, bi ^ 1, k8, sl ^ 1, nn, tn, cntn, nfarn); asm volatile("s_waitcnt vmcnt(8)" ::: "memory"); }
            else asm volatile("s_waitcnt vmcnt(0)" ::: "memory");
            const LAS unsigned char* kb_ = kvb + bi * 8192;
            f32x4 S[2];
#pragma unroll
            for (int T = 0; T < 2; ++T) { f32x4 a4 = {0.f, 0.f, 0.f, 0.f};
#pragma unroll
                for (int s_ = 0; s_ < 4; ++s_) { const s16x8 a = *(const LAS s16x8*)(kb_ + qk_off + 4096 * T + 64 * ((unsigned)s_ ^ qk_sx)); a4 = __builtin_amdgcn_mfma_f32_16x16x32_bf16(a, qf[s_], a4, 0, 0, 0); }
                S[T] = a4; }
            if (ch < nfar) {
#pragma unroll
                for (int T = 0; T < 2; ++T)
#pragma unroll
                    for (int r_ = 0; r_ < 4; ++r_) S[T][r_] = S[T][r_] + (bfar - Mref);
            } else
#pragma unroll
            for (int T = 0; T < 2; ++T) { const v2u d4 = *(const LAS v2u*)(wsb + 1024 + bi * 64 + 2 * (16 * T + grow));
#pragma unroll
                for (int r_ = 0; r_ < 4; ++r_) { const unsigned dw = r_ < 2 ? d4.x : d4.y; const unsigned dd = (r_ & 1) ? (dw >> 16) : (dw & 0xffffu);
                    const float bsv = biasL[(dd > 128u ? 128u : dd) * 8 + (l15 & 7)]; S[T][r_] = (dd == 255u) ? -INFINITY : S[T][r_] + (bsv - Mref); } }
#pragma unroll
            for (int T = 0; T < 2; ++T)
#pragma unroll
                for (int r_ = 0; r_ < 4; ++r_) { const float pv = __expf(S[T][r_]); S[T][r_] = pv; l_run += pv; }
            s16x8 P;
            { const unsigned p0 = cvt_pk(S[0][0], S[0][1]), p1 = cvt_pk(S[0][2], S[0][3]), p2 = cvt_pk(S[1][0], S[1][1]), p3 = cvt_pk(S[1][2], S[1][3]);
              const v4u pw_ = {p0, p1, p2, p3}; P = __builtin_bit_cast(s16x8, pw_); }
            { const unsigned kba = (unsigned)(size_t)kb_; s16x4 ta[8], tb[8];
#pragma unroll
              for (int m = 0; m < 8; ++m) { const unsigned ad = kba + trm[m];
                  asm volatile("ds_read_b64_tr_b16 %0, %1" : "=v"(ta[m]) : "v"(ad) : "memory"); asm volatile("ds_read_b64_tr_b16 %0, %1 offset:4096" : "=v"(tb[m]) : "v"(ad) : "memory"); }
              asm volatile("s_waitcnt lgkmcnt(8)" ::: "memory"); __builtin_amdgcn_sched_barrier(0);
#pragma unroll
              for (int m = 0; m < 4; ++m) O[m] = __builtin_amdgcn_mfma_f32_16x16x32_bf16(__builtin_shufflevector(ta[m], tb[m], 0, 1, 2, 3, 4, 5, 6, 7), P, O[m], 0, 0, 0);
              asm volatile("s_waitcnt lgkmcnt(0)" ::: "memory"); __builtin_amdgcn_sched_barrier(0);
#pragma unroll
              for (int m = 4; m < 8; ++m) O[m] = __builtin_amdgcn_mfma_f32_16x16x32_bf16(__builtin_shufflevector(ta[m], tb[m], 0, 1, 2, 3, 4, 5, 6, 7), P, O[m], 0, 0, 0); }
        }
        l_run = x16_sum(l_run); l_run = x32_sum(l_run);
        const float inv = 1.0f / fmaxf(l_run, 1e-37f);
        { LAS unsigned char* stg = kvb + ((b0 + nch - 1) & 1) * 8192;
          if (l15 < 8) {
#pragma unroll
              for (int m = 0; m < 8; ++m) *(LAS v2u*)(stg + (l15 * 128 + 16 * m + 4 * g4) * 2) = (v2u){cvt_pk(O[m][0] * inv, O[m][1] * inv), cvt_pk(O[m][2] * inv, O[m][3] * inv)}; }
          asm volatile("s_waitcnt lgkmcnt(0)" ::: "memory");
          const v4u oa = *(const LAS v4u*)(stg + lane * 16), ob = *(const LAS v4u*)(stg + 1024 + lane * 16);
          bf16* op = (bf16*)(c.ws + WS_XB) + (size_t)n * 1024 + lane * 8;
          *(v4u*)op = oa; *(v4u*)(op + 512) = ob; }
        b0 = (b0 + nch) & 1; sl ^= 1; t = tn; cnt = cntn; nch = nchn; nfar = nfarn; Mref = Mrefn; n = nn;
#pragma unroll
        for (int s_ = 0; s_ < 4; ++s_) qf[s_] = qfn[s_];
    }
#undef DSA_QIDX
#undef DSA_LOADQ
#undef DSA_PREP
#undef DSA_ISSUE
    asm volatile("s_waitcnt vmcnt(0) lgkmcnt(0)" ::: "memory");
    if (wv >= 4) for (int eit = gw; eit < P0_EXPERT_ITEMS; eit += NGW) p0_expert_item(c, (LAS float*)kvb, eit);
    __syncthreads();
}

__device__ __forceinline__ void p3b_swa(const Ctx& c) {
    const int lane = c.lane, wv = c.wave, l15 = lane & 15, g4 = lane >> 4, g = wv & 3, hq = wv >> 2;
    LAS float* biasL = (LAS float*)(c.lds + DSA_BIAS_OFF);
    __syncthreads();
    for (int i = c.tid; i < 128 * 8; i += NTHR) biasL[i] = ((const float*)(c.ws + WS_BIAS) + 129 * 8)[i];
    __syncthreads();
    const unsigned kr_off = (unsigned)(128 * l15), kr_x = (unsigned)(l15 & 7);
    const int vrow = 4 * g4 + (l15 >> 2); const unsigned vr_x = (unsigned)(vrow & 7), vp1 = (unsigned)((lane & 3) >> 1);
    const unsigned vr_off = (unsigned)(128 * vrow + 8 * (lane & 1));
    for (int unit = c.bid; unit < 256; unit += c.G) {
        const int b = unit >> 5, qb = (unit >> 1) & 15, kvh = unit & 1, head = kvh * 4 + g;
        __syncthreads();
#pragma unroll
        for (int j = 0; j < 4; ++j) { const int piece = wv * 4 + j, row = 8 * piece + (lane >> 3), chunk = (lane & 7) ^ (row & 7); int key = (qb - 1) * 128 + row; key = key < 0 ? 0 : key;
            const size_t so = ((size_t)(b * SEQ + key) * 128 + kvh * 64 + chunk * 8);
            __builtin_amdgcn_global_load_lds((const unsigned*)((const bf16*)(c.ws + WS_KB) + so), (LAS unsigned*)(c.lds + piece * 1024), 16, 0, 0);
            __builtin_amdgcn_global_load_lds((const unsigned*)((const bf16*)(c.ws + WS_VB) + so), (LAS unsigned*)(c.lds + 32768 + piece * 1024), 16, 0, 0); }
        float bt[9][4];
#pragma unroll
        for (int ta = 0; ta < 9; ++ta)
#pragma unroll
            for (int r_ = 0; r_ < 4; ++r_) { const int dist = 128 + l15 - 16 * ta - 4 * g4 - r_; bt[ta][r_] = (dist >= 0 && dist < 128) ? biasL[dist * 8 + head] : -INFINITY; }
        const float sink = c.sinks[head];
        asm volatile("s_waitcnt vmcnt(0)" ::: "memory");
        __syncthreads();
#pragma unroll 1
        for (int jj = 0; jj < 4; ++jj) {
            const int j = 4 * hq + jj; const size_t nrow = (size_t)(b * SEQ + qb * 128 + 16 * j + l15);
            bf16* qrow = (bf16*)(c.ws + WS_QB) + nrow * 512 + head * 64;
            const s16x8 q0 = *(const s16x8*)(qrow + 8 * g4), q1 = *(const s16x8*)(qrow + 32 + 8 * g4);
            f32x4 S[9]; float mx = sink;
#pragma unroll
            for (int ta = 0; ta < 9; ++ta) { const int kt = j + ta; const LAS unsigned char* kp = c.lds + kr_off + 2048 * kt;
                f32x4 a4 = {0.f, 0.f, 0.f, 0.f};
                a4 = __builtin_amdgcn_mfma_f32_16x16x32_bf16(*(const LAS s16x8*)(kp + 16 * ((unsigned)g4 ^ kr_x)), q0, a4, 0, 0, 0);
                a4 = __builtin_amdgcn_mfma_f32_16x16x32_bf16(*(const LAS s16x8*)(kp + 16 * ((unsigned)(4 + g4) ^ kr_x)), q1, a4, 0, 0, 0);
                const bool dead = (qb == 0 && kt < 8);
#pragma unroll
                for (int r_ = 0; r_ < 4; ++r_) { const float sv = dead ? -INFINITY : a4[r_] + bt[ta][r_]; a4[r_] = sv; mx = fmaxf(mx, sv); }
                S[ta] = a4; }
            mx = x16_max(mx); mx = x32_max(mx);
            float ps = 0.f;
#pragma unroll
            for (int ta = 0; ta < 9; ++ta)
#pragma unroll
                for (int r_ = 0; r_ < 4; ++r_) { const float pv = __expf(S[ta][r_] - mx); S[ta][r_] = pv; ps += pv; }
            ps = x16_sum(ps); ps = x32_sum(ps);
            const float inv = 1.0f / (ps + __expf(sink - mx));
            f32x4 O[4];
#pragma unroll
            for (int m = 0; m < 4; ++m) O[m] = (f32x4){0.f, 0.f, 0.f, 0.f};
#pragma unroll
            for (int pp = 0; pp < 5; ++pp) {
                const int ta = 2 * pp, tb = 2 * pp + 1;
                v4u pw_; pw_.x = cvt_pk(S[ta][0] * inv, S[ta][1] * inv); pw_.y = cvt_pk(S[ta][2] * inv, S[ta][3] * inv);
                if (tb < 9) { pw_.z = cvt_pk(S[tb < 9 ? tb : 0][0] * inv, S[tb < 9 ? tb : 0][1] * inv); pw_.w = cvt_pk(S[tb < 9 ? tb : 0][2] * inv, S[tb < 9 ? tb : 0][3] * inv); } else { pw_.z = 0u; pw_.w = 0u; }
                const s16x8 P = __builtin_bit_cast(s16x8, pw_);
                const LAS unsigned char* va = c.lds + 32768 + vr_off + 2048 * (j + ta); const LAS unsigned char* vb_ = c.lds + 32768 + vr_off + 2048 * (j + (tb < 9 ? tb : ta));
#pragma unroll
                for (int m = 0; m < 4; ++m) { const unsigned co = 16u * ((unsigned)(2 * m + vp1) ^ vr_x);
                    const s16x4 a0 = __builtin_amdgcn_ds_read_tr16_b64_v4i16((LAS s16x4*)(va + co)), a1 = __builtin_amdgcn_ds_read_tr16_b64_v4i16((LAS s16x4*)(vb_ + co));
                    O[m] = __builtin_amdgcn_mfma_f32_16x16x32_bf16(__builtin_shufflevector(a0, a1, 0, 1, 2, 3, 4, 5, 6, 7), P, O[m], 0, 0, 0); }
            }
#pragma unroll
            for (int m = 0; m < 4; ++m) *(v2u*)(qrow + 16 * m + 4 * g4) = (v2u){cvt_pk(O[m][0], O[m][1]), cvt_pk(O[m][2], O[m][3])};
        }
    }
    __syncthreads();
}

__device__ __forceinline__ void p6_ln_router(const Ctx& c, bf16* x1b) {
    const int lane = c.lane, wv = c.wave, l15 = lane & 15, g4 = lane >> 4;
    LAS unsigned char* XH = c.lds; LAS unsigned char* XL = c.lds + 32768;
    LAS float* PL = (LAS float*)(c.lds + 65536);
    LAS float* LG = (LAS float*)(c.lds + 65536 + 24576);
    const bf16* WH = (const bf16*)(c.ws + WS_WRT); const bf16* WL = WH + 48 * 1024;
    LAS unsigned* PEX = (LAS unsigned*)(c.lds + 65536 + 24576 + 12288);
    LAS unsigned* EB = PEX + 128;
    LAS int* TOKN = (LAS int*)(EB + 32);
    int nbase = 0;
    s16x8 wbh[4][3], wbl[4][3];
#pragma unroll
    for (int s_ = 0; s_ < 4; ++s_)
#pragma unroll
        for (int nt = 0; nt < 3; ++nt) { const size_t wo = (size_t)(16 * nt + l15) * 1024 + 128 * wv + 32 * s_ + 8 * g4; wbh[s_][nt] = *(const s16x8*)(WH + wo); wbl[s_][nt] = *(const s16x8*)(WL + wo); }
    f32x4 vn[2][4];
    if (c.bid < NTOK / 16) {
#pragma unroll
        for (int q = 0; q < 2; ++q)
#pragma unroll
            for (int j = 0; j < 4; ++j) vn[q][j] = ((const f32x4*)(c.out + (size_t)(c.bid * 16 + 2 * wv + q) * D) + lane)[64 * j]; }
    for (int u = c.bid; u < NTOK / 16; u += c.G) {
        __syncthreads();
#pragma unroll
        for (int q = 0; q < 2; ++q) { const int tk = 2 * wv + q, n = u * 16 + tk;
            f32x4 v[4]; float s = 0.f;
#pragma unroll
            for (int j = 0; j < 4; ++j) { v[j] = vn[q][j]; s += (v[j].x + v[j].y) + (v[j].z + v[j].w); }
            const float mean = wave_sum(s) * (1.f / D); float s2 = 0.f;
#pragma unroll
            for (int j = 0; j < 4; ++j) { v[j] = v[j] - mean; s2 += (v[j].x * v[j].x + v[j].y * v[j].y) + (v[j].z * v[j].z + v[j].w * v[j].w); }
            const float rstd = 1.f / sqrtf(wave_sum(s2) * (1.f / D) + LN_EPS);
#pragma unroll
            for (int j = 0; j < 4; ++j) { const int k0 = 4 * lane + 256 * j;
                const f32x4 g = *(const f32x4*)(c.ln1_g + k0), bb = *(const f32x4*)(c.ln1_b + k0);
                const f32x4 y = v[j] * rstd * g + bb;
                const unsigned h01 = pk2(y.x, y.y), h23 = pk2(y.z, y.w);
                *(v2u*)(x1b + (size_t)n * D + k0) = (v2u){h01, h23};
                const unsigned l01 = pk2(y.x - bflo(h01), y.y - bfhi(h01)), l23 = pk2(y.z - bflo(h23), y.w - bfhi(h23));
                const unsigned off = (unsigned)(tk * 2048 + ((((lane >> 1) + 32 * j) ^ tk) << 4) + 8 * (lane & 1));
                *(LAS v2u*)(XH + off) = (v2u){h01, h23}; *(LAS v2u*)(XL + off) = (v2u){l01, l23}; } }
        if (u + c.G < NTOK / 16) {
#pragma unroll
            for (int q = 0; q < 2; ++q)
#pragma unroll
                for (int j = 0; j < 4; ++j) vn[q][j] = ((const f32x4*)(c.out + (size_t)((u + c.G) * 16 + 2 * wv + q) * D) + lane)[64 * j]; }
        __syncthreads();
        { f32x4 acc[3];
#pragma unroll
          for (int nt = 0; nt < 3; ++nt) acc[nt] = (f32x4){0.f, 0.f, 0.f, 0.f};
#pragma unroll
          for (int s_ = 0; s_ < 4; ++s_) { const int chunk = 4 * (4 * wv + s_) + g4; const unsigned off = (unsigned)(l15 * 2048 + ((chunk ^ l15) << 4));
              const s16x8 ah = *(const LAS s16x8*)(XH + off), al = *(const LAS s16x8*)(XL + off);
#pragma unroll
              for (int nt = 0; nt < 3; ++nt) { const s16x8 bh = wbh[s_][nt], bl = wbl[s_][nt];
                  acc[nt] = __builtin_amdgcn_mfma_f32_16x16x32_bf16(al, bl, acc[nt], 0, 0, 0); acc[nt] = __builtin_amdgcn_mfma_f32_16x16x32_bf16(al, bh, acc[nt], 0, 0, 0);
                  acc[nt] = __builtin_amdgcn_mfma_f32_16x16x32_bf16(ah, bl, acc[nt], 0, 0, 0); acc[nt] = __builtin_amdgcn_mfma_f32_16x16x32_bf16(ah, bh, acc[nt], 0, 0, 0); } }
#pragma unroll
          for (int nt = 0; nt < 3; ++nt)
#pragma unroll
              for (int r_ = 0; r_ < 4; ++r_) PL[(wv * 16 + 4 * g4 + r_) * 48 + 16 * nt + l15] = acc[nt][r_]; }
        __syncthreads();
        const int ub = nbase >> 5;
        for (int i = c.tid; i < 16 * 48; i += NTHR) { float a = 0.f;
#pragma unroll
            for (int w = 0; w < 8; ++w) a += PL[w * 768 + i];
            const int o = i % 48; a += o < 32 ? c.b_router[o] : (o < 36 ? c.b_group[o - 32] : 0.f);
            LG[ub * 768 + i] = a; }
        if (c.tid < 16) TOKN[ub * 16 + c.tid] = u * 16 + c.tid;
        nbase += 32;
        if (nbase == 128 || u + c.G >= NTOK / 16) {
            __syncthreads();
            if (c.tid < (nbase >> 1)) { const int n = TOKN[c.tid]; const LAS float* lg = LG + c.tid * 48; const int nloc = 2 * c.tid;
                int gs = 0; float gm = lg[32];
                for (int o = 1; o < 4; ++o) { const float v = lg[32 + o]; if (v > gm) { gm = v; gs = o; } }
                float gsum = 0.f;
                for (int o = 0; o < 4; ++o) gsum += __expf(lg[32 + o] - gm);
                const float gw_ = 1.0f / gsum;
                int i1 = 0; float m1 = lg[gs * 8];
                for (int o = 1; o < 8; ++o) { const float v = lg[gs * 8 + o]; if (v > m1) { m1 = v; i1 = o; } }
                int i2 = -1; float m2 = -INFINITY;
                for (int o = 0; o < 8; ++o) { const float v = lg[gs * 8 + o]; if (o != i1 && v > m2) { m2 = v; i2 = o; } }
                const float e2 = __expf(m2 - m1), w1 = gw_ / (1.0f + e2), w2 = gw_ * e2 / (1.0f + e2);
                const int ex1 = gs * 8 + i1, ex2 = gs * 8 + i2;
                ((unsigned*)(c.ws + WS_PE))[2 * n] = ex1; ((unsigned*)(c.ws + WS_PE))[2 * n + 1] = ex2; ((float*)(c.ws + WS_PW))[2 * n] = w1; ((float*)(c.ws + WS_PW))[2 * n + 1] = w2;
                PEX[nloc] = (unsigned)ex1 | ((unsigned)(2 * n) << 8); PEX[nloc + 1] = (unsigned)ex2 | ((unsigned)(2 * n + 1) << 8); }
            __syncthreads();
            if (c.tid < 32) { unsigned cntE = 0; for (int j = 0; j < nbase; ++j) cntE += ((PEX[j] & 0xffu) == (unsigned)c.tid) ? 1u : 0u;
                EB[c.tid] = cntE ? atomicAdd(c.ctl + CW_CNT + c.tid, cntE) : 0u; }
            __syncthreads();
            if (c.tid < nbase) { const unsigned rec = PEX[c.tid], e = rec & 0xffu; unsigned rk = 0; for (int j = 0; j < c.tid; ++j) rk += ((PEX[j] & 0xffu) == e) ? 1u : 0u;
                ((unsigned*)(c.ws + WS_LIST))[(size_t)e * 32768 + EB[e] + rk] = rec >> 8; }
            nbase = 0;
        }
    }
    __syncthreads();
}


__device__ __forceinline__ void p9_ln2(const Ctx& c) {
    const int gw = c.bid * NWAVES + c.wave, NGW = c.G * NWAVES;
    f32x4 vn[4]; v2u san[4], sbn[4];
#define P9_LOAD(n_) do { const f32x4* r_ = (const f32x4*)(c.out + (size_t)(n_) * D) + c.lane; \
        _Pragma("unroll") for (int j = 0; j < 4; ++j) { const int k0 = 4 * c.lane + 256 * j; vn[j] = r_[64 * j]; \
            san[j] = *(const v2u*)((const bf16*)(c.ws + WS_SLOT) + (size_t)(2 * (n_)) * D + k0); sbn[j] = *(const v2u*)((const bf16*)(c.ws + WS_SLOT) + (size_t)(2 * (n_) + 1) * D + k0); } } while (0)
    if (gw < NTOK) P9_LOAD(gw);
    for (int n = gw; n < NTOK; n += NGW) {
        f32x4* row = (f32x4*)(c.out + (size_t)n * D) + c.lane;
        f32x4 v[4]; v2u sa[4], sb[4]; float s = 0.f;
#pragma unroll
        for (int j = 0; j < 4; ++j) { v[j] = vn[j]; sa[j] = san[j]; sb[j] = sbn[j]; s += (v[j].x + v[j].y) + (v[j].z + v[j].w); }
        if (n + NGW < NTOK) P9_LOAD(n + NGW);
        const float mean1 = wave_sum(s) * (1.f / D); float q1 = 0.f;
#pragma unroll
        for (int j = 0; j < 4; ++j) { v[j] = v[j] - mean1; q1 += (v[j].x * v[j].x + v[j].y * v[j].y) + (v[j].z * v[j].z + v[j].w * v[j].w); }
        const float rstd1 = 1.f / sqrtf(wave_sum(q1) * (1.f / D) + LN_EPS);
        s = 0.f;
#pragma unroll
        for (int j = 0; j < 4; ++j) { const int k0 = 4 * c.lane + 256 * j; const f32x4 g = *(const f32x4*)(c.ln1_g + k0), bb = *(const f32x4*)(c.ln1_b + k0);
            f32x4 y = (v[j] * rstd1 * g + bb) * ALPHA; y.x += bflo(sa[j].x) + bflo(sb[j].x); y.y += bfhi(sa[j].x) + bfhi(sb[j].x); y.z += bflo(sa[j].y) + bflo(sb[j].y); y.w += bfhi(sa[j].y) + bfhi(sb[j].y);
            v[j] = y; s += (y.x + y.y) + (y.z + y.w); }
        const float mean = wave_sum(s) * (1.f / D); float s2 = 0.f;
#pragma unroll
        for (int j = 0; j < 4; ++j) { v[j] = v[j] - mean; s2 += (v[j].x * v[j].x + v[j].y * v[j].y) + (v[j].z * v[j].z + v[j].w * v[j].w); }
        const float rstd = 1.f / sqrtf(wave_sum(s2) * (1.f / D) + LN_EPS);
#pragma unroll
        for (int j = 0; j < 4; ++j) { const int k0 = 4 * c.lane + 256 * j; const f32x4 g = *(const f32x4*)(c.ln2_g + k0), bb = *(const f32x4*)(c.ln2_b + k0); row[64 * j] = v[j] * rstd * g + bb; }
    }
#undef P9_LOAD
}

namespace pg8 {
typedef short bf16x8 __attribute__((ext_vector_type(8)));
constexpr int BM = 256, BK = 64, HALF = 128, HTB = HALF * BK * 2, STAGE_BYTES = 8 * HTB, NXCD = 8, WGM = 8;
__host__ __device__ __forceinline__ int lds_byte(int r, int c) { const int st = (r >> 4) * 2 + (c >> 5), rr = r & 15, cc = c & 31, ob = rr * 64 + cc * 2; return st * 1024 + (ob ^ (((ob >> 9) & 1) << 5)); }
__host__ __device__ __forceinline__ void stage_rc(int b, int& R, int& C) { const int st = b / 1024, sb = b % 1024, swz = sb ^ (((sb >> 9) & 1) << 5); R = (st >> 1) * 16 + swz / 64; C = (st & 1) * 32 + (swz % 64) / 2; }
__host__ __device__ __forceinline__ int perm32(int rho) { const int n = rho >> 4, i = rho & 15; return 8 * (i >> 2) + 4 * n + (i & 3); }
__device__ __forceinline__ unsigned cvt_pk_bf16(float lo, float hi) { unsigned r; asm volatile("v_cvt_pk_bf16_f32 %0, %1, %2" : "=v"(r) : "v"(lo), "v"(hi)); return r; }

struct Unit { int pm, pn, pb, aux; };

struct StaticOrder {
    int nM, nN, nwg, G, c;
    __device__ void init(int M, int N, int G_, int c_) { nM = M / BM; nN = N / BM; nwg = nM * nN; G = G_; c = c_; }
    __device__ bool next(int i, Unit& u) const {
        const long L = (long)i * G + c; if (L >= nwg) return false;
        int wgid = (int)L; { const int q = nwg / NXCD, r = nwg % NXCD, xcd = wgid % NXCD, off = wgid / NXCD; wgid = (xcd < r ? xcd * (q + 1) : r * (q + 1) + (xcd - r) * q) + off; }
        const int nig = WGM * nN, gid = wgid / nig, fm = gid * WGM, gsz = (nM - fm) < WGM ? (nM - fm) : WGM;
        u.pm = fm + ((wgid % nig) % gsz); u.pn = (wgid % nig) / gsz; u.pb = u.pn; u.aux = 0; return true;
    }
    __device__ __forceinline__ void a_ready(const Unit&) const {}
    __device__ __forceinline__ void done(const Unit&) const {}
};
struct DenseProb {
    static constexpr bool GATHER = false;
    const bf16* A; const bf16* Bt; int K;
    __device__ __forceinline__ const char* a_base(const Unit& u) const { return (const char*)A + (size_t)u.pm * 256 * K * 2; }
    __device__ __forceinline__ const char* b_base(const Unit& u) const { return (const char*)Bt + (size_t)u.pb * 256 * K * 2; }
    __device__ __forceinline__ void a_offs(const Unit&, int R0, int C0, int R1, int C1, unsigned (&o)[2][2]) const {
        o[0][0] = (unsigned)(R0 * K + C0) * 2u; o[0][1] = (unsigned)(R1 * K + C1) * 2u; o[1][0] = o[0][0] + (unsigned)(HALF * K * 2); o[1][1] = o[0][1] + (unsigned)(HALF * K * 2); }
};

template <class Prob, class Epi, class Sched>
__device__ __forceinline__ void gemm_phase(LAS unsigned char* lds, const Prob& P, const Sched& S, const Epi& E) {
    const int tid = threadIdx.x, wid = __builtin_amdgcn_readfirstlane(tid >> 6), lane = tid & 63, wr = wid >> 2, wc = wid & 3, fr = lane & 15, fq = lane >> 4;
    const int K = P.K, nt = K / BK;
    int sR[2], sC[2];
    unsigned offB[2][2], offA[2][2];
#pragma unroll
    for (int i = 0; i < 2; ++i) { stage_rc(tid * 16 + i * 8192, sR[i], sC[i]); const int Rb = Epi::PERM ? ((sR[i] & ~31) + perm32(sR[i] & 31)) : sR[i];
        offB[0][i] = (unsigned)(Rb * K + sC[i]) * 2u; offB[1][i] = offB[0][i] + (unsigned)(HALF * K * 2); }
    const size_t kstep = (size_t)(BK * 2);
    const unsigned ldsw = (unsigned)wid * 1024u;
    const int aoff = lds_byte(wr * 64 + fr, fq * 8), boff = lds_byte(wc * 32 + fr, fq * 8);
#define PG8_SA(b, h) (((b) * 2 + (h)) * HTB)
#define PG8_SB(b, h) ((4 + (b) * 2 + (h)) * HTB)
#define PG8_STAGE(bufoff, gbase, offs) do { _Pragma("unroll") for (int _i = 0; _i < 2; ++_i) \
        __builtin_amdgcn_global_load_lds((const unsigned*)((gbase) + (offs)[_i]), (LAS unsigned*)(lds + (bufoff) + ldsw + _i * 8192), 16, 0, 0); } while (0)
#define PG8_STA(b, h, tau) PG8_STAGE(PG8_SA(b, h), sA + (size_t)(tau) * kstep, offA[h])
#define PG8_STB(b, h, tau) PG8_STAGE(PG8_SB(b, h), sB + (size_t)(tau) * kstep, offB[h])
#define PG8_LDA(dst, b, h) do { _Pragma("unroll") for (int m = 0; m < 4; ++m) _Pragma("unroll") for (int k = 0; k < 2; ++k) dst[m][k] = *(const LAS bf16x8*)(lds + PG8_SA(b, h) + aoff + m * 2048 + k * 1024); } while (0)
#define PG8_LDB(dst, b, h) do { _Pragma("unroll") for (int n = 0; n < 2; ++n) _Pragma("unroll") for (int k = 0; k < 2; ++k) dst[n][k] = *(const LAS bf16x8*)(lds + PG8_SB(b, h) + boff + n * 2048 + k * 1024); } while (0)
#define PG8_MMA(ai, bj, At, Bt) do { __builtin_amdgcn_s_setprio(1); _Pragma("unroll") for (int m = 0; m < 4; ++m) _Pragma("unroll") for (int n = 0; n < 2; ++n) _Pragma("unroll") for (int k = 0; k < 2; ++k) \
        acc[ai][bj][m][n] = __builtin_amdgcn_mfma_f32_16x16x32_bf16(Bt[n][k], At[m][k], acc[ai][bj][m][n], 0, 0, 0); __builtin_amdgcn_s_setprio(0); } while (0)
#define PG8_WAIT_V(n) asm volatile("s_waitcnt vmcnt(" #n ")" ::: "memory")
#define PG8_WAIT_L(n) asm volatile("s_waitcnt lgkmcnt(" #n ")" ::: "memory")
#define PG8_BAR __builtin_amdgcn_s_barrier()
#define PG8_SCHED __builtin_amdgcn_sched_barrier(0)
    Unit cur, nxt; int ui = 0;
    if (!S.next(0, cur)) return;
    f32x4 acc[2][2][4][2];
#pragma unroll
    for (int a = 0; a < 2; ++a)
#pragma unroll
        for (int b = 0; b < 2; ++b)
#pragma unroll
            for (int m = 0; m < 4; ++m)
#pragma unroll
                for (int n = 0; n < 2; ++n) acc[a][b][m][n] = (f32x4){0.f, 0.f, 0.f, 0.f};
    bf16x8 At[4][2], B0[2][2], B1[2][2];
    const char* sA = P.a_base(cur); const char* sB = P.b_base(cur);
    S.a_ready(cur);
    P.a_offs(cur, sR[0], sC[0], sR[1], sC[1], offA);
    PG8_STB(0, 0, 0); PG8_STB(0, 1, 0); PG8_STA(0, 0, 0); PG8_STA(0, 1, 0);
    if (wr == 1) PG8_BAR;
    PG8_WAIT_V(2); PG8_BAR;
    PG8_STB(1, 0, 1); PG8_STA(1, 0, 1); PG8_STB(1, 1, 1);
    PG8_WAIT_V(6); PG8_BAR;
    for (;;) {
        const bool has_next = S.next(ui + 1, nxt);
        unsigned nOffA[2][2];
        if (Prob::GATHER) { if (has_next) P.a_offs(nxt, sR[0], sC[0], sR[1], sC[1], nOffA); else {
#pragma unroll
            for (int h = 0; h < 2; ++h)
#pragma unroll
                for (int i = 0; i < 2; ++i) nOffA[h][i] = offA[h][i]; } }
        const char* nA = has_next ? P.a_base(nxt) : sA; const char* nB = has_next ? P.b_base(nxt) : sB;
        for (int t = 0; t < nt; t += 2) {
            const bool last = (t == nt - 2);
            if (last && has_next) S.a_ready(nxt);
            PG8_LDB(B0, 0, 0); PG8_LDB(B1, 0, 1); PG8_SCHED; PG8_LDA(At, 0, 0); PG8_STA(1, 1, t + 1);
            PG8_WAIT_V(8); PG8_WAIT_L(0); PG8_BAR; PG8_MMA(0, 0, At, B0); PG8_MMA(0, 1, At, B1); PG8_BAR; PG8_SCHED;
            if (last) {
                sA = nA - (size_t)nt * kstep; sB = nB - (size_t)nt * kstep;
                if (Prob::GATHER) {
#pragma unroll
                    for (int h = 0; h < 2; ++h)
#pragma unroll
                        for (int i = 0; i < 2; ++i) offA[h][i] = nOffA[h][i]; }
            }
            PG8_LDA(At, 0, 1); PG8_STB(0, 0, t + 2); PG8_STB(0, 1, t + 2); PG8_STA(0, 0, t + 2);
            PG8_WAIT_V(8); PG8_WAIT_L(0); PG8_BAR; PG8_MMA(1, 0, At, B0); PG8_MMA(1, 1, At, B1); PG8_BAR; PG8_SCHED;
            PG8_LDB(B0, 1, 0); PG8_LDB(B1, 1, 1); PG8_SCHED; PG8_LDA(At, 1, 0); PG8_STA(0, 1, t + 2);
            PG8_WAIT_V(8); PG8_WAIT_L(0); PG8_BAR; PG8_MMA(0, 0, At, B0); PG8_MMA(0, 1, At, B1); PG8_BAR; PG8_SCHED;
            PG8_LDA(At, 1, 1); PG8_STB(1, 0, t + 3); PG8_STB(1, 1, t + 3); PG8_STA(1, 0, t + 3);
            PG8_WAIT_V(8); PG8_WAIT_L(0); PG8_BAR; PG8_MMA(1, 0, At, B0); PG8_MMA(1, 1, At, B1); PG8_BAR; PG8_SCHED;
        }
        if (wr == 0) PG8_BAR;
        E(acc, cur, wr, wc, fr, fq); S.done(cur);
        if (!has_next) break;
#pragma unroll
        for (int a = 0; a < 2; ++a)
#pragma unroll
            for (int b = 0; b < 2; ++b)
#pragma unroll
                for (int m = 0; m < 4; ++m)
#pragma unroll
                    for (int n = 0; n < 2; ++n) acc[a][b][m][n] = (f32x4){0.f, 0.f, 0.f, 0.f};
        cur = nxt; ++ui; sA = nA; sB = nB;
        if (wr == 1) PG8_BAR;
    }
    PG8_WAIT_V(0);
    PG8_BAR;
#undef PG8_SA
#undef PG8_SB
#undef PG8_STAGE
#undef PG8_STA
#undef PG8_STB
#undef PG8_LDA
#undef PG8_LDB
#undef PG8_MMA
#undef PG8_WAIT_V
#undef PG8_WAIT_L
#undef PG8_BAR
#undef PG8_SCHED
}

template <class Epi, class Sched>
__device__ __forceinline__ void gemm_phase_dual(LAS unsigned char* lds, const bf16* A1, const bf16* Bt1, int K1, const bf16* A2, const bf16* Bt2, int K2, const Sched& S, const Epi& E) {
    const int tid = threadIdx.x, wid = __builtin_amdgcn_readfirstlane(tid >> 6), lane = tid & 63, wr = wid >> 2, wc = wid & 3, fr = lane & 15, fq = lane >> 4;
    const int nt1 = K1 / BK, nt = (K1 + K2) / BK;
    unsigned offB1[2][2], offA1[2][2]; const unsigned dK2 = (unsigned)(2 * (K2 - K1));
#pragma unroll
    for (int i = 0; i < 2; ++i) { int R, C; stage_rc(tid * 16 + i * 8192, R, C); const int Rb = (R & ~31) + perm32(R & 31);
        offA1[0][i] = (unsigned)(R * K1 + C) * 2u; offA1[1][i] = offA1[0][i] + (unsigned)(HALF * K1 * 2); offB1[0][i] = (unsigned)(Rb * K1 + C) * 2u; offB1[1][i] = offB1[0][i] + (unsigned)(HALF * K1 * 2); }
    const size_t kstep = (size_t)(BK * 2);
    const unsigned ldsw = (unsigned)wid * 1024u;
    const int aoff = lds_byte(wr * 64 + fr, fq * 8), boff = lds_byte(wc * 32 + fr, fq * 8);
#define PG8_SA(b, h) (((b) * 2 + (h)) * HTB)
#define PG8_SB(b, h) ((4 + (b) * 2 + (h)) * HTB)
#define PG8_STX(bufoff, tau, g1, g2, o1, o2) do { const int _t = (tau); const bool _s2 = _t >= nt1; const long long _d = _s2 ? (long long)((g2) - (g1)) - (long long)nt1 * (long long)kstep : 0ll; const char* _g = (g1) + (size_t)_t * kstep + _d; \
        _Pragma("unroll") for (int _i = 0; _i < 2; ++_i) { const unsigned _o = (o1)[_i] + (_s2 ? ((o1)[_i] >> 11) * dK2 : 0u); \
        __builtin_amdgcn_global_load_lds((const unsigned*)(_g + _o), (LAS unsigned*)(lds + (bufoff) + ldsw + _i * 8192), 16, 0, 0); } } while (0)
#define PG8_STA(b, h, tau) PG8_STX(PG8_SA(b, h), tau, sA1, sA2, offA1[h], 0)
#define PG8_STB(b, h, tau) PG8_STX(PG8_SB(b, h), tau, sB1, sB2, offB1[h], 0)
#define PG8_LDA(dst, b, h) do { _Pragma("unroll") for (int m = 0; m < 4; ++m) _Pragma("unroll") for (int k = 0; k < 2; ++k) dst[m][k] = *(const LAS bf16x8*)(lds + PG8_SA(b, h) + aoff + m * 2048 + k * 1024); } while (0)
#define PG8_LDB(dst, b, h) do { _Pragma("unroll") for (int n = 0; n < 2; ++n) _Pragma("unroll") for (int k = 0; k < 2; ++k) dst[n][k] = *(const LAS bf16x8*)(lds + PG8_SB(b, h) + boff + n * 2048 + k * 1024); } while (0)
#define PG8_MMA(ai, bj, At, Bt) do { __builtin_amdgcn_s_setprio(1); _Pragma("unroll") for (int m = 0; m < 4; ++m) _Pragma("unroll") for (int n = 0; n < 2; ++n) _Pragma("unroll") for (int k = 0; k < 2; ++k) \
        acc[ai][bj][m][n] = __builtin_amdgcn_mfma_f32_16x16x32_bf16(Bt[n][k], At[m][k], acc[ai][bj][m][n], 0, 0, 0); __builtin_amdgcn_s_setprio(0); } while (0)
#define PG8_WAIT_V(n) asm volatile("s_waitcnt vmcnt(" #n ")" ::: "memory")
#define PG8_WAIT_L(n) asm volatile("s_waitcnt lgkmcnt(" #n ")" ::: "memory")
#define PG8_BAR __builtin_amdgcn_s_barrier()
#define PG8_SCHED __builtin_amdgcn_sched_barrier(0)
    Unit cur, nxt; int ui = 0;
    if (!S.next(0, cur)) return;
    f32x4 acc[2][2][4][2];
#pragma unroll
    for (int a = 0; a < 2; ++a)
#pragma unroll
        for (int b = 0; b < 2; ++b)
#pragma unroll
            for (int m = 0; m < 4; ++m)
#pragma unroll
                for (int n = 0; n < 2; ++n) acc[a][b][m][n] = (f32x4){0.f, 0.f, 0.f, 0.f};
    bf16x8 At[4][2], B0[2][2], B1[2][2];
    const char* sA1 = (const char*)A1 + (size_t)cur.pm * 256 * K1 * 2; const char* sB1 = (const char*)Bt1 + (size_t)cur.pn * 256 * K1 * 2;
    const char* sA2 = (const char*)A2 + (size_t)cur.pm * 256 * K2 * 2; const char* sB2 = (const char*)Bt2 + (size_t)cur.pn * 256 * K2 * 2;
    PG8_STB(0, 0, 0); PG8_STB(0, 1, 0); PG8_STA(0, 0, 0); PG8_STA(0, 1, 0);
    if (wr == 1) PG8_BAR;
    PG8_WAIT_V(2); PG8_BAR;
    PG8_STB(1, 0, 1); PG8_STA(1, 0, 1); PG8_STB(1, 1, 1);
    PG8_WAIT_V(6); PG8_BAR;
    for (;;) {
        const bool has_next = S.next(ui + 1, nxt);
        const int npm = has_next ? nxt.pm : cur.pm, npn = has_next ? nxt.pn : cur.pn;
        const char* nA1 = (const char*)A1 + (size_t)npm * 256 * K1 * 2; const char* nB1 = (const char*)Bt1 + (size_t)npn * 256 * K1 * 2;
        const char* nA2 = (const char*)A2 + (size_t)npm * 256 * K2 * 2; const char* nB2 = (const char*)Bt2 + (size_t)npn * 256 * K2 * 2;
        for (int t = 0; t < nt; t += 2) {
            const bool last = (t == nt - 2);
            const int t2 = last ? 0 : t + 2, t3 = last ? 1 : t + 3;
            if (t == nt1) { E.mid(acc, cur, wr, wc, fr, fq); PG8_SCHED; }
            PG8_LDB(B0, 0, 0); PG8_LDB(B1, 0, 1); PG8_SCHED; PG8_LDA(At, 0, 0); PG8_STA(1, 1, t + 1);
            PG8_WAIT_V(8); PG8_WAIT_L(0); PG8_BAR; PG8_MMA(0, 0, At, B0); PG8_MMA(0, 1, At, B1); PG8_BAR; PG8_SCHED;
            if (last) { sA1 = nA1; sB1 = nB1; sA2 = nA2; sB2 = nB2; }
            PG8_LDA(At, 0, 1); PG8_STB(0, 0, t2); PG8_STB(0, 1, t2); PG8_STA(0, 0, t2);
            PG8_WAIT_V(8); PG8_WAIT_L(0); PG8_BAR; PG8_MMA(1, 0, At, B0); PG8_MMA(1, 1, At, B1); PG8_BAR; PG8_SCHED;
            PG8_LDB(B0, 1, 0); PG8_LDB(B1, 1, 1); PG8_SCHED; PG8_LDA(At, 1, 0); PG8_STA(0, 1, t2);
            PG8_WAIT_V(8); PG8_WAIT_L(0); PG8_BAR; PG8_MMA(0, 0, At, B0); PG8_MMA(0, 1, At, B1); PG8_BAR; PG8_SCHED;
            PG8_LDA(At, 1, 1); PG8_STB(1, 0, t3); PG8_STB(1, 1, t3); PG8_STA(1, 0, t3);
            PG8_WAIT_V(8); PG8_WAIT_L(0); PG8_BAR; PG8_MMA(1, 0, At, B0); PG8_MMA(1, 1, At, B1); PG8_BAR; PG8_SCHED;
        }
        if (wr == 0) PG8_BAR;
        E(acc, cur, wr, wc, fr, fq);
        if (!has_next) break;
#pragma unroll
        for (int a = 0; a < 2; ++a)
#pragma unroll
            for (int b = 0; b < 2; ++b)
#pragma unroll
                for (int m = 0; m < 4; ++m)
#pragma unroll
                    for (int n = 0; n < 2; ++n) acc[a][b][m][n] = (f32x4){0.f, 0.f, 0.f, 0.f};
        cur = nxt; ++ui;
        if (wr == 1) PG8_BAR;
    }
    PG8_WAIT_V(0);
    PG8_BAR;
#undef PG8_SA
#undef PG8_SB
#undef PG8_STX
#undef PG8_STA
#undef PG8_STB
#undef PG8_LDA
#undef PG8_LDB
#undef PG8_MMA
#undef PG8_WAIT_V
#undef PG8_WAIT_L
#undef PG8_BAR
#undef PG8_SCHED
}
__device__ __forceinline__ v4u pack8(f32x4 v0, f32x4 v1) { v4u w; w.x = cvt_pk_bf16(v0[0], v0[1]); w.y = cvt_pk_bf16(v0[2], v0[3]); w.z = cvt_pk_bf16(v1[0], v1[1]); w.w = cvt_pk_bf16(v1[2], v1[3]); return w; }
__device__ __forceinline__ float sigm(float v) { return __builtin_amdgcn_rcpf(1.0f + __expf(-v)); }

struct EpiMergedDual {
    static constexpr bool PERM = true;
    const bf16* ga; const bf16* gb; bf16* merged;
    __device__ __forceinline__ void mid(f32x4 (&acc)[2][2][4][2], const Unit& u, int wr, int wc, int fr, int fq) const {
        int row0 = u.pm * BM + wr * 64 + fr; const int col0 = u.pn * BM + wc * 32 + 8 * fq;
        asm volatile("" : "+v"(row0));
#pragma unroll
        for (int ai = 0; ai < 2; ++ai)
#pragma unroll
            for (int m = 0; m < 4; ++m) { const size_t o = (size_t)(row0 + ai * HALF + m * 16) * 1024 + col0;
#pragma unroll
                for (int bj = 0; bj < 2; ++bj) { const v4u a = *(const v4u*)(ga + o + bj * HALF), b = *(const v4u*)(gb + o + bj * HALF);
                    f32x4 r0 = {bflo(a.x) * __builtin_amdgcn_rcpf(bflo(b.x)), bfhi(a.x) * __builtin_amdgcn_rcpf(bfhi(b.x)), bflo(a.y) * __builtin_amdgcn_rcpf(bflo(b.y)), bfhi(a.y) * __builtin_amdgcn_rcpf(bfhi(b.y))};
                    f32x4 r1 = {bflo(a.z) * __builtin_amdgcn_rcpf(bflo(b.z)), bfhi(a.z) * __builtin_amdgcn_rcpf(bfhi(b.z)), bflo(a.w) * __builtin_amdgcn_rcpf(bflo(b.w)), bfhi(a.w) * __builtin_amdgcn_rcpf(bfhi(b.w))};
                    acc[ai][bj][m][0] = acc[ai][bj][m][0] * r0; acc[ai][bj][m][1] = acc[ai][bj][m][1] * r1; }
                asm volatile("" ::: "memory"); }
    }
    __device__ __forceinline__ void operator()(const f32x4 (&acc)[2][2][4][2], const Unit& u, int wr, int wc, int fr, int fq) const {
        int row0 = u.pm * BM + wr * 64 + fr; const int col0 = u.pn * BM + wc * 32 + 8 * fq;
        asm volatile("" : "+v"(row0));
#pragma unroll
        for (int ai = 0; ai < 2; ++ai)
#pragma unroll
            for (int m = 0; m < 4; ++m) { const size_t o = (size_t)(row0 + ai * HALF + m * 16) * 1024 + col0;
#pragma unroll
                for (int bj = 0; bj < 2; ++bj) { const v4u g = *(const v4u*)(gb + o + bj * HALF);
                    f32x4 g0 = {bflo(g.x), bfhi(g.x), bflo(g.y), bfhi(g.y)}, g1 = {bflo(g.z), bfhi(g.z), bflo(g.w), bfhi(g.w)};
                    *(v4u*)(merged + o + bj * HALF) = pack8(g0 * acc[ai][bj][m][0], g1 * acc[ai][bj][m][1]); } }
    }
};
struct EpiProj {
    static constexpr bool PERM = true;
    unsigned char* ws;
    __device__ __forceinline__ void operator()(const f32x4 (&acc)[2][2][4][2], const Unit& u, int wr, int wc, int fr, int fq) const {
        const int row0 = u.pm * BM + wr * 64 + fr, cw = wc * 32 + 8 * fq, pn = u.pn;
        if (pn == 4) {
#pragma unroll
            for (int ai = 0; ai < 2; ++ai)
#pragma unroll
                for (int m = 0; m < 4; ++m) { const size_t row = (size_t)(row0 + ai * HALF + m * 16);
                    float* cr = (float*)(ws + WS_CKVRAW) + row * 128 + cw; *(f32x4*)cr = acc[ai][0][m][0]; *(f32x4*)(cr + 4) = acc[ai][0][m][1];
                    if (cw < 64) *(v4u*)((bf16*)(ws + WS_KIDX) + ((((row >> 4) * 8 + (cw >> 3)) * 16 + (row & 15)) << 3)) = pack8(acc[ai][1][m][0], acc[ai][1][m][1]);
                    else if (cw == 64) { float* wr_ = (float*)(ws + WS_WIDX) + row * 8; *(f32x4*)wr_ = acc[ai][1][m][0] * IDXW_SCALE; *(f32x4*)(wr_ + 4) = acc[ai][1][m][1] * IDXW_SCALE; } }
            return;
        }
        bf16* base; int ld, c0; float sc = 1.f; bool sg = false;
        if (pn < 4) { base = (bf16*)(ws + WS_QLAT); ld = 1024; c0 = pn * 256; sc = ATT_SCALE; }
        else if (pn < 7) { base = (bf16*)(ws + WS_QIDX); ld = 512; c0 = (pn - 5) * 256; }
        else if (pn < 9) { base = (bf16*)(ws + WS_QB); ld = 512; c0 = (pn - 7) * 256; sc = 0.125f; }
        else if (pn == 9) { base = (bf16*)(ws + WS_KB); ld = 128; c0 = 0; }
        else if (pn < 14) { base = (bf16*)(ws + WS_GA); ld = 1024; c0 = (pn - 10) * 256; sg = true; }
        else { base = (bf16*)(ws + WS_GB); ld = 1024; c0 = (pn - 14) * 256; sg = true; }
        const size_t bjstep = (pn == 9) ? (size_t)(WS_VB - WS_KB) / 2 : (size_t)HALF;
#pragma unroll
        for (int ai = 0; ai < 2; ++ai)
#pragma unroll
            for (int m = 0; m < 4; ++m) { bf16* rowp = base + (size_t)(row0 + ai * HALF + m * 16) * ld + c0 + cw;
#pragma unroll
                for (int bj = 0; bj < 2; ++bj) { f32x4 v0 = acc[ai][bj][m][0], v1 = acc[ai][bj][m][1];
                    if (sg) {
#pragma unroll
                        for (int j = 0; j < 4; ++j) { v0[j] = sigm(v0[j]); v1[j] = sigm(v1[j]); } }
                    else { v0 = v0 * sc; v1 = v1 * sc; }
                    *(v4u*)(rowp + bj * bjstep) = pack8(v0, v1); } }
    }
};
struct EpiWoutM {
    static constexpr bool PERM = true;
    const float* x; float* out;
    __device__ __forceinline__ void operator()(const f32x4 (&acc)[2][2][4][2], const Unit& u, int wr, int wc, int fr, int fq) const {
        const int row0 = u.pm * BM + wr * 64 + fr, col0 = u.pn * BM + wc * 32 + 8 * fq;
#pragma unroll
        for (int ai = 0; ai < 2; ++ai)
#pragma unroll
            for (int m = 0; m < 4; ++m) { const size_t o = (size_t)(row0 + ai * HALF + m * 16) * 1024 + col0;
#pragma unroll
                for (int bj = 0; bj < 2; ++bj) { const f32x4 x0 = *(const f32x4*)(x + o + bj * HALF), x1 = *(const f32x4*)(x + o + bj * HALF + 4);
                    *(f32x4*)(out + o + bj * HALF) = x0 * ALPHA + acc[ai][bj][m][0]; *(f32x4*)(out + o + bj * HALF + 4) = x1 * ALPHA + acc[ai][bj][m][1]; } }
    }
};
constexpr int MOE_TB_OFF = 131072 + 1024;
constexpr int CW_RDY = 16384;
constexpr int CW_TMO = 8;
struct MoeOrder {
    const LAS int* tb; int npn, G, c; unsigned* ctl;
    __device__ bool next(int i, Unit& u) const {
        const int L = i * G + c; if (L >= tb[32] * npn) return false;
        const int rt = L / npn, pn = L - rt * npn; int e = 0;
        for (int j = 1; j < 32; ++j) e = (tb[j] <= rt) ? j : e;
        u.pm = rt; u.pn = pn; u.pb = e * npn + pn; u.aux = e; return true;
    }
    __device__ __forceinline__ void a_ready(const Unit&) const {}
    __device__ __forceinline__ void done(const Unit& u) const {
        asm volatile("s_waitcnt vmcnt(0)" ::: "memory");
        if ((threadIdx.x & 63) == 0) __hip_atomic_fetch_add(ctl + CW_RDY + 64 * u.pm, 1u, __ATOMIC_RELAXED, __HIP_MEMORY_SCOPE_AGENT);
    }
};
struct MoeDownOrder {
    const LAS int* tb; int G, c; unsigned* ctl;
    __device__ bool next(int i, Unit& u) const {
        const int nT = tb[32], nD = 4 * nT; int R = 2 * nT - G; R = R < 0 ? 0 : (R > G ? G : R);
        int L;
        if (c >= R) { L = (i < 4) ? i * (G - R) + (c - R) : 4 * (G - R) + (i - 4) * G + c; }
        else { L = 4 * (G - R) + i * G + c; }
        if (L >= nD) return false;
        const int rt = L >> 2, pn = L & 3; int e = 0;
        for (int j = 1; j < 32; ++j) e = (tb[j] <= rt) ? j : e;
        u.pm = rt; u.pn = pn; u.pb = e * 4 + pn; u.aux = e; return true;
    }
    __device__ __forceinline__ void a_ready(const Unit& u) const {
        if (threadIdx.x < 64) {
            unsigned* w = ctl + CW_RDY + 64 * u.pm; unsigned sp = 0;
            while ((unsigned)__builtin_amdgcn_readfirstlane(__hip_atomic_load(w, __ATOMIC_RELAXED, __HIP_MEMORY_SCOPE_AGENT)) < 16u) {
                __builtin_amdgcn_s_sleep(2);
                if ((++sp & 1023u) == 0u) { if (__hip_atomic_load(ctl + CW_TMO, __ATOMIC_RELAXED, __HIP_MEMORY_SCOPE_AGENT) != 0u) break;
                    if (sp > (1u << 22)) { __hip_atomic_store(ctl + CW_TMO, 1u, __ATOMIC_RELAXED, __HIP_MEMORY_SCOPE_AGENT); break; } } }
            __builtin_amdgcn_fence(__ATOMIC_ACQUIRE, "agent");
            asm volatile("s_waitcnt vmcnt(0)" ::: "memory");
        }
        asm volatile("" ::: "memory"); __builtin_amdgcn_s_barrier(); asm volatile("" ::: "memory");
    }
    __device__ __forceinline__ void done(const Unit&) const {}
};
struct GatherProb {
    static constexpr bool GATHER = true;
    const bf16* A; const bf16* Bt; int K; const LAS int* tb; const unsigned* list;
    __device__ __forceinline__ const char* a_base(const Unit&) const { return (const char*)A; }
    __device__ __forceinline__ const char* b_base(const Unit& u) const { return (const char*)Bt + (size_t)u.pb * 256 * K * 2; }
    __device__ __forceinline__ void a_offs(const Unit& u, int R0, int C0, int R1, int C1, unsigned (&o)[2][2]) const {
        const int e = u.aux, lbase = (u.pm - tb[e]) * 256, cnt = tb[64 + e];
        const unsigned* le = list + (size_t)e * 32768;
#pragma unroll
        for (int h = 0; h < 2; ++h) { const int l0 = lbase + h * HALF + R0, l1 = lbase + h * HALF + R1;
            const unsigned t0 = l0 < cnt ? (le[l0] >> 1) : 0u, t1 = l1 < cnt ? (le[l1] >> 1) : 0u;
            o[h][0] = (t0 * (unsigned)K + (unsigned)C0) * 2u; o[h][1] = (t1 * (unsigned)K + (unsigned)C1) * 2u; }
    }
};
struct EpiGU {
    static constexpr bool PERM = true;
    bf16* hbuf;
    __device__ __forceinline__ void operator()(const f32x4 (&acc)[2][2][4][2], const Unit& u, int wr, int wc, int fr, int fq) const {
        const int row0 = u.pm * BM + wr * 64 + fr, col0 = u.pn * HALF + wc * 32 + 8 * fq;
#pragma unroll
        for (int ai = 0; ai < 2; ++ai)
#pragma unroll
            for (int m = 0; m < 4; ++m) { f32x4 h0, h1;
#pragma unroll
                for (int j = 0; j < 4; ++j) { const float g0 = acc[ai][0][m][0][j], g1 = acc[ai][0][m][1][j];
                    h0[j] = g0 * sigm(g0) * acc[ai][1][m][0][j]; h1[j] = g1 * sigm(g1) * acc[ai][1][m][1][j]; }
                { const v4u hv = pack8(h0, h1); bf16* hp = hbuf + (size_t)(row0 + ai * HALF + m * 16) * 256 + col0;
                  asm volatile("global_store_dwordx4 %0, %1, off sc1\n\ts_nop 1" :: "v"(hp), "v"(hv) : "memory"); } }
    }
};
struct EpiDown {
    static constexpr bool PERM = true;
    bf16* slot; const LAS int* tb; const unsigned* list; const float* pw;
    __device__ __forceinline__ void operator()(const f32x4 (&acc)[2][2][4][2], const Unit& u, int wr, int wc, int fr, int fq) const {
        const int e = u.aux, lbase = (u.pm - tb[e]) * 256 + wr * 64 + fr, cnt = tb[64 + e], col0 = u.pn * BM + wc * 32 + 8 * fq;
        const unsigned* le = list + (size_t)e * 32768;
#pragma unroll
        for (int ai = 0; ai < 2; ++ai)
#pragma unroll
            for (int m = 0; m < 4; ++m) { const int l = lbase + ai * HALF + m * 16;
                if (l < cnt) { const unsigned pair = le[l]; const float w = pw[pair]; bf16* rowp = slot + (size_t)pair * 1024 + col0;
#pragma unroll
                    for (int bj = 0; bj < 2; ++bj) *(v4u*)(rowp + bj * HALF) = pack8(acc[ai][bj][m][0] * w, acc[ai][bj][m][1] * w); } }
    }
};
}

struct Args { const float* in[20]; float* out; unsigned char* ws; int ph_lo, ph_hi; };
__global__ void __launch_bounds__(NTHR, 2) fwd_kernel(Args args) {
    extern __shared__ __attribute__((aligned(16))) unsigned char lds_raw[];
    Ctx c;
    c.lds = (LAS unsigned char*)lds_raw;
    c.tid = threadIdx.x; c.lane = c.tid & 63; c.wave = __builtin_amdgcn_readfirstlane(c.tid >> 6); c.bid = blockIdx.x; c.G = gridDim.x;
    c.x = args.in[0]; c.w_in = args.in[1]; c.kv_g = args.in[2]; c.w_uv = args.in[3]; c.w_a = args.in[4]; c.sinks = args.in[5]; c.w_b = args.in[6]; c.w_out = args.in[7]; c.rel_bias = args.in[8];
    c.ln1_g = args.in[9]; c.ln1_b = args.in[10]; c.w_group = args.in[11]; c.b_group = args.in[12]; c.w_router = args.in[13]; c.b_router = args.in[14]; c.w_gate = args.in[15]; c.w_up = args.in[16]; c.w_down = args.in[17];
    c.ln2_g = args.in[18]; c.ln2_b = args.in[19]; c.out = args.out; c.ws = args.ws; unsigned char* ws = args.ws;
    c.ctl = (unsigned*)(ws + WS_CTL);
    volatile LAS unsigned* MISC = (volatile LAS unsigned*)(c.lds + MISC_OFF);
    if (c.tid < 32) MISC[c.tid] = 0u;
    __syncthreads();
    XcdBarrier bar; bar.bar = c.ctl + CW_BAR; bar.x = 0; bar.st = nullptr;
    if (MK_N_LAUNCHES == 1) bar = xcd_barrier_post(c.ctl + CW_BAR, MISC + 8);
    const int lo = args.ph_lo, hi = args.ph_hi;
#define IN(k) (lo <= (k) && (k) < hi)
#define SEAM(k) do { if (IN(k) && IN((k) + 1)) xcd_barrier(bar); } while (0)
    bf16* merged = ((bf16*)(c.ws + WS_QLAT)); bf16* x1b = ((bf16*)(c.ws + WS_XB));

    if (IN(0)) { p0_prologue(c); } SEAM(0);
    if (IN(1)) { pg8::DenseProb P{(const bf16*)(c.ws + WS_XB), (const bf16*)(c.ws + WS_WIN), 1024}; pg8::StaticOrder S; S.init(NTOK, NPROJ, c.G, c.bid); pg8::EpiProj E{c.ws};
        pg8::gemm_phase(c.lds, P, S, E); } SEAM(1);
    if (IN(2)) { p_rmsnorm(c); __syncthreads(); p2_indexer_topk(c); } SEAM(2);
    if (IN(3)) { p3a_dsa(c); p3b_swa(c); } SEAM(3);
    if (IN(4)) { pg8::StaticOrder S; S.init(NTOK, 1024, c.G, c.bid); pg8::EpiMergedDual E{(const bf16*)(c.ws + WS_GA), (const bf16*)(c.ws + WS_GB), merged};
        pg8::gemm_phase_dual(c.lds, (const bf16*)(c.ws + WS_XB), (const bf16*)(c.ws + WS_WC), 1024, (const bf16*)(c.ws + WS_QB), (const bf16*)(c.ws + WS_WB), 512, S, E); } SEAM(4);
    if (IN(5)) { pg8::DenseProb P{(const bf16*)merged, (const bf16*)(c.ws + WS_WO), 1024}; pg8::StaticOrder S; S.init(NTOK, 1024, c.G, c.bid); pg8::EpiWoutM E{c.x, c.out};
        pg8::gemm_phase(c.lds, P, S, E); } SEAM(5);
    if (IN(6)) { p6_ln_router(c, x1b); } SEAM(6);
    LAS int* tb = (LAS int*)(c.lds + pg8::MOE_TB_OFF);
    if (IN(7) || IN(8)) {
        if (c.tid < 32) tb[64 + c.tid] = (int)__hip_atomic_load(c.ctl + CW_CNT + c.tid, __ATOMIC_RELAXED, __HIP_MEMORY_SCOPE_AGENT);
        __syncthreads();
        if (c.tid == 0) { int a = 0; for (int e = 0; e < 32; ++e) { tb[e] = a; a += (tb[64 + e] + 255) >> 8; } tb[32] = a; }
        __syncthreads();
    }
    if (IN(7)) { pg8::GatherProb P{(const bf16*)x1b, (const bf16*)(c.ws + WS_WGU), 1024, tb, (const unsigned*)(c.ws + WS_LIST)}; pg8::MoeOrder S{tb, 2, c.G, c.bid, c.ctl}; pg8::EpiGU E{(bf16*)(c.ws + WS_QLAT)};
        pg8::gemm_phase(c.lds, P, S, E); }
    if (MK_N_LAUNCHES != 1) SEAM(7);
    if (IN(8)) { pg8::DenseProb P{(const bf16*)(c.ws + WS_QLAT), (const bf16*)(c.ws + WS_WD), 256}; pg8::MoeDownOrder S{tb, c.G, c.bid, c.ctl};
        pg8::EpiDown E{(bf16*)(c.ws + WS_SLOT), tb, (const unsigned*)(c.ws + WS_LIST), (const float*)(c.ws + WS_PW)};
        pg8::gemm_phase(c.lds, P, S, E); } SEAM(8);
    if (IN(9)) { p9_ln2(c); }
#undef IN
#undef SEAM
}

extern "C" void kernel_launch(void* const* d_in, const int* in_sizes, int n_in, void* d_out, int out_size, void* d_ws, size_t ws_size, hipStream_t stream) {
    static int grid = 0;
    if (grid == 0) {
        if (n_in != 20 || out_size != NTOK * D || ws_size < WS_END) { fprintf(stderr, "kernel_launch: unexpected shapes (n_in %d out %d ws %zu)\n", n_in, out_size, ws_size); grid = -1; return; }
        int dev = 0, cus = 0, per_cu = 0;
        if (hipGetDevice(&dev) != hipSuccess || hipDeviceGetAttribute(&cus, hipDeviceAttributeMultiprocessorCount, dev) != hipSuccess) { grid = -1; return; }
        if (hipFuncSetAttribute((const void*)fwd_kernel, hipFuncAttributeMaxDynamicSharedMemorySize, LDS_BYTES) != hipSuccess) { fprintf(stderr, "kernel_launch: hipFuncSetAttribute failed\n"); grid = -1; return; }
        if (hipOccupancyMaxActiveBlocksPerMultiprocessor(&per_cu, (const void*)fwd_kernel, NTHR, LDS_BYTES) != hipSuccess || per_cu < 1) { fprintf(stderr, "kernel_launch: occupancy query says %d\n", per_cu); }
        (void)hipGetLastError();
        grid = cus;
    }
    if (grid < 0) return;
    if (hipMemsetAsync((char*)d_ws + WS_CTL, 0, CTL_ZERO_BYTES, stream) != hipSuccess) return;
    Args a{};
    for (int i = 0; i < 20; ++i) a.in[i] = (const float*)d_in[i];
    a.out = (float*)d_out; a.ws = (unsigned char*)d_ws;
    if (MK_N_LAUNCHES == 1) { a.ph_lo = 0; a.ph_hi = NPHASE; hipLaunchKernelGGL(fwd_kernel, dim3(grid), dim3(NTHR), LDS_BYTES, stream, a); }
    else { for (int p = 0; p < NPHASE; ++p) { a.ph_lo = p; a.ph_hi = p + 1; hipLaunchKernelGGL(fwd_kernel, dim3(grid), dim3(NTHR), LDS_BYTES, stream, a); } }
}
```

```cpp
#include <hip/hip_runtime.h>
#include <cstdio>
#include <cstdint>

#ifndef MK_N_LAUNCHES
#define MK_N_LAUNCHES 1
#endif

constexpr int D = 1024, BATCH = 8, SEQ = 2048, NTOK = BATCH * SEQ;
constexpr int A_HEADS = 8, A_LAT = 128, IDX_HEADS = 8, IDX_DIM = 64, KSEL = 256;
constexpr int B_HEADS = 8, B_HD = 64, WINDOW = 128;
constexpr int NEXP = 32, EPG = 8, NGRP = 4, DEXP = 256;
constexpr int IN_WIDTH = 4552, NPROJ = 4608;
constexpr float ALPHA = 1.189207115002721f;
constexpr float LN_EPS = 1e-5f, RMS_EPS = 1e-6f;
constexpr float ATT_SCALE = 0.08838834764831845f;
constexpr float IDXW_SCALE = 0.125f * 0.35355339059327373f;
constexpr int NPHASE = 10;

constexpr size_t MiB = 1u << 20;
constexpr size_t WS_CTL = 0, CTL_ZERO_BYTES = 128 * 1024;
constexpr size_t WS_WIN = 1 * MiB;
constexpr size_t WS_SEL = 1 * MiB;
constexpr size_t WS_WC = 10 * MiB;
constexpr size_t WS_WB = 12 * MiB;
constexpr size_t WS_WO = 13 * MiB;
constexpr size_t WS_WIDX = 15 * MiB;
constexpr size_t WS_BIAS = 16 * MiB;
constexpr size_t WS_PE = 16 * MiB + 64 * 1024;
constexpr size_t WS_PW = 16 * MiB + 256 * 1024;
constexpr size_t WS_WGU = 17 * MiB;
constexpr size_t WS_WD = 49 * MiB;
constexpr size_t WS_XB = 65 * MiB;
constexpr size_t WS_QLAT = 97 * MiB;
constexpr size_t WS_CKV = 129 * MiB;
constexpr size_t WS_KIDX = 133 * MiB;
constexpr size_t WS_QIDX = 135 * MiB;
constexpr size_t WS_QB = 151 * MiB;
constexpr size_t WS_KB = 167 * MiB;
constexpr size_t WS_VB = 171 * MiB;
constexpr size_t WS_GA = 175 * MiB;
constexpr size_t WS_GB = 207 * MiB;
constexpr size_t WS_CKVRAW = 239 * MiB;
constexpr size_t WS_LIST = 247 * MiB;
constexpr size_t WS_SLOT = 129 * MiB;
constexpr size_t WS_END = 252 * MiB;
constexpr int CW_CNT = 64;
constexpr int CW_BAR = 4096;

constexpr int NWAVES = 8, NTHR = 512;
constexpr int LDS_BYTES = 155648;
constexpr int MISC_OFF = 131072 + 320;

#define GAS __attribute__((address_space(1)))
#define LAS __attribute__((address_space(3)))
typedef unsigned short bf16;
typedef unsigned v4u __attribute__((ext_vector_type(4)));
typedef unsigned v2u __attribute__((ext_vector_type(2)));
typedef float f32x4 __attribute__((ext_vector_type(4)));

__device__ __forceinline__ float bf2f(unsigned v) { return __builtin_bit_cast(float, v << 16); }
__device__ __forceinline__ float bflo(unsigned v) { return __builtin_bit_cast(float, v << 16); }
__device__ __forceinline__ float bfhi(unsigned v) { return __builtin_bit_cast(float, v & 0xffff0000u); }
__device__ __forceinline__ unsigned f2bf(float f) { unsigned u = __builtin_bit_cast(unsigned, f); return (u + 0x7fffu + ((u >> 16) & 1u)) >> 16; }
__device__ __forceinline__ unsigned cvt_pk(float lo, float hi) { unsigned r; asm volatile("v_cvt_pk_bf16_f32 %0, %1, %2" : "=v"(r) : "v"(lo), "v"(hi)); return r; }
__device__ __forceinline__ unsigned pk2(float lo, float hi) { return f2bf(lo) | (f2bf(hi) << 16); }
__device__ __forceinline__ float wave_sum(float v) {
#pragma unroll
    for (int o = 1; o < 64; o <<= 1) v += __shfl_xor(v, o);
    return v;
}
__device__ __forceinline__ float wave_max(float v) {
#pragma unroll
    for (int o = 1; o < 64; o <<= 1) v = fmaxf(v, __shfl_xor(v, o));
    return v;
}

typedef unsigned u2v __attribute__((ext_vector_type(2)));
#define DPP_I(v, ctrl) __builtin_amdgcn_update_dpp(0, (v), (ctrl), 0xf, 0xf, true)
#define DPP_F(v, ctrl) __builtin_bit_cast(float, __builtin_amdgcn_update_dpp(0, __builtin_bit_cast(int, (v)), (ctrl), 0xf, 0xf, true))
__device__ __forceinline__ void swap16(unsigned a, unsigned& x, unsigned& y) { unsigned b = a; asm volatile("" : "+v"(b)); auto r = __builtin_amdgcn_permlane16_swap(a, b, false, false); x = r[0]; y = r[1]; }
__device__ __forceinline__ void swap32(unsigned a, unsigned& x, unsigned& y) { unsigned b = a; asm volatile("" : "+v"(b)); auto r = __builtin_amdgcn_permlane32_swap(a, b, false, false); x = r[0]; y = r[1]; }
__device__ __forceinline__ float x16_sum(float v) { unsigned x, y; swap16(__builtin_bit_cast(unsigned, v), x, y); return __builtin_bit_cast(float, x) + __builtin_bit_cast(float, y); }
__device__ __forceinline__ float x16_max(float v) { unsigned x, y; swap16(__builtin_bit_cast(unsigned, v), x, y); return fmaxf(__builtin_bit_cast(float, x), __builtin_bit_cast(float, y)); }
__device__ __forceinline__ float x16_min(float v) { unsigned x, y; swap16(__builtin_bit_cast(unsigned, v), x, y); return fminf(__builtin_bit_cast(float, x), __builtin_bit_cast(float, y)); }
__device__ __forceinline__ int x16_sumi(int v) { unsigned x, y; swap16((unsigned)v, x, y); return (int)(x + y); }
__device__ __forceinline__ float x32_sum(float v) { unsigned x, y; swap32(__builtin_bit_cast(unsigned, v), x, y); return __builtin_bit_cast(float, x) + __builtin_bit_cast(float, y); }
__device__ __forceinline__ float x32_max(float v) { unsigned x, y; swap32(__builtin_bit_cast(unsigned, v), x, y); return fmaxf(__builtin_bit_cast(float, x), __builtin_bit_cast(float, y)); }

#define XB_TMO      128
#define XB_XCNT(j)  (256  + 64 * (j))
#define XB_XSUB(j)  (1280 + 64 * (j))
#define XB_XGEN(j)  (2304 + 64 * (j))
#define XB_TOP      3328
#define XB_TOPGEN   3392
#define XCD_BAR_WORDS 3456
#define XB_SPIN_CAP (1u << 22)

__device__ __forceinline__ unsigned xb_ld(unsigned* p)              { return __hip_atomic_load(p, __ATOMIC_RELAXED, __HIP_MEMORY_SCOPE_AGENT); }
__device__ __forceinline__ unsigned xb_add(unsigned* p, unsigned v) { return __hip_atomic_fetch_add(p, v, __ATOMIC_RELAXED, __HIP_MEMORY_SCOPE_AGENT); }
__device__ __forceinline__ unsigned xb_xcc_id() { return (unsigned)__builtin_amdgcn_s_getreg((3 << 11) | 20) & 0xFu; }
#define XB_SPIN(cond, bar) do { unsigned _sp = 0; while (cond) { __builtin_amdgcn_s_sleep(1); \
    if ((++_sp & 255u) == 0u) { if (xb_ld(&(bar)[XB_TMO])) break; if (_sp > XB_SPIN_CAP) { atomicAdd(&(bar)[XB_TMO], 1u); break; } } } } while (0)

struct XcdBarrier { unsigned* bar; unsigned x; volatile LAS unsigned* st; };

__device__ __forceinline__ XcdBarrier xcd_barrier_post(unsigned* bar, volatile LAS unsigned* st) {
    XcdBarrier b; b.bar = bar; b.x = xb_xcc_id(); b.st = st;
    if (threadIdx.x == 0) (void)xb_add(&bar[XB_XCNT(b.x)], 1u);
    return b;
}
__device__ __forceinline__ void xcd_barrier_complete(unsigned* bar, unsigned x, unsigned& nloc, unsigned& nx) {
    const unsigned G = gridDim.x * gridDim.y * gridDim.z;
    unsigned sum, cnt, mine, sp = 0u;
    for (;;) {
        sum = 0u; cnt = 0u; mine = 0u;
#pragma unroll
        for (unsigned j = 0; j < 16; ++j) { const unsigned c = xb_ld(&bar[XB_XCNT(j)]); sum += c; cnt += (c > 0u) ? 1u : 0u; mine = (j == x) ? c : mine; }
        if (sum == G) break;
        __builtin_amdgcn_s_sleep(1);
        if ((++sp & 255u) == 0u) { if (xb_ld(&bar[XB_TMO])) break; if (sp > XB_SPIN_CAP) { atomicAdd(&bar[XB_TMO], 1u); break; } }
    }
    nloc = mine > 0u ? mine : 1u; nx = cnt > 0u ? cnt : 1u;
}
__device__ __forceinline__ void xcd_barrier(const XcdBarrier& b) {
    asm volatile("s_waitcnt vmcnt(0)" ::: "memory");
    __syncthreads();
    if (threadIdx.x == 0) {
        unsigned* bar = b.bar;
        __builtin_amdgcn_s_waitcnt(0);
        unsigned nloc = b.st[0], nx = b.st[1];
        if (nloc == 0u) { xcd_barrier_complete(bar, b.x, nloc, nx); b.st[0] = nloc; b.st[1] = nx; }
        const unsigned old = xb_add(&bar[XB_XSUB(b.x)], 1u);
        const unsigned gen = old / nloc;
        if (old + 1u == (gen + 1u) * nloc) {
            __builtin_amdgcn_fence(__ATOMIC_RELEASE, "agent");
            asm volatile("s_waitcnt vmcnt(0)" ::: "memory");
            const unsigned og = xb_add(&bar[XB_TOP], 1u);
            const unsigned tg = og / nx;
            if (og + 1u == (tg + 1u) * nx) xb_add(&bar[XB_TOPGEN], 1u);
            else XB_SPIN(xb_ld(&bar[XB_TOPGEN]) == tg, bar);
            __builtin_amdgcn_fence(__ATOMIC_ACQUIRE, "agent");
            xb_add(&bar[XB_XGEN(b.x)], 1u);
            asm volatile("s_waitcnt vmcnt(0)" ::: "memory");
        } else {
            XB_SPIN(xb_ld(&bar[XB_XGEN(b.x)]) == gen, bar);
            __builtin_amdgcn_fence(__ATOMIC_ACQUIRE, "agent");
            asm volatile("s_waitcnt vmcnt(0)" ::: "memory");
        }
    }
    __syncthreads();
}

struct Ctx {
    const float *x, *w_in, *kv_g, *w_uv, *w_a, *sinks, *w_b, *w_out, *rel_bias, *ln1_g, *ln1_b, *w_group, *b_group, *w_router, *b_router, *w_gate, *w_up, *w_down, *ln2_g, *ln2_b;
    float* out;
    unsigned char* ws;
    unsigned* ctl;
    __device__ __forceinline__ bf16* P(size_t off) const { return (bf16*)(ws + off); }
    LAS unsigned char* lds;
    int tid, lane, wave, bid, G;
};

__device__ __forceinline__ int proj_src_col(int j) {
    if (j < 1024) return j;
    if (j < 1152) return j;
    if (j < 1216) return 1664 + (j - 1152);
    if (j < 1224) return 1728 + (j - 1216);
    if (j < 1280) return -1;
    if (j < 1792) return 1152 + (j - 1280);
    if (j < 2304) return 1736 + (j - 1792);
    if (j < 2432) return 2248 + (j - 2304);
    if (j < 2560) return 2376 + (j - 2432);
    if (j < 3584) return 2504 + (j - 2560);
    return 3528 + (j - 3584);
}
__device__ __forceinline__ float sigmoidf_(float v) { return 1.0f / (1.0f + __expf(-v)); }

template <class Src> __device__ __forceinline__ void transpose_item(const Ctx& c, LAS float* scr, const Src& src, bf16* dst, int dstK, int k0, int n0) {
    const int lane = c.lane;
    f32x4 tv[8]; const int kr = lane >> 3, n4 = (lane & 7) * 4;
#pragma unroll
    for (int i = 0; i < 8; ++i) tv[i] = src.v4(k0 + 8 * i + kr, n0 + n4);
#pragma unroll
    for (int i = 0; i < 8; ++i) { LAS float* d = scr + (8 * i + kr) * 33 + n4; d[0] = tv[i].x; d[1] = tv[i].y; d[2] = tv[i].z; d[3] = tv[i].w; }
    asm volatile("s_waitcnt lgkmcnt(0)" ::: "memory");
    const int cc = lane & 7;
#pragma unroll
    for (int j = 0; j < 4; ++j) { const int n = (lane >> 3) + 8 * j; const LAS float* q = scr + (8 * cc) * 33 + n;
        v4u o; o.x = pk2(q[0 * 33], q[1 * 33]); o.y = pk2(q[2 * 33], q[3 * 33]); o.z = pk2(q[4 * 33], q[5 * 33]); o.w = pk2(q[6 * 33], q[7 * 33]);
        *(v4u*)(dst + (size_t)(n0 + n) * dstK + k0 + 8 * cc) = o; }
    asm volatile("s_waitcnt lgkmcnt(0)" ::: "memory");
}
struct SrcWin { const float* w; __device__ __forceinline__ f32x4 v4(int k, int n) const { const int s = proj_src_col(n); return s < 0 ? (f32x4){0.f, 0.f, 0.f, 0.f} : *(const f32x4*)(w + (size_t)k * IN_WIDTH + s); } };
struct SrcPlain { const float* w; int N; __device__ __forceinline__ f32x4 v4(int k, int n) const { return *(const f32x4*)(w + (size_t)k * N + n); } };
struct SrcShift { const float* w; int N; int shift; __device__ __forceinline__ f32x4 v4(int k, int n) const { return *(const f32x4*)(w + (size_t)k * N + n + shift); } };

__device__ __forceinline__ float t5_bias_bucket(int dist) {
    if (dist < 16) return (float)dist;
    int b = 16 + (int)(logf((float)dist / 16.0f) / logf(8.0f) * 16.0f);
    return (float)(b < 31 ? b : 31);
}
constexpr int P0_EXPERT_ITEMS = 32 * 256 + 32 * 128;
__device__ __forceinline__ void p0_expert_item(const Ctx& c, LAS float* scr, int r) {
    constexpr int I_GU = 32 * 256;
    if (r < I_GU) { const int e = r / 256, q = r % 256, n0 = (q / 16) * 32, half = (n0 >> 7) & 1, col0 = (n0 >> 8) * 128 + (n0 & 127);
        if (half) { SrcShift s_{c.w_up + (size_t)e * 1024 * 256, DEXP, col0 - n0}; transpose_item(c, scr, s_, (bf16*)(c.ws + WS_WGU) + (size_t)e * 512 * 1024, 1024, (q % 16) * 64, n0); }
        else { SrcShift s_{c.w_gate + (size_t)e * 1024 * 256, DEXP, col0 - n0}; transpose_item(c, scr, s_, (bf16*)(c.ws + WS_WGU) + (size_t)e * 512 * 1024, 1024, (q % 16) * 64, n0); }
        return; }
    r -= I_GU;
    { const int e = r / 128, q = r % 128; SrcPlain s_{c.w_down + (size_t)e * 256 * 1024, 1024};
        transpose_item(c, scr, s_, (bf16*)(c.ws + WS_WD) + (size_t)e * 1024 * 256, 256, (q % 4) * 64, (q / 4) * 32); }
}
constexpr size_t WS_WRT = 16 * MiB + 512 * 1024;
__device__ __forceinline__ void p0_prologue(const Ctx& c) {
    { const size_t n8 = (size_t)NTOK * D / 8; const f32x4* xs = (const f32x4*)c.x; v4u* xd = (v4u*)((bf16*)(c.ws + WS_XB));
      const size_t st = (size_t)c.G * NTHR;
      size_t i = (size_t)c.bid * NTHR + c.tid;
      for (; i + 3 * st < n8; i += 4 * st) { f32x4 a[4], b[4];
#pragma unroll
          for (int u = 0; u < 4; ++u) { a[u] = xs[2 * (i + u * st)]; b[u] = xs[2 * (i + u * st) + 1]; }
#pragma unroll
          for (int u = 0; u < 4; ++u) { v4u o; o.x = pk2(a[u].x, a[u].y); o.y = pk2(a[u].z, a[u].w); o.z = pk2(b[u].x, b[u].y); o.w = pk2(b[u].z, b[u].w); xd[i + u * st] = o; } }
      for (; i < n8; i += st) { const f32x4 a = xs[2 * i], b = xs[2 * i + 1]; v4u o; o.x = pk2(a.x, a.y); o.y = pk2(a.z, a.w); o.z = pk2(b.x, b.y); o.w = pk2(b.z, b.w); xd[i] = o; } }
    { LAS float* scr = (LAS float*)(c.lds + c.wave * 8704);
      constexpr int I_WIN = 16 * 144, I_WB = 8 * 32, I_WO = 16 * 32, I_ALL = I_WIN + I_WB + I_WO;
      for (int it = c.bid * NWAVES + c.wave; it < I_ALL; it += c.G * NWAVES) {
        int r = it;
        if (r < I_WIN) { SrcWin s_{c.w_in}; transpose_item(c, scr, s_, (bf16*)(c.ws + WS_WIN), 1024, (r % 16) * 64, (r / 16) * 32); continue; } r -= I_WIN;
        if (r < I_WB) { SrcPlain s_{c.w_b, 1024}; transpose_item(c, scr, s_, (bf16*)(c.ws + WS_WB), 512, (r % 8) * 64, (r / 8) * 32); continue; } r -= I_WB;
        { SrcPlain s_{c.w_out, 1024}; transpose_item(c, scr, s_, (bf16*)(c.ws + WS_WO), 1024, (r % 16) * 64, (r / 16) * 32); }
      } }
    __syncthreads();
    { LAS float* tile = (LAS float*)c.lds; LAS float* Us = tile + 64 * 65; LAS float* As = Us + 64 * 65;
      for (int tI = c.bid; tI < 256; tI += c.G) { const int k0 = (tI & 15) * 64, n0 = (tI >> 4) * 64, h = k0 >> 7;
        const int r = c.tid >> 6, cc = c.tid & 63;
#pragma unroll
        for (int pI = 0; pI < 8; ++pI) { const int kk = pI * 8 + r; Us[kk * 65 + cc] = c.w_uv[(size_t)(k0 + kk) * 64 + cc]; As[kk * 65 + cc] = c.w_a[(size_t)(h * 64 + kk) * 1024 + n0 + cc]; }
        __syncthreads();
#pragma unroll
        for (int pI = 0; pI < 8; ++pI) { const int kk = pI * 8 + r; float a = 0.f;
#pragma unroll 16
            for (int d = 0; d < 64; ++d) a += Us[kk * 65 + d] * As[d * 65 + cc];
            tile[kk * 65 + cc] = a; }
        __syncthreads();
        const int nl = c.tid >> 3, kc = c.tid & 7; v4u o;
        o.x = pk2(tile[(8 * kc + 0) * 65 + nl], tile[(8 * kc + 1) * 65 + nl]); o.y = pk2(tile[(8 * kc + 2) * 65 + nl], tile[(8 * kc + 3) * 65 + nl]);
        o.z = pk2(tile[(8 * kc + 4) * 65 + nl], tile[(8 * kc + 5) * 65 + nl]); o.w = pk2(tile[(8 * kc + 6) * 65 + nl], tile[(8 * kc + 7) * 65 + nl]);
        *(v4u*)((bf16*)(c.ws + WS_WC) + (size_t)(n0 + nl) * 1024 + k0 + 8 * kc) = o;
        __syncthreads(); } }
    for (int i = c.bid * NTHR + c.tid; i < 48 * 1024; i += c.G * NTHR) { const int o = i >> 10, k = i & 1023;
        const float v = o < 32 ? c.w_router[(size_t)k * 32 + o] : (o < 36 ? c.w_group[(size_t)k * 4 + (o - 32)] : 0.f);
        const unsigned hi = f2bf(v); const float rem = v - bf2f(hi);
        ((bf16*)(c.ws + WS_WRT))[i] = (bf16)hi; ((bf16*)(c.ws + WS_WRT))[48 * 1024 + i] = (bf16)f2bf(rem); }
    if (c.bid == 0) { for (int i = c.tid; i < 129 * 8; i += NTHR) { const int d = i >> 3, h = i & 7; const int b = (int)t5_bias_bucket(d);
            ((float*)(c.ws + WS_BIAS))[i] = c.rel_bias[b * 16 + h]; ((float*)(c.ws + WS_BIAS) + 129 * 8)[i] = c.rel_bias[b * 16 + 8 + h]; } }
}


__device__ __forceinline__ void p_rmsnorm(const Ctx& c) {
    const int gw = c.bid * NWAVES + c.wave, NGW = c.G * NWAVES, l15 = c.lane & 15, g4 = c.lane >> 4;
    const f32x4 g0 = *(const f32x4*)(c.kv_g + 8 * l15), g1 = *(const f32x4*)(c.kv_g + 8 * l15 + 4);
    for (int r = 4 * gw + g4; r < NTOK; r += 4 * NGW) {
        const float* src = (const float*)(c.ws + WS_CKVRAW) + (size_t)r * 128 + 8 * l15;
        const f32x4 a = *(const f32x4*)src, b = *(const f32x4*)(src + 4);
        float ss = (a.x * a.x + a.y * a.y) + (a.z * a.z + a.w * a.w) + (b.x * b.x + b.y * b.y) + (b.z * b.z + b.w * b.w);
        ss += DPP_F(ss, 0xB1); ss += DPP_F(ss, 0x4E); ss += DPP_F(ss, 0x141); ss += DPP_F(ss, 0x140);
        const float rs = 1.0f / sqrtf(ss * (1.0f / 128.0f) + RMS_EPS);
        v4u o; o.x = pk2(a.x * rs * g0.x, a.y * rs * g0.y); o.y = pk2(a.z * rs * g0.z, a.w * rs * g0.w); o.z = pk2(b.x * rs * g1.x, b.y * rs * g1.y); o.w = pk2(b.z * rs * g1.z, b.w * rs * g1.w);
        *(v4u*)((bf16*)(c.ws + WS_CKV) + (size_t)r * 128 + 8 * l15) = o;
    }
}


typedef float f32x16 __attribute__((ext_vector_type(16)));
typedef short s16x8 __attribute__((ext_vector_type(8)));
__device__ __forceinline__ float half_min(float v) {
    v = fminf(v, DPP_F(v, 0xB1)); v = fminf(v, DPP_F(v, 0x4E)); v = fminf(v, DPP_F(v, 0x141)); v = fminf(v, DPP_F(v, 0x140)); return x16_min(v); }
__device__ __forceinline__ float half_max(float v) {
    v = fmaxf(v, DPP_F(v, 0xB1)); v = fmaxf(v, DPP_F(v, 0x4E)); v = fmaxf(v, DPP_F(v, 0x141)); v = fmaxf(v, DPP_F(v, 0x140)); return x16_max(v); }
__device__ __forceinline__ int half_sum(int v) {
    v += DPP_I(v, 0xB1); v += DPP_I(v, 0x4E); v += DPP_I(v, 0x141); v += DPP_I(v, 0x140); return x16_sumi(v); }
__device__ __forceinline__ void p2_unit(const Ctx& c, int b, int blk) {
    LAS unsigned char* kst = c.lds;
    const int lane = c.lane, wv = c.wave, r = lane & 31, hh = lane >> 5, g4 = lane >> 4, c16 = lane & 15;
    const int t0 = blk * 16 + 2 * wv, n0 = b * SEQ + t0, ntile = blk + 1, nst = (ntile + 15) >> 4;
    const unsigned char* ksrc = c.ws + WS_KIDX + (size_t)(b * 128) * 2048;
#define P2_ISSUE(st) do { _Pragma("unroll") for (int _j = 0; _j < 4; ++_j) \
        __builtin_amdgcn_global_load_lds((const unsigned*)(ksrc + (size_t)(st) * 32768 + (_j * 512 + c.tid) * 16), (LAS unsigned*)(kst + ((st) & 1) * 32768 + (_j * 512 + wv * 64) * 16), 16, 0, 0); } while (0)
    P2_ISSUE(0);
    s16x8 af[2];
    { const bf16* qp = (const bf16*)(c.ws + WS_QIDX) + (size_t)(n0 + (c16 >> 3)) * 512 + (c16 & 7) * 64 + 8 * g4;
      af[0] = *(const s16x8*)qp; af[1] = *(const s16x8*)(qp + 32); }
    const f32x4 wq = *(const f32x4*)((const float*)(c.ws + WS_WIDX) + (size_t)(n0 + hh) * 8 + 4 * (g4 & 1));
    asm volatile("" :: "v"(af[0]), "v"(af[1]), "v"(wq));
    float sc0[64];
#pragma unroll
    for (int i = 0; i < 64; ++i) sc0[i] = -INFINITY;
    const int lim0 = 2 * wv + hh;
#pragma unroll
    for (int st = 0; st < 8; ++st) {
        if (st < nst) {
            if (st + 1 < nst) { P2_ISSUE(st + 1); asm volatile("s_waitcnt vmcnt(4)" ::: "memory"); }
            else asm volatile("s_waitcnt vmcnt(0)" ::: "memory");
            __builtin_amdgcn_s_barrier();
            const LAS unsigned char* kb_ = kst + (st & 1) * 32768 + lane * 16;
#pragma unroll
            for (int tp = 0; tp < 8; ++tp) {
                const int tile = st * 16 + 2 * tp;
                if (tile < ntile) {
                    float sv[2];
#pragma unroll
                    for (int u2 = 0; u2 < 2; ++u2) {
                        const s16x8 b0 = *(const LAS s16x8*)(kb_ + (2 * tp + u2) * 2048), b1 = *(const LAS s16x8*)(kb_ + (2 * tp + u2) * 2048 + 1024);
                        f32x4 acc = {0.f, 0.f, 0.f, 0.f};
                        acc = __builtin_amdgcn_mfma_f32_16x16x32_bf16(af[0], b0, acc, 0, 0, 0);
                        acc = __builtin_amdgcn_mfma_f32_16x16x32_bf16(af[1], b1, acc, 0, 0, 0);
                        float v = wq.x * fmaxf(acc[0], 0.f) + wq.y * fmaxf(acc[1], 0.f) + wq.z * fmaxf(acc[2], 0.f) + wq.w * fmaxf(acc[3], 0.f);
                        v = x16_sum(v) + 0.0f;
                        const int tl = tile + u2;
                        if (tl == blk) v = (c16 <= lim0) ? v : -INFINITY;
                        if (tl > blk) v = -INFINITY;
                        sv[u2] = v;
                    }
                    sc0[st * 8 + tp] = (g4 & 1) ? sv[1] : sv[0];
                    if (tp & 1) __builtin_amdgcn_sched_barrier(0);
                }
            }
            asm volatile("s_waitcnt lgkmcnt(0)" ::: "memory");
            __builtin_amdgcn_s_barrier();
        }
    }
#undef P2_ISSUE
    const int nreg = (ntile + 1) >> 1;
    float thr0 = -INFINITY; int quota0 = 0;
    if (blk >= 16) {
        float mn0 = INFINITY, mx0 = -INFINITY; int cp = 0, cn = 0;
#pragma unroll
        for (int g = 0; g < 4; ++g) if (nreg > 16 * g) {
#pragma unroll
            for (int i = 16 * g; i < 16 * g + 16; ++i) { mx0 = fmaxf(mx0, sc0[i]); mn0 = fminf(mn0, sc0[i] == -INFINITY ? INFINITY : sc0[i]); cp += (sc0[i] > 0.f) ? 1 : 0; cn += (sc0[i] >= 0.f) ? 1 : 0; } }
        mn0 = half_min(mn0); mx0 = half_max(mx0); cp = half_sum(cp); cn = half_sum(cn);
        float lo0, hi0; int chi0, clo0; bool done0 = false;
        if (cp <= KSEL && cn >= KSEL) { done0 = true; thr0 = 0.f; quota0 = KSEL - cp; lo0 = hi0 = 0.f; chi0 = 0; clo0 = KSEL + 1; }
        else if (cp > KSEL) { lo0 = 0.f; clo0 = cn; hi0 = mx0 + fabsf(mx0) * 1e-6f + 1e-30f; chi0 = 0; }
        else { lo0 = mn0; clo0 = t0 + hh + 1; hi0 = 0.f; chi0 = cn; }
        for (int it = 0; it < 200; ++it) {
            if (__builtin_amdgcn_ballot_w64(!done0) == 0ull) break;
            const float half_ = 0.5f * (lo0 + hi0);
            float mid0 = half_;
            if (!(it & 1)) { const float fr_ = ((float)(clo0 - KSEL) + 0.5f) / (float)(clo0 - chi0); const float mi = lo0 + (hi0 - lo0) * fr_; mid0 = (mi > lo0 && mi < hi0) ? mi : half_; }
            unsigned sa = 0u, sb = 0u; int nproc = 0;
#pragma unroll
            for (int g = 0; g < 4; ++g) if (nreg > 16 * g) { nproc += 16;
#pragma unroll
                for (int i = 16 * g; i < 16 * g + 16; ++i) { const unsigned tb_ = __builtin_bit_cast(unsigned, sc0[i] - mid0);
                    if (g < 2) sa = __builtin_amdgcn_alignbit(sa, tb_, 31); else sb = __builtin_amdgcn_alignbit(sb, tb_, 31); } }
            int c0 = half_sum(nproc - __builtin_popcount(sa) - __builtin_popcount(sb));
            if (!done0) { if (c0 == KSEL) { done0 = true; thr0 = mid0; quota0 = KSEL; } else if (mid0 <= lo0 || mid0 >= hi0) { done0 = true; thr0 = lo0; quota0 = KSEL - chi0; } else if (c0 > KSEL) { lo0 = mid0; clo0 = c0; } else { hi0 = mid0; chi0 = c0; } }
        }
        if (!done0) { thr0 = lo0; quota0 = KSEL - chi0; }
    }
    unsigned short* selp0 = (unsigned short*)(c.ws + WS_SEL) + (size_t)(n0 + hh) * KSEL;
    int base0 = 0, eq0 = 0; const unsigned ltm = (1u << r) - 1u;
#pragma unroll
    for (int g = 0; g < 4; ++g) if (nreg > 16 * g) {
#pragma unroll
        for (int i = 16 * g; i < 16 * g + 16; ++i) {
            bool sel_ = sc0[i] > thr0; const bool pe = sc0[i] == thr0; const unsigned long long me = __builtin_amdgcn_ballot_w64(pe);
            if (me) { const unsigned mh = hh ? (unsigned)(me >> 32) : (unsigned)me; sel_ = sel_ || (pe && (eq0 + __builtin_popcount(mh & ltm) < quota0)); eq0 += __builtin_popcount(mh); }
            const unsigned long long ms = __builtin_amdgcn_ballot_w64(sel_); const unsigned mh2 = hh ? (unsigned)(ms >> 32) : (unsigned)ms;
            const int pos = base0 + __builtin_popcount(mh2 & ltm); if (sel_ && pos < KSEL) selp0[pos] = (unsigned short)(32 * i + r); base0 += __builtin_popcount(mh2);
        } }
}
__device__ __forceinline__ void p2_indexer_topk(const Ctx& c) {
    for (int pu = c.bid; pu < 256; pu += c.G) {
        const int b = pu >> 5, j = pu & 31;
#pragma unroll 1
        for (int q = 0; q < 4; ++q) p2_unit(c, b, q == 0 ? j : (q == 1 ? 63 - j : (q == 2 ? 64 + j : 127 - j)));
    }
}


typedef short s16x4 __attribute__((ext_vector_type(4)));
constexpr int DSA_WS_OFF = 131072 + 2048;
constexpr int DSA_BIAS_OFF = 131072 + 2048 + 10240;
__device__ __forceinline__ void p3a_dsa(const Ctx& c) {
    const int lane = c.lane, wv = c.wave, l15 = lane & 15, g4 = lane >> 4;
    LAS unsigned char* kvb = c.lds + wv * 16384;
    LAS unsigned char* wsb = c.lds + DSA_WS_OFF + wv * 1280;
    LAS float* biasL = (LAS float*)(c.lds + DSA_BIAS_OFF);
    for (int i = c.tid; i < 129 * 8; i += NTHR) biasL[i] = ((const float*)(c.ws + WS_BIAS))[i];
    __syncthreads();
    const int prow = (l15 & 3) | ((l15 & 4) << 1) | ((l15 & 8) >> 1);
    const int rowx = ((prow & 3) << 2) | (prow >> 2);
    const unsigned qk_off = (unsigned)(256 * prow + 16 * (g4 ^ (rowx & 3))), qk_sx = (unsigned)(rowx >> 2);
    const int grow = 8 * (g4 & 1) + 4 * (g4 >> 1);
    const int trow = grow + (l15 >> 2), trx = ((trow & 3) << 2) | ((trow >> 2) & 3);
    const unsigned tr_off = (unsigned)(256 * trow + 16 * (((lane & 3) >> 1) ^ (trx & 1)) + 8 * (lane & 1)), tr_mx = (unsigned)(trx >> 1);
    const bf16* ckv = (const bf16*)(c.ws + WS_CKV);
    const float bfar = biasL[128 * 8 + (l15 & 7)];
    float bmax = 0.f;
    for (int d = 0; d <= 128; ++d) bmax = fmaxf(bmax, fabsf(biasL[d * 8 + (l15 & 7)]));
    const float kvmax = 11.313708499f * 1.004f * wave_max(fmaxf(fabsf(c.kv_g[2 * lane]), fabsf(c.kv_g[2 * lane + 1])));
    unsigned trm[8];
#pragma unroll
    for (int m = 0; m < 8; ++m) trm[m] = tr_off + 32u * ((unsigned)m ^ tr_mx);
    const int gw = c.bid * NWAVES + wv, NGW = c.G * NWAVES;
    if (wv < 4) for (int eit = gw; eit < P0_EXPERT_ITEMS; eit += NGW) p0_expert_item(c, (LAS float*)kvb, eit);
    asm volatile("s_waitcnt lgkmcnt(0)" ::: "memory");
#define DSA_LOADQ(n_, raw_, qf_) do { raw_ = *(const v2u*)((const unsigned short*)(c.ws + WS_SEL) + (size_t)(n_) * KSEL + 4 * lane); \
        const s16x8* qp_ = (const s16x8*)((const bf16*)(c.ws + WS_QLAT) + (size_t)(n_) * 1024 + (l15 & 7) * 128 + 8 * g4); \
        _Pragma("unroll") for (int s_ = 0; s_ < 4; ++s_) qf_[s_] = qp_[4 * s_]; } while (0)
#define DSA_PREP(n_, raw_, qf_, sl_, t_, cnt_, nch_, nfar_, mref_) do { t_ = (n_) & 2047; cnt_ = (t_ + 1 < KSEL) ? t_ + 1 : KSEL; nch_ = (cnt_ + 31) >> 5; \
        { const int i0 = 4 * lane, lim = t_ - 128; \
          raw_.x = (i0 < cnt_ ? (raw_.x & 0xffffu) : 0u) | (i0 + 1 < cnt_ ? (raw_.x & 0xffff0000u) : 0u); raw_.y = (i0 + 2 < cnt_ ? (raw_.y & 0xffffu) : 0u) | (i0 + 3 < cnt_ ? (raw_.y & 0xffff0000u) : 0u); \
          *(LAS v2u*)(wsb + (sl_) * 512 + 8 * lane) = raw_; \
          const int e0 = (i0 < cnt_ && (int)(raw_.x & 0xffffu) <= lim) ? 1 : 0, e1 = (i0 + 1 < cnt_ && (int)(raw_.x >> 16) <= lim) ? 1 : 0, e2 = (i0 + 2 < cnt_ && (int)(raw_.y & 0xffffu) <= lim) ? 1 : 0, e3 = (i0 + 3 < cnt_ && (int)(raw_.y >> 16) <= lim) ? 1 : 0; \
          int nf = e0 + e1 + e2 + e3; nf += DPP_I(nf, 0xB1); nf += DPP_I(nf, 0x4E); nf += DPP_I(nf, 0x141); nf += DPP_I(nf, 0x140); nf = x16_sumi(nf); { unsigned xa, xb; swap32((unsigned)nf, xa, xb); nf = (int)(xa + xb); } \
          nfar_ = __builtin_amdgcn_readfirstlane(nf) >> 5; } \
        { float q2 = 0.f; \
          _Pragma("unroll") for (int s_ = 0; s_ < 4; ++s_) { if (l15 >= 8) qf_[s_] = (s16x8){0, 0, 0, 0, 0, 0, 0, 0}; \
              _Pragma("unroll") for (int e = 0; e < 8; ++e) { const float qv = bf2f((unsigned)(unsigned short)qf_[s_][e]); q2 += qv * qv; } } \
          q2 = x16_sum(q2); q2 = x32_sum(q2); mref_ = sqrtf(q2) * kvmax + bmax; } } while (0)
#define DSA_ISSUE(ch_, bi_, k8_, sl_, n_, t_, cnt_, nfar_) do { const bf16* ckb_ = ckv + (size_t)((n_) >> 11) * SEQ * 128; \
            _Pragma("unroll") for (int u = 0; u < 8; ++u) { const unsigned kw = u < 2 ? k8_.x : (u < 4 ? k8_.y : (u < 6 ? k8_.z : k8_.w)); const unsigned key = (u & 1) ? (kw >> 16) : (kw & 0xffffu); \
                const int chl = l15 ^ ((g4 << 2) | (u & 3)); \
                __builtin_amdgcn_global_load_lds((const unsigned*)((const char*)ckb_ + (size_t)(unsigned)(key * 256u + (unsigned)chl * 16u)), (LAS unsigned*)(kvb + (bi_) * 8192 + u * 1024), 16, 0, 0); } \
            if ((ch_) >= (nfar_) && lane < 32) { const int kap = 32 * (ch_) + 8 * (lane & 3) + (lane >> 2); const int key = *(const LAS unsigned short*)(wsb + (sl_) * 512 + 2 * kap); int dd = (t_) - key; dd = dd > 128 ? 128 : dd; dd = kap < (cnt_) ? dd : 255; \
                *(LAS unsigned short*)(wsb + 1024 + (bi_) * 64 + 2 * lane) = (unsigned short)dd; } } while (0)
    const bool mixq = (NGW == SEQ);
#define DSA_QIDX(i_) (mixq ? ((i_) * SEQ + ((gw + 293 * (i_)) & (SEQ - 1))) : (gw + (i_) * NGW))
    const int nq = mixq ? BATCH : (NTOK - gw + NGW - 1) / NGW;
    int qi = 0, n = DSA_QIDX(0), sl = 0, b0 = 0, t = 0, cnt = 0, nch = 0, nfar = 0; float Mref = 0.f;
    s16x8 qf[4]; v2u rawn; s16x8 qfn[4];
    if (nq > 0) { v2u raw0; DSA_LOADQ(n, raw0, qf); DSA_PREP(n, raw0, qf, 0, t, cnt, nch, nfar, Mref);
        asm volatile("s_waitcnt lgkmcnt(0)" ::: "memory");
        const v4u k80 = *(const LAS v4u*)(wsb + (8 * g4) * 2); DSA_ISSUE(0, 0, k80, 0, n, t, cnt, nfar); }
    for (; qi < nq; ++qi) {
        const bool has_next = qi + 1 < nq; const int nn = has_next ? DSA_QIDX(qi + 1) : n;
        if (has_next) DSA_LOADQ(nn, rawn, qfn);
        int tn = 0, cntn = 0, nchn = 0, nfarn = 0; float Mrefn = 0.f;
        f32x4 O[8];
#pragma unroll
        for (int m = 0; m < 8; ++m) O[m] = (f32x4){0.f, 0.f, 0.f, 0.f};
        float l_run = 0.f;
        v4u k8n = *(const LAS v4u*)(wsb + sl * 512 + (32 * (nch > 1 ? 1 : 0) + 8 * g4) * 2);
        for (int ch = 0; ch < nch; ++ch) {
            const int bi = (b0 + ch) & 1;
            asm volatile("s_waitcnt lgkmcnt(0)" ::: "memory");
            if (ch + 1 < nch) { const v4u k8 = k8n; k8n = *(const LAS v4u*)(wsb + sl * 512 + (32 * (ch + 2 < 8 ? ch + 2 : 7) + 8 * g4) * 2);
                DSA_ISSUE(ch + 1, bi ^ 1, k8, sl, n, t, cnt, nfar); asm volatile("s_waitcnt vmcnt(8)" ::: "memory"); }
            else if (has_next) { DSA_PREP(nn, rawn, qfn, sl ^ 1, tn, cntn, nchn, nfarn, Mrefn);
                asm volatile("s_waitcnt lgkmcnt(0)" ::: "memory");
                const v4u k8 = *(const LAS v4u*)(wsb + (sl ^ 1) * 512 + (8 * g4) * 2);
                DSA_ISSUE(0, bi ^ 1, k8, sl ^ 1, nn, tn, cntn, nfarn); asm volatile("s_waitcnt vmcnt(8)" ::: "memory"); }
            else asm volatile("s_waitcnt vmcnt(0)" ::: "memory");
            const LAS unsigned char* kb_ = kvb + bi * 8192;
            f32x4 S[2];
#pragma unroll
            for (int T = 0; T < 2; ++T) { f32x4 a4 = {0.f, 0.f, 0.f, 0.f};
#pragma unroll
                for (int s_ = 0; s_ < 4; ++s_) { const s16x8 a = *(const LAS s16x8*)(kb_ + qk_off + 4096 * T + 64 * ((unsigned)s_ ^ qk_sx)); a4 = __builtin_amdgcn_mfma_f32_16x16x32_bf16(a, qf[s_], a4, 0, 0, 0); }
                S[T] = a4; }
            if (ch < nfar) {
#pragma unroll
                for (int T = 0; T < 2; ++T)
#pragma unroll
                    for (int r_ = 0; r_ < 4; ++r_) S[T][r_] = S[T][r_] + (bfar - Mref);
            } else
#pragma unroll
            for (int T = 0; T < 2; ++T) { const v2u d4 = *(const LAS v2u*)(wsb + 1024 + bi * 64 + 2 * (16 * T + grow));
#pragma unroll
                for (int r_ = 0; r_ < 4; ++r_) { const unsigned dw = r_ < 2 ? d4.x : d4.y; const unsigned dd = (r_ & 1) ? (dw >> 16) : (dw & 0xffffu);
                    const float bsv = biasL[(dd > 128u ? 128u : dd) * 8 + (l15 & 7)]; S[T][r_] = (dd == 255u) ? -INFINITY : S[T][r_] + (bsv - Mref); } }
#pragma unroll
            for (int T = 0; T < 2; ++T)
#pragma unroll
                for (int r_ = 0; r_ < 4; ++r_) { const float pv = __expf(S[T][r_]); S[T][r_] = pv; l_run += pv; }
            s16x8 P;
            { const unsigned p0 = cvt_pk(S[0][0], S[0][1]), p1 = cvt_pk(S[0][2], S[0][3]), p2 = cvt_pk(S[1][0], S[1][1]), p3 = cvt_pk(S[1][2], S[1][3]);
              const v4u pw_ = {p0, p1, p2, p3}; P = __builtin_bit_cast(s16x8, pw_); }
            { const unsigned kba = (unsigned)(size_t)kb_; s16x4 ta[8], tb[8];
#pragma unroll
              for (int m = 0; m < 8; ++m) { const unsigned ad = kba + trm[m];
                  asm volatile("ds_read_b64_tr_b16 %0, %1" : "=v"(ta[m]) : "v"(ad) : "memory"); asm volatile("ds_read_b64_tr_b16 %0, %1 offset:4096" : "=v"(tb[m]) : "v"(ad) : "memory"); }
              asm volatile("s_waitcnt lgkmcnt(8)" ::: "memory"); __builtin_amdgcn_sched_barrier(0);
#pragma unroll
              for (int m = 0; m < 4; ++m) O[m] = __builtin_amdgcn_mfma_f32_16x16x32_bf16(__builtin_shufflevector(ta[m], tb[m], 0, 1, 2, 3, 4, 5, 6, 7), P, O[m], 0, 0, 0);
              asm volatile("s_waitcnt lgkmcnt(0)" ::: "memory"); __builtin_amdgcn_sched_barrier(0);
#pragma unroll
              for (int m = 4; m < 8; ++m) O[m] = __builtin_amdgcn_mfma_f32_16x16x32_bf16(__builtin_shufflevector(ta[m], tb[m], 0, 1, 2, 3, 4, 5, 6, 7), P, O[m], 0, 0, 0); }
        }
        l_run = x16_sum(l_run); l_run = x32_sum(l_run);
        const float inv = 1.0f / fmaxf(l_run, 1e-37f);
        { LAS unsigned char* stg = kvb + ((b0 + nch - 1) & 1) * 8192;
          if (l15 < 8) {
#pragma unroll
              for (int m = 0; m < 8; ++m) *(LAS v2u*)(stg + (l15 * 128 + 16 * m + 4 * g4) * 2) = (v2u){cvt_pk(O[m][0] * inv, O[m][1] * inv), cvt_pk(O[m][2] * inv, O[m][3] * inv)}; }
          asm volatile("s_waitcnt lgkmcnt(0)" ::: "memory");
          const v4u oa = *(const LAS v4u*)(stg + lane * 16), ob = *(const LAS v4u*)(stg + 1024 + lane * 16);
          bf16* op = (bf16*)(c.ws + WS_XB) + (size_t)n * 1024 + lane * 8;
          *(v4u*)op = oa; *(v4u*)(op + 512) = ob; }
        b0 = (b0 + nch) & 1; sl ^= 1; t = tn; cnt = cntn; nch = nchn; nfar = nfarn; Mref = Mrefn; n = nn;
#pragma unroll
        for (int s_ = 0; s_ < 4; ++s_) qf[s_] = qfn[s_];
    }
#undef DSA_QIDX
#undef DSA_LOADQ
#undef DSA_PREP
#undef DSA_ISSUE
    asm volatile("s_waitcnt vmcnt(0) lgkmcnt(0)" ::: "memory");
    if (wv >= 4) for (int eit = gw; eit < P0_EXPERT_ITEMS; eit += NGW) p0_expert_item(c, (LAS float*)kvb, eit);
    __syncthreads();
}

__device__ __forceinline__ void p3b_swa(const Ctx& c) {
    const int lane = c.lane, wv = c.wave, l15 = lane & 15, g4 = lane >> 4, g = wv & 3, hq = wv >> 2;
    LAS float* biasL = (LAS float*)(c.lds + DSA_BIAS_OFF);
    __syncthreads();
    for (int i = c.tid; i < 128 * 8; i += NTHR) biasL[i] = ((const float*)(c.ws + WS_BIAS) + 129 * 8)[i];
    __syncthreads();
    const unsigned kr_off = (unsigned)(128 * l15), kr_x = (unsigned)(l15 & 7);
    const int vrow = 4 * g4 + (l15 >> 2); const unsigned vr_x = (unsigned)(vrow & 7), vp1 = (unsigned)((lane & 3) >> 1);
    const unsigned vr_off = (unsigned)(128 * vrow + 8 * (lane & 1));
    for (int unit = c.bid; unit < 256; unit += c.G) {
        const int b = unit >> 5, qb = (unit >> 1) & 15, kvh = unit & 1, head = kvh * 4 + g;
        __syncthreads();
#pragma unroll
        for (int j = 0; j < 4; ++j) { const int piece = wv * 4 + j, row = 8 * piece + (lane >> 3), chunk = (lane & 7) ^ (row & 7); int key = (qb - 1) * 128 + row; key = key < 0 ? 0 : key;
            const size_t so = ((size_t)(b * SEQ + key) * 128 + kvh * 64 + chunk * 8);
            __builtin_amdgcn_global_load_lds((const unsigned*)((const bf16*)(c.ws + WS_KB) + so), (LAS unsigned*)(c.lds + piece * 1024), 16, 0, 0);
            __builtin_amdgcn_global_load_lds((const unsigned*)((const bf16*)(c.ws + WS_VB) + so), (LAS unsigned*)(c.lds + 32768 + piece * 1024), 16, 0, 0); }
        float bt[9][4];
#pragma unroll
        for (int ta = 0; ta < 9; ++ta)
#pragma unroll
            for (int r_ = 0; r_ < 4; ++r_) { const int dist = 128 + l15 - 16 * ta - 4 * g4 - r_; bt[ta][r_] = (dist >= 0 && dist < 128) ? biasL[dist * 8 + head] : -INFINITY; }
        const float sink = c.sinks[head];
        asm volatile("s_waitcnt vmcnt(0)" ::: "memory");
        __syncthreads();
#pragma unroll 1
        for (int jj = 0; jj < 4; ++jj) {
            const int j = 4 * hq + jj; const size_t nrow = (size_t)(b * SEQ + qb * 128 + 16 * j + l15);
            bf16* qrow = (bf16*)(c.ws + WS_QB) + nrow * 512 + head * 64;
            const s16x8 q0 = *(const s16x8*)(qrow + 8 * g4), q1 = *(const s16x8*)(qrow + 32 + 8 * g4);
            f32x4 S[9]; float mx = sink;
#pragma unroll
            for (int ta = 0; ta < 9; ++ta) { const int kt = j + ta; const LAS unsigned char* kp = c.lds + kr_off + 2048 * kt;
                f32x4 a4 = {0.f, 0.f, 0.f, 0.f};
                a4 = __builtin_amdgcn_mfma_f32_16x16x32_bf16(*(const LAS s16x8*)(kp + 16 * ((unsigned)g4 ^ kr_x)), q0, a4, 0, 0, 0);
                a4 = __builtin_amdgcn_mfma_f32_16x16x32_bf16(*(const LAS s16x8*)(kp + 16 * ((unsigned)(4 + g4) ^ kr_x)), q1, a4, 0, 0, 0);
                const bool dead = (qb == 0 && kt < 8);
#pragma unroll
                for (int r_ = 0; r_ < 4; ++r_) { const float sv = dead ? -INFINITY : a4[r_] + bt[ta][r_]; a4[r_] = sv; mx = fmaxf(mx, sv); }
                S[ta] = a4; }
            mx = x16_max(mx); mx = x32_max(mx);
            float ps = 0.f;
#pragma unroll
            for (int ta = 0; ta < 9; ++ta)
#pragma unroll
                for (int r_ = 0; r_ < 4; ++r_) { const float pv = __expf(S[ta][r_] - mx); S[ta][r_] = pv; ps += pv; }
            ps = x16_sum(ps); ps = x32_sum(ps);
            const float inv = 1.0f / (ps + __expf(sink - mx));
            f32x4 O[4];
#pragma unroll
            for (int m = 0; m < 4; ++m) O[m] = (f32x4){0.f, 0.f, 0.f, 0.f};
#pragma unroll
            for (int pp = 0; pp < 5; ++pp) {
                const int ta = 2 * pp, tb = 2 * pp + 1;
                v4u pw_; pw_.x = cvt_pk(S[ta][0] * inv, S[ta][1] * inv); pw_.y = cvt_pk(S[ta][2] * inv, S[ta][3] * inv);
                if (tb < 9) { pw_.z = cvt_pk(S[tb < 9 ? tb : 0][0] * inv, S[tb < 9 ? tb : 0][1] * inv); pw_.w = cvt_pk(S[tb < 9 ? tb : 0][2] * inv, S[tb < 9 ? tb : 0][3] * inv); } else { pw_.z = 0u; pw_.w = 0u; }
                const s16x8 P = __builtin_bit_cast(s16x8, pw_);
                const LAS unsigned char* va = c.lds + 32768 + vr_off + 2048 * (j + ta); const LAS unsigned char* vb_ = c.lds + 32768 + vr_off + 2048 * (j + (tb < 9 ? tb : ta));
#pragma unroll
                for (int m = 0; m < 4; ++m) { const unsigned co = 16u * ((unsigned)(2 * m + vp1) ^ vr_x);
                    const s16x4 a0 = __builtin_amdgcn_ds_read_tr16_b64_v4i16((LAS s16x4*)(va + co)), a1 = __builtin_amdgcn_ds_read_tr16_b64_v4i16((LAS s16x4*)(vb_ + co));
                    O[m] = __builtin_amdgcn_mfma_f32_16x16x32_bf16(__builtin_shufflevector(a0, a1, 0, 1, 2, 3, 4, 5, 6, 7), P, O[m], 0, 0, 0); }
            }
#pragma unroll
            for (int m = 0; m < 4; ++m) *(v2u*)(qrow + 16 * m + 4 * g4) = (v2u){cvt_pk(O[m][0], O[m][1]), cvt_pk(O[m][2], O[m][3])};
        }
    }
    __syncthreads();
}

__device__ __forceinline__ void p6_ln_router(const Ctx& c, bf16* x1b) {
    const int lane = c.lane, wv = c.wave, l15 = lane & 15, g4 = lane >> 4;
    LAS unsigned char* XH = c.lds; LAS unsigned char* XL = c.lds + 32768;
    LAS float* PL = (LAS float*)(c.lds + 65536);
    LAS float* LG = (LAS float*)(c.lds + 65536 + 24576);
    const bf16* WH = (const bf16*)(c.ws + WS_WRT); const bf16* WL = WH + 48 * 1024;
    LAS unsigned* PEX = (LAS unsigned*)(c.lds + 65536 + 24576 + 4096);
    LAS unsigned* EB = PEX + 128;
    int nbase = 0;
    s16x8 wbh[4][3], wbl[4][3];
#pragma unroll
    for (int s_ = 0; s_ < 4; ++s_)
#pragma unroll
        for (int nt = 0; nt < 3; ++nt) { const size_t wo = (size_t)(16 * nt + l15) * 1024 + 128 * wv + 32 * s_ + 8 * g4; wbh[s_][nt] = *(const s16x8*)(WH + wo); wbl[s_][nt] = *(const s16x8*)(WL + wo); }
    f32x4 vn[2][4];
    if (c.bid < NTOK / 16) {
#pragma unroll
        for (int q = 0; q < 2; ++q)
#pragma unroll
            for (int j = 0; j < 4; ++j) vn[q][j] = ((const f32x4*)(c.out + (size_t)(c.bid * 16 + 2 * wv + q) * D) + lane)[64 * j]; }
    for (int u = c.bid; u < NTOK / 16; u += c.G) {
        __syncthreads();
#pragma unroll
        for (int q = 0; q < 2; ++q) { const int tk = 2 * wv + q, n = u * 16 + tk;
            f32x4 v[4]; float s = 0.f;
#pragma unroll
            for (int j = 0; j < 4; ++j) { v[j] = vn[q][j]; s += (v[j].x + v[j].y) + (v[j].z + v[j].w); }
            const float mean = wave_sum(s) * (1.f / D); float s2 = 0.f;
#pragma unroll
            for (int j = 0; j < 4; ++j) { v[j] = v[j] - mean; s2 += (v[j].x * v[j].x + v[j].y * v[j].y) + (v[j].z * v[j].z + v[j].w * v[j].w); }
            const float rstd = 1.f / sqrtf(wave_sum(s2) * (1.f / D) + LN_EPS);
#pragma unroll
            for (int j = 0; j < 4; ++j) { const int k0 = 4 * lane + 256 * j;
                const f32x4 g = *(const f32x4*)(c.ln1_g + k0), bb = *(const f32x4*)(c.ln1_b + k0);
                const f32x4 y = v[j] * rstd * g + bb;
                const unsigned h01 = pk2(y.x, y.y), h23 = pk2(y.z, y.w);
                *(v2u*)(x1b + (size_t)n * D + k0) = (v2u){h01, h23};
                const unsigned l01 = pk2(y.x - bflo(h01), y.y - bfhi(h01)), l23 = pk2(y.z - bflo(h23), y.w - bfhi(h23));
                const unsigned off = (unsigned)(tk * 2048 + ((((lane >> 1) + 32 * j) ^ tk) << 4) + 8 * (lane & 1));
                *(LAS v2u*)(XH + off) = (v2u){h01, h23}; *(LAS v2u*)(XL + off) = (v2u){l01, l23}; } }
        if (u + c.G < NTOK / 16) {
#pragma unroll
            for (int q = 0; q < 2; ++q)
#pragma unroll
                for (int j = 0; j < 4; ++j) vn[q][j] = ((const f32x4*)(c.out + (size_t)((u + c.G) * 16 + 2 * wv + q) * D) + lane)[64 * j]; }
        __syncthreads();
        { f32x4 acc[3];
#pragma unroll
          for (int nt = 0; nt < 3; ++nt) acc[nt] = (f32x4){0.f, 0.f, 0.f, 0.f};
#pragma unroll
          for (int s_ = 0; s_ < 4; ++s_) { const int chunk = 4 * (4 * wv + s_) + g4; const unsigned off = (unsigned)(l15 * 2048 + ((chunk ^ l15) << 4));
              const s16x8 ah = *(const LAS s16x8*)(XH + off), al = *(const LAS s16x8*)(XL + off);
#pragma unroll
              for (int nt = 0; nt < 3; ++nt) { const s16x8 bh = wbh[s_][nt], bl = wbl[s_][nt];
                  acc[nt] = __builtin_amdgcn_mfma_f32_16x16x32_bf16(al, bl, acc[nt], 0, 0, 0); acc[nt] = __builtin_amdgcn_mfma_f32_16x16x32_bf16(al, bh, acc[nt], 0, 0, 0);
                  acc[nt] = __builtin_amdgcn_mfma_f32_16x16x32_bf16(ah, bl, acc[nt], 0, 0, 0); acc[nt] = __builtin_amdgcn_mfma_f32_16x16x32_bf16(ah, bh, acc[nt], 0, 0, 0); } }
#pragma unroll
          for (int nt = 0; nt < 3; ++nt)
#pragma unroll
              for (int r_ = 0; r_ < 4; ++r_) PL[(wv * 16 + 4 * g4 + r_) * 48 + 16 * nt + l15] = acc[nt][r_]; }
        __syncthreads();
        for (int i = c.tid; i < 16 * 48; i += NTHR) { float a = 0.f;
#pragma unroll
            for (int w = 0; w < 8; ++w) a += PL[w * 768 + i];
            const int o = i % 48; a += o < 32 ? c.b_router[o] : (o < 36 ? c.b_group[o - 32] : 0.f);
            LG[i] = a; }
        __syncthreads();
        if (c.tid < 16) { const int n = u * 16 + c.tid; const LAS float* lg = LG + c.tid * 48; const int nloc = nbase + 2 * c.tid;
            int gs = 0; float gm = lg[32];
            for (int o = 1; o < 4; ++o) { const float v = lg[32 + o]; if (v > gm) { gm = v; gs = o; } }
            float gsum = 0.f;
            for (int o = 0; o < 4; ++o) gsum += __expf(lg[32 + o] - gm);
            const float gw_ = 1.0f / gsum;
            int i1 = 0; float m1 = lg[gs * 8];
            for (int o = 1; o < 8; ++o) { const float v = lg[gs * 8 + o]; if (v > m1) { m1 = v; i1 = o; } }
            int i2 = -1; float m2 = -INFINITY;
            for (int o = 0; o < 8; ++o) { const float v = lg[gs * 8 + o]; if (o != i1 && v > m2) { m2 = v; i2 = o; } }
            const float e2 = __expf(m2 - m1), w1 = gw_ / (1.0f + e2), w2 = gw_ * e2 / (1.0f + e2);
            const int ex1 = gs * 8 + i1, ex2 = gs * 8 + i2;
            ((unsigned*)(c.ws + WS_PE))[2 * n] = ex1; ((unsigned*)(c.ws + WS_PE))[2 * n + 1] = ex2; ((float*)(c.ws + WS_PW))[2 * n] = w1; ((float*)(c.ws + WS_PW))[2 * n + 1] = w2;
            PEX[nloc] = (unsigned)ex1 | ((unsigned)(2 * n) << 8); PEX[nloc + 1] = (unsigned)ex2 | ((unsigned)(2 * n + 1) << 8); }
        nbase += 32;
        if (nbase == 128 || u + c.G >= NTOK / 16) {
            __syncthreads();
            if (c.tid < 32) { unsigned cntE = 0; for (int j = 0; j < nbase; ++j) cntE += ((PEX[j] & 0xffu) == (unsigned)c.tid) ? 1u : 0u;
                EB[c.tid] = cntE ? atomicAdd(c.ctl + CW_CNT + c.tid, cntE) : 0u; }
            __syncthreads();
            if (c.tid < nbase) { const unsigned rec = PEX[c.tid], e = rec & 0xffu; unsigned rk = 0; for (int j = 0; j < c.tid; ++j) rk += ((PEX[j] & 0xffu) == e) ? 1u : 0u;
                ((unsigned*)(c.ws + WS_LIST))[(size_t)e * 32768 + EB[e] + rk] = rec >> 8; }
            nbase = 0;
        }
    }
    __syncthreads();
}


__device__ __forceinline__ void p9_ln2(const Ctx& c) {
    const int gw = c.bid * NWAVES + c.wave, NGW = c.G * NWAVES;
    f32x4 vn[4]; v2u san[4], sbn[4];
#define P9_LOAD(n_) do { const f32x4* r_ = (const f32x4*)(c.out + (size_t)(n_) * D) + c.lane; \
        _Pragma("unroll") for (int j = 0; j < 4; ++j) { const int k0 = 4 * c.lane + 256 * j; vn[j] = r_[64 * j]; \
            san[j] = *(const v2u*)((const bf16*)(c.ws + WS_SLOT) + (size_t)(2 * (n_)) * D + k0); sbn[j] = *(const v2u*)((const bf16*)(c.ws + WS_SLOT) + (size_t)(2 * (n_) + 1) * D + k0); } } while (0)
    if (gw < NTOK) P9_LOAD(gw);
    for (int n = gw; n < NTOK; n += NGW) {
        f32x4* row = (f32x4*)(c.out + (size_t)n * D) + c.lane;
        f32x4 v[4]; v2u sa[4], sb[4]; float s = 0.f;
#pragma unroll
        for (int j = 0; j < 4; ++j) { v[j] = vn[j]; sa[j] = san[j]; sb[j] = sbn[j]; s += (v[j].x + v[j].y) + (v[j].z + v[j].w); }
        if (n + NGW < NTOK) P9_LOAD(n + NGW);
        const float mean1 = wave_sum(s) * (1.f / D); float q1 = 0.f;
#pragma unroll
        for (int j = 0; j < 4; ++j) { v[j] = v[j] - mean1; q1 += (v[j].x * v[j].x + v[j].y * v[j].y) + (v[j].z * v[j].z + v[j].w * v[j].w); }
        const float rstd1 = 1.f / sqrtf(wave_sum(q1) * (1.f / D) + LN_EPS);
        s = 0.f;
#pragma unroll
        for (int j = 0; j < 4; ++j) { const int k0 = 4 * c.lane + 256 * j; const f32x4 g = *(const f32x4*)(c.ln1_g + k0), bb = *(const f32x4*)(c.ln1_b + k0);
            f32x4 y = (v[j] * rstd1 * g + bb) * ALPHA; y.x += bflo(sa[j].x) + bflo(sb[j].x); y.y += bfhi(sa[j].x) + bfhi(sb[j].x); y.z += bflo(sa[j].y) + bflo(sb[j].y); y.w += bfhi(sa[j].y) + bfhi(sb[j].y);
            v[j] = y; s += (y.x + y.y) + (y.z + y.w); }
        const float mean = wave_sum(s) * (1.f / D); float s2 = 0.f;
#pragma unroll
        for (int j = 0; j < 4; ++j) { v[j] = v[j] - mean; s2 += (v[j].x * v[j].x + v[j].y * v[j].y) + (v[j].z * v[j].z + v[j].w * v[j].w); }
        const float rstd = 1.f / sqrtf(wave_sum(s2) * (1.f / D) + LN_EPS);
#pragma unroll
        for (int j = 0; j < 4; ++j) { const int k0 = 4 * c.lane + 256 * j; const f32x4 g = *(const f32x4*)(c.ln2_g + k0), bb = *(const f32x4*)(c.ln2_b + k0); row[64 * j] = v[j] * rstd * g + bb; }
    }
#undef P9_LOAD
}

namespace pg8 {
typedef short bf16x8 __attribute__((ext_vector_type(8)));
constexpr int BM = 256, BK = 64, HALF = 128, HTB = HALF * BK * 2, STAGE_BYTES = 8 * HTB, NXCD = 8, WGM = 8;
__host__ __device__ __forceinline__ int lds_byte(int r, int c) { const int st = (r >> 4) * 2 + (c >> 5), rr = r & 15, cc = c & 31, ob = rr * 64 + cc * 2; return st * 1024 + (ob ^ (((ob >> 9) & 1) << 5)); }
__host__ __device__ __forceinline__ void stage_rc(int b, int& R, int& C) { const int st = b / 1024, sb = b % 1024, swz = sb ^ (((sb >> 9) & 1) << 5); R = (st >> 1) * 16 + swz / 64; C = (st & 1) * 32 + (swz % 64) / 2; }
__host__ __device__ __forceinline__ int perm32(int rho) { const int n = rho >> 4, i = rho & 15; return 8 * (i >> 2) + 4 * n + (i & 3); }
__device__ __forceinline__ unsigned cvt_pk_bf16(float lo, float hi) { unsigned r; asm volatile("v_cvt_pk_bf16_f32 %0, %1, %2" : "=v"(r) : "v"(lo), "v"(hi)); return r; }

struct Unit { int pm, pn, pb, aux; };

struct StaticOrder {
    int nM, nN, nwg, G, c;
    __device__ void init(int M, int N, int G_, int c_) { nM = M / BM; nN = N / BM; nwg = nM * nN; G = G_; c = c_; }
    __device__ bool next(int i, Unit& u) const {
        const long L = (long)i * G + c; if (L >= nwg) return false;
        int wgid = (int)L; { const int q = nwg / NXCD, r = nwg % NXCD, xcd = wgid % NXCD, off = wgid / NXCD; wgid = (xcd < r ? xcd * (q + 1) : r * (q + 1) + (xcd - r) * q) + off; }
        const int nig = WGM * nN, gid = wgid / nig, fm = gid * WGM, gsz = (nM - fm) < WGM ? (nM - fm) : WGM;
        u.pm = fm + ((wgid % nig) % gsz); u.pn = (wgid % nig) / gsz; u.pb = u.pn; u.aux = 0; return true;
    }
    __device__ __forceinline__ void a_ready(const Unit&) const {}
    __device__ __forceinline__ void done(const Unit&) const {}
};
struct DenseProb {
    static constexpr bool GATHER = false;
    const bf16* A; const bf16* Bt; int K;
    __device__ __forceinline__ const char* a_base(const Unit& u) const { return (const char*)A + (size_t)u.pm * 256 * K * 2; }
    __device__ __forceinline__ const char* b_base(const Unit& u) const { return (const char*)Bt + (size_t)u.pb * 256 * K * 2; }
    __device__ __forceinline__ void a_offs(const Unit&, int R0, int C0, int R1, int C1, unsigned (&o)[2][2]) const {
        o[0][0] = (unsigned)(R0 * K + C0) * 2u; o[0][1] = (unsigned)(R1 * K + C1) * 2u; o[1][0] = o[0][0] + (unsigned)(HALF * K * 2); o[1][1] = o[0][1] + (unsigned)(HALF * K * 2); }
};

template <class Prob, class Epi, class Sched>
__device__ __forceinline__ void gemm_phase(LAS unsigned char* lds, const Prob& P, const Sched& S, const Epi& E) {
    const int tid = threadIdx.x, wid = __builtin_amdgcn_readfirstlane(tid >> 6), lane = tid & 63, wr = wid >> 2, wc = wid & 3, fr = lane & 15, fq = lane >> 4;
    const int K = P.K, nt = K / BK;
    int sR[2], sC[2];
    unsigned offB[2][2], offA[2][2];
#pragma unroll
    for (int i = 0; i < 2; ++i) { stage_rc(tid * 16 + i * 8192, sR[i], sC[i]); const int Rb = Epi::PERM ? ((sR[i] & ~31) + perm32(sR[i] & 31)) : sR[i];
        offB[0][i] = (unsigned)(Rb * K + sC[i]) * 2u; offB[1][i] = offB[0][i] + (unsigned)(HALF * K * 2); }
    const size_t kstep = (size_t)(BK * 2);
    const unsigned ldsw = (unsigned)wid * 1024u;
    const int aoff = lds_byte(wr * 64 + fr, fq * 8), boff = lds_byte(wc * 32 + fr, fq * 8);
#define PG8_SA(b, h) (((b) * 2 + (h)) * HTB)
#define PG8_SB(b, h) ((4 + (b) * 2 + (h)) * HTB)
#define PG8_STAGE(bufoff, gbase, offs) do { _Pragma("unroll") for (int _i = 0; _i < 2; ++_i) \
        __builtin_amdgcn_global_load_lds((const unsigned*)((gbase) + (offs)[_i]), (LAS unsigned*)(lds + (bufoff) + ldsw + _i * 8192), 16, 0, 0); } while (0)
#define PG8_STA(b, h, tau) PG8_STAGE(PG8_SA(b, h), sA + (size_t)(tau) * kstep, offA[h])
#define PG8_STB(b, h, tau) PG8_STAGE(PG8_SB(b, h), sB + (size_t)(tau) * kstep, offB[h])
#define PG8_LDA(dst, b, h) do { _Pragma("unroll") for (int m = 0; m < 4; ++m) _Pragma("unroll") for (int k = 0; k < 2; ++k) dst[m][k] = *(const LAS bf16x8*)(lds + PG8_SA(b, h) + aoff + m * 2048 + k * 1024); } while (0)
#define PG8_LDB(dst, b, h) do { _Pragma("unroll") for (int n = 0; n < 2; ++n) _Pragma("unroll") for (int k = 0; k < 2; ++k) dst[n][k] = *(const LAS bf16x8*)(lds + PG8_SB(b, h) + boff + n * 2048 + k * 1024); } while (0)
#define PG8_MMA(ai, bj, At, Bt) do { __builtin_amdgcn_s_setprio(1); _Pragma("unroll") for (int m = 0; m < 4; ++m) _Pragma("unroll") for (int n = 0; n < 2; ++n) _Pragma("unroll") for (int k = 0; k < 2; ++k) \
        acc[ai][bj][m][n] = __builtin_amdgcn_mfma_f32_16x16x32_bf16(Bt[n][k], At[m][k], acc[ai][bj][m][n], 0, 0, 0); __builtin_amdgcn_s_setprio(0); } while (0)
#define PG8_WAIT_V(n) asm volatile("s_waitcnt vmcnt(" #n ")" ::: "memory")
#define PG8_WAIT_L(n) asm volatile("s_waitcnt lgkmcnt(" #n ")" ::: "memory")
#define PG8_BAR __builtin_amdgcn_s_barrier()
#define PG8_SCHED __builtin_amdgcn_sched_barrier(0)
    Unit cur, nxt; int ui = 0;
    if (!S.next(0, cur)) return;
    f32x4 acc[2][2][4][2];
#pragma unroll
    for (int a = 0; a < 2; ++a)
#pragma unroll
        for (int b = 0; b < 2; ++b)
#pragma unroll
            for (int m = 0; m < 4; ++m)
#pragma unroll
                for (int n = 0; n < 2; ++n) acc[a][b][m][n] = (f32x4){0.f, 0.f, 0.f, 0.f};
    bf16x8 At[4][2], B0[2][2], B1[2][2];
    const char* sA = P.a_base(cur); const char* sB = P.b_base(cur);
    S.a_ready(cur);
    P.a_offs(cur, sR[0], sC[0], sR[1], sC[1], offA);
    PG8_STB(0, 0, 0); PG8_STB(0, 1, 0); PG8_STA(0, 0, 0); PG8_STA(0, 1, 0);
    if (wr == 1) PG8_BAR;
    PG8_WAIT_V(2); PG8_BAR;
    PG8_STB(1, 0, 1); PG8_STA(1, 0, 1); PG8_STB(1, 1, 1);
    PG8_WAIT_V(6); PG8_BAR;
    for (;;) {
        const bool has_next = S.next(ui + 1, nxt);
        unsigned nOffA[2][2];
        if (Prob::GATHER) { if (has_next) P.a_offs(nxt, sR[0], sC[0], sR[1], sC[1], nOffA); else {
#pragma unroll
            for (int h = 0; h < 2; ++h)
#pragma unroll
                for (int i = 0; i < 2; ++i) nOffA[h][i] = offA[h][i]; } }
        const char* nA = has_next ? P.a_base(nxt) : sA; const char* nB = has_next ? P.b_base(nxt) : sB;
        for (int t = 0; t < nt; t += 2) {
            const bool last = (t == nt - 2);
            if (last && has_next) S.a_ready(nxt);
            PG8_LDB(B0, 0, 0); PG8_LDB(B1, 0, 1); PG8_SCHED; PG8_LDA(At, 0, 0); PG8_STA(1, 1, t + 1);
            PG8_WAIT_V(8); PG8_WAIT_L(0); PG8_BAR; PG8_MMA(0, 0, At, B0); PG8_MMA(0, 1, At, B1); PG8_BAR; PG8_SCHED;
            if (last) {
                sA = nA - (size_t)nt * kstep; sB = nB - (size_t)nt * kstep;
                if (Prob::GATHER) {
#pragma unroll
                    for (int h = 0; h < 2; ++h)
#pragma unroll
                        for (int i = 0; i < 2; ++i) offA[h][i] = nOffA[h][i]; }
            }
            PG8_LDA(At, 0, 1); PG8_STB(0, 0, t + 2); PG8_STB(0, 1, t + 2); PG8_STA(0, 0, t + 2);
            PG8_WAIT_V(8); PG8_WAIT_L(0); PG8_BAR; PG8_MMA(1, 0, At, B0); PG8_MMA(1, 1, At, B1); PG8_BAR; PG8_SCHED;
            PG8_LDB(B0, 1, 0); PG8_LDB(B1, 1, 1); PG8_SCHED; PG8_LDA(At, 1, 0); PG8_STA(0, 1, t + 2);
            PG8_WAIT_V(8); PG8_WAIT_L(0); PG8_BAR; PG8_MMA(0, 0, At, B0); PG8_MMA(0, 1, At, B1); PG8_BAR; PG8_SCHED;
            PG8_LDA(At, 1, 1); PG8_STB(1, 0, t + 3); PG8_STB(1, 1, t + 3); PG8_STA(1, 0, t + 3);
            PG8_WAIT_V(8); PG8_WAIT_L(0); PG8_BAR; PG8_MMA(1, 0, At, B0); PG8_MMA(1, 1, At, B1); PG8_BAR; PG8_SCHED;
        }
        if (wr == 0) PG8_BAR;
        E(acc, cur, wr, wc, fr, fq); S.done(cur);
        if (!has_next) break;
#pragma unroll
        for (int a = 0; a < 2; ++a)
#pragma unroll
            for (int b = 0; b < 2; ++b)
#pragma unroll
                for (int m = 0; m < 4; ++m)
#pragma unroll
                    for (int n = 0; n < 2; ++n) acc[a][b][m][n] = (f32x4){0.f, 0.f, 0.f, 0.f};
        cur = nxt; ++ui; sA = nA; sB = nB;
        if (wr == 1) PG8_BAR;
    }
    PG8_WAIT_V(0);
    PG8_BAR;
#undef PG8_SA
#undef PG8_SB
#undef PG8_STAGE
#undef PG8_STA
#undef PG8_STB
#undef PG8_LDA
#undef PG8_LDB
#undef PG8_MMA
#undef PG8_WAIT_V
#undef PG8_WAIT_L
#undef PG8_BAR
#undef PG8_SCHED
}

template <class Epi, class Sched>
__device__ __forceinline__ void gemm_phase_dual(LAS unsigned char* lds, const bf16* A1, const bf16* Bt1, int K1, const bf16* A2, const bf16* Bt2, int K2, const Sched& S, const Epi& E) {
    const int tid = threadIdx.x, wid = __builtin_amdgcn_readfirstlane(tid >> 6), lane = tid & 63, wr = wid >> 2, wc = wid & 3, fr = lane & 15, fq = lane >> 4;
    const int nt1 = K1 / BK, nt = (K1 + K2) / BK;
    unsigned offB1[2][2], offA1[2][2]; const unsigned dK2 = (unsigned)(2 * (K2 - K1));
#pragma unroll
    for (int i = 0; i < 2; ++i) { int R, C; stage_rc(tid * 16 + i * 8192, R, C); const int Rb = (R & ~31) + perm32(R & 31);
        offA1[0][i] = (unsigned)(R * K1 + C) * 2u; offA1[1][i] = offA1[0][i] + (unsigned)(HALF * K1 * 2); offB1[0][i] = (unsigned)(Rb * K1 + C) * 2u; offB1[1][i] = offB1[0][i] + (unsigned)(HALF * K1 * 2); }
    const size_t kstep = (size_t)(BK * 2);
    const unsigned ldsw = (unsigned)wid * 1024u;
    const int aoff = lds_byte(wr * 64 + fr, fq * 8), boff = lds_byte(wc * 32 + fr, fq * 8);
#define PG8_SA(b, h) (((b) * 2 + (h)) * HTB)
#define PG8_SB(b, h) ((4 + (b) * 2 + (h)) * HTB)
#define PG8_STX(bufoff, tau, g1, g2, o1, o2) do { const int _t = (tau); const bool _s2 = _t >= nt1; const long long _d = _s2 ? (long long)((g2) - (g1)) - (long long)nt1 * (long long)kstep : 0ll; const char* _g = (g1) + (size_t)_t * kstep + _d; \
        _Pragma("unroll") for (int _i = 0; _i < 2; ++_i) { const unsigned _o = (o1)[_i] + (_s2 ? ((o1)[_i] >> 11) * dK2 : 0u); \
        __builtin_amdgcn_global_load_lds((const unsigned*)(_g + _o), (LAS unsigned*)(lds + (bufoff) + ldsw + _i * 8192), 16, 0, 0); } } while (0)
#define PG8_STA(b, h, tau) PG8_STX(PG8_SA(b, h), tau, sA1, sA2, offA1[h], 0)
#define PG8_STB(b, h, tau) PG8_STX(PG8_SB(b, h), tau, sB1, sB2, offB1[h], 0)
#define PG8_LDA(dst, b, h) do { _Pragma("unroll") for (int m = 0; m < 4; ++m) _Pragma("unroll") for (int k = 0; k < 2; ++k) dst[m][k] = *(const LAS bf16x8*)(lds + PG8_SA(b, h) + aoff + m * 2048 + k * 1024); } while (0)
#define PG8_LDB(dst, b, h) do { _Pragma("unroll") for (int n = 0; n < 2; ++n) _Pragma("unroll") for (int k = 0; k < 2; ++k) dst[n][k] = *(const LAS bf16x8*)(lds + PG8_SB(b, h) + boff + n * 2048 + k * 1024); } while (0)
#define PG8_MMA(ai, bj, At, Bt) do { __builtin_amdgcn_s_setprio(1); _Pragma("unroll") for (int m = 0; m < 4; ++m) _Pragma("unroll") for (int n = 0; n < 2; ++n) _Pragma("unroll") for (int k = 0; k < 2; ++k) \
        acc[ai][bj][m][n] = __builtin_amdgcn_mfma_f32_16x16x32_bf16(Bt[n][k], At[m][k], acc[ai][bj][m][n], 0, 0, 0); __builtin_amdgcn_s_setprio(0); } while (0)
#define PG8_WAIT_V(n) asm volatile("s_waitcnt vmcnt(" #n ")" ::: "memory")
#define PG8_WAIT_L(n) asm volatile("s_waitcnt lgkmcnt(" #n ")" ::: "memory")
#define PG8_BAR __builtin_amdgcn_s_barrier()
#define PG8_SCHED __builtin_amdgcn_sched_barrier(0)
    Unit cur, nxt; int ui = 0;
    if (!S.next(0, cur)) return;
    f32x4 acc[2][2][4][2];
#pragma unroll
    for (int a = 0; a < 2; ++a)
#pragma unroll
        for (int b = 0; b < 2; ++b)
#pragma unroll
            for (int m = 0; m < 4; ++m)
#pragma unroll
                for (int n = 0; n < 2; ++n) acc[a][b][m][n] = (f32x4){0.f, 0.f, 0.f, 0.f};
    bf16x8 At[4][2], B0[2][2], B1[2][2];
    const char* sA1 = (const char*)A1 + (size_t)cur.pm * 256 * K1 * 2; const char* sB1 = (const char*)Bt1 + (size_t)cur.pn * 256 * K1 * 2;
    const char* sA2 = (const char*)A2 + (size_t)cur.pm * 256 * K2 * 2; const char* sB2 = (const char*)Bt2 + (size_t)cur.pn * 256 * K2 * 2;
    PG8_STB(0, 0, 0); PG8_STB(0, 1, 0); PG8_STA(0, 0, 0); PG8_STA(0, 1, 0);
    if (wr == 1) PG8_BAR;
    PG8_WAIT_V(2); PG8_BAR;
    PG8_STB(1, 0, 1); PG8_STA(1, 0, 1); PG8_STB(1, 1, 1);
    PG8_WAIT_V(6); PG8_BAR;
    for (;;) {
        const bool has_next = S.next(ui + 1, nxt);
        const int npm = has_next ? nxt.pm : cur.pm, npn = has_next ? nxt.pn : cur.pn;
        const char* nA1 = (const char*)A1 + (size_t)npm * 256 * K1 * 2; const char* nB1 = (const char*)Bt1 + (size_t)npn * 256 * K1 * 2;
        const char* nA2 = (const char*)A2 + (size_t)npm * 256 * K2 * 2; const char* nB2 = (const char*)Bt2 + (size_t)npn * 256 * K2 * 2;
        for (int t = 0; t < nt; t += 2) {
            const bool last = (t == nt - 2);
            const int t2 = last ? 0 : t + 2, t3 = last ? 1 : t + 3;
            if (t == nt1) { E.mid(acc, cur, wr, wc, fr, fq); PG8_SCHED; }
            PG8_LDB(B0, 0, 0); PG8_LDB(B1, 0, 1); PG8_SCHED; PG8_LDA(At, 0, 0); PG8_STA(1, 1, t + 1);
            PG8_WAIT_V(8); PG8_WAIT_L(0); PG8_BAR; PG8_MMA(0, 0, At, B0); PG8_MMA(0, 1, At, B1); PG8_BAR; PG8_SCHED;
            if (last) { sA1 = nA1; sB1 = nB1; sA2 = nA2; sB2 = nB2; }
            PG8_LDA(At, 0, 1); PG8_STB(0, 0, t2); PG8_STB(0, 1, t2); PG8_STA(0, 0, t2);
            PG8_WAIT_V(8); PG8_WAIT_L(0); PG8_BAR; PG8_MMA(1, 0, At, B0); PG8_MMA(1, 1, At, B1); PG8_BAR; PG8_SCHED;
            PG8_LDB(B0, 1, 0); PG8_LDB(B1, 1, 1); PG8_SCHED; PG8_LDA(At, 1, 0); PG8_STA(0, 1, t2);
            PG8_WAIT_V(8); PG8_WAIT_L(0); PG8_BAR; PG8_MMA(0, 0, At, B0); PG8_MMA(0, 1, At, B1); PG8_BAR; PG8_SCHED;
            PG8_LDA(At, 1, 1); PG8_STB(1, 0, t3); PG8_STB(1, 1, t3); PG8_STA(1, 0, t3);
            PG8_WAIT_V(8); PG8_WAIT_L(0); PG8_BAR; PG8_MMA(1, 0, At, B0); PG8_MMA(1, 1, At, B1); PG8_BAR; PG8_SCHED;
        }
        if (wr == 0) PG8_BAR;
        E(acc, cur, wr, wc, fr, fq);
        if (!has_next) break;
#pragma unroll
        for (int a = 0; a < 2; ++a)
#pragma unroll
            for (int b = 0; b < 2; ++b)
#pragma unroll
                for (int m = 0; m < 4; ++m)
#pragma unroll
                    for (int n = 0; n < 2; ++n) acc[a][b][m][n] = (f32x4){0.f, 0.f, 0.f, 0.f};
        cur = nxt; ++ui;
        if (wr == 1) PG8_BAR;
    }
    PG8_WAIT_V(0);
    PG8_BAR;
#undef PG8_SA
#undef PG8_SB
#undef PG8_STX
#undef PG8_STA
#undef PG8_STB
#undef PG8_LDA
#undef PG8_LDB
#undef PG8_MMA
#undef PG8_WAIT_V
#undef PG8_WAIT_L
#undef PG8_BAR
#undef PG8_SCHED
}
__device__ __forceinline__ v4u pack8(f32x4 v0, f32x4 v1) { v4u w; w.x = cvt_pk_bf16(v0[0], v0[1]); w.y = cvt_pk_bf16(v0[2], v0[3]); w.z = cvt_pk_bf16(v1[0], v1[1]); w.w = cvt_pk_bf16(v1[2], v1[3]); return w; }
__device__ __forceinline__ float sigm(float v) { return __builtin_amdgcn_rcpf(1.0f + __expf(-v)); }

struct EpiMergedDual {
    static constexpr bool PERM = true;
    const bf16* ga; const bf16* gb; bf16* merged;
    __device__ __forceinline__ void mid(f32x4 (&acc)[2][2][4][2], const Unit& u, int wr, int wc, int fr, int fq) const {
        int row0 = u.pm * BM + wr * 64 + fr; const int col0 = u.pn * BM + wc * 32 + 8 * fq;
        asm volatile("" : "+v"(row0));
#pragma unroll
        for (int ai = 0; ai < 2; ++ai)
#pragma unroll
            for (int m = 0; m < 4; ++m) { const size_t o = (size_t)(row0 + ai * HALF + m * 16) * 1024 + col0;
#pragma unroll
                for (int bj = 0; bj < 2; ++bj) { const v4u a = *(const v4u*)(ga + o + bj * HALF), b = *(const v4u*)(gb + o + bj * HALF);
                    f32x4 r0 = {bflo(a.x) * __builtin_amdgcn_rcpf(bflo(b.x)), bfhi(a.x) * __builtin_amdgcn_rcpf(bfhi(b.x)), bflo(a.y) * __builtin_amdgcn_rcpf(bflo(b.y)), bfhi(a.y) * __builtin_amdgcn_rcpf(bfhi(b.y))};
                    f32x4 r1 = {bflo(a.z) * __builtin_amdgcn_rcpf(bflo(b.z)), bfhi(a.z) * __builtin_amdgcn_rcpf(bfhi(b.z)), bflo(a.w) * __builtin_amdgcn_rcpf(bflo(b.w)), bfhi(a.w) * __builtin_amdgcn_rcpf(bfhi(b.w))};
                    acc[ai][bj][m][0] = acc[ai][bj][m][0] * r0; acc[ai][bj][m][1] = acc[ai][bj][m][1] * r1; }
                asm volatile("" ::: "memory"); }
    }
    __device__ __forceinline__ void operator()(const f32x4 (&acc)[2][2][4][2], const Unit& u, int wr, int wc, int fr, int fq) const {
        int row0 = u.pm * BM + wr * 64 + fr; const int col0 = u.pn * BM + wc * 32 + 8 * fq;
        asm volatile("" : "+v"(row0));
#pragma unroll
        for (int ai = 0; ai < 2; ++ai)
#pragma unroll
            for (int m = 0; m < 4; ++m) { const size_t o = (size_t)(row0 + ai * HALF + m * 16) * 1024 + col0;
#pragma unroll
                for (int bj = 0; bj < 2; ++bj) { const v4u g = *(const v4u*)(gb + o + bj * HALF);
                    f32x4 g0 = {bflo(g.x), bfhi(g.x), bflo(g.y), bfhi(g.y)}, g1 = {bflo(g.z), bfhi(g.z), bflo(g.w), bfhi(g.w)};
                    *(v4u*)(merged + o + bj * HALF) = pack8(g0 * acc[ai][bj][m][0], g1 * acc[ai][bj][m][1]); } }
    }
};
struct EpiProj {
    static constexpr bool PERM = true;
    unsigned char* ws;
    __device__ __forceinline__ void operator()(const f32x4 (&acc)[2][2][4][2], const Unit& u, int wr, int wc, int fr, int fq) const {
        const int row0 = u.pm * BM + wr * 64 + fr, cw = wc * 32 + 8 * fq, pn = u.pn;
        if (pn == 4) {
#pragma unroll
            for (int ai = 0; ai < 2; ++ai)
#pragma unroll
                for (int m = 0; m < 4; ++m) { const size_t row = (size_t)(row0 + ai * HALF + m * 16);
                    float* cr = (float*)(ws + WS_CKVRAW) + row * 128 + cw; *(f32x4*)cr = acc[ai][0][m][0]; *(f32x4*)(cr + 4) = acc[ai][0][m][1];
                    if (cw < 64) *(v4u*)((bf16*)(ws + WS_KIDX) + ((((row >> 4) * 8 + (cw >> 3)) * 16 + (row & 15)) << 3)) = pack8(acc[ai][1][m][0], acc[ai][1][m][1]);
                    else if (cw == 64) { float* wr_ = (float*)(ws + WS_WIDX) + row * 8; *(f32x4*)wr_ = acc[ai][1][m][0] * IDXW_SCALE; *(f32x4*)(wr_ + 4) = acc[ai][1][m][1] * IDXW_SCALE; } }
            return;
        }
        bf16* base; int ld, c0; float sc = 1.f; bool sg = false;
        if (pn < 4) { base = (bf16*)(ws + WS_QLAT); ld = 1024; c0 = pn * 256; sc = ATT_SCALE; }
        else if (pn < 7) { base = (bf16*)(ws + WS_QIDX); ld = 512; c0 = (pn - 5) * 256; }
        else if (pn < 9) { base = (bf16*)(ws + WS_QB); ld = 512; c0 = (pn - 7) * 256; sc = 0.125f; }
        else if (pn == 9) { base = (bf16*)(ws + WS_KB); ld = 128; c0 = 0; }
        else if (pn < 14) { base = (bf16*)(ws + WS_GA); ld = 1024; c0 = (pn - 10) * 256; sg = true; }
        else { base = (bf16*)(ws + WS_GB); ld = 1024; c0 = (pn - 14) * 256; sg = true; }
        const size_t bjstep = (pn == 9) ? (size_t)(WS_VB - WS_KB) / 2 : (size_t)HALF;
#pragma unroll
        for (int ai = 0; ai < 2; ++ai)
#pragma unroll
            for (int m = 0; m < 4; ++m) { bf16* rowp = base + (size_t)(row0 + ai * HALF + m * 16) * ld + c0 + cw;
#pragma unroll
                for (int bj = 0; bj < 2; ++bj) { f32x4 v0 = acc[ai][bj][m][0], v1 = acc[ai][bj][m][1];
                    if (sg) {
#pragma unroll
                        for (int j = 0; j < 4; ++j) { v0[j] = sigm(v0[j]); v1[j] = sigm(v1[j]); } }
                    else { v0 = v0 * sc; v1 = v1 * sc; }
                    *(v4u*)(rowp + bj * bjstep) = pack8(v0, v1); } }
    }
};
struct EpiWoutM {
    static constexpr bool PERM = true;
    const float* x; float* out;
    __device__ __forceinline__ void operator()(const f32x4 (&acc)[2][2][4][2], const Unit& u, int wr, int wc, int fr, int fq) const {
        const int row0 = u.pm * BM + wr * 64 + fr, col0 = u.pn * BM + wc * 32 + 8 * fq;
#pragma unroll
        for (int ai = 0; ai < 2; ++ai)
#pragma unroll
            for (int m = 0; m < 4; ++m) { const size_t o = (size_t)(row0 + ai * HALF + m * 16) * 1024 + col0;
#pragma unroll
                for (int bj = 0; bj < 2; ++bj) { const f32x4 x0 = *(const f32x4*)(x + o + bj * HALF), x1 = *(const f32x4*)(x + o + bj * HALF + 4);
                    *(f32x4*)(out + o + bj * HALF) = x0 * ALPHA + acc[ai][bj][m][0]; *(f32x4*)(out + o + bj * HALF + 4) = x1 * ALPHA + acc[ai][bj][m][1]; } }
    }
};
constexpr int MOE_TB_OFF = 131072 + 1024;
constexpr int CW_RDY = 16384;
constexpr int CW_TMO = 8;
struct MoeOrder {
    const LAS int* tb; int npn, G, c; unsigned* ctl;
    __device__ bool next(int i, Unit& u) const {
        const int L = i * G + c; if (L >= tb[32] * npn) return false;
        const int rt = L / npn, pn = L - rt * npn; int e = 0;
        for (int j = 1; j < 32; ++j) e = (tb[j] <= rt) ? j : e;
        u.pm = rt; u.pn = pn; u.pb = e * npn + pn; u.aux = e; return true;
    }
    __device__ __forceinline__ void a_ready(const Unit&) const {}
    __device__ __forceinline__ void done(const Unit& u) const {
        asm volatile("s_waitcnt vmcnt(0)" ::: "memory");
        if ((threadIdx.x & 63) == 0) __hip_atomic_fetch_add(ctl + CW_RDY + 64 * u.pm, 1u, __ATOMIC_RELAXED, __HIP_MEMORY_SCOPE_AGENT);
    }
};
struct MoeDownOrder {
    const LAS int* tb; int G, c; unsigned* ctl;
    __device__ bool next(int i, Unit& u) const {
        const int nT = tb[32], nD = 4 * nT; int R = 2 * nT - G; R = R < 0 ? 0 : (R > G ? G : R);
        int L;
        if (c >= R) { L = (i < 4) ? i * (G - R) + (c - R) : 4 * (G - R) + (i - 4) * G + c; }
        else { L = 4 * (G - R) + i * G + c; }
        if (L >= nD) return false;
        const int rt = L >> 2, pn = L & 3; int e = 0;
        for (int j = 1; j < 32; ++j) e = (tb[j] <= rt) ? j : e;
        u.pm = rt; u.pn = pn; u.pb = e * 4 + pn; u.aux = e; return true;
    }
    __device__ __forceinline__ void a_ready(const Unit& u) const {
        if (threadIdx.x < 64) {
            unsigned* w = ctl + CW_RDY + 64 * u.pm; unsigned sp = 0;
            while ((unsigned)__builtin_amdgcn_readfirstlane(__hip_atomic_load(w, __ATOMIC_RELAXED, __HIP_MEMORY_SCOPE_AGENT)) < 16u) {
                __builtin_amdgcn_s_sleep(2);
                if ((++sp & 1023u) == 0u) { if (__hip_atomic_load(ctl + CW_TMO, __ATOMIC_RELAXED, __HIP_MEMORY_SCOPE_AGENT) != 0u) break;
                    if (sp > (1u << 22)) { __hip_atomic_store(ctl + CW_TMO, 1u, __ATOMIC_RELAXED, __HIP_MEMORY_SCOPE_AGENT); break; } } }
            __builtin_amdgcn_fence(__ATOMIC_ACQUIRE, "agent");
            asm volatile("s_waitcnt vmcnt(0)" ::: "memory");
        }
        asm volatile("" ::: "memory"); __builtin_amdgcn_s_barrier(); asm volatile("" ::: "memory");
    }
    __device__ __forceinline__ void done(const Unit&) const {}
};
struct GatherProb {
    static constexpr bool GATHER = true;
    const bf16* A; const bf16* Bt; int K; const LAS int* tb; const unsigned* list;
    __device__ __forceinline__ const char* a_base(const Unit&) const { return (const char*)A; }
    __device__ __forceinline__ const char* b_base(const Unit& u) const { return (const char*)Bt + (size_t)u.pb * 256 * K * 2; }
    __device__ __forceinline__ void a_offs(const Unit& u, int R0, int C0, int R1, int C1, unsigned (&o)[2][2]) const {
        const int e = u.aux, lbase = (u.pm - tb[e]) * 256, cnt = tb[64 + e];
        const unsigned* le = list + (size_t)e * 32768;
#pragma unroll
        for (int h = 0; h < 2; ++h) { const int l0 = lbase + h * HALF + R0, l1 = lbase + h * HALF + R1;
            const unsigned t0 = l0 < cnt ? (le[l0] >> 1) : 0u, t1 = l1 < cnt ? (le[l1] >> 1) : 0u;
            o[h][0] = (t0 * (unsigned)K + (unsigned)C0) * 2u; o[h][1] = (t1 * (unsigned)K + (unsigned)C1) * 2u; }
    }
};
struct EpiGU {
    static constexpr bool PERM = true;
    bf16* hbuf;
    __device__ __forceinline__ void operator()(const f32x4 (&acc)[2][2][4][2], const Unit& u, int wr, int wc, int fr, int fq) const {
        const int row0 = u.pm * BM + wr * 64 + fr, col0 = u.pn * HALF + wc * 32 + 8 * fq;
#pragma unroll
        for (int ai = 0; ai < 2; ++ai)
#pragma unroll
            for (int m = 0; m < 4; ++m) { f32x4 h0, h1;
#pragma unroll
                for (int j = 0; j < 4; ++j) { const float g0 = acc[ai][0][m][0][j], g1 = acc[ai][0][m][1][j];
                    h0[j] = g0 * sigm(g0) * acc[ai][1][m][0][j]; h1[j] = g1 * sigm(g1) * acc[ai][1][m][1][j]; }
                { const v4u hv = pack8(h0, h1); bf16* hp = hbuf + (size_t)(row0 + ai * HALF + m * 16) * 256 + col0;
                  asm volatile("global_store_dwordx4 %0, %1, off sc1\n\ts_nop 1" :: "v"(hp), "v"(hv) : "memory"); } }
    }
};
struct EpiDown {
    static constexpr bool PERM = true;
    bf16* slot; const LAS int* tb; const unsigned* list; const float* pw;
    __device__ __forceinline__ void operator()(const f32x4 (&acc)[2][2][4][2], const Unit& u, int wr, int wc, int fr, int fq) const {
        const int e = u.aux, lbase = (u.pm - tb[e]) * 256 + wr * 64 + fr, cnt = tb[64 + e], col0 = u.pn * BM + wc * 32 + 8 * fq;
        const unsigned* le = list + (size_t)e * 32768;
#pragma unroll
        for (int ai = 0; ai < 2; ++ai)
#pragma unroll
            for (int m = 0; m < 4; ++m) { const int l = lbase + ai * HALF + m * 16;
                if (l < cnt) { const unsigned pair = le[l]; const float w = pw[pair]; bf16* rowp = slot + (size_t)pair * 1024 + col0;
#pragma unroll
                    for (int bj = 0; bj < 2; ++bj) *(v4u*)(rowp + bj * HALF) = pack8(acc[ai][bj][m][0] * w, acc[ai][bj][m][1] * w); } }
    }
};
}

struct Args { const float* in[20]; float* out; unsigned char* ws; int ph_lo, ph_hi; };
__global__ void __launch_bounds__(NTHR, 2) fwd_kernel(Args args) {
    extern __shared__ __attribute__((aligned(16))) unsigned char lds_raw[];
    Ctx c;
    c.lds = (LAS unsigned char*)lds_raw;
    c.tid = threadIdx.x; c.lane = c.tid & 63; c.wave = __builtin_amdgcn_readfirstlane(c.tid >> 6); c.bid = blockIdx.x; c.G = gridDim.x;
    c.x = args.in[0]; c.w_in = args.in[1]; c.kv_g = args.in[2]; c.w_uv = args.in[3]; c.w_a = args.in[4]; c.sinks = args.in[5]; c.w_b = args.in[6]; c.w_out = args.in[7]; c.rel_bias = args.in[8];
    c.ln1_g = args.in[9]; c.ln1_b = args.in[10]; c.w_group = args.in[11]; c.b_group = args.in[12]; c.w_router = args.in[13]; c.b_router = args.in[14]; c.w_gate = args.in[15]; c.w_up = args.in[16]; c.w_down = args.in[17];
    c.ln2_g = args.in[18]; c.ln2_b = args.in[19]; c.out = args.out; c.ws = args.ws; unsigned char* ws = args.ws;
    c.ctl = (unsigned*)(ws + WS_CTL);
    volatile LAS unsigned* MISC = (volatile LAS unsigned*)(c.lds + MISC_OFF);
    if (c.tid < 32) MISC[c.tid] = 0u;
    __syncthreads();
    XcdBarrier bar; bar.bar = c.ctl + CW_BAR; bar.x = 0; bar.st = nullptr;
    if (MK_N_LAUNCHES == 1) bar = xcd_barrier_post(c.ctl + CW_BAR, MISC + 8);
    const int lo = args.ph_lo, hi = args.ph_hi;
#define IN(k) (lo <= (k) && (k) < hi)
#define SEAM(k) do { if (IN(k) && IN((k) + 1)) xcd_barrier(bar); } while (0)
    bf16* merged = ((bf16*)(c.ws + WS_QLAT)); bf16* x1b = ((bf16*)(c.ws + WS_XB));

    if (IN(0)) { p0_prologue(c); } SEAM(0);
    if (IN(1)) { pg8::DenseProb P{(const bf16*)(c.ws + WS_XB), (const bf16*)(c.ws + WS_WIN), 1024}; pg8::StaticOrder S; S.init(NTOK, NPROJ, c.G, c.bid); pg8::EpiProj E{c.ws};
        pg8::gemm_phase(c.lds, P, S, E); } SEAM(1);
    if (IN(2)) { p_rmsnorm(c); __syncthreads(); p2_indexer_topk(c); } SEAM(2);
    if (IN(3)) { p3a_dsa(c); p3b_swa(c); } SEAM(3);
    if (IN(4)) { pg8::StaticOrder S; S.init(NTOK, 1024, c.G, c.bid); pg8::EpiMergedDual E{(const bf16*)(c.ws + WS_GA), (const bf16*)(c.ws + WS_GB), merged};
        pg8::gemm_phase_dual(c.lds, (const bf16*)(c.ws + WS_XB), (const bf16*)(c.ws + WS_WC), 1024, (const bf16*)(c.ws + WS_QB), (const bf16*)(c.ws + WS_WB), 512, S, E); } SEAM(4);
    if (IN(5)) { pg8::DenseProb P{(const bf16*)merged, (const bf16*)(c.ws + WS_WO), 1024}; pg8::StaticOrder S; S.init(NTOK, 1024, c.G, c.bid); pg8::EpiWoutM E{c.x, c.out};
        pg8::gemm_phase(c.lds, P, S, E); } SEAM(5);
    if (IN(6)) { p6_ln_router(c, x1b); } SEAM(6);
    LAS int* tb = (LAS int*)(c.lds + pg8::MOE_TB_OFF);
    if (IN(7) || IN(8)) {
        if (c.tid < 32) tb[64 + c.tid] = (int)__hip_atomic_load(c.ctl + CW_CNT + c.tid, __ATOMIC_RELAXED, __HIP_MEMORY_SCOPE_AGENT);
        __syncthreads();
        if (c.tid == 0) { int a = 0; for (int e = 0; e < 32; ++e) { tb[e] = a; a += (tb[64 + e] + 255) >> 8; } tb[32] = a; }
        __syncthreads();
    }
    if (IN(7)) { pg8::GatherProb P{(const bf16*)x1b, (const bf16*)(c.ws + WS_WGU), 1024, tb, (const unsigned*)(c.ws + WS_LIST)}; pg8::MoeOrder S{tb, 2, c.G, c.bid, c.ctl}; pg8::EpiGU E{(bf16*)(c.ws + WS_QLAT)};
        pg8::gemm_phase(c.lds, P, S, E); }
    if (MK_N_LAUNCHES != 1) SEAM(7);
    if (IN(8)) { pg8::DenseProb P{(const bf16*)(c.ws + WS_QLAT), (const bf16*)(c.ws + WS_WD), 256}; pg8::MoeDownOrder S{tb, c.G, c.bid, c.ctl};
        pg8::EpiDown E{(bf16*)(c.ws + WS_SLOT), tb, (const unsigned*)(c.ws + WS_LIST), (const float*)(c.ws + WS_PW)};
        pg8::gemm_phase(c.lds, P, S, E); } SEAM(8);
    if (IN(9)) { p9_ln2(c); }
#undef IN
#undef SEAM
}

extern "C" void kernel_launch(void* const* d_in, const int* in_sizes, int n_in, void* d_out, int out_size, void* d_ws, size_t ws_size, hipStream_t stream) {
    static int grid = 0;
    if (grid == 0) {
        if (n_in != 20 || out_size != NTOK * D || ws_size < WS_END) { fprintf(stderr, "kernel_launch: unexpected shapes (n_in %d out %d ws %zu)\n", n_in, out_size, ws_size); grid = -1; return; }
        int dev = 0, cus = 0, per_cu = 0;
        if (hipGetDevice(&dev) != hipSuccess || hipDeviceGetAttribute(&cus, hipDeviceAttributeMultiprocessorCount, dev) != hipSuccess) { grid = -1; return; }
        if (hipFuncSetAttribute((const void*)fwd_kernel, hipFuncAttributeMaxDynamicSharedMemorySize, LDS_BYTES) != hipSuccess) { fprintf(stderr, "kernel_launch: hipFuncSetAttribute failed\n"); grid = -1; return; }
        if (hipOccupancyMaxActiveBlocksPerMultiprocessor(&per_cu, (const void*)fwd_kernel, NTHR, LDS_BYTES) != hipSuccess || per_cu < 1) { fprintf(stderr, "kernel_launch: occupancy query says %d\n", per_cu); }
        (void)hipGetLastError();
        grid = cus;
    }
    if (grid < 0) return;
    if (hipMemsetAsync((char*)d_ws + WS_CTL, 0, CTL_ZERO_BYTES, stream) != hipSuccess) return;
    Args a{};
    for (int i = 0; i < 20; ++i) a.in[i] = (const float*)d_in[i];
    a.out = (float*)d_out; a.ws = (unsigned char*)d_ws;
    if (MK_N_LAUNCHES == 1) { a.ph_lo = 0; a.ph_hi = NPHASE; hipLaunchKernelGGL(fwd_kernel, dim3(grid), dim3(NTHR), LDS_BYTES, stream, a); }
    else { for (int p = 0; p < NPHASE; ++p) { a.ph_lo = p; a.ph_hi = p + 1; hipLaunchKernelGGL(fwd_kernel, dim3(grid), dim3(NTHR), LDS_BYTES, stream, a); } }
}
```

```cpp
#include <hip/hip_runtime.h>
#include <cstdio>
#include <cstdint>

#ifndef MK_N_LAUNCHES
#define MK_N_LAUNCHES 1
#endif

constexpr int D = 1024, BATCH = 8, SEQ = 2048, NTOK = BATCH * SEQ;
constexpr int A_HEADS = 8, A_LAT = 128, IDX_HEADS = 8, IDX_DIM = 64, KSEL = 256;
constexpr int B_HEADS = 8, B_HD = 64, WINDOW = 128;
constexpr int NEXP = 32, EPG = 8, NGRP = 4, DEXP = 256;
constexpr int IN_WIDTH = 4552, NPROJ = 4608;
constexpr float ALPHA = 1.189207115002721f;
constexpr float LN_EPS = 1e-5f, RMS_EPS = 1e-6f;
constexpr float ATT_SCALE = 0.08838834764831845f;
constexpr float IDXW_SCALE = 0.125f * 0.35355339059327373f;
constexpr int NPHASE = 10;

constexpr size_t MiB = 1u << 20;
constexpr size_t WS_CTL = 0, CTL_ZERO_BYTES = 128 * 1024;
constexpr size_t WS_WIN = 1 * MiB;
constexpr size_t WS_SEL = 1 * MiB;
constexpr size_t WS_WC = 10 * MiB;
constexpr size_t WS_WB = 12 * MiB;
constexpr size_t WS_WO = 13 * MiB;
constexpr size_t WS_WIDX = 15 * MiB;
constexpr size_t WS_BIAS = 16 * MiB;
constexpr size_t WS_PE = 16 * MiB + 64 * 1024;
constexpr size_t WS_PW = 16 * MiB + 256 * 1024;
constexpr size_t WS_WGU = 17 * MiB;
constexpr size_t WS_WD = 49 * MiB;
constexpr size_t WS_XB = 65 * MiB;
constexpr size_t WS_QLAT = 97 * MiB;
constexpr size_t WS_CKV = 129 * MiB;
constexpr size_t WS_KIDX = 133 * MiB;
constexpr size_t WS_QIDX = 135 * MiB;
constexpr size_t WS_QB = 151 * MiB;
constexpr size_t WS_KB = 167 * MiB;
constexpr size_t WS_VB = 171 * MiB;
constexpr size_t WS_GA = 175 * MiB;
constexpr size_t WS_GB = 207 * MiB;
constexpr size_t WS_CKVRAW = 239 * MiB;
constexpr size_t WS_LIST = 247 * MiB;
constexpr size_t WS_SLOT = 129 * MiB;
constexpr size_t WS_END = 252 * MiB;
constexpr int CW_CNT = 64;
constexpr int CW_BAR = 4096;

constexpr int NWAVES = 8, NTHR = 512;
constexpr int LDS_BYTES = 155648;
constexpr int MISC_OFF = 131072 + 320;

#define GAS __attribute__((address_space(1)))
#define LAS __attribute__((address_space(3)))
typedef unsigned short bf16;
typedef unsigned v4u __attribute__((ext_vector_type(4)));
typedef unsigned v2u __attribute__((ext_vector_type(2)));
typedef float f32x4 __attribute__((ext_vector_type(4)));

__device__ __forceinline__ float bf2f(unsigned v) { return __builtin_bit_cast(float, v << 16); }
__device__ __forceinline__ float bflo(unsigned v) { return __builtin_bit_cast(float, v << 16); }
__device__ __forceinline__ float bfhi(unsigned v) { return __builtin_bit_cast(float, v & 0xffff0000u); }
__device__ __forceinline__ unsigned f2bf(float f) { unsigned u = __builtin_bit_cast(unsigned, f); return (u + 0x7fffu + ((u >> 16) & 1u)) >> 16; }
__device__ __forceinline__ unsigned cvt_pk(float lo, float hi) { unsigned r; asm volatile("v_cvt_pk_bf16_f32 %0, %1, %2" : "=v"(r) : "v"(lo), "v"(hi)); return r; }
__device__ __forceinline__ unsigned pk2(float lo, float hi) { return f2bf(lo) | (f2bf(hi) << 16); }
__device__ __forceinline__ float wave_sum(float v) {
#pragma unroll
    for (int o = 1; o < 64; o <<= 1) v += __shfl_xor(v, o);
    return v;
}
__device__ __forceinline__ float wave_max(float v) {
#pragma unroll
    for (int o = 1; o < 64; o <<= 1) v = fmaxf(v, __shfl_xor(v, o));
    return v;
}

typedef unsigned u2v __attribute__((ext_vector_type(2)));
#define DPP_I(v, ctrl) __builtin_amdgcn_update_dpp(0, (v), (ctrl), 0xf, 0xf, true)
#define DPP_F(v, ctrl) __builtin_bit_cast(float, __builtin_amdgcn_update_dpp(0, __builtin_bit_cast(int, (v)), (ctrl), 0xf, 0xf, true))
__device__ __forceinline__ void swap16(unsigned a, unsigned& x, unsigned& y) { auto r = __builtin_amdgcn_permlane16_swap(a, a, false, false); x = r[0]; y = r[1]; }
__device__ __forceinline__ void swap32(unsigned a, unsigned& x, unsigned& y) { auto r = __builtin_amdgcn_permlane32_swap(a, a, false, false); x = r[0]; y = r[1]; }
__device__ __forceinline__ float x16_sum(float v) { unsigned x, y; swap16(__builtin_bit_cast(unsigned, v), x, y); return __builtin_bit_cast(float, x) + __builtin_bit_cast(float, y); }
__device__ __forceinline__ float x16_max(float v) { unsigned x, y; swap16(__builtin_bit_cast(unsigned, v), x, y); return fmaxf(__builtin_bit_cast(float, x), __builtin_bit_cast(float, y)); }
__device__ __forceinline__ float x16_min(float v) { unsigned x, y; swap16(__builtin_bit_cast(unsigned, v), x, y); return fminf(__builtin_bit_cast(float, x), __builtin_bit_cast(float, y)); }
__device__ __forceinline__ int x16_sumi(int v) { unsigned x, y; swap16((unsigned)v, x, y); return (int)(x + y); }
__device__ __forceinline__ float x32_sum(float v) { unsigned x, y; swap32(__builtin_bit_cast(unsigned, v), x, y); return __builtin_bit_cast(float, x) + __builtin_bit_cast(float, y); }
__device__ __forceinline__ float x32_max(float v) { unsigned x, y; swap32(__builtin_bit_cast(unsigned, v), x, y); return fmaxf(__builtin_bit_cast(float, x), __builtin_bit_cast(float, y)); }

#define XB_TMO      128
#define XB_XCNT(j)  (256  + 64 * (j))
#define XB_XSUB(j)  (1280 + 64 * (j))
#define XB_XGEN(j)  (2304 + 64 * (j))
#define XB_TOP      3328
#define XB_TOPGEN   3392
#define XCD_BAR_WORDS 3456
#define XB_SPIN_CAP (1u << 22)

__device__ __forceinline__ unsigned xb_ld(unsigned* p)              { return __hip_atomic_load(p, __ATOMIC_RELAXED, __HIP_MEMORY_SCOPE_AGENT); }
__device__ __forceinline__ unsigned xb_add(unsigned* p, unsigned v) { return __hip_atomic_fetch_add(p, v, __ATOMIC_RELAXED, __HIP_MEMORY_SCOPE_AGENT); }
__device__ __forceinline__ unsigned xb_xcc_id() { return (unsigned)__builtin_amdgcn_s_getreg((3 << 11) | 20) & 0xFu; }
#define XB_SPIN(cond, bar) do { unsigned _sp = 0; while (cond) { __builtin_amdgcn_s_sleep(1); \
    if ((++_sp & 255u) == 0u) { if (xb_ld(&(bar)[XB_TMO])) break; if (_sp > XB_SPIN_CAP) { atomicAdd(&(bar)[XB_TMO], 1u); break; } } } } while (0)

struct XcdBarrier { unsigned* bar; unsigned x; volatile LAS unsigned* st; };

__device__ __forceinline__ XcdBarrier xcd_barrier_post(unsigned* bar, volatile LAS unsigned* st) {
    XcdBarrier b; b.bar = bar; b.x = xb_xcc_id(); b.st = st;
    if (threadIdx.x == 0) (void)xb_add(&bar[XB_XCNT(b.x)], 1u);
    return b;
}
__device__ __forceinline__ void xcd_barrier_complete(unsigned* bar, unsigned x, unsigned& nloc, unsigned& nx) {
    const unsigned G = gridDim.x * gridDim.y * gridDim.z;
    unsigned sum, cnt, mine, sp = 0u;
    for (;;) {
        sum = 0u; cnt = 0u; mine = 0u;
#pragma unroll
        for (unsigned j = 0; j < 16; ++j) { const unsigned c = xb_ld(&bar[XB_XCNT(j)]); sum += c; cnt += (c > 0u) ? 1u : 0u; mine = (j == x) ? c : mine; }
        if (sum == G) break;
        __builtin_amdgcn_s_sleep(1);
        if ((++sp & 255u) == 0u) { if (xb_ld(&bar[XB_TMO])) break; if (sp > XB_SPIN_CAP) { atomicAdd(&bar[XB_TMO], 1u); break; } }
    }
    nloc = mine > 0u ? mine : 1u; nx = cnt > 0u ? cnt : 1u;
}
__device__ __forceinline__ void xcd_barrier(const XcdBarrier& b) {
    asm volatile("s_waitcnt vmcnt(0)" ::: "memory");
    __syncthreads();
    if (threadIdx.x == 0) {
        unsigned* bar = b.bar;
        __builtin_amdgcn_s_waitcnt(0);
        unsigned nloc = b.st[0], nx = b.st[1];
        if (nloc == 0u) { xcd_barrier_complete(bar, b.x, nloc, nx); b.st[0] = nloc; b.st[1] = nx; }
        const unsigned old = xb_add(&bar[XB_XSUB(b.x)], 1u);
        const unsigned gen = old / nloc;
        if (old + 1u == (gen + 1u) * nloc) {
            __builtin_amdgcn_fence(__ATOMIC_RELEASE, "agent");
            asm volatile("s_waitcnt vmcnt(0)" ::: "memory");
            const unsigned og = xb_add(&bar[XB_TOP], 1u);
            const unsigned tg = og / nx;
            if (og + 1u == (tg + 1u) * nx) xb_add(&bar[XB_TOPGEN], 1u);
            else XB_SPIN(xb_ld(&bar[XB_TOPGEN]) == tg, bar);
            __builtin_amdgcn_fence(__ATOMIC_ACQUIRE, "agent");
            xb_add(&bar[XB_XGEN(b.x)], 1u);
            asm volatile("s_waitcnt vmcnt(0)" ::: "memory");
        } else {
            XB_SPIN(xb_ld(&bar[XB_XGEN(b.x)]) == gen, bar);
            __builtin_amdgcn_fence(__ATOMIC_ACQUIRE, "agent");
            asm volatile("s_waitcnt vmcnt(0)" ::: "memory");
        }
    }
    __syncthreads();
}

struct Ctx {
    const float *x, *w_in, *kv_g, *w_uv, *w_a, *sinks, *w_b, *w_out, *rel_bias, *ln1_g, *ln1_b, *w_group, *b_group, *w_router, *b_router, *w_gate, *w_up, *w_down, *ln2_g, *ln2_b;
    float* out;
    unsigned char* ws;
    unsigned* ctl;
    __device__ __forceinline__ bf16* P(size_t off) const { return (bf16*)(ws + off); }
    LAS unsigned char* lds;
    int tid, lane, wave, bid, G;
};

__device__ __forceinline__ int proj_src_col(int j) {
    if (j < 1024) return j;
    if (j < 1152) return j;
    if (j < 1216) return 1664 + (j - 1152);
    if (j < 1224) return 1728 + (j - 1216);
    if (j < 1280) return -1;
    if (j < 1792) return 1152 + (j - 1280);
    if (j < 2304) return 1736 + (j - 1792);
    if (j < 2432) return 2248 + (j - 2304);
    if (j < 2560) return 2376 + (j - 2432);
    if (j < 3584) return 2504 + (j - 2560);
    return 3528 + (j - 3584);
}
__device__ __forceinline__ float sigmoidf_(float v) { return 1.0f / (1.0f + __expf(-v)); }

template <class Src> __device__ __forceinline__ void transpose_item(const Ctx& c, LAS float* scr, const Src& src, bf16* dst, int dstK, int k0, int n0) {
    const int lane = c.lane;
    f32x4 tv[8]; const int kr = lane >> 3, n4 = (lane & 7) * 4;
#pragma unroll
    for (int i = 0; i < 8; ++i) tv[i] = src.v4(k0 + 8 * i + kr, n0 + n4);
#pragma unroll
    for (int i = 0; i < 8; ++i) { LAS float* d = scr + (8 * i + kr) * 33 + n4; d[0] = tv[i].x; d[1] = tv[i].y; d[2] = tv[i].z; d[3] = tv[i].w; }
    asm volatile("s_waitcnt lgkmcnt(0)" ::: "memory");
    const int cc = lane & 7;
#pragma unroll
    for (int j = 0; j < 4; ++j) { const int n = (lane >> 3) + 8 * j; const LAS float* q = scr + (8 * cc) * 33 + n;
        v4u o; o.x = pk2(q[0 * 33], q[1 * 33]); o.y = pk2(q[2 * 33], q[3 * 33]); o.z = pk2(q[4 * 33], q[5 * 33]); o.w = pk2(q[6 * 33], q[7 * 33]);
        *(v4u*)(dst + (size_t)(n0 + n) * dstK + k0 + 8 * cc) = o; }
    asm volatile("s_waitcnt lgkmcnt(0)" ::: "memory");
}
struct SrcWin { const float* w; __device__ __forceinline__ f32x4 v4(int k, int n) const { const int s = proj_src_col(n); return s < 0 ? (f32x4){0.f, 0.f, 0.f, 0.f} : *(const f32x4*)(w + (size_t)k * IN_WIDTH + s); } };
struct SrcPlain { const float* w; int N; __device__ __forceinline__ f32x4 v4(int k, int n) const { return *(const f32x4*)(w + (size_t)k * N + n); } };
struct SrcShift { const float* w; int N; int shift; __device__ __forceinline__ f32x4 v4(int k, int n) const { return *(const f32x4*)(w + (size_t)k * N + n + shift); } };

__device__ __forceinline__ float t5_bias_bucket(int dist) {
    if (dist < 16) return (float)dist;
    int b = 16 + (int)(logf((float)dist / 16.0f) / logf(8.0f) * 16.0f);
    return (float)(b < 31 ? b : 31);
}
constexpr int P0_EXPERT_ITEMS = 32 * 256 + 32 * 128;
__device__ __forceinline__ void p0_expert_item(const Ctx& c, LAS float* scr, int r) {
    constexpr int I_GU = 32 * 256;
    if (r < I_GU) { const int e = r / 256, q = r % 256, n0 = (q / 16) * 32, half = (n0 >> 7) & 1, col0 = (n0 >> 8) * 128 + (n0 & 127);
        if (half) { SrcShift s_{c.w_up + (size_t)e * 1024 * 256, DEXP, col0 - n0}; transpose_item(c, scr, s_, (bf16*)(c.ws + WS_WGU) + (size_t)e * 512 * 1024, 1024, (q % 16) * 64, n0); }
        else { SrcShift s_{c.w_gate + (size_t)e * 1024 * 256, DEXP, col0 - n0}; transpose_item(c, scr, s_, (bf16*)(c.ws + WS_WGU) + (size_t)e * 512 * 1024, 1024, (q % 16) * 64, n0); }
        return; }
    r -= I_GU;
    { const int e = r / 128, q = r % 128; SrcPlain s_{c.w_down + (size_t)e * 256 * 1024, 1024};
        transpose_item(c, scr, s_, (bf16*)(c.ws + WS_WD) + (size_t)e * 1024 * 256, 256, (q % 4) * 64, (q / 4) * 32); }
}
constexpr size_t WS_WRT = 16 * MiB + 512 * 1024;
__device__ __forceinline__ void p0_prologue(const Ctx& c) {
    { const size_t n8 = (size_t)NTOK * D / 8; const f32x4* xs = (const f32x4*)c.x; v4u* xd = (v4u*)((bf16*)(c.ws + WS_XB));
      const size_t st = (size_t)c.G * NTHR;
      size_t i = (size_t)c.bid * NTHR + c.tid;
      for (; i + 3 * st < n8; i += 4 * st) { f32x4 a[4], b[4];
#pragma unroll
          for (int u = 0; u < 4; ++u) { a[u] = xs[2 * (i + u * st)]; b[u] = xs[2 * (i + u * st) + 1]; }
#pragma unroll
          for (int u = 0; u < 4; ++u) { v4u o; o.x = pk2(a[u].x, a[u].y); o.y = pk2(a[u].z, a[u].w); o.z = pk2(b[u].x, b[u].y); o.w = pk2(b[u].z, b[u].w); xd[i + u * st] = o; } }
      for (; i < n8; i += st) { const f32x4 a = xs[2 * i], b = xs[2 * i + 1]; v4u o; o.x = pk2(a.x, a.y); o.y = pk2(a.z, a.w); o.z = pk2(b.x, b.y); o.w = pk2(b.z, b.w); xd[i] = o; } }
    { LAS float* scr = (LAS float*)(c.lds + c.wave * 8704);
      constexpr int I_WIN = 16 * 144, I_WB = 8 * 32, I_WO = 16 * 32, I_ALL = I_WIN + I_WB + I_WO;
      for (int it = c.bid * NWAVES + c.wave; it < I_ALL; it += c.G * NWAVES) {
        int r = it;
        if (r < I_WIN) { SrcWin s_{c.w_in}; transpose_item(c, scr, s_, (bf16*)(c.ws + WS_WIN), 1024, (r % 16) * 64, (r / 16) * 32); continue; } r -= I_WIN;
        if (r < I_WB) { SrcPlain s_{c.w_b, 1024}; transpose_item(c, scr, s_, (bf16*)(c.ws + WS_WB), 512, (r % 8) * 64, (r / 8) * 32); continue; } r -= I_WB;
        { SrcPlain s_{c.w_out, 1024}; transpose_item(c, scr, s_, (bf16*)(c.ws + WS_WO), 1024, (r % 16) * 64, (r / 16) * 32); }
      } }
    __syncthreads();
    { LAS float* tile = (LAS float*)c.lds; LAS float* Us = tile + 64 * 65; LAS float* As = Us + 64 * 65;
      for (int tI = c.bid; tI < 256; tI += c.G) { const int k0 = (tI & 15) * 64, n0 = (tI >> 4) * 64, h = k0 >> 7;
        const int r = c.tid >> 6, cc = c.tid & 63;
#pragma unroll
        for (int pI = 0; pI < 8; ++pI) { const int kk = pI * 8 + r; Us[kk * 65 + cc] = c.w_uv[(size_t)(k0 + kk) * 64 + cc]; As[kk * 65 + cc] = c.w_a[(size_t)(h * 64 + kk) * 1024 + n0 + cc]; }
        __syncthreads();
#pragma unroll
        for (int pI = 0; pI < 8; ++pI) { const int kk = pI * 8 + r; float a = 0.f;
#pragma unroll 16
            for (int d = 0; d < 64; ++d) a += Us[kk * 65 + d] * As[d * 65 + cc];
            tile[kk * 65 + cc] = a; }
        __syncthreads();
        const int nl = c.tid >> 3, kc = c.tid & 7; v4u o;
        o.x = pk2(tile[(8 * kc + 0) * 65 + nl], tile[(8 * kc + 1) * 65 + nl]); o.y = pk2(tile[(8 * kc + 2) * 65 + nl], tile[(8 * kc + 3) * 65 + nl]);
        o.z = pk2(tile[(8 * kc + 4) * 65 + nl], tile[(8 * kc + 5) * 65 + nl]); o.w = pk2(tile[(8 * kc + 6) * 65 + nl], tile[(8 * kc + 7) * 65 + nl]);
        *(v4u*)((bf16*)(c.ws + WS_WC) + (size_t)(n0 + nl) * 1024 + k0 + 8 * kc) = o;
        __syncthreads(); } }
    for (int i = c.bid * NTHR + c.tid; i < 48 * 1024; i += c.G * NTHR) { const int o = i >> 10, k = i & 1023;
        const float v = o < 32 ? c.w_router[(size_t)k * 32 + o] : (o < 36 ? c.w_group[(size_t)k * 4 + (o - 32)] : 0.f);
        const unsigned hi = f2bf(v); const float rem = v - bf2f(hi);
        ((bf16*)(c.ws + WS_WRT))[i] = (bf16)hi; ((bf16*)(c.ws + WS_WRT))[48 * 1024 + i] = (bf16)f2bf(rem); }
    if (c.bid == 0) { for (int i = c.tid; i < 129 * 8; i += NTHR) { const int d = i >> 3, h = i & 7; const int b = (int)t5_bias_bucket(d);
            ((float*)(c.ws + WS_BIAS))[i] = c.rel_bias[b * 16 + h]; ((float*)(c.ws + WS_BIAS) + 129 * 8)[i] = c.rel_bias[b * 16 + 8 + h]; } }
}


__device__ __forceinline__ void p_rmsnorm(const Ctx& c) {
    const int gw = c.bid * NWAVES + c.wave, NGW = c.G * NWAVES, l15 = c.lane & 15, g4 = c.lane >> 4;
    const f32x4 g0 = *(const f32x4*)(c.kv_g + 8 * l15), g1 = *(const f32x4*)(c.kv_g + 8 * l15 + 4);
    for (int r = 4 * gw + g4; r < NTOK; r += 4 * NGW) {
        const float* src = (const float*)(c.ws + WS_CKVRAW) + (size_t)r * 128 + 8 * l15;
        const f32x4 a = *(const f32x4*)src, b = *(const f32x4*)(src + 4);
        float ss = (a.x * a.x + a.y * a.y) + (a.z * a.z + a.w * a.w) + (b.x * b.x + b.y * b.y) + (b.z * b.z + b.w * b.w);
        ss += DPP_F(ss, 0xB1); ss += DPP_F(ss, 0x4E); ss += DPP_F(ss, 0x141); ss += DPP_F(ss, 0x140);
        const float rs = 1.0f / sqrtf(ss * (1.0f / 128.0f) + RMS_EPS);
        v4u o; o.x = pk2(a.x * rs * g0.x, a.y * rs * g0.y); o.y = pk2(a.z * rs * g0.z, a.w * rs * g0.w); o.z = pk2(b.x * rs * g1.x, b.y * rs * g1.y); o.w = pk2(b.z * rs * g1.z, b.w * rs * g1.w);
        *(v4u*)((bf16*)(c.ws + WS_CKV) + (size_t)r * 128 + 8 * l15) = o;
    }
}


typedef float f32x16 __attribute__((ext_vector_type(16)));
typedef short s16x8 __attribute__((ext_vector_type(8)));
__device__ __forceinline__ float half_min(float v) {
    v = fminf(v, DPP_F(v, 0xB1)); v = fminf(v, DPP_F(v, 0x4E)); v = fminf(v, DPP_F(v, 0x141)); v = fminf(v, DPP_F(v, 0x140)); return x16_min(v); }
__device__ __forceinline__ float half_max(float v) {
    v = fmaxf(v, DPP_F(v, 0xB1)); v = fmaxf(v, DPP_F(v, 0x4E)); v = fmaxf(v, DPP_F(v, 0x141)); v = fmaxf(v, DPP_F(v, 0x140)); return x16_max(v); }
__device__ __forceinline__ int half_sum(int v) {
    v += DPP_I(v, 0xB1); v += DPP_I(v, 0x4E); v += DPP_I(v, 0x141); v += DPP_I(v, 0x140); return x16_sumi(v); }
struct P2B { s16x8 b[8]; };
__device__ __forceinline__ P2B p2_ld4(const LAS unsigned char* kb_, int tb) { P2B r;
#pragma unroll
    for (int u = 0; u < 4; ++u) { r.b[2 * u] = *(const LAS s16x8*)(kb_ + (tb + u) * 2048); r.b[2 * u + 1] = *(const LAS s16x8*)(kb_ + (tb + u) * 2048 + 1024); }
    return r; }
__device__ __forceinline__ float p2_relu(float x) { const int xi = __builtin_bit_cast(int, x); return __builtin_bit_cast(float, xi > 0 ? xi : 0); }
__device__ __forceinline__ float p2_wsum(const f32x4 a, const f32x4 w) {
    float p = fmaf(w.x, p2_relu(a[0]), 0.f); p = fmaf(w.y, p2_relu(a[1]), p); p = fmaf(w.z, p2_relu(a[2]), p); return fmaf(w.w, p2_relu(a[3]), p); }
__device__ __forceinline__ void p2_score4(const P2B& B, const s16x8 a0, const s16x8 a1, const f32x4 wq, float& r0, float& r1) {
    f32x4 acc[4];
#pragma unroll
    for (int u = 0; u < 4; ++u) { const f32x4 z = {0.f, 0.f, 0.f, 0.f}; acc[u] = __builtin_amdgcn_mfma_f32_16x16x32_bf16(a0, B.b[2 * u], z, 0, 0, 0); }
#pragma unroll
    for (int u = 0; u < 4; ++u) acc[u] = __builtin_amdgcn_mfma_f32_16x16x32_bf16(a1, B.b[2 * u + 1], acc[u], 0, 0, 0);
    const float p0 = p2_wsum(acc[0], wq), p1 = p2_wsum(acc[1], wq), p2 = p2_wsum(acc[2], wq), p3 = p2_wsum(acc[3], wq);
    { auto s_ = __builtin_amdgcn_permlane16_swap(__builtin_bit_cast(unsigned, p0), __builtin_bit_cast(unsigned, p1), false, false); const unsigned x_ = s_[0], y_ = s_[1];
      r0 = __builtin_bit_cast(float, x_) + __builtin_bit_cast(float, y_); }
    { auto s_ = __builtin_amdgcn_permlane16_swap(__builtin_bit_cast(unsigned, p2), __builtin_bit_cast(unsigned, p3), false, false); const unsigned x_ = s_[0], y_ = s_[1];
      r1 = __builtin_bit_cast(float, x_) + __builtin_bit_cast(float, y_); }
}
__device__ __forceinline__ void p2_unit(const Ctx& c, int b, int blk) {
    LAS unsigned char* kst = c.lds;
    const int lane = c.lane, wv = c.wave, r = lane & 31, hh = lane >> 5, g4 = lane >> 4, c16 = lane & 15;
    const int t0 = blk * 16 + 2 * wv, n0 = b * SEQ + t0, ntile = blk + 1, nst = (ntile + 15) >> 4;
    const unsigned char* ksrc = c.ws + WS_KIDX + (size_t)(b * 128) * 2048;
#define P2_ISSUE(st) do { _Pragma("unroll") for (int _j = 0; _j < 4; ++_j) \
        __builtin_amdgcn_global_load_lds((const unsigned*)(ksrc + (size_t)(st) * 32768 + (_j * 512 + c.tid) * 16), (LAS unsigned*)(kst + ((st) & 1) * 32768 + (_j * 512 + wv * 64) * 16), 16, 0, 0); } while (0)
    P2_ISSUE(0);
    s16x8 af[2];
    { const bf16* qp = (const bf16*)(c.ws + WS_QIDX) + (size_t)(n0 + (c16 >> 3)) * 512 + (c16 & 7) * 64 + 8 * g4;
      af[0] = *(const s16x8*)qp; af[1] = *(const s16x8*)(qp + 32); }
    const f32x4 wq = *(const f32x4*)((const float*)(c.ws + WS_WIDX) + (size_t)(n0 + hh) * 8 + 4 * (g4 & 1));
    asm volatile("" :: "v"(af[0]), "v"(af[1]), "v"(wq));
    float sc0[64];
#pragma unroll
    for (int i = 0; i < 64; ++i) sc0[i] = -INFINITY;
    const int lim0 = 2 * wv + hh;
    const int lastst = blk >> 4;
    const int limt = (blk - (g4 & 1)) - ((c16 <= lim0) ? 0 : 1);
#pragma unroll
    for (int st = 0; st < 8; ++st) {
        if (st <= lastst) {
            if (st < lastst) { P2_ISSUE(st + 1); asm volatile("s_waitcnt vmcnt(4)" ::: "memory"); }
            else asm volatile("s_waitcnt vmcnt(0)" ::: "memory");
            __builtin_amdgcn_s_barrier();
            const LAS unsigned char* kb_ = kst + (st & 1) * 32768 + lane * 16;
            if (st < lastst) {
                P2B Ba = p2_ld4(kb_, 0), Bb = p2_ld4(kb_, 4);
                p2_score4(Ba, af[0], af[1], wq, sc0[st * 8 + 0], sc0[st * 8 + 1]); __builtin_amdgcn_sched_barrier(0);
                Ba = p2_ld4(kb_, 8);
                p2_score4(Bb, af[0], af[1], wq, sc0[st * 8 + 2], sc0[st * 8 + 3]); __builtin_amdgcn_sched_barrier(0);
                Bb = p2_ld4(kb_, 12);
                p2_score4(Ba, af[0], af[1], wq, sc0[st * 8 + 4], sc0[st * 8 + 5]); __builtin_amdgcn_sched_barrier(0);
                p2_score4(Bb, af[0], af[1], wq, sc0[st * 8 + 6], sc0[st * 8 + 7]);
            } else {
#pragma unroll
                for (int g = 0; g < 4; ++g) if (st * 16 + 4 * g <= blk) {
                    const P2B B = p2_ld4(kb_, 4 * g);
                    float r0, r1; p2_score4(B, af[0], af[1], wq, r0, r1);
                    sc0[st * 8 + 2 * g] = (st * 16 + 4 * g <= limt) ? r0 : -INFINITY;
                    sc0[st * 8 + 2 * g + 1] = (st * 16 + 4 * g + 2 <= limt) ? r1 : -INFINITY;
                    __builtin_amdgcn_sched_barrier(0);
                }
            }
            asm volatile("s_waitcnt lgkmcnt(0)" ::: "memory");
            __builtin_amdgcn_s_barrier();
        }
    }
#undef P2_ISSUE
    const int nreg = (ntile + 1) >> 1;
    float thr0 = -INFINITY; int quota0 = 0;
    if (blk >= 16) {
        float mn0 = INFINITY, mx0 = -INFINITY; int cp = 0, cn = 0;
#pragma unroll
        for (int g = 0; g < 4; ++g) if (nreg > 16 * g) {
#pragma unroll
            for (int i = 16 * g; i < 16 * g + 16; ++i) { mx0 = fmaxf(mx0, sc0[i]); mn0 = fminf(mn0, sc0[i] == -INFINITY ? INFINITY : sc0[i]); cp += (sc0[i] > 0.f) ? 1 : 0; cn += (sc0[i] >= 0.f) ? 1 : 0; } }
        mn0 = half_min(mn0); mx0 = half_max(mx0); cp = half_sum(cp); cn = half_sum(cn);
        float lo0, hi0; int chi0, clo0; bool done0 = false;
        if (cp <= KSEL && cn >= KSEL) { done0 = true; thr0 = 0.f; quota0 = KSEL - cp; lo0 = hi0 = 0.f; chi0 = 0; clo0 = KSEL + 1; }
        else if (cp > KSEL) { lo0 = 0.f; clo0 = cn; hi0 = mx0 + fabsf(mx0) * 1e-6f + 1e-30f; chi0 = 0; }
        else { lo0 = mn0; clo0 = t0 + hh + 1; hi0 = 0.f; chi0 = cn; }
        for (int it = 0; it < 200; ++it) {
            if (__builtin_amdgcn_ballot_w64(!done0) == 0ull) break;
            const float half_ = 0.5f * (lo0 + hi0);
            float mid0 = half_;
            if (!(it & 1)) { const float fr_ = ((float)(clo0 - KSEL) + 0.5f) / (float)(clo0 - chi0); const float mi = lo0 + (hi0 - lo0) * fr_; mid0 = (mi > lo0 && mi < hi0) ? mi : half_; }
            unsigned sa = 0u, sb = 0u; int nproc = 0;
#pragma unroll
            for (int g = 0; g < 4; ++g) if (nreg > 16 * g) { nproc += 16;
#pragma unroll
                for (int i = 16 * g; i < 16 * g + 16; ++i) { const unsigned tb_ = __builtin_bit_cast(unsigned, sc0[i] - mid0);
                    if (g < 2) sa = __builtin_amdgcn_alignbit(sa, tb_, 31); else sb = __builtin_amdgcn_alignbit(sb, tb_, 31); } }
            int c0 = half_sum(nproc - __builtin_popcount(sa) - __builtin_popcount(sb));
            if (!done0) { if (c0 == KSEL) { done0 = true; thr0 = mid0; quota0 = KSEL; } else if (mid0 <= lo0 || mid0 >= hi0) { done0 = true; thr0 = lo0; quota0 = KSEL - chi0; } else if (c0 > KSEL) { lo0 = mid0; clo0 = c0; } else { hi0 = mid0; chi0 = c0; } }
        }
        if (!done0) { thr0 = lo0; quota0 = KSEL - chi0; }
    }
    unsigned short* selp0 = (unsigned short*)(c.ws + WS_SEL) + (size_t)(n0 + hh) * KSEL;
    int base0 = 0, eq0 = 0; const unsigned ltm = (1u << r) - 1u;
#pragma unroll
    for (int g = 0; g < 4; ++g) if (nreg > 16 * g) {
#pragma unroll
        for (int i = 16 * g; i < 16 * g + 16; ++i) {
            bool sel_ = sc0[i] > thr0; const bool pe = sc0[i] == thr0; const unsigned long long me = __builtin_amdgcn_ballot_w64(pe);
            if (me) { const unsigned mh = hh ? (unsigned)(me >> 32) : (unsigned)me; sel_ = sel_ || (pe && (eq0 + __builtin_popcount(mh & ltm) < quota0)); eq0 += __builtin_popcount(mh); }
            const unsigned long long ms = __builtin_amdgcn_ballot_w64(sel_); const unsigned mh2 = hh ? (unsigned)(ms >> 32) : (unsigned)ms;
            const int pos = base0 + __builtin_popcount(mh2 & ltm); if (sel_ && pos < KSEL) selp0[pos] = (unsigned short)(32 * i + r); base0 += __builtin_popcount(mh2);
        } }
}
__device__ __forceinline__ void p2_indexer_topk(const Ctx& c) {
    for (int pu = c.bid; pu < 256; pu += c.G) {
        const int b = pu >> 5, j = pu & 31;
#pragma unroll 1
        for (int q = 0; q < 4; ++q) p2_unit(c, b, q == 0 ? j : (q == 1 ? 63 - j : (q == 2 ? 64 + j : 127 - j)));
    }
}


typedef short s16x4 __attribute__((ext_vector_type(4)));
constexpr int DSA_WS_OFF = 131072 + 2048;
constexpr int DSA_BIAS_OFF = 131072 + 2048 + 10240;
__device__ __forceinline__ void p3a_dsa(const Ctx& c) {
    const int lane = c.lane, wv = c.wave, l15 = lane & 15, g4 = lane >> 4;
    LAS unsigned char* kvb = c.lds + wv * 16384;
    LAS unsigned char* wsb = c.lds + DSA_WS_OFF + wv * 1280;
    LAS float* biasL = (LAS float*)(c.lds + DSA_BIAS_OFF);
    for (int i = c.tid; i < 129 * 8; i += NTHR) biasL[i] = ((const float*)(c.ws + WS_BIAS))[i];
    __syncthreads();
    const int prow = (l15 & 3) | ((l15 & 4) << 1) | ((l15 & 8) >> 1);
    const int rowx = ((prow & 3) << 2) | (prow >> 2);
    const unsigned qk_off = (unsigned)(256 * prow + 16 * (g4 ^ (rowx & 3))), qk_sx = (unsigned)(rowx >> 2);
    const int grow = 8 * (g4 & 1) + 4 * (g4 >> 1);
    const int trow = grow + (l15 >> 2), trx = ((trow & 3) << 2) | ((trow >> 2) & 3);
    const unsigned tr_off = (unsigned)(256 * trow + 16 * (((lane & 3) >> 1) ^ (trx & 1)) + 8 * (lane & 1)), tr_mx = (unsigned)(trx >> 1);
    const bf16* ckv = (const bf16*)(c.ws + WS_CKV);
    const float bfar = biasL[128 * 8 + (l15 & 7)];
    float bmax = 0.f;
    for (int d = 0; d <= 128; ++d) bmax = fmaxf(bmax, fabsf(biasL[d * 8 + (l15 & 7)]));
    const float kvmax = 11.313708499f * 1.004f * wave_max(fmaxf(fabsf(c.kv_g[2 * lane]), fabsf(c.kv_g[2 * lane + 1])));
    unsigned trm[8];
#pragma unroll
    for (int m = 0; m < 8; ++m) trm[m] = tr_off + 32u * ((unsigned)m ^ tr_mx);
    const int gw = c.bid * NWAVES + wv, NGW = c.G * NWAVES;
    if (wv < 4) for (int eit = gw; eit < P0_EXPERT_ITEMS; eit += NGW) p0_expert_item(c, (LAS float*)kvb, eit);
    asm volatile("s_waitcnt lgkmcnt(0)" ::: "memory");
#define DSA_LOADQ(n_, raw_, qf_) do { raw_ = *(const v2u*)((const unsigned short*)(c.ws + WS_SEL) + (size_t)(n_) * KSEL + 4 * lane); \
        const s16x8* qp_ = (const s16x8*)((const bf16*)(c.ws + WS_QLAT) + (size_t)(n_) * 1024 + (l15 & 7) * 128 + 8 * g4); \
        _Pragma("unroll") for (int s_ = 0; s_ < 4; ++s_) qf_[s_] = qp_[4 * s_]; } while (0)
#define DSA_PREP(n_, raw_, qf_, sl_, t_, cnt_, nch_, nfar_, mref_) do { t_ = (n_) & 2047; cnt_ = (t_ + 1 < KSEL) ? t_ + 1 : KSEL; nch_ = (cnt_ + 31) >> 5; \
        { const int i0 = 4 * lane, lim = t_ - 128; \
          raw_.x = (i0 < cnt_ ? (raw_.x & 0xffffu) : 0u) | (i0 + 1 < cnt_ ? (raw_.x & 0xffff0000u) : 0u); raw_.y = (i0 + 2 < cnt_ ? (raw_.y & 0xffffu) : 0u) | (i0 + 3 < cnt_ ? (raw_.y & 0xffff0000u) : 0u); \
          *(LAS v2u*)(wsb + (sl_) * 512 + 8 * lane) = raw_; \
          const int e0 = (i0 < cnt_ && (int)(raw_.x & 0xffffu) <= lim) ? 1 : 0, e1 = (i0 + 1 < cnt_ && (int)(raw_.x >> 16) <= lim) ? 1 : 0, e2 = (i0 + 2 < cnt_ && (int)(raw_.y & 0xffffu) <= lim) ? 1 : 0, e3 = (i0 + 3 < cnt_ && (int)(raw_.y >> 16) <= lim) ? 1 : 0; \
          int nf = e0 + e1 + e2 + e3; nf += DPP_I(nf, 0xB1); nf += DPP_I(nf, 0x4E); nf += DPP_I(nf, 0x141); nf += DPP_I(nf, 0x140); nf = x16_sumi(nf); { unsigned xa, xb; swap32((unsigned)nf, xa, xb); nf = (int)(xa + xb); } \
          nfar_ = __builtin_amdgcn_readfirstlane(nf) >> 5; } \
        { float q2 = 0.f; \
          _Pragma("unroll") for (int s_ = 0; s_ < 4; ++s_) { if (l15 >= 8) qf_[s_] = (s16x8){0, 0, 0, 0, 0, 0, 0, 0}; \
              _Pragma("unroll") for (int e = 0; e < 8; ++e) { const float qv = bf2f((unsigned)(unsigned short)qf_[s_][e]); q2 += qv * qv; } } \
          q2 = x16_sum(q2); q2 = x32_sum(q2); mref_ = sqrtf(q2) * kvmax + bmax; } } while (0)
#define DSA_ISSUE(ch_, bi_, k8_, sl_, n_, t_, cnt_, nfar_) do { const bf16* ckb_ = ckv + (size_t)((n_) >> 11) * SEQ * 128; \
            _Pragma("unroll") for (int u = 0; u < 8; ++u) { const unsigned kw = u < 2 ? k8_.x : (u < 4 ? k8_.y : (u < 6 ? k8_.z : k8_.w)); const unsigned key = (u & 1) ? (kw >> 16) : (kw & 0xffffu); \
                const int chl = l15 ^ ((g4 << 2) | (u & 3)); \
                __builtin_amdgcn_global_load_lds((const unsigned*)((const char*)ckb_ + (size_t)(unsigned)(key * 256u + (unsigned)chl * 16u)), (LAS unsigned*)(kvb + (bi_) * 8192 + u * 1024), 16, 0, 0); } \
            if ((ch_) >= (nfar_) && lane < 32) { const int kap = 32 * (ch_) + 8 * (lane & 3) + (lane >> 2); const int key = *(const LAS unsigned short*)(wsb + (sl_) * 512 + 2 * kap); int dd = (t_) - key; dd = dd > 128 ? 128 : dd; dd = kap < (cnt_) ? dd : 255; \
                *(LAS unsigned short*)(wsb + 1024 + (bi_) * 64 + 2 * lane) = (unsigned short)dd; } } while (0)
    const bool mixq = (NGW == SEQ);
#define DSA_QIDX(i_) (mixq ? ((i_) * SEQ + ((gw + 293 * (i_)) & (SEQ - 1))) : (gw + (i_) * NGW))
    const int nq = mixq ? BATCH : (NTOK - gw + NGW - 1) / NGW;
    int qi = 0, n = DSA_QIDX(0), sl = 0, b0 = 0, t = 0, cnt = 0, nch = 0, nfar = 0; float Mref = 0.f;
    s16x8 qf[4]; v2u rawn; s16x8 qfn[4];
    if (nq > 0) { v2u raw0; DSA_LOADQ(n, raw0, qf); DSA_PREP(n, raw0, qf, 0, t, cnt, nch, nfar, Mref);
        asm volatile("s_waitcnt lgkmcnt(0)" ::: "memory");
        const v4u k80 = *(const LAS v4u*)(wsb + (8 * g4) * 2); DSA_ISSUE(0, 0, k80, 0, n, t, cnt, nfar); }
    for (; qi < nq; ++qi) {
        const bool has_next = qi + 1 < nq; const int nn = has_next ? DSA_QIDX(qi + 1) : n;
        if (has_next) DSA_LOADQ(nn, rawn, qfn);
        int tn = 0, cntn = 0, nchn = 0, nfarn = 0; float Mrefn = 0.f;
        f32x4 O[8];
#pragma unroll
        for (int m = 0; m < 8; ++m) O[m] = (f32x4){0.f, 0.f, 0.f, 0.f};
        float l_run = 0.f;
        v4u k8n = *(const LAS v4u*)(wsb + sl * 512 + (32 * (nch > 1 ? 1 : 0) + 8 * g4) * 2);
        for (int ch = 0; ch < nch; ++ch) {
            const int bi = (b0 + ch) & 1;
            asm volatile("s_waitcnt lgkmcnt(0)" ::: "memory");
            if (ch + 1 < nch) { const v4u k8 = k8n; k8n = *(const LAS v4u*)(wsb + sl * 512 + (32 * (ch + 2 < 8 ? ch + 2 : 7) + 8 * g4) * 2);
                DSA_ISSUE(ch + 1, bi ^ 1, k8, sl, n, t, cnt, nfar); asm volatile("s_waitcnt vmcnt(8)" ::: "memory"); }
            else if (has_next) { DSA_PREP(nn, rawn, qfn, sl ^ 1, tn, cntn, nchn, nfarn, Mrefn);
                asm volatile("s_waitcnt lgkmcnt(0)" ::: "memory");
                const v4u k8 = *(const LAS v4u*)(wsb + (sl ^ 1) * 512 + (8 * g4) * 2);
                DSA_ISSUE(0, bi ^ 1, k8, sl ^ 1, nn, tn, cntn, nfarn); asm volatile("s_waitcnt vmcnt(8)" ::: "memory"); }
            else asm volatile("s_waitcnt vmcnt(0)" ::: "memory");
            const LAS unsigned char* kb_ = kvb + bi * 8192;
            f32x4 S[2];
#pragma unroll
            for (int T = 0; T < 2; ++T) { f32x4 a4 = {0.f, 0.f, 0.f, 0.f};
#pragma unroll
                for (int s_ = 0; s_ < 4; ++s_) { const s16x8 a = *(const LAS s16x8*)(kb_ + qk_off + 4096 * T + 64 * ((unsigned)s_ ^ qk_sx)); a4 = __builtin_amdgcn_mfma_f32_16x16x32_bf16(a, qf[s_], a4, 0, 0, 0); }
                S[T] = a4; }
            if (ch < nfar) {
#pragma unroll
                for (int T = 0; T < 2; ++T)
#pragma unroll
                    for (int r_ = 0; r_ < 4; ++r_) S[T][r_] = S[T][r_] + (bfar - Mref);
            } else
#pragma unroll
            for (int T = 0; T < 2; ++T) { const v2u d4 = *(const LAS v2u*)(wsb + 1024 + bi * 64 + 2 * (16 * T + grow));
#pragma unroll
                for (int r_ = 0; r_ < 4; ++r_) { const unsigned dw = r_ < 2 ? d4.x : d4.y; const unsigned dd = (r_ & 1) ? (dw >> 16) : (dw & 0xffffu);
                    const float bsv = biasL[(dd > 128u ? 128u : dd) * 8 + (l15 & 7)]; S[T][r_] = (dd == 255u) ? -INFINITY : S[T][r_] + (bsv - Mref); } }
#pragma unroll
            for (int T = 0; T < 2; ++T)
#pragma unroll
                for (int r_ = 0; r_ < 4; ++r_) { const float pv = __expf(S[T][r_]); S[T][r_] = pv; l_run += pv; }
            s16x8 P;
            { const unsigned p0 = cvt_pk(S[0][0], S[0][1]), p1 = cvt_pk(S[0][2], S[0][3]), p2 = cvt_pk(S[1][0], S[1][1]), p3 = cvt_pk(S[1][2], S[1][3]);
              const v4u pw_ = {p0, p1, p2, p3}; P = __builtin_bit_cast(s16x8, pw_); }
            { const unsigned kba = (unsigned)(size_t)kb_; s16x4 ta[8], tb[8];
#pragma unroll
              for (int m = 0; m < 8; ++m) { const unsigned ad = kba + trm[m];
                  asm volatile("ds_read_b64_tr_b16 %0, %1" : "=v"(ta[m]) : "v"(ad) : "memory"); asm volatile("ds_read_b64_tr_b16 %0, %1 offset:4096" : "=v"(tb[m]) : "v"(ad) : "memory"); }
              asm volatile("s_waitcnt lgkmcnt(8)" ::: "memory"); __builtin_amdgcn_sched_barrier(0);
#pragma unroll
              for (int m = 0; m < 4; ++m) O[m] = __builtin_amdgcn_mfma_f32_16x16x32_bf16(__builtin_shufflevector(ta[m], tb[m], 0, 1, 2, 3, 4, 5, 6, 7), P, O[m], 0, 0, 0);
              asm volatile("s_waitcnt lgkmcnt(0)" ::: "memory"); __builtin_amdgcn_sched_barrier(0);
#pragma unroll
              for (int m = 4; m < 8; ++m) O[m] = __builtin_amdgcn_mfma_f32_16x16x32_bf16(__builtin_shufflevector(ta[m], tb[m], 0, 1, 2, 3, 4, 5, 6, 7), P, O[m], 0, 0, 0); }
        }
        l_run = x16_sum(l_run); l_run = x32_sum(l_run);
        const float inv = 1.0f / fmaxf(l_run, 1e-37f);
        { LAS unsigned char* stg = kvb + ((b0 + nch - 1) & 1) * 8192;
          if (l15 < 8) {
#pragma unroll
              for (int m = 0; m < 8; ++m) *(LAS v2u*)(stg + (l15 * 128 + 16 * m + 4 * g4) * 2) = (v2u){cvt_pk(O[m][0] * inv, O[m][1] * inv), cvt_pk(O[m][2] * inv, O[m][3] * inv)}; }
          asm volatile("s_waitcnt lgkmcnt(0)" ::: "memory");
          const v4u oa = *(const LAS v4u*)(stg + lane * 16), ob = *(const LAS v4u*)(stg + 1024 + lane * 16);
          bf16* op = (bf16*)(c.ws + WS_XB) + (size_t)n * 1024 + lane * 8;
          *(v4u*)op = oa; *(v4u*)(op + 512) = ob; }
        b0 = (b0 + nch) & 1; sl ^= 1; t = tn; cnt = cntn; nch = nchn; nfar = nfarn; Mref = Mrefn; n = nn;
#pragma unroll
        for (int s_ = 0; s_ < 4; ++s_) qf[s_] = qfn[s_];
    }
#undef DSA_QIDX
#undef DSA_LOADQ
#undef DSA_PREP
#undef DSA_ISSUE
    asm volatile("s_waitcnt vmcnt(0) lgkmcnt(0)" ::: "memory");
    if (wv >= 4) for (int eit = gw; eit < P0_EXPERT_ITEMS; eit += NGW) p0_expert_item(c, (LAS float*)kvb, eit);
    __syncthreads();
}

__device__ __forceinline__ void p3b_swa(const Ctx& c) {
    const int lane = c.lane, wv = c.wave, l15 = lane & 15, g4 = lane >> 4, g = wv & 3, hq = wv >> 2;
    LAS float* biasL = (LAS float*)(c.lds + DSA_BIAS_OFF);
    __syncthreads();
    for (int i = c.tid; i < 128 * 8; i += NTHR) biasL[i] = ((const float*)(c.ws + WS_BIAS) + 129 * 8)[i];
    __syncthreads();
    const unsigned kr_off = (unsigned)(128 * l15), kr_x = (unsigned)(l15 & 7);
    const int vrow = 4 * g4 + (l15 >> 2); const unsigned vr_x = (unsigned)(vrow & 7), vp1 = (unsigned)((lane & 3) >> 1);
    const unsigned vr_off = (unsigned)(128 * vrow + 8 * (lane & 1));
    for (int unit = c.bid; unit < 256; unit += c.G) {
        const int b = unit >> 5, qb = (unit >> 1) & 15, kvh = unit & 1, head = kvh * 4 + g;
        __syncthreads();
#pragma unroll
        for (int j = 0; j < 4; ++j) { const int piece = wv * 4 + j, row = 8 * piece + (lane >> 3), chunk = (lane & 7) ^ (row & 7); int key = (qb - 1) * 128 + row; key = key < 0 ? 0 : key;
            const size_t so = ((size_t)(b * SEQ + key) * 128 + kvh * 64 + chunk * 8);
            __builtin_amdgcn_global_load_lds((const unsigned*)((const bf16*)(c.ws + WS_KB) + so), (LAS unsigned*)(c.lds + piece * 1024), 16, 0, 0);
            __builtin_amdgcn_global_load_lds((const unsigned*)((const bf16*)(c.ws + WS_VB) + so), (LAS unsigned*)(c.lds + 32768 + piece * 1024), 16, 0, 0); }
        float bt[9][4];
#pragma unroll
        for (int ta = 0; ta < 9; ++ta)
#pragma unroll
            for (int r_ = 0; r_ < 4; ++r_) { const int dist = 128 + l15 - 16 * ta - 4 * g4 - r_; bt[ta][r_] = (dist >= 0 && dist < 128) ? biasL[dist * 8 + head] : -INFINITY; }
        const float sink = c.sinks[head];
        asm volatile("s_waitcnt vmcnt(0)" ::: "memory");
        __syncthreads();
#pragma unroll 1
        for (int jj = 0; jj < 4; ++jj) {
            const int j = 4 * hq + jj; const size_t nrow = (size_t)(b * SEQ + qb * 128 + 16 * j + l15);
            bf16* qrow = (bf16*)(c.ws + WS_QB) + nrow * 512 + head * 64;
            const s16x8 q0 = *(const s16x8*)(qrow + 8 * g4), q1 = *(const s16x8*)(qrow + 32 + 8 * g4);
            f32x4 S[9]; float mx = sink;
#pragma unroll
            for (int ta = 0; ta < 9; ++ta) { const int kt = j + ta; const LAS unsigned char* kp = c.lds + kr_off + 2048 * kt;
                f32x4 a4 = {0.f, 0.f, 0.f, 0.f};
                a4 = __builtin_amdgcn_mfma_f32_16x16x32_bf16(*(const LAS s16x8*)(kp + 16 * ((unsigned)g4 ^ kr_x)), q0, a4, 0, 0, 0);
                a4 = __builtin_amdgcn_mfma_f32_16x16x32_bf16(*(const LAS s16x8*)(kp + 16 * ((unsigned)(4 + g4) ^ kr_x)), q1, a4, 0, 0, 0);
                const bool dead = (qb == 0 && kt < 8);
#pragma unroll
                for (int r_ = 0; r_ < 4; ++r_) { const float sv = dead ? -INFINITY : a4[r_] + bt[ta][r_]; a4[r_] = sv; mx = fmaxf(mx, sv); }
                S[ta] = a4; }
            mx = x16_max(mx); mx = x32_max(mx);
            float ps = 0.f;
#pragma unroll
            for (int ta = 0; ta < 9; ++ta)
#pragma unroll
                for (int r_ = 0; r_ < 4; ++r_) { const float pv = __expf(S[ta][r_] - mx); S[ta][r_] = pv; ps += pv; }
            ps = x16_sum(ps); ps = x32_sum(ps);
            const float inv = 1.0f / (ps + __expf(sink - mx));
            f32x4 O[4];
#pragma unroll
            for (int m = 0; m < 4; ++m) O[m] = (f32x4){0.f, 0.f, 0.f, 0.f};
#pragma unroll
            for (int pp = 0; pp < 5; ++pp) {
                const int ta = 2 * pp, tb = 2 * pp + 1;
                v4u pw_; pw_.x = cvt_pk(S[ta][0] * inv, S[ta][1] * inv); pw_.y = cvt_pk(S[ta][2] * inv, S[ta][3] * inv);
                if (tb < 9) { pw_.z = cvt_pk(S[tb < 9 ? tb : 0][0] * inv, S[tb < 9 ? tb : 0][1] * inv); pw_.w = cvt_pk(S[tb < 9 ? tb : 0][2] * inv, S[tb < 9 ? tb : 0][3] * inv); } else { pw_.z = 0u; pw_.w = 0u; }
                const s16x8 P = __builtin_bit_cast(s16x8, pw_);
                const LAS unsigned char* va = c.lds + 32768 + vr_off + 2048 * (j + ta); const LAS unsigned char* vb_ = c.lds + 32768 + vr_off + 2048 * (j + (tb < 9 ? tb : ta));
#pragma unroll
                for (int m = 0; m < 4; ++m) { const unsigned co = 16u * ((unsigned)(2 * m + vp1) ^ vr_x);
                    const s16x4 a0 = __builtin_amdgcn_ds_read_tr16_b64_v4i16((LAS s16x4*)(va + co)), a1 = __builtin_amdgcn_ds_read_tr16_b64_v4i16((LAS s16x4*)(vb_ + co));
                    O[m] = __builtin_amdgcn_mfma_f32_16x16x32_bf16(__builtin_shufflevector(a0, a1, 0, 1, 2, 3, 4, 5, 6, 7), P, O[m], 0, 0, 0); }
            }
#pragma unroll
            for (int m = 0; m < 4; ++m) *(v2u*)(qrow + 16 * m + 4 * g4) = (v2u){cvt_pk(O[m][0], O[m][1]), cvt_pk(O[m][2], O[m][3])};
        }
    }
    __syncthreads();
}

__device__ __forceinline__ void p6_ln_router(const Ctx& c, bf16* x1b) {
    const int lane = c.lane, wv = c.wave, l15 = lane & 15, g4 = lane >> 4;
    LAS unsigned char* XH = c.lds; LAS unsigned char* XL = c.lds + 32768;
    LAS float* PL = (LAS float*)(c.lds + 65536);
    LAS float* LG = (LAS float*)(c.lds + 65536 + 24576);
    const bf16* WH = (const bf16*)(c.ws + WS_WRT); const bf16* WL = WH + 48 * 1024;
    LAS unsigned* PEX = (LAS unsigned*)(c.lds + 65536 + 24576 + 4096);
    LAS unsigned* EB = PEX + 128;
    int nbase = 0;
    s16x8 wbh[4][3], wbl[4][3];
#pragma unroll
    for (int s_ = 0; s_ < 4; ++s_)
#pragma unroll
        for (int nt = 0; nt < 3; ++nt) { const size_t wo = (size_t)(16 * nt + l15) * 1024 + 128 * wv + 32 * s_ + 8 * g4; wbh[s_][nt] = *(const s16x8*)(WH + wo); wbl[s_][nt] = *(const s16x8*)(WL + wo); }
    f32x4 vn[2][4];
    if (c.bid < NTOK / 16) {
#pragma unroll
        for (int q = 0; q < 2; ++q)
#pragma unroll
            for (int j = 0; j < 4; ++j) vn[q][j] = ((const f32x4*)(c.out + (size_t)(c.bid * 16 + 2 * wv + q) * D) + lane)[64 * j]; }
    for (int u = c.bid; u < NTOK / 16; u += c.G) {
        __syncthreads();
#pragma unroll
        for (int q = 0; q < 2; ++q) { const int tk = 2 * wv + q, n = u * 16 + tk;
            f32x4 v[4]; float s = 0.f;
#pragma unroll
            for (int j = 0; j < 4; ++j) { v[j] = vn[q][j]; s += (v[j].x + v[j].y) + (v[j].z + v[j].w); }
            const float mean = wave_sum(s) * (1.f / D); float s2 = 0.f;
#pragma unroll
            for (int j = 0; j < 4; ++j) { v[j] = v[j] - mean; s2 += (v[j].x * v[j].x + v[j].y * v[j].y) + (v[j].z * v[j].z + v[j].w * v[j].w); }
            const float rstd = 1.f / sqrtf(wave_sum(s2) * (1.f / D) + LN_EPS);
#pragma unroll
            for (int j = 0; j < 4; ++j) { const int k0 = 4 * lane + 256 * j;
                const f32x4 g = *(const f32x4*)(c.ln1_g + k0), bb = *(const f32x4*)(c.ln1_b + k0);
                const f32x4 y = v[j] * rstd * g + bb;
                const unsigned h01 = pk2(y.x, y.y), h23 = pk2(y.z, y.w);
                *(v2u*)(x1b + (size_t)n * D + k0) = (v2u){h01, h23};
                const unsigned l01 = pk2(y.x - bflo(h01), y.y - bfhi(h01)), l23 = pk2(y.z - bflo(h23), y.w - bfhi(h23));
                const unsigned off = (unsigned)(tk * 2048 + ((((lane >> 1) + 32 * j) ^ tk) << 4) + 8 * (lane & 1));
                *(LAS v2u*)(XH + off) = (v2u){h01, h23}; *(LAS v2u*)(XL + off) = (v2u){l01, l23}; } }
        if (u + c.G < NTOK / 16) {
#pragma unroll
            for (int q = 0; q < 2; ++q)
#pragma unroll
                for (int j = 0; j < 4; ++j) vn[q][j] = ((const f32x4*)(c.out + (size_t)((u + c.G) * 16 + 2 * wv + q) * D) + lane)[64 * j]; }
        __syncthreads();
        { f32x4 acc[3];
#pragma unroll
          for (int nt = 0; nt < 3; ++nt) acc[nt] = (f32x4){0.f, 0.f, 0.f, 0.f};
#pragma unroll
          for (int s_ = 0; s_ < 4; ++s_) { const int chunk = 4 * (4 * wv + s_) + g4; const unsigned off = (unsigned)(l15 * 2048 + ((chunk ^ l15) << 4));
              const s16x8 ah = *(const LAS s16x8*)(XH + off), al = *(const LAS s16x8*)(XL + off);
#pragma unroll
              for (int nt = 0; nt < 3; ++nt) { const s16x8 bh = wbh[s_][nt], bl = wbl[s_][nt];
                  acc[nt] = __builtin_amdgcn_mfma_f32_16x16x32_bf16(al, bl, acc[nt], 0, 0, 0); acc[nt] = __builtin_amdgcn_mfma_f32_16x16x32_bf16(al, bh, acc[nt], 0, 0, 0);
                  acc[nt] = __builtin_amdgcn_mfma_f32_16x16x32_bf16(ah, bl, acc[nt], 0, 0, 0); acc[nt] = __builtin_amdgcn_mfma_f32_16x16x32_bf16(ah, bh, acc[nt], 0, 0, 0); } }
#pragma unroll
          for (int nt = 0; nt < 3; ++nt)
#pragma unroll
              for (int r_ = 0; r_ < 4; ++r_) PL[(wv * 16 + 4 * g4 + r_) * 48 + 16 * nt + l15] = acc[nt][r_]; }
        __syncthreads();
        for (int i = c.tid; i < 16 * 48; i += NTHR) { float a = 0.f;
#pragma unroll
            for (int w = 0; w < 8; ++w) a += PL[w * 768 + i];
            const int o = i % 48; a += o < 32 ? c.b_router[o] : (o < 36 ? c.b_group[o - 32] : 0.f);
            LG[i] = a; }
        __syncthreads();
        if (c.tid < 16) { const int n = u * 16 + c.tid; const LAS float* lg = LG + c.tid * 48; const int nloc = nbase + 2 * c.tid;
            int gs = 0; float gm = lg[32];
            for (int o = 1; o < 4; ++o) { const float v = lg[32 + o]; if (v > gm) { gm = v; gs = o; } }
            float gsum = 0.f;
            for (int o = 0; o < 4; ++o) gsum += __expf(lg[32 + o] - gm);
            const float gw_ = 1.0f / gsum;
            int i1 = 0; float m1 = lg[gs * 8];
            for (int o = 1; o < 8; ++o) { const float v = lg[gs * 8 + o]; if (v > m1) { m1 = v; i1 = o; } }
            int i2 = -1; float m2 = -INFINITY;
            for (int o = 0; o < 8; ++o) { const float v = lg[gs * 8 + o]; if (o != i1 && v > m2) { m2 = v; i2 = o; } }
            const float e2 = __expf(m2 - m1), w1 = gw_ / (1.0f + e2), w2 = gw_ * e2 / (1.0f + e2);
            const int ex1 = gs * 8 + i1, ex2 = gs * 8 + i2;
            ((unsigned*)(c.ws + WS_PE))[2 * n] = ex1; ((unsigned*)(c.ws + WS_PE))[2 * n + 1] = ex2; ((float*)(c.ws + WS_PW))[2 * n] = w1; ((float*)(c.ws + WS_PW))[2 * n + 1] = w2;
            PEX[nloc] = (unsigned)ex1 | ((unsigned)(2 * n) << 8); PEX[nloc + 1] = (unsigned)ex2 | ((unsigned)(2 * n + 1) << 8); }
        nbase += 32;
        if (nbase == 128 || u + c.G >= NTOK / 16) {
            __syncthreads();
            if (c.tid < 32) { unsigned cntE = 0; for (int j = 0; j < nbase; ++j) cntE += ((PEX[j] & 0xffu) == (unsigned)c.tid) ? 1u : 0u;
                EB[c.tid] = cntE ? atomicAdd(c.ctl + CW_CNT + c.tid, cntE) : 0u; }
            __syncthreads();
            if (c.tid < nbase) { const unsigned rec = PEX[c.tid], e = rec & 0xffu; unsigned rk = 0; for (int j = 0; j < c.tid; ++j) rk += ((PEX[j] & 0xffu) == e) ? 1u : 0u;
                ((unsigned*)(c.ws + WS_LIST))[(size_t)e * 32768 + EB[e] + rk] = rec >> 8; }
            nbase = 0;
        }
    }
    __syncthreads();
}


__device__ __forceinline__ void p9_ln2(const Ctx& c) {
    const int gw = c.bid * NWAVES + c.wave, NGW = c.G * NWAVES;
    f32x4 vn[4]; v2u san[4], sbn[4];
#define P9_LOAD(n_) do { const f32x4* r_ = (const f32x4*)(c.out + (size_t)(n_) * D) + c.lane; \
        _Pragma("unroll") for (int j = 0; j < 4; ++j) { const int k0 = 4 * c.lane + 256 * j; vn[j] = r_[64 * j]; \
            san[j] = *(const v2u*)((const bf16*)(c.ws + WS_SLOT) + (size_t)(2 * (n_)) * D + k0); sbn[j] = *(const v2u*)((const bf16*)(c.ws + WS_SLOT) + (size_t)(2 * (n_) + 1) * D + k0); } } while (0)
    if (gw < NTOK) P9_LOAD(gw);
    for (int n = gw; n < NTOK; n += NGW) {
        f32x4* row = (f32x4*)(c.out + (size_t)n * D) + c.lane;
        f32x4 v[4]; v2u sa[4], sb[4]; float s = 0.f;
#pragma unroll
        for (int j = 0; j < 4; ++j) { v[j] = vn[j]; sa[j] = san[j]; sb[j] = sbn[j]; s += (v[j].x + v[j].y) + (v[j].z + v[j].w); }
        if (n + NGW < NTOK) P9_LOAD(n + NGW);
        const float mean1 = wave_sum(s) * (1.f / D); float q1 = 0.f;
#pragma unroll
        for (int j = 0; j < 4; ++j) { v[j] = v[j] - mean1; q1 += (v[j].x * v[j].x + v[j].y * v[j].y) + (v[j].z * v[j].z + v[j].w * v[j].w); }
        const float rstd1 = 1.f / sqrtf(wave_sum(q1) * (1.f / D) + LN_EPS);
        s = 0.f;
#pragma unroll
        for (int j = 0; j < 4; ++j) { const int k0 = 4 * c.lane + 256 * j; const f32x4 g = *(const f32x4*)(c.ln1_g + k0), bb = *(const f32x4*)(c.ln1_b + k0);
            f32x4 y = (v[j] * rstd1 * g + bb) * ALPHA; y.x += bflo(sa[j].x) + bflo(sb[j].x); y.y += bfhi(sa[j].x) + bfhi(sb[j].x); y.z += bflo(sa[j].y) + bflo(sb[j].y); y.w += bfhi(sa[j].y) + bfhi(sb[j].y);
            v[j] = y; s += (y.x + y.y) + (y.z + y.w); }
        const float mean = wave_sum(s) * (1.f / D); float s2 = 0.f;
#pragma unroll
        for (int j = 0; j < 4; ++j) { v[j] = v[j] - mean; s2 += (v[j].x * v[j].x + v[j].y * v[j].y) + (v[j].z * v[j].z + v[j].w * v[j].w); }
        const float rstd = 1.f / sqrtf(wave_sum(s2) * (1.f / D) + LN_EPS);
#pragma unroll
        for (int j = 0; j < 4; ++j) { const int k0 = 4 * c.lane + 256 * j; const f32x4 g = *(const f32x4*)(c.ln2_g + k0), bb = *(const f32x4*)(c.ln2_b + k0); row[64 * j] = v[j] * rstd * g + bb; }
    }
#undef P9_LOAD
}

namespace pg8 {
typedef short bf16x8 __attribute__((ext_vector_type(8)));
constexpr int BM = 256, BK = 64, HALF = 128, HTB = HALF * BK * 2, STAGE_BYTES = 8 * HTB, NXCD = 8, WGM = 8;
__host__ __device__ __forceinline__ int lds_byte(int r, int c) { const int st = (r >> 4) * 2 + (c >> 5), rr = r & 15, cc = c & 31, ob = rr * 64 + cc * 2; return st * 1024 + (ob ^ (((ob >> 9) & 1) << 5)); }
__host__ __device__ __forceinline__ void stage_rc(int b, int& R, int& C) { const int st = b / 1024, sb = b % 1024, swz = sb ^ (((sb >> 9) & 1) << 5); R = (st >> 1) * 16 + swz / 64; C = (st & 1) * 32 + (swz % 64) / 2; }
__host__ __device__ __forceinline__ int perm32(int rho) { const int n = rho >> 4, i = rho & 15; return 8 * (i >> 2) + 4 * n + (i & 3); }
__device__ __forceinline__ unsigned cvt_pk_bf16(float lo, float hi) { unsigned r; asm volatile("v_cvt_pk_bf16_f32 %0, %1, %2" : "=v"(r) : "v"(lo), "v"(hi)); return r; }

struct Unit { int pm, pn, pb, aux; };

struct StaticOrder {
    int nM, nN, nwg, G, c;
    __device__ void init(int M, int N, int G_, int c_) { nM = M / BM; nN = N / BM; nwg = nM * nN; G = G_; c = c_; }
    __device__ bool next(int i, Unit& u) const {
        const long L = (long)i * G + c; if (L >= nwg) return false;
        int wgid = (int)L; { const int q = nwg / NXCD, r = nwg % NXCD, xcd = wgid % NXCD, off = wgid / NXCD; wgid = (xcd < r ? xcd * (q + 1) : r * (q + 1) + (xcd - r) * q) + off; }
        const int nig = WGM * nN, gid = wgid / nig, fm = gid * WGM, gsz = (nM - fm) < WGM ? (nM - fm) : WGM;
        u.pm = fm + ((wgid % nig) % gsz); u.pn = (wgid % nig) / gsz; u.pb = u.pn; u.aux = 0; return true;
    }
    __device__ __forceinline__ void a_ready(const Unit&) const {}
    __device__ __forceinline__ void done(const Unit&) const {}
};
struct DenseProb {
    static constexpr bool GATHER = false;
    const bf16* A; const bf16* Bt; int K;
    __device__ __forceinline__ const char* a_base(const Unit& u) const { return (const char*)A + (size_t)u.pm * 256 * K * 2; }
    __device__ __forceinline__ const char* b_base(const Unit& u) const { return (const char*)Bt + (size_t)u.pb * 256 * K * 2; }
    __device__ __forceinline__ void a_offs(const Unit&, int R0, int C0, int R1, int C1, unsigned (&o)[2][2]) const {
        o[0][0] = (unsigned)(R0 * K + C0) * 2u; o[0][1] = (unsigned)(R1 * K + C1) * 2u; o[1][0] = o[0][0] + (unsigned)(HALF * K * 2); o[1][1] = o[0][1] + (unsigned)(HALF * K * 2); }
};

template <class Prob, class Epi, class Sched>
__device__ __forceinline__ void gemm_phase(LAS unsigned char* lds, const Prob& P, const Sched& S, const Epi& E) {
    const int tid = threadIdx.x, wid = __builtin_amdgcn_readfirstlane(tid >> 6), lane = tid & 63, wr = wid >> 2, wc = wid & 3, fr = lane & 15, fq = lane >> 4;
    const int K = P.K, nt = K / BK;
    int sR[2], sC[2];
    unsigned offB[2][2], offA[2][2];
#pragma unroll
    for (int i = 0; i < 2; ++i) { stage_rc(tid * 16 + i * 8192, sR[i], sC[i]); const int Rb = Epi::PERM ? ((sR[i] & ~31) + perm32(sR[i] & 31)) : sR[i];
        offB[0][i] = (unsigned)(Rb * K + sC[i]) * 2u; offB[1][i] = offB[0][i] + (unsigned)(HALF * K * 2); }
    const size_t kstep = (size_t)(BK * 2);
    const unsigned ldsw = (unsigned)wid * 1024u;
    const int aoff = lds_byte(wr * 64 + fr, fq * 8), boff = lds_byte(wc * 32 + fr, fq * 8);
#define PG8_SA(b, h) (((b) * 2 + (h)) * HTB)
#define PG8_SB(b, h) ((4 + (b) * 2 + (h)) * HTB)
#define PG8_STAGE(bufoff, gbase, offs) do { _Pragma("unroll") for (int _i = 0; _i < 2; ++_i) \
        __builtin_amdgcn_global_load_lds((const unsigned*)((gbase) + (offs)[_i]), (LAS unsigned*)(lds + (bufoff) + ldsw + _i * 8192), 16, 0, 0); } while (0)
#define PG8_STA(b, h, tau) PG8_STAGE(PG8_SA(b, h), sA + (size_t)(tau) * kstep, offA[h])
#define PG8_STB(b, h, tau) PG8_STAGE(PG8_SB(b, h), sB + (size_t)(tau) * kstep, offB[h])
#define PG8_LDA(dst, b, h) do { _Pragma("unroll") for (int m = 0; m < 4; ++m) _Pragma("unroll") for (int k = 0; k < 2; ++k) dst[m][k] = *(const LAS bf16x8*)(lds + PG8_SA(b, h) + aoff + m * 2048 + k * 1024); } while (0)
#define PG8_LDB(dst, b, h) do { _Pragma("unroll") for (int n = 0; n < 2; ++n) _Pragma("unroll") for (int k = 0; k < 2; ++k) dst[n][k] = *(const LAS bf16x8*)(lds + PG8_SB(b, h) + boff + n * 2048 + k * 1024); } while (0)
#define PG8_MMA(ai, bj, At, Bt) do { __builtin_amdgcn_s_setprio(1); _Pragma("unroll") for (int m = 0; m < 4; ++m) _Pragma("unroll") for (int n = 0; n < 2; ++n) _Pragma("unroll") for (int k = 0; k < 2; ++k) \
        acc[ai][bj][m][n] = __builtin_amdgcn_mfma_f32_16x16x32_bf16(Bt[n][k], At[m][k], acc[ai][bj][m][n], 0, 0, 0); __builtin_amdgcn_s_setprio(0); } while (0)
#define PG8_WAIT_V(n) asm volatile("s_waitcnt vmcnt(" #n ")" ::: "memory")
#define PG8_WAIT_L(n) asm volatile("s_waitcnt lgkmcnt(" #n ")" ::: "memory")
#define PG8_BAR __builtin_amdgcn_s_barrier()
#define PG8_SCHED __builtin_amdgcn_sched_barrier(0)
    Unit cur, nxt; int ui = 0;
    if (!S.next(0, cur)) return;
    f32x4 acc[2][2][4][2];
#pragma unroll
    for (int a = 0; a < 2; ++a)
#pragma unroll
        for (int b = 0; b < 2; ++b)
#pragma unroll
            for (int m = 0; m < 4; ++m)
#pragma unroll
                for (int n = 0; n < 2; ++n) acc[a][b][m][n] = (f32x4){0.f, 0.f, 0.f, 0.f};
    bf16x8 At[4][2], B0[2][2], B1[2][2];
    const char* sA = P.a_base(cur); const char* sB = P.b_base(cur);
    S.a_ready(cur);
    P.a_offs(cur, sR[0], sC[0], sR[1], sC[1], offA);
    PG8_STB(0, 0, 0); PG8_STB(0, 1, 0); PG8_STA(0, 0, 0); PG8_STA(0, 1, 0);
    if (wr == 1) PG8_BAR;
    PG8_WAIT_V(2); PG8_BAR;
    PG8_STB(1, 0, 1); PG8_STA(1, 0, 1); PG8_STB(1, 1, 1);
    PG8_WAIT_V(6); PG8_BAR;
    for (;;) {
        const bool has_next = S.next(ui + 1, nxt);
        unsigned nOffA[2][2];
        if (Prob::GATHER) { if (has_next) P.a_offs(nxt, sR[0], sC[0], sR[1], sC[1], nOffA); else {
#pragma unroll
            for (int h = 0; h < 2; ++h)
#pragma unroll
                for (int i = 0; i < 2; ++i) nOffA[h][i] = offA[h][i]; } }
        const char* nA = has_next ? P.a_base(nxt) : sA; const char* nB = has_next ? P.b_base(nxt) : sB;
        for (int t = 0; t < nt; t += 2) {
            const bool last = (t == nt - 2);
            if (last && has_next) S.a_ready(nxt);
            PG8_LDB(B0, 0, 0); PG8_LDB(B1, 0, 1); PG8_SCHED; PG8_LDA(At, 0, 0); PG8_STA(1, 1, t + 1);
            PG8_WAIT_V(8); PG8_WAIT_L(0); PG8_BAR; PG8_MMA(0, 0, At, B0); PG8_MMA(0, 1, At, B1); PG8_BAR; PG8_SCHED;
            if (last) {
                sA = nA - (size_t)nt * kstep; sB = nB - (size_t)nt * kstep;
                if (Prob::GATHER) {
#pragma unroll
                    for (int h = 0; h < 2; ++h)
#pragma unroll
                        for (int i = 0; i < 2; ++i) offA[h][i] = nOffA[h][i]; }
            }
            PG8_LDA(At, 0, 1); PG8_STB(0, 0, t + 2); PG8_STB(0, 1, t + 2); PG8_STA(0, 0, t + 2);
            PG8_WAIT_V(8); PG8_WAIT_L(0); PG8_BAR; PG8_MMA(1, 0, At, B0); PG8_MMA(1, 1, At, B1); PG8_BAR; PG8_SCHED;
            PG8_LDB(B0, 1, 0); PG8_LDB(B1, 1, 1); PG8_SCHED; PG8_LDA(At, 1, 0); PG8_STA(0, 1, t + 2);
            PG8_WAIT_V(8); PG8_WAIT_L(0); PG8_BAR; PG8_MMA(0, 0, At, B0); PG8_MMA(0, 1, At, B1); PG8_BAR; PG8_SCHED;
            PG8_LDA(At, 1, 1); PG8_STB(1, 0, t + 3); PG8_STB(1, 1, t + 3); PG8_STA(1, 0, t + 3);
            PG8_WAIT_V(8); PG8_WAIT_L(0); PG8_BAR; PG8_MMA(1, 0, At, B0); PG8_MMA(1, 1, At, B1); PG8_BAR; PG8_SCHED;
        }
        if (wr == 0) PG8_BAR;
        E(acc, cur, wr, wc, fr, fq); S.done(cur);
        if (!has_next) break;
#pragma unroll
        for (int a = 0; a < 2; ++a)
#pragma unroll
            for (int b = 0; b < 2; ++b)
#pragma unroll
                for (int m = 0; m < 4; ++m)
#pragma unroll
                    for (int n = 0; n < 2; ++n) acc[a][b][m][n] = (f32x4){0.f, 0.f, 0.f, 0.f};
        cur = nxt; ++ui; sA = nA; sB = nB;
        if (wr == 1) PG8_BAR;
    }
    PG8_WAIT_V(0);
    PG8_BAR;
#undef PG8_SA
#undef PG8_SB
#undef PG8_STAGE
#undef PG8_STA
#undef PG8_STB
#undef PG8_LDA
#undef PG8_LDB
#undef PG8_MMA
#undef PG8_WAIT_V
#undef PG8_WAIT_L
#undef PG8_BAR
#undef PG8_SCHED
}

template <class Epi, class Sched>
__device__ __forceinline__ void gemm_phase_dual(LAS unsigned char* lds, const bf16* A1, const bf16* Bt1, int K1, const bf16* A2, const bf16* Bt2, int K2, const Sched& S, const Epi& E) {
    const int tid = threadIdx.x, wid = __builtin_amdgcn_readfirstlane(tid >> 6), lane = tid & 63, wr = wid >> 2, wc = wid & 3, fr = lane & 15, fq = lane >> 4;
    const int nt1 = K1 / BK, nt = (K1 + K2) / BK;
    unsigned offB1[2][2], offA1[2][2]; const unsigned dK2 = (unsigned)(2 * (K2 - K1));
#pragma unroll
    for (int i = 0; i < 2; ++i) { int R, C; stage_rc(tid * 16 + i * 8192, R, C); const int Rb = (R & ~31) + perm32(R & 31);
        offA1[0][i] = (unsigned)(R * K1 + C) * 2u; offA1[1][i] = offA1[0][i] + (unsigned)(HALF * K1 * 2); offB1[0][i] = (unsigned)(Rb * K1 + C) * 2u; offB1[1][i] = offB1[0][i] + (unsigned)(HALF * K1 * 2); }
    const size_t kstep = (size_t)(BK * 2);
    const unsigned ldsw = (unsigned)wid * 1024u;
    const int aoff = lds_byte(wr * 64 + fr, fq * 8), boff = lds_byte(wc * 32 + fr, fq * 8);
#define PG8_SA(b, h) (((b) * 2 + (h)) * HTB)
#define PG8_SB(b, h) ((4 + (b) * 2 + (h)) * HTB)
#define PG8_STX(bufoff, tau, g1, g2, o1, o2) do { const int _t = (tau); const bool _s2 = _t >= nt1; const long long _d = _s2 ? (long long)((g2) - (g1)) - (long long)nt1 * (long long)kstep : 0ll; const char* _g = (g1) + (size_t)_t * kstep + _d; \
        _Pragma("unroll") for (int _i = 0; _i < 2; ++_i) { const unsigned _o = (o1)[_i] + (_s2 ? ((o1)[_i] >> 11) * dK2 : 0u); \
        __builtin_amdgcn_global_load_lds((const unsigned*)(_g + _o), (LAS unsigned*)(lds + (bufoff) + ldsw + _i * 8192), 16, 0, 0); } } while (0)
#define PG8_STA(b, h, tau) PG8_STX(PG8_SA(b, h), tau, sA1, sA2, offA1[h], 0)
#define PG8_STB(b, h, tau) PG8_STX(PG8_SB(b, h), tau, sB1, sB2, offB1[h], 0)
#define PG8_LDA(dst, b, h) do { _Pragma("unroll") for (int m = 0; m < 4; ++m) _Pragma("unroll") for (int k = 0; k < 2; ++k) dst[m][k] = *(const LAS bf16x8*)(lds + PG8_SA(b, h) + aoff + m * 2048 + k * 1024); } while (0)
#define PG8_LDB(dst, b, h) do { _Pragma("unroll") for (int n = 0; n < 2; ++n) _Pragma("unroll") for (int k = 0; k < 2; ++k) dst[n][k] = *(const LAS bf16x8*)(lds + PG8_SB(b, h) + boff + n * 2048 + k * 1024); } while (0)
#define PG8_MMA(ai, bj, At, Bt) do { __builtin_amdgcn_s_setprio(1); _Pragma("unroll") for (int m = 0; m < 4; ++m) _Pragma("unroll") for (int n = 0; n < 2; ++n) _Pragma("unroll") for (int k = 0; k < 2; ++k) \
        acc[ai][bj][m][n] = __builtin_amdgcn_mfma_f32_16x16x32_bf16(Bt[n][k], At[m][k], acc[ai][bj][m][n], 0, 0, 0); __builtin_amdgcn_s_setprio(0); } while (0)
#define PG8_WAIT_V(n) asm volatile("s_waitcnt vmcnt(" #n ")" ::: "memory")
#define PG8_WAIT_L(n) asm volatile("s_waitcnt lgkmcnt(" #n ")" ::: "memory")
#define PG8_BAR __builtin_amdgcn_s_barrier()
#define PG8_SCHED __builtin_amdgcn_sched_barrier(0)
    Unit cur, nxt; int ui = 0;
    if (!S.next(0, cur)) return;
    f32x4 acc[2][2][4][2];
#pragma unroll
    for (int a = 0; a < 2; ++a)
#pragma unroll
        for (int b = 0; b < 2; ++b)
#pragma unroll
            for (int m = 0; m < 4; ++m)
#pragma unroll
                for (int n = 0; n < 2; ++n) acc[a][b][m][n] = (f32x4){0.f, 0.f, 0.f, 0.f};
    bf16x8 At[4][2], B0[2][2], B1[2][2];
    const char* sA1 = (const char*)A1 + (size_t)cur.pm * 256 * K1 * 2; const char* sB1 = (const char*)Bt1 + (size_t)cur.pn * 256 * K1 * 2;
    const char* sA2 = (const char*)A2 + (size_t)cur.pm * 256 * K2 * 2; const char* sB2 = (const char*)Bt2 + (size_t)cur.pn * 256 * K2 * 2;
    PG8_STB(0, 0, 0); PG8_STB(0, 1, 0); PG8_STA(0, 0, 0); PG8_STA(0, 1, 0);
    if (wr == 1) PG8_BAR;
    PG8_WAIT_V(2); PG8_BAR;
    PG8_STB(1, 0, 1); PG8_STA(1, 0, 1); PG8_STB(1, 1, 1);
    PG8_WAIT_V(6); PG8_BAR;
    for (;;) {
        const bool has_next = S.next(ui + 1, nxt);
        const int npm = has_next ? nxt.pm : cur.pm, npn = has_next ? nxt.pn : cur.pn;
        const char* nA1 = (const char*)A1 + (size_t)npm * 256 * K1 * 2; const char* nB1 = (const char*)Bt1 + (size_t)npn * 256 * K1 * 2;
        const char* nA2 = (const char*)A2 + (size_t)npm * 256 * K2 * 2; const char* nB2 = (const char*)Bt2 + (size_t)npn * 256 * K2 * 2;
        for (int t = 0; t < nt; t += 2) {
            const bool last = (t == nt - 2);
            const int t2 = last ? 0 : t + 2, t3 = last ? 1 : t + 3;
            if (t == nt1) { E.mid(acc, cur, wr, wc, fr, fq); PG8_SCHED; }
            PG8_LDB(B0, 0, 0); PG8_LDB(B1, 0, 1); PG8_SCHED; PG8_LDA(At, 0, 0); PG8_STA(1, 1, t + 1);
            PG8_WAIT_V(8); PG8_WAIT_L(0); PG8_BAR; PG8_MMA(0, 0, At, B0); PG8_MMA(0, 1, At, B1); PG8_BAR; PG8_SCHED;
            if (last) { sA1 = nA1; sB1 = nB1; sA2 = nA2; sB2 = nB2; }
            PG8_LDA(At, 0, 1); PG8_STB(0, 0, t2); PG8_STB(0, 1, t2); PG8_STA(0, 0, t2);
            PG8_WAIT_V(8); PG8_WAIT_L(0); PG8_BAR; PG8_MMA(1, 0, At, B0); PG8_MMA(1, 1, At, B1); PG8_BAR; PG8_SCHED;
            PG8_LDB(B0, 1, 0); PG8_LDB(B1, 1, 1); PG8_SCHED; PG8_LDA(At, 1, 0); PG8_STA(0, 1, t2);
            PG8_WAIT_V(8); PG8_WAIT_L(0); PG8_BAR; PG8_MMA(0, 0, At, B0); PG8_MMA(0, 1, At, B1); PG8_BAR; PG8_SCHED;
            PG8_LDA(At, 1, 1); PG8_STB(1, 0, t3); PG8_STB(1, 1, t3); PG8_STA(1, 0, t3);
            PG8_WAIT_V(8); PG8_WAIT_L(0); PG8_BAR; PG8_MMA(1, 0, At, B0); PG8_MMA(1, 1, At, B1); PG8_BAR; PG8_SCHED;
        }
        if (wr == 0) PG8_BAR;
        E(acc, cur, wr, wc, fr, fq);
        if (!has_next) break;
#pragma unroll
        for (int a = 0; a < 2; ++a)
#pragma unroll
            for (int b = 0; b < 2; ++b)
#pragma unroll
                for (int m = 0; m < 4; ++m)
#pragma unroll
                    for (int n = 0; n < 2; ++n) acc[a][b][m][n] = (f32x4){0.f, 0.f, 0.f, 0.f};
        cur = nxt; ++ui;
        if (wr == 1) PG8_BAR;
    }
    PG8_WAIT_V(0);
    PG8_BAR;
#undef PG8_SA
#undef PG8_SB
#undef PG8_STX
#undef PG8_STA
#undef PG8_STB
#undef PG8_LDA
#undef PG8_LDB
#undef PG8_MMA
#undef PG8_WAIT_V
#undef PG8_WAIT_L
#undef PG8_BAR
#undef PG8_SCHED
}
__device__ __forceinline__ v4u pack8(f32x4 v0, f32x4 v1) { v4u w; w.x = cvt_pk_bf16(v0[0], v0[1]); w.y = cvt_pk_bf16(v0[2], v0[3]); w.z = cvt_pk_bf16(v1[0], v1[1]); w.w = cvt_pk_bf16(v1[2], v1[3]); return w; }
__device__ __forceinline__ float sigm(float v) { return __builtin_amdgcn_rcpf(1.0f + __expf(-v)); }

struct EpiMergedDual {
    static constexpr bool PERM = true;
    const bf16* ga; const bf16* gb; bf16* merged;
    __device__ __forceinline__ void mid(f32x4 (&acc)[2][2][4][2], const Unit& u, int wr, int wc, int fr, int fq) const {
        int row0 = u.pm * BM + wr * 64 + fr; const int col0 = u.pn * BM + wc * 32 + 8 * fq;
        asm volatile("" : "+v"(row0));
#pragma unroll
        for (int ai = 0; ai < 2; ++ai)
#pragma unroll
            for (int m = 0; m < 4; ++m) { const size_t o = (size_t)(row0 + ai * HALF + m * 16) * 1024 + col0;
#pragma unroll
                for (int bj = 0; bj < 2; ++bj) { const v4u a = *(const v4u*)(ga + o + bj * HALF), b = *(const v4u*)(gb + o + bj * HALF);
                    f32x4 r0 = {bflo(a.x) * __builtin_amdgcn_rcpf(bflo(b.x)), bfhi(a.x) * __builtin_amdgcn_rcpf(bfhi(b.x)), bflo(a.y) * __builtin_amdgcn_rcpf(bflo(b.y)), bfhi(a.y) * __builtin_amdgcn_rcpf(bfhi(b.y))};
                    f32x4 r1 = {bflo(a.z) * __builtin_amdgcn_rcpf(bflo(b.z)), bfhi(a.z) * __builtin_amdgcn_rcpf(bfhi(b.z)), bflo(a.w) * __builtin_amdgcn_rcpf(bflo(b.w)), bfhi(a.w) * __builtin_amdgcn_rcpf(bfhi(b.w))};
                    acc[ai][bj][m][0] = acc[ai][bj][m][0] * r0; acc[ai][bj][m][1] = acc[ai][bj][m][1] * r1; }
                asm volatile("" ::: "memory"); }
    }
    __device__ __forceinline__ void operator()(const f32x4 (&acc)[2][2][4][2], const Unit& u, int wr, int wc, int fr, int fq) const {
        int row0 = u.pm * BM + wr * 64 + fr; const int col0 = u.pn * BM + wc * 32 + 8 * fq;
        asm volatile("" : "+v"(row0));
#pragma unroll
        for (int ai = 0; ai < 2; ++ai)
#pragma unroll
            for (int m = 0; m < 4; ++m) { const size_t o = (size_t)(row0 + ai * HALF + m * 16) * 1024 + col0;
#pragma unroll
                for (int bj = 0; bj < 2; ++bj) { const v4u g = *(const v4u*)(gb + o + bj * HALF);
                    f32x4 g0 = {bflo(g.x), bfhi(g.x), bflo(g.y), bfhi(g.y)}, g1 = {bflo(g.z), bfhi(g.z), bflo(g.w), bfhi(g.w)};
                    *(v4u*)(merged + o + bj * HALF) = pack8(g0 * acc[ai][bj][m][0], g1 * acc[ai][bj][m][1]); } }
    }
};
struct EpiProj {
    static constexpr bool PERM = true;
    unsigned char* ws;
    __device__ __forceinline__ void operator()(const f32x4 (&acc)[2][2][4][2], const Unit& u, int wr, int wc, int fr, int fq) const {
        const int row0 = u.pm * BM + wr * 64 + fr, cw = wc * 32 + 8 * fq, pn = u.pn;
        if (pn == 4) {
#pragma unroll
            for (int ai = 0; ai < 2; ++ai)
#pragma unroll
                for (int m = 0; m < 4; ++m) { const size_t row = (size_t)(row0 + ai * HALF + m * 16);
                    float* cr = (float*)(ws + WS_CKVRAW) + row * 128 + cw; *(f32x4*)cr = acc[ai][0][m][0]; *(f32x4*)(cr + 4) = acc[ai][0][m][1];
                    if (cw < 64) *(v4u*)((bf16*)(ws + WS_KIDX) + ((((row >> 4) * 8 + (cw >> 3)) * 16 + (row & 15)) << 3)) = pack8(acc[ai][1][m][0], acc[ai][1][m][1]);
                    else if (cw == 64) { float* wr_ = (float*)(ws + WS_WIDX) + row * 8; *(f32x4*)wr_ = acc[ai][1][m][0] * IDXW_SCALE; *(f32x4*)(wr_ + 4) = acc[ai][1][m][1] * IDXW_SCALE; } }
            return;
        }
        bf16* base; int ld, c0; float sc = 1.f; bool sg = false;
        if (pn < 4) { base = (bf16*)(ws + WS_QLAT); ld = 1024; c0 = pn * 256; sc = ATT_SCALE; }
        else if (pn < 7) { base = (bf16*)(ws + WS_QIDX); ld = 512; c0 = (pn - 5) * 256; }
        else if (pn < 9) { base = (bf16*)(ws + WS_QB); ld = 512; c0 = (pn - 7) * 256; sc = 0.125f; }
        else if (pn == 9) { base = (bf16*)(ws + WS_KB); ld = 128; c0 = 0; }
        else if (pn < 14) { base = (bf16*)(ws + WS_GA); ld = 1024; c0 = (pn - 10) * 256; sg = true; }
        else { base = (bf16*)(ws + WS_GB); ld = 1024; c0 = (pn - 14) * 256; sg = true; }
        const size_t bjstep = (pn == 9) ? (size_t)(WS_VB - WS_KB) / 2 : (size_t)HALF;
#pragma unroll
        for (int ai = 0; ai < 2; ++ai)
#pragma unroll
            for (int m = 0; m < 4; ++m) { bf16* rowp = base + (size_t)(row0 + ai * HALF + m * 16) * ld + c0 + cw;
#pragma unroll
                for (int bj = 0; bj < 2; ++bj) { f32x4 v0 = acc[ai][bj][m][0], v1 = acc[ai][bj][m][1];
                    if (sg) {
#pragma unroll
                        for (int j = 0; j < 4; ++j) { v0[j] = sigm(v0[j]); v1[j] = sigm(v1[j]); } }
                    else { v0 = v0 * sc; v1 = v1 * sc; }
                    *(v4u*)(rowp + bj * bjstep) = pack8(v0, v1); } }
    }
};
struct EpiWoutM {
    static constexpr bool PERM = true;
    const float* x; float* out;
    __device__ __forceinline__ void operator()(const f32x4 (&acc)[2][2][4][2], const Unit& u, int wr, int wc, int fr, int fq) const {
        const int row0 = u.pm * BM + wr * 64 + fr, col0 = u.pn * BM + wc * 32 + 8 * fq;
#pragma unroll
        for (int ai = 0; ai < 2; ++ai)
#pragma unroll
            for (int m = 0; m < 4; ++m) { const size_t o = (size_t)(row0 + ai * HALF + m * 16) * 1024 + col0;
#pragma unroll
                for (int bj = 0; bj < 2; ++bj) { const f32x4 x0 = *(const f32x4*)(x + o + bj * HALF), x1 = *(const f32x4*)(x + o + bj * HALF + 4);
                    *(f32x4*)(out + o + bj * HALF) = x0 * ALPHA + acc[ai][bj][m][0]; *(f32x4*)(out + o + bj * HALF + 4) = x1 * ALPHA + acc[ai][bj][m][1]; } }
    }
};
constexpr int MOE_TB_OFF = 131072 + 1024;
constexpr int CW_RDY = 16384;
constexpr int CW_TMO = 8;
struct MoeOrder {
    const LAS int* tb; int npn, G, c; unsigned* ctl;
    __device__ bool next(int i, Unit& u) const {
        const int L = i * G + c; if (L >= tb[32] * npn) return false;
        const int rt = L / npn, pn = L - rt * npn; int e = 0;
        for (int j = 1; j < 32; ++j) e = (tb[j] <= rt) ? j : e;
        u.pm = rt; u.pn = pn; u.pb = e * npn + pn; u.aux = e; return true;
    }
    __device__ __forceinline__ void a_ready(const Unit&) const {}
    __device__ __forceinline__ void done(const Unit& u) const {
        asm volatile("s_waitcnt vmcnt(0)" ::: "memory");
        if ((threadIdx.x & 63) == 0) __hip_atomic_fetch_add(ctl + CW_RDY + 64 * u.pm, 1u, __ATOMIC_RELAXED, __HIP_MEMORY_SCOPE_AGENT);
    }
};
struct MoeDownOrder {
    const LAS int* tb; int G, c; unsigned* ctl;
    __device__ bool next(int i, Unit& u) const {
        const int nT = tb[32], nD = 4 * nT; int R = 2 * nT - G; R = R < 0 ? 0 : (R > G ? G : R);
        int L;
        if (c >= R) { L = (i < 4) ? i * (G - R) + (c - R) : 4 * (G - R) + (i - 4) * G + c; }
        else { L = 4 * (G - R) + i * G + c; }
        if (L >= nD) return false;
        const int rt = L >> 2, pn = L & 3; int e = 0;
        for (int j = 1; j < 32; ++j) e = (tb[j] <= rt) ? j : e;
        u.pm = rt; u.pn = pn; u.pb = e * 4 + pn; u.aux = e; return true;
    }
    __device__ __forceinline__ void a_ready(const Unit& u) const {
        if (threadIdx.x < 64) {
            unsigned* w = ctl + CW_RDY + 64 * u.pm; unsigned sp = 0;
            while ((unsigned)__builtin_amdgcn_readfirstlane(__hip_atomic_load(w, __ATOMIC_RELAXED, __HIP_MEMORY_SCOPE_AGENT)) < 16u) {
                __builtin_amdgcn_s_sleep(2);
                if ((++sp & 1023u) == 0u) { if (__hip_atomic_load(ctl + CW_TMO, __ATOMIC_RELAXED, __HIP_MEMORY_SCOPE_AGENT) != 0u) break;
                    if (sp > (1u << 22)) { __hip_atomic_store(ctl + CW_TMO, 1u, __ATOMIC_RELAXED, __HIP_MEMORY_SCOPE_AGENT); break; } } }
            __builtin_amdgcn_fence(__ATOMIC_ACQUIRE, "agent");
            asm volatile("s_waitcnt vmcnt(0)" ::: "memory");
        }
        asm volatile("" ::: "memory"); __builtin_amdgcn_s_barrier(); asm volatile("" ::: "memory");
    }
    __device__ __forceinline__ void done(const Unit&) const {}
};
struct GatherProb {
    static constexpr bool GATHER = true;
    const bf16* A; const bf16* Bt; int K; const LAS int* tb; const unsigned* list;
    __device__ __forceinline__ const char* a_base(const Unit&) const { return (const char*)A; }
    __device__ __forceinline__ const char* b_base(const Unit& u) const { return (const char*)Bt + (size_t)u.pb * 256 * K * 2; }
    __device__ __forceinline__ void a_offs(const Unit& u, int R0, int C0, int R1, int C1, unsigned (&o)[2][2]) const {
        const int e = u.aux, lbase = (u.pm - tb[e]) * 256, cnt = tb[64 + e];
        const unsigned* le = list + (size_t)e * 32768;
#pragma unroll
        for (int h = 0; h < 2; ++h) { const int l0 = lbase + h * HALF + R0, l1 = lbase + h * HALF + R1;
            const unsigned t0 = l0 < cnt ? (le[l0] >> 1) : 0u, t1 = l1 < cnt ? (le[l1] >> 1) : 0u;
            o[h][0] = (t0 * (unsigned)K + (unsigned)C0) * 2u; o[h][1] = (t1 * (unsigned)K + (unsigned)C1) * 2u; }
    }
};
struct EpiGU {
    static constexpr bool PERM = true;
    bf16* hbuf;
    __device__ __forceinline__ void operator()(const f32x4 (&acc)[2][2][4][2], const Unit& u, int wr, int wc, int fr, int fq) const {
        const int row0 = u.pm * BM + wr * 64 + fr, col0 = u.pn * HALF + wc * 32 + 8 * fq;
#pragma unroll
        for (int ai = 0; ai < 2; ++ai)
#pragma unroll
            for (int m = 0; m < 4; ++m) { f32x4 h0, h1;
#pragma unroll
                for (int j = 0; j < 4; ++j) { const float g0 = acc[ai][0][m][0][j], g1 = acc[ai][0][m][1][j];
                    h0[j] = g0 * sigm(g0) * acc[ai][1][m][0][j]; h1[j] = g1 * sigm(g1) * acc[ai][1][m][1][j]; }
                { const v4u hv = pack8(h0, h1); bf16* hp = hbuf + (size_t)(row0 + ai * HALF + m * 16) * 256 + col0;
                  asm volatile("global_store_dwordx4 %0, %1, off sc1\n\ts_nop 1" :: "v"(hp), "v"(hv) : "memory"); } }
    }
};
struct EpiDown {
    static constexpr bool PERM = true;
    bf16* slot; const LAS int* tb; const unsigned* list; const float* pw;
    __device__ __forceinline__ void operator()(const f32x4 (&acc)[2][2][4][2], const Unit& u, int wr, int wc, int fr, int fq) const {
        const int e = u.aux, lbase = (u.pm - tb[e]) * 256 + wr * 64 + fr, cnt = tb[64 + e], col0 = u.pn * BM + wc * 32 + 8 * fq;
        const unsigned* le = list + (size_t)e * 32768;
#pragma unroll
        for (int ai = 0; ai < 2; ++ai)
#pragma unroll
            for (int m = 0; m < 4; ++m) { const int l = lbase + ai * HALF + m * 16;
                if (l < cnt) { const unsigned pair = le[l]; const float w = pw[pair]; bf16* rowp = slot + (size_t)pair * 1024 + col0;
#pragma unroll
                    for (int bj = 0; bj < 2; ++bj) *(v4u*)(rowp + bj * HALF) = pack8(acc[ai][bj][m][0] * w, acc[ai][bj][m][1] * w); } }
    }
};
}

struct Args { const float* in[20]; float* out; unsigned char* ws; int ph_lo, ph_hi; };
__global__ void __launch_bounds__(NTHR, 2) fwd_kernel(Args args) {
    extern __shared__ __attribute__((aligned(16))) unsigned char lds_raw[];
    Ctx c;
    c.lds = (LAS unsigned char*)lds_raw;
    c.tid = threadIdx.x; c.lane = c.tid & 63; c.wave = __builtin_amdgcn_readfirstlane(c.tid >> 6); c.bid = blockIdx.x; c.G = gridDim.x;
    c.x = args.in[0]; c.w_in = args.in[1]; c.kv_g = args.in[2]; c.w_uv = args.in[3]; c.w_a = args.in[4]; c.sinks = args.in[5]; c.w_b = args.in[6]; c.w_out = args.in[7]; c.rel_bias = args.in[8];
    c.ln1_g = args.in[9]; c.ln1_b = args.in[10]; c.w_group = args.in[11]; c.b_group = args.in[12]; c.w_router = args.in[13]; c.b_router = args.in[14]; c.w_gate = args.in[15]; c.w_up = args.in[16]; c.w_down = args.in[17];
    c.ln2_g = args.in[18]; c.ln2_b = args.in[19]; c.out = args.out; c.ws = args.ws; unsigned char* ws = args.ws;
    c.ctl = (unsigned*)(ws + WS_CTL);
    volatile LAS unsigned* MISC = (volatile LAS unsigned*)(c.lds + MISC_OFF);
    if (c.tid < 32) MISC[c.tid] = 0u;
    __syncthreads();
    XcdBarrier bar; bar.bar = c.ctl + CW_BAR; bar.x = 0; bar.st = nullptr;
    if (MK_N_LAUNCHES == 1) bar = xcd_barrier_post(c.ctl + CW_BAR, MISC + 8);
    const int lo = args.ph_lo, hi = args.ph_hi;
#define IN(k) (lo <= (k) && (k) < hi)
#define SEAM(k) do { if (IN(k) && IN((k) + 1)) xcd_barrier(bar); } while (0)
    bf16* merged = ((bf16*)(c.ws + WS_QLAT)); bf16* x1b = ((bf16*)(c.ws + WS_XB));

    if (IN(0)) { p0_prologue(c); } SEAM(0);
    if (IN(1)) { pg8::DenseProb P{(const bf16*)(c.ws + WS_XB), (const bf16*)(c.ws + WS_WIN), 1024}; pg8::StaticOrder S; S.init(NTOK, NPROJ, c.G, c.bid); pg8::EpiProj E{c.ws};
        pg8::gemm_phase(c.lds, P, S, E); } SEAM(1);
    if (IN(2)) { p_rmsnorm(c); __syncthreads(); p2_indexer_topk(c); } SEAM(2);
    if (IN(3)) { p3a_dsa(c); p3b_swa(c); } SEAM(3);
    if (IN(4)) { pg8::StaticOrder S; S.init(NTOK, 1024, c.G, c.bid); pg8::EpiMergedDual E{(const bf16*)(c.ws + WS_GA), (const bf16*)(c.ws + WS_GB), merged};
        pg8::gemm_phase_dual(c.lds, (const bf16*)(c.ws + WS_XB), (const bf16*)(c.ws + WS_WC), 1024, (const bf16*)(c.ws + WS_QB), (const bf16*)(c.ws + WS_WB), 512, S, E); } SEAM(4);
    if (IN(5)) { pg8::DenseProb P{(const bf16*)merged, (const bf16*)(c.ws + WS_WO), 1024}; pg8::StaticOrder S; S.init(NTOK, 1024, c.G, c.bid); pg8::EpiWoutM E{c.x, c.out};
        pg8::gemm_phase(c.lds, P, S, E); } SEAM(5);
    if (IN(6)) { p6_ln_router(c, x1b); } SEAM(6);
    LAS int* tb = (LAS int*)(c.lds + pg8::MOE_TB_OFF);
    if (IN(7) || IN(8)) {
        if (c.tid < 32) tb[64 + c.tid] = (int)__hip_atomic_load(c.ctl + CW_CNT + c.tid, __ATOMIC_RELAXED, __HIP_MEMORY_SCOPE_AGENT);
        __syncthreads();
        if (c.tid == 0) { int a = 0; for (int e = 0; e < 32; ++e) { tb[e] = a; a += (tb[64 + e] + 255) >> 8; } tb[32] = a; }
        __syncthreads();
    }
    if (IN(7)) { pg8::GatherProb P{(const bf16*)x1b, (const bf16*)(c.ws + WS_WGU), 1024, tb, (const unsigned*)(c.ws + WS_LIST)}; pg8::MoeOrder S{tb, 2, c.G, c.bid, c.ctl}; pg8::EpiGU E{(bf16*)(c.ws + WS_QLAT)};
        pg8::gemm_phase(c.lds, P, S, E); }
    if (MK_N_LAUNCHES != 1) SEAM(7);
    if (IN(8)) { pg8::DenseProb P{(const bf16*)(c.ws + WS_QLAT), (const bf16*)(c.ws + WS_WD), 256}; pg8::MoeDownOrder S{tb, c.G, c.bid, c.ctl};
        pg8::EpiDown E{(bf16*)(c.ws + WS_SLOT), tb, (const unsigned*)(c.ws + WS_LIST), (const float*)(c.ws + WS_PW)};
        pg8::gemm_phase(c.lds, P, S, E); } SEAM(8);
    if (IN(9)) { p9_ln2(c); }
#undef IN
#undef SEAM
}

extern "C" void kernel_launch(void* const* d_in, const int* in_sizes, int n_in, void* d_out, int out_size, void* d_ws, size_t ws_size, hipStream_t stream) {
    static int grid = 0;
    if (grid == 0) {
        if (n_in != 20 || out_size != NTOK * D || ws_size < WS_END) { fprintf(stderr, "kernel_launch: unexpected shapes (n_in %d out %d ws %zu)\n", n_in, out_size, ws_size); grid = -1; return; }
        int dev = 0, cus = 0, per_cu = 0;
        if (hipGetDevice(&dev) != hipSuccess || hipDeviceGetAttribute(&cus, hipDeviceAttributeMultiprocessorCount, dev) != hipSuccess) { grid = -1; return; }
        if (hipFuncSetAttribute((const void*)fwd_kernel, hipFuncAttributeMaxDynamicSharedMemorySize, LDS_BYTES) != hipSuccess) { fprintf(stderr, "kernel_launch: hipFuncSetAttribute failed\n"); grid = -1; return; }
        if (hipOccupancyMaxActiveBlocksPerMultiprocessor(&per_cu, (const void*)fwd_kernel, NTHR, LDS_BYTES) != hipSuccess || per_cu < 1) { fprintf(stderr, "kernel_launch: occupancy query says %d\n", per_cu); }
        (void)hipGetLastError();
        grid = cus;
    }
    if (grid < 0) return;
    if (hipMemsetAsync((char*)d_ws + WS_CTL, 0, CTL_ZERO_BYTES, stream) != hipSuccess) return;
    Args a{};
    for (int i = 0; i < 20; ++i) a.in[i] = (const float*)d_in[i];
    a.out = (float*)d_out; a.ws = (unsigned char*)d_ws;
    if (MK_N_LAUNCHES == 1) { a.ph_lo = 0; a.ph_hi = NPHASE; hipLaunchKernelGGL(fwd_kernel, dim3(grid), dim3(NTHR), LDS_BYTES, stream, a); }
    else { for (int p = 0; p < NPHASE; ++p) { a.ph_lo = p; a.ph_hi = p + 1; hipLaunchKernelGGL(fwd_kernel, dim3(grid), dim3(NTHR), LDS_BYTES, stream, a); } }
}
```

```cpp
#include <hip/hip_runtime.h>
#include <cstdio>
#include <cstdint>

#ifndef MK_N_LAUNCHES
#define MK_N_LAUNCHES 1
#endif

constexpr int D = 1024, BATCH = 8, SEQ = 2048, NTOK = BATCH * SEQ;
constexpr int A_HEADS = 8, A_LAT = 128, IDX_HEADS = 8, IDX_DIM = 64, KSEL = 256;
constexpr int B_HEADS = 8, B_HD = 64, WINDOW = 128;
constexpr int NEXP = 32, EPG = 8, NGRP = 4, DEXP = 256;
constexpr int IN_WIDTH = 4552, NPROJ = 4608;
constexpr float ALPHA = 1.189207115002721f;
constexpr float LN_EPS = 1e-5f, RMS_EPS = 1e-6f;
constexpr float ATT_SCALE = 0.08838834764831845f;
constexpr float IDXW_SCALE = 0.125f * 0.35355339059327373f;
constexpr int NPHASE = 10;

constexpr size_t MiB = 1u << 20;
constexpr size_t WS_CTL = 0, CTL_ZERO_BYTES = 128 * 1024;
constexpr size_t WS_WIN = 1 * MiB;
constexpr size_t WS_SEL = 1 * MiB;
constexpr size_t WS_WC = 10 * MiB;
constexpr size_t WS_WB = 12 * MiB;
constexpr size_t WS_WO = 13 * MiB;
constexpr size_t WS_WIDX = 15 * MiB;
constexpr size_t WS_BIAS = 16 * MiB;
constexpr size_t WS_PE = 16 * MiB + 64 * 1024;
constexpr size_t WS_PW = 16 * MiB + 256 * 1024;
constexpr size_t WS_WGU = 17 * MiB;
constexpr size_t WS_WD = 49 * MiB;
constexpr size_t WS_XB = 65 * MiB;
constexpr size_t WS_QLAT = 97 * MiB;
constexpr size_t WS_CKV = 129 * MiB;
constexpr size_t WS_KIDX = 133 * MiB;
constexpr size_t WS_QIDX = 135 * MiB;
constexpr size_t WS_QB = 151 * MiB;
constexpr size_t WS_KB = 167 * MiB;
constexpr size_t WS_VB = 171 * MiB;
constexpr size_t WS_GA = 175 * MiB;
constexpr size_t WS_GB = 207 * MiB;
constexpr size_t WS_CKVRAW = 239 * MiB;
constexpr size_t WS_LIST = 247 * MiB;
constexpr size_t WS_SLOT = 129 * MiB;
constexpr size_t WS_END = 252 * MiB;
constexpr int CW_CNT = 64;
constexpr int CW_BAR = 4096;

constexpr int NWAVES = 8, NTHR = 512;
constexpr int LDS_BYTES = 155648;
constexpr int MISC_OFF = 131072 + 320;

#define GAS __attribute__((address_space(1)))
#define LAS __attribute__((address_space(3)))
typedef unsigned short bf16;
typedef unsigned v4u __attribute__((ext_vector_type(4)));
typedef unsigned v2u __attribute__((ext_vector_type(2)));
typedef float f32x4 __attribute__((ext_vector_type(4)));

__device__ __forceinline__ float bf2f(unsigned v) { return __builtin_bit_cast(float, v << 16); }
__device__ __forceinline__ float bflo(unsigned v) { return __builtin_bit_cast(float, v << 16); }
__device__ __forceinline__ float bfhi(unsigned v) { return __builtin_bit_cast(float, v & 0xffff0000u); }
__device__ __forceinline__ unsigned f2bf(float f) { unsigned u = __builtin_bit_cast(unsigned, f); return (u + 0x7fffu + ((u >> 16) & 1u)) >> 16; }
__device__ __forceinline__ unsigned cvt_pk(float lo, float hi) { unsigned r; asm volatile("v_cvt_pk_bf16_f32 %0, %1, %2" : "=v"(r) : "v"(lo), "v"(hi)); return r; }
__device__ __forceinline__ unsigned pk2(float lo, float hi) { return f2bf(lo) | (f2bf(hi) << 16); }
__device__ __forceinline__ float wave_sum(float v) {
#pragma unroll
    for (int o = 1; o < 64; o <<= 1) v += __shfl_xor(v, o);
    return v;
}
__device__ __forceinline__ float wave_max(float v) {
#pragma unroll
    for (int o = 1; o < 64; o <<= 1) v = fmaxf(v, __shfl_xor(v, o));
    return v;
}

typedef unsigned u2v __attribute__((ext_vector_type(2)));
#define DPP_I(v, ctrl) __builtin_amdgcn_update_dpp(0, (v), (ctrl), 0xf, 0xf, true)
#define DPP_F(v, ctrl) __builtin_bit_cast(float, __builtin_amdgcn_update_dpp(0, __builtin_bit_cast(int, (v)), (ctrl), 0xf, 0xf, true))
__device__ __forceinline__ void swap16(unsigned a, unsigned& x, unsigned& y) { auto r = __builtin_amdgcn_permlane16_swap(a, a, false, false); x = r[0]; y = r[1]; }
__device__ __forceinline__ void swap32(unsigned a, unsigned& x, unsigned& y) { auto r = __builtin_amdgcn_permlane32_swap(a, a, false, false); x = r[0]; y = r[1]; }
__device__ __forceinline__ float x16_sum(float v) { unsigned x, y; swap16(__builtin_bit_cast(unsigned, v), x, y); return __builtin_bit_cast(float, x) + __builtin_bit_cast(float, y); }
__device__ __forceinline__ float x16_max(float v) { unsigned x, y; swap16(__builtin_bit_cast(unsigned, v), x, y); return fmaxf(__builtin_bit_cast(float, x), __builtin_bit_cast(float, y)); }
__device__ __forceinline__ float x16_min(float v) { unsigned x, y; swap16(__builtin_bit_cast(unsigned, v), x, y); return fminf(__builtin_bit_cast(float, x), __builtin_bit_cast(float, y)); }
__device__ __forceinline__ int x16_sumi(int v) { unsigned x, y; swap16((unsigned)v, x, y); return (int)(x + y); }
__device__ __forceinline__ float x32_sum(float v) { unsigned x, y; swap32(__builtin_bit_cast(unsigned, v), x, y); return __builtin_bit_cast(float, x) + __builtin_bit_cast(float, y); }
__device__ __forceinline__ float x32_max(float v) { unsigned x, y; swap32(__builtin_bit_cast(unsigned, v), x, y); return fmaxf(__builtin_bit_cast(float, x), __builtin_bit_cast(float, y)); }

#define XB_TMO      128
#define XB_XCNT(j)  (256  + 64 * (j))
#define XB_XSUB(j)  (1280 + 64 * (j))
#define XB_XGEN(j)  (2304 + 64 * (j))
#define XB_TOP      3328
#define XB_TOPGEN   3392
#define XCD_BAR_WORDS 3456
#define XB_SPIN_CAP (1u << 22)

__device__ __forceinline__ unsigned xb_ld(unsigned* p)              { return __hip_atomic_load(p, __ATOMIC_RELAXED, __HIP_MEMORY_SCOPE_AGENT); }
__device__ __forceinline__ unsigned xb_add(unsigned* p, unsigned v) { return __hip_atomic_fetch_add(p, v, __ATOMIC_RELAXED, __HIP_MEMORY_SCOPE_AGENT); }
__device__ __forceinline__ unsigned xb_xcc_id() { return (unsigned)__builtin_amdgcn_s_getreg((3 << 11) | 20) & 0xFu; }
#define XB_SPIN(cond, bar) do { unsigned _sp = 0; while (cond) { __builtin_amdgcn_s_sleep(1); \
    if ((++_sp & 255u) == 0u) { if (xb_ld(&(bar)[XB_TMO])) break; if (_sp > XB_SPIN_CAP) { atomicAdd(&(bar)[XB_TMO], 1u); break; } } } } while (0)

struct XcdBarrier { unsigned* bar; unsigned x; volatile LAS unsigned* st; };

__device__ __forceinline__ XcdBarrier xcd_barrier_post(unsigned* bar, volatile LAS unsigned* st) {
    XcdBarrier b; b.bar = bar; b.x = xb_xcc_id(); b.st = st;
    if (threadIdx.x == 0) (void)xb_add(&bar[XB_XCNT(b.x)], 1u);
    return b;
}
__device__ __forceinline__ void xcd_barrier_complete(unsigned* bar, unsigned x, unsigned& nloc, unsigned& nx) {
    const unsigned G = gridDim.x * gridDim.y * gridDim.z;
    unsigned sum, cnt, mine, sp = 0u;
    for (;;) {
        sum = 0u; cnt = 0u; mine = 0u;
#pragma unroll
        for (unsigned j = 0; j < 16; ++j) { const unsigned c = xb_ld(&bar[XB_XCNT(j)]); sum += c; cnt += (c > 0u) ? 1u : 0u; mine = (j == x) ? c : mine; }
        if (sum == G) break;
        __builtin_amdgcn_s_sleep(1);
        if ((++sp & 255u) == 0u) { if (xb_ld(&bar[XB_TMO])) break; if (sp > XB_SPIN_CAP) { atomicAdd(&bar[XB_TMO], 1u); break; } }
    }
    nloc = mine > 0u ? mine : 1u; nx = cnt > 0u ? cnt : 1u;
}
__device__ __forceinline__ void xcd_barrier(const XcdBarrier& b) {
    asm volatile("s_waitcnt vmcnt(0)" ::: "memory");
    __syncthreads();
    if (threadIdx.x == 0) {
        unsigned* bar = b.bar;
        __builtin_amdgcn_s_waitcnt(0);
        unsigned nloc = b.st[0], nx = b.st[1];
        if (nloc == 0u) { xcd_barrier_complete(bar, b.x, nloc, nx); b.st[0] = nloc; b.st[1] = nx; }
        const unsigned old = xb_add(&bar[XB_XSUB(b.x)], 1u);
        const unsigned gen = old / nloc;
        if (old + 1u == (gen + 1u) * nloc) {
            __builtin_amdgcn_fence(__ATOMIC_RELEASE, "agent");
            asm volatile("s_waitcnt vmcnt(0)" ::: "memory");
            const unsigned og = xb_add(&bar[XB_TOP], 1u);
            const unsigned tg = og / nx;
            if (og + 1u == (tg + 1u) * nx) xb_add(&bar[XB_TOPGEN], 1u);
            else XB_SPIN(xb_ld(&bar[XB_TOPGEN]) == tg, bar);
            __builtin_amdgcn_fence(__ATOMIC_ACQUIRE, "agent");
            xb_add(&bar[XB_XGEN(b.x)], 1u);
            asm volatile("s_waitcnt vmcnt(0)" ::: "memory");
        } else {
            XB_SPIN(xb_ld(&bar[XB_XGEN(b.x)]) == gen, bar);
            __builtin_amdgcn_fence(__ATOMIC_ACQUIRE, "agent");
            asm volatile("s_waitcnt vmcnt(0)" ::: "memory");
        }
    }
    __syncthreads();
}

struct Ctx {
    const float *x, *w_in, *kv_g, *w_uv, *w_a, *sinks, *w_b, *w_out, *rel_bias, *ln1_g, *ln1_b, *w_group, *b_group, *w_router, *b_router, *w_gate, *w_up, *w_down, *ln2_g, *ln2_b;
    float* out;
    unsigned char* ws;
    unsigned* ctl;
    __device__ __forceinline__ bf16* P(size_t off) const { return (bf16*)(ws + off); }
    LAS unsigned char* lds;
    int tid, lane, wave, bid, G;
};

__device__ __forceinline__ int proj_src_col(int j) {
    if (j < 1024) return j;
    if (j < 1152) return j;
    if (j < 1216) return 1664 + (j - 1152);
    if (j < 1224) return 1728 + (j - 1216);
    if (j < 1280) return -1;
    if (j < 1792) return 1152 + (j - 1280);
    if (j < 2304) return 1736 + (j - 1792);
    if (j < 2432) return 2248 + (j - 2304);
    if (j < 2560) return 2376 + (j - 2432);
    if (j < 3584) return 2504 + (j - 2560);
    return 3528 + (j - 3584);
}
__device__ __forceinline__ float sigmoidf_(float v) { return 1.0f / (1.0f + __expf(-v)); }

template <class Src> __device__ __forceinline__ void titem_load(const Ctx& c, const Src& src, int k0, int n0, f32x4 (&tv)[8]) {
    const int kr = c.lane >> 3, n4 = (c.lane & 7) * 4;
#pragma unroll
    for (int i = 0; i < 8; ++i) tv[i] = src.v4(k0 + 8 * i + kr, n0 + n4);
}
__device__ __forceinline__ void titem_finish(const Ctx& c, LAS float* scr, const f32x4 (&tv)[8], bf16* dst, int dstK, int k0, int n0) {
    const int lane = c.lane, kr = lane >> 3, n4 = (lane & 7) * 4;
#pragma unroll
    for (int i = 0; i < 8; ++i) { LAS float* d = scr + (8 * i + kr) * 33 + n4; d[0] = tv[i].x; d[1] = tv[i].y; d[2] = tv[i].z; d[3] = tv[i].w; }
    asm volatile("s_waitcnt lgkmcnt(0)" ::: "memory");
    const int cc = lane & 7;
#pragma unroll
    for (int j = 0; j < 4; ++j) { const int n = (lane >> 3) + 8 * j; const LAS float* q = scr + (8 * cc) * 33 + n;
        v4u o; o.x = pk2(q[0 * 33], q[1 * 33]); o.y = pk2(q[2 * 33], q[3 * 33]); o.z = pk2(q[4 * 33], q[5 * 33]); o.w = pk2(q[6 * 33], q[7 * 33]);
        *(v4u*)(dst + (size_t)(n0 + n) * dstK + k0 + 8 * cc) = o; }
    asm volatile("s_waitcnt lgkmcnt(0)" ::: "memory");
}
template <class Src> __device__ __forceinline__ void transpose_item(const Ctx& c, LAS float* scr, const Src& src, bf16* dst, int dstK, int k0, int n0) {
    f32x4 tv[8]; titem_load(c, src, k0, n0, tv); titem_finish(c, scr, tv, dst, dstK, k0, n0);
}
struct SrcWin { const float* w; __device__ __forceinline__ f32x4 v4(int k, int n) const { const int s = proj_src_col(n); return s < 0 ? (f32x4){0.f, 0.f, 0.f, 0.f} : *(const f32x4*)(w + (size_t)k * IN_WIDTH + s); } };
struct SrcPlain { const float* w; int N; __device__ __forceinline__ f32x4 v4(int k, int n) const { return *(const f32x4*)(w + (size_t)k * N + n); } };
struct SrcShift { const float* w; int N; int shift; __device__ __forceinline__ f32x4 v4(int k, int n) const { return *(const f32x4*)(w + (size_t)k * N + n + shift); } };

__device__ __forceinline__ float t5_bias_bucket(int dist) {
    if (dist < 16) return (float)dist;
    int b = 16 + (int)(logf((float)dist / 16.0f) / logf(8.0f) * 16.0f);
    return (float)(b < 31 ? b : 31);
}
constexpr int P0_EXPERT_ITEMS = 32 * 256 + 32 * 128;
__device__ __forceinline__ void p0_expert_item(const Ctx& c, LAS float* scr, int r) {
    constexpr int I_GU = 32 * 256;
    if (r < I_GU) { const int e = r / 256, q = r % 256, n0 = (q / 16) * 32, half = (n0 >> 7) & 1, col0 = (n0 >> 8) * 128 + (n0 & 127);
        if (half) { SrcShift s_{c.w_up + (size_t)e * 1024 * 256, DEXP, col0 - n0}; transpose_item(c, scr, s_, (bf16*)(c.ws + WS_WGU) + (size_t)e * 512 * 1024, 1024, (q % 16) * 64, n0); }
        else { SrcShift s_{c.w_gate + (size_t)e * 1024 * 256, DEXP, col0 - n0}; transpose_item(c, scr, s_, (bf16*)(c.ws + WS_WGU) + (size_t)e * 512 * 1024, 1024, (q % 16) * 64, n0); }
        return; }
    r -= I_GU;
    { const int e = r / 128, q = r % 128; SrcPlain s_{c.w_down + (size_t)e * 256 * 1024, 1024};
        transpose_item(c, scr, s_, (bf16*)(c.ws + WS_WD) + (size_t)e * 1024 * 256, 256, (q % 4) * 64, (q / 4) * 32); }
}
__device__ __forceinline__ void gu_item_load(const Ctx& c, int r, f32x4 (&tv)[8]) {
    const int e = r / 256, q = r % 256, n0 = (q / 16) * 32, half = (n0 >> 7) & 1, col0 = (n0 >> 8) * 128 + (n0 & 127);
    if (half) { SrcShift s_{c.w_up + (size_t)e * 1024 * 256, DEXP, col0 - n0}; titem_load(c, s_, (q % 16) * 64, n0, tv); }
    else { SrcShift s_{c.w_gate + (size_t)e * 1024 * 256, DEXP, col0 - n0}; titem_load(c, s_, (q % 16) * 64, n0, tv); }
}
__device__ __forceinline__ void gu_item_finish(const Ctx& c, LAS float* scr, int r, const f32x4 (&tv)[8]) {
    const int e = r / 256, q = r % 256, n0 = (q / 16) * 32;
    titem_finish(c, scr, tv, (bf16*)(c.ws + WS_WGU) + (size_t)e * 512 * 1024, 1024, (q % 16) * 64, n0);
}
constexpr size_t WS_WRT = 16 * MiB + 512 * 1024;
__device__ __forceinline__ void p0_prologue(const Ctx& c) {
    { const size_t n8 = (size_t)NTOK * D / 8; const f32x4* xs = (const f32x4*)c.x; v4u* xd = (v4u*)((bf16*)(c.ws + WS_XB));
      const size_t st = (size_t)c.G * NTHR;
      size_t i = (size_t)c.bid * NTHR + c.tid;
      for (; i + 3 * st < n8; i += 4 * st) { f32x4 a[4], b[4];
#pragma unroll
          for (int u = 0; u < 4; ++u) { a[u] = xs[2 * (i + u * st)]; b[u] = xs[2 * (i + u * st) + 1]; }
#pragma unroll
          for (int u = 0; u < 4; ++u) { v4u o; o.x = pk2(a[u].x, a[u].y); o.y = pk2(a[u].z, a[u].w); o.z = pk2(b[u].x, b[u].y); o.w = pk2(b[u].z, b[u].w); xd[i + u * st] = o; } }
      for (; i < n8; i += st) { const f32x4 a = xs[2 * i], b = xs[2 * i + 1]; v4u o; o.x = pk2(a.x, a.y); o.y = pk2(a.z, a.w); o.z = pk2(b.x, b.y); o.w = pk2(b.z, b.w); xd[i] = o; } }
    { LAS float* scr = (LAS float*)(c.lds + c.wave * 8704);
      constexpr int I_WIN = 16 * 144, I_WB = 8 * 32, I_WO = 16 * 32, I_ALL = I_WIN + I_WB + I_WO;
      for (int it = c.bid * NWAVES + c.wave; it < I_ALL; it += c.G * NWAVES) {
        int r = it;
        if (r < I_WIN) { SrcWin s_{c.w_in}; transpose_item(c, scr, s_, (bf16*)(c.ws + WS_WIN), 1024, (r % 16) * 64, (r / 16) * 32); continue; } r -= I_WIN;
        if (r < I_WB) { SrcPlain s_{c.w_b, 1024}; transpose_item(c, scr, s_, (bf16*)(c.ws + WS_WB), 512, (r % 8) * 64, (r / 8) * 32); continue; } r -= I_WB;
        { SrcPlain s_{c.w_out, 1024}; transpose_item(c, scr, s_, (bf16*)(c.ws + WS_WO), 1024, (r % 16) * 64, (r / 16) * 32); }
      } }
    __syncthreads();
    { LAS float* tile = (LAS float*)c.lds; LAS float* Us = tile + 64 * 65; LAS float* As = Us + 64 * 65;
      for (int tI = c.bid; tI < 256; tI += c.G) { const int k0 = (tI & 15) * 64, n0 = (tI >> 4) * 64, h = k0 >> 7;
        const int r = c.tid >> 6, cc = c.tid & 63;
#pragma unroll
        for (int pI = 0; pI < 8; ++pI) { const int kk = pI * 8 + r; Us[kk * 65 + cc] = c.w_uv[(size_t)(k0 + kk) * 64 + cc]; As[kk * 65 + cc] = c.w_a[(size_t)(h * 64 + kk) * 1024 + n0 + cc]; }
        __syncthreads();
#pragma unroll
        for (int pI = 0; pI < 8; ++pI) { const int kk = pI * 8 + r; float a = 0.f;
#pragma unroll 16
            for (int d = 0; d < 64; ++d) a += Us[kk * 65 + d] * As[d * 65 + cc];
            tile[kk * 65 + cc] = a; }
        __syncthreads();
        const int nl = c.tid >> 3, kc = c.tid & 7; v4u o;
        o.x = pk2(tile[(8 * kc + 0) * 65 + nl], tile[(8 * kc + 1) * 65 + nl]); o.y = pk2(tile[(8 * kc + 2) * 65 + nl], tile[(8 * kc + 3) * 65 + nl]);
        o.z = pk2(tile[(8 * kc + 4) * 65 + nl], tile[(8 * kc + 5) * 65 + nl]); o.w = pk2(tile[(8 * kc + 6) * 65 + nl], tile[(8 * kc + 7) * 65 + nl]);
        *(v4u*)((bf16*)(c.ws + WS_WC) + (size_t)(n0 + nl) * 1024 + k0 + 8 * kc) = o;
        __syncthreads(); } }
    for (int i = c.bid * NTHR + c.tid; i < 48 * 1024; i += c.G * NTHR) { const int o = i >> 10, k = i & 1023;
        const float v = o < 32 ? c.w_router[(size_t)k * 32 + o] : (o < 36 ? c.w_group[(size_t)k * 4 + (o - 32)] : 0.f);
        const unsigned hi = f2bf(v); const float rem = v - bf2f(hi);
        ((bf16*)(c.ws + WS_WRT))[i] = (bf16)hi; ((bf16*)(c.ws + WS_WRT))[48 * 1024 + i] = (bf16)f2bf(rem); }
    if (c.bid == 0) { for (int i = c.tid; i < 129 * 8; i += NTHR) { const int d = i >> 3, h = i & 7; const int b = (int)t5_bias_bucket(d);
            ((float*)(c.ws + WS_BIAS))[i] = c.rel_bias[b * 16 + h]; ((float*)(c.ws + WS_BIAS) + 129 * 8)[i] = c.rel_bias[b * 16 + 8 + h]; } }
}


__device__ __forceinline__ void p_rmsnorm(const Ctx& c) {
    const int gw = c.bid * NWAVES + c.wave, NGW = c.G * NWAVES, l15 = c.lane & 15, g4 = c.lane >> 4;
    const f32x4 g0 = *(const f32x4*)(c.kv_g + 8 * l15), g1 = *(const f32x4*)(c.kv_g + 8 * l15 + 4);
    for (int r = 4 * gw + g4; r < NTOK; r += 4 * NGW) {
        const float* src = (const float*)(c.ws + WS_CKVRAW) + (size_t)r * 128 + 8 * l15;
        const f32x4 a = *(const f32x4*)src, b = *(const f32x4*)(src + 4);
        float ss = (a.x * a.x + a.y * a.y) + (a.z * a.z + a.w * a.w) + (b.x * b.x + b.y * b.y) + (b.z * b.z + b.w * b.w);
        ss += DPP_F(ss, 0xB1); ss += DPP_F(ss, 0x4E); ss += DPP_F(ss, 0x141); ss += DPP_F(ss, 0x140);
        const float rs = 1.0f / sqrtf(ss * (1.0f / 128.0f) + RMS_EPS);
        v4u o; o.x = pk2(a.x * rs * g0.x, a.y * rs * g0.y); o.y = pk2(a.z * rs * g0.z, a.w * rs * g0.w); o.z = pk2(b.x * rs * g1.x, b.y * rs * g1.y); o.w = pk2(b.z * rs * g1.z, b.w * rs * g1.w);
        *(v4u*)((bf16*)(c.ws + WS_CKV) + (size_t)r * 128 + 8 * l15) = o;
    }
}


typedef float f32x16 __attribute__((ext_vector_type(16)));
typedef short s16x8 __attribute__((ext_vector_type(8)));
__device__ __forceinline__ float half_min(float v) {
    v = fminf(v, DPP_F(v, 0xB1)); v = fminf(v, DPP_F(v, 0x4E)); v = fminf(v, DPP_F(v, 0x141)); v = fminf(v, DPP_F(v, 0x140)); return x16_min(v); }
__device__ __forceinline__ float half_max(float v) {
    v = fmaxf(v, DPP_F(v, 0xB1)); v = fmaxf(v, DPP_F(v, 0x4E)); v = fmaxf(v, DPP_F(v, 0x141)); v = fmaxf(v, DPP_F(v, 0x140)); return x16_max(v); }
__device__ __forceinline__ int half_sum(int v) {
    v += DPP_I(v, 0xB1); v += DPP_I(v, 0x4E); v += DPP_I(v, 0x141); v += DPP_I(v, 0x140); return x16_sumi(v); }
struct P2B { s16x8 b[8]; };
__device__ __forceinline__ P2B p2_ld4(const LAS unsigned char* kb_, int tb) { P2B r;
#pragma unroll
    for (int u = 0; u < 4; ++u) { r.b[2 * u] = *(const LAS s16x8*)(kb_ + (tb + u) * 2048); r.b[2 * u + 1] = *(const LAS s16x8*)(kb_ + (tb + u) * 2048 + 1024); }
    return r; }
__device__ __forceinline__ float p2_relu(float x) { const int xi = __builtin_bit_cast(int, x); return __builtin_bit_cast(float, xi > 0 ? xi : 0); }
__device__ __forceinline__ float p2_wsum(const f32x4 a, const f32x4 w) {
    float p = fmaf(w.x, p2_relu(a[0]), 0.f); p = fmaf(w.y, p2_relu(a[1]), p); p = fmaf(w.z, p2_relu(a[2]), p); return fmaf(w.w, p2_relu(a[3]), p); }
__device__ __forceinline__ void p2_score4(const P2B& B, const s16x8 a0, const s16x8 a1, const f32x4 wq, float& r0, float& r1) {
    f32x4 acc[4];
#pragma unroll
    for (int u = 0; u < 4; ++u) { const f32x4 z = {0.f, 0.f, 0.f, 0.f}; acc[u] = __builtin_amdgcn_mfma_f32_16x16x32_bf16(a0, B.b[2 * u], z, 0, 0, 0); }
#pragma unroll
    for (int u = 0; u < 4; ++u) acc[u] = __builtin_amdgcn_mfma_f32_16x16x32_bf16(a1, B.b[2 * u + 1], acc[u], 0, 0, 0);
    const float p0 = p2_wsum(acc[0], wq), p1 = p2_wsum(acc[1], wq), p2 = p2_wsum(acc[2], wq), p3 = p2_wsum(acc[3], wq);
    { auto s_ = __builtin_amdgcn_permlane16_swap(__builtin_bit_cast(unsigned, p0), __builtin_bit_cast(unsigned, p1), false, false); const unsigned x_ = s_[0], y_ = s_[1];
      r0 = __builtin_bit_cast(float, x_) + __builtin_bit_cast(float, y_); }
    { auto s_ = __builtin_amdgcn_permlane16_swap(__builtin_bit_cast(unsigned, p2), __builtin_bit_cast(unsigned, p3), false, false); const unsigned x_ = s_[0], y_ = s_[1];
      r1 = __builtin_bit_cast(float, x_) + __builtin_bit_cast(float, y_); }
}
__device__ __forceinline__ void p2_unit(const Ctx& c, int b, int blk, int item) {
    LAS unsigned char* kst = c.lds;
    const int lane = c.lane, wv = c.wave, r = lane & 31, hh = lane >> 5, g4 = lane >> 4, c16 = lane & 15;
    const int t0 = blk * 16 + 2 * wv, n0 = b * SEQ + t0, ntile = blk + 1, nst = (ntile + 15) >> 4;
    const unsigned char* ksrc = c.ws + WS_KIDX + (size_t)(b * 128) * 2048;
#define P2_ISSUE(st) do { _Pragma("unroll") for (int _j = 0; _j < 4; ++_j) \
        __builtin_amdgcn_global_load_lds((const unsigned*)(ksrc + (size_t)(st) * 32768 + (_j * 512 + c.tid) * 16), (LAS unsigned*)(kst + ((st) & 1) * 32768 + (_j * 512 + wv * 64) * 16), 16, 0, 0); } while (0)
    P2_ISSUE(0);
    s16x8 af[2];
    { const bf16* qp = (const bf16*)(c.ws + WS_QIDX) + (size_t)(n0 + (c16 >> 3)) * 512 + (c16 & 7) * 64 + 8 * g4;
      af[0] = *(const s16x8*)qp; af[1] = *(const s16x8*)(qp + 32); }
    const f32x4 wq = *(const f32x4*)((const float*)(c.ws + WS_WIDX) + (size_t)(n0 + hh) * 8 + 4 * (g4 & 1));
    asm volatile("" :: "v"(af[0]), "v"(af[1]), "v"(wq));
    float sc0[64];
#pragma unroll
    for (int i = 0; i < 64; ++i) sc0[i] = -INFINITY;
    const int lim0 = 2 * wv + hh;
    const int lastst = blk >> 4;
    const int limt = (blk - (g4 & 1)) - ((c16 <= lim0) ? 0 : 1);
#pragma unroll
    for (int st = 0; st < 8; ++st) {
        if (st <= lastst) {
            if (st < lastst) { P2_ISSUE(st + 1); asm volatile("s_waitcnt vmcnt(4)" ::: "memory"); }
            else asm volatile("s_waitcnt vmcnt(0)" ::: "memory");
            __builtin_amdgcn_s_barrier();
            const LAS unsigned char* kb_ = kst + (st & 1) * 32768 + lane * 16;
            if (st < lastst) {
                P2B Ba = p2_ld4(kb_, 0), Bb = p2_ld4(kb_, 4);
                p2_score4(Ba, af[0], af[1], wq, sc0[st * 8 + 0], sc0[st * 8 + 1]); __builtin_amdgcn_sched_barrier(0);
                Ba = p2_ld4(kb_, 8);
                p2_score4(Bb, af[0], af[1], wq, sc0[st * 8 + 2], sc0[st * 8 + 3]); __builtin_amdgcn_sched_barrier(0);
                Bb = p2_ld4(kb_, 12);
                p2_score4(Ba, af[0], af[1], wq, sc0[st * 8 + 4], sc0[st * 8 + 5]); __builtin_amdgcn_sched_barrier(0);
                p2_score4(Bb, af[0], af[1], wq, sc0[st * 8 + 6], sc0[st * 8 + 7]);
            } else {
#pragma unroll
                for (int g = 0; g < 4; ++g) if (st * 16 + 4 * g <= blk) {
                    const P2B B = p2_ld4(kb_, 4 * g);
                    float r0, r1; p2_score4(B, af[0], af[1], wq, r0, r1);
                    sc0[st * 8 + 2 * g] = (st * 16 + 4 * g <= limt) ? r0 : -INFINITY;
                    sc0[st * 8 + 2 * g + 1] = (st * 16 + 4 * g + 2 <= limt) ? r1 : -INFINITY;
                    __builtin_amdgcn_sched_barrier(0);
                }
            }
            asm volatile("s_waitcnt lgkmcnt(0)" ::: "memory");
            __builtin_amdgcn_s_barrier();
        }
    }
#undef P2_ISSUE
    f32x4 tv[8];
    if (item >= 0) gu_item_load(c, item, tv);
    const int nreg = (ntile + 1) >> 1;
    float thr0 = -INFINITY; int quota0 = 0;
    if (blk >= 16) {
        float mn0 = INFINITY, mx0 = -INFINITY; int cp = 0, cn = 0;
#pragma unroll
        for (int g = 0; g < 4; ++g) if (nreg > 16 * g) {
#pragma unroll
            for (int i = 16 * g; i < 16 * g + 16; ++i) { mx0 = fmaxf(mx0, sc0[i]); mn0 = fminf(mn0, sc0[i] == -INFINITY ? INFINITY : sc0[i]); cp += (sc0[i] > 0.f) ? 1 : 0; cn += (sc0[i] >= 0.f) ? 1 : 0; } }
        mn0 = half_min(mn0); mx0 = half_max(mx0); cp = half_sum(cp); cn = half_sum(cn);
        float lo0, hi0; int chi0, clo0; bool done0 = false;
        if (cp <= KSEL && cn >= KSEL) { done0 = true; thr0 = 0.f; quota0 = KSEL - cp; lo0 = hi0 = 0.f; chi0 = 0; clo0 = KSEL + 1; }
        else if (cp > KSEL) { lo0 = 0.f; clo0 = cn; hi0 = mx0 + fabsf(mx0) * 1e-6f + 1e-30f; chi0 = 0; }
        else { lo0 = mn0; clo0 = t0 + hh + 1; hi0 = 0.f; chi0 = cn; }
        for (int it = 0; it < 200; ++it) {
            if (__builtin_amdgcn_ballot_w64(!done0) == 0ull) break;
            const float half_ = 0.5f * (lo0 + hi0);
            float mid0 = half_;
            if (!(it & 1)) { const float fr_ = ((float)(clo0 - KSEL) + 0.5f) / (float)(clo0 - chi0); const float mi = lo0 + (hi0 - lo0) * fr_; mid0 = (mi > lo0 && mi < hi0) ? mi : half_; }
            unsigned sa = 0u, sb = 0u; int nproc = 0;
#pragma unroll
            for (int g = 0; g < 4; ++g) if (nreg > 16 * g) { nproc += 16;
#pragma unroll
                for (int i = 16 * g; i < 16 * g + 16; ++i) { const unsigned tb_ = __builtin_bit_cast(unsigned, sc0[i] - mid0);
                    if (g < 2) sa = __builtin_amdgcn_alignbit(sa, tb_, 31); else sb = __builtin_amdgcn_alignbit(sb, tb_, 31); } }
            int c0 = half_sum(nproc - __builtin_popcount(sa) - __builtin_popcount(sb));
            if (!done0) { if (c0 == KSEL) { done0 = true; thr0 = mid0; quota0 = KSEL; } else if (mid0 <= lo0 || mid0 >= hi0) { done0 = true; thr0 = lo0; quota0 = KSEL - chi0; } else if (c0 > KSEL) { lo0 = mid0; clo0 = c0; } else { hi0 = mid0; chi0 = c0; } }
        }
        if (!done0) { thr0 = lo0; quota0 = KSEL - chi0; }
    }
    unsigned short* selp0 = (unsigned short*)(c.ws + WS_SEL) + (size_t)(n0 + hh) * KSEL;
    int base0 = 0, eq0 = 0; const unsigned ltm = (1u << r) - 1u;
#pragma unroll
    for (int g = 0; g < 4; ++g) if (nreg > 16 * g) {
#pragma unroll
        for (int i = 16 * g; i < 16 * g + 16; ++i) {
            bool sel_ = sc0[i] > thr0; const bool pe = sc0[i] == thr0; const unsigned long long me = __builtin_amdgcn_ballot_w64(pe);
            if (me) { const unsigned mh = hh ? (unsigned)(me >> 32) : (unsigned)me; sel_ = sel_ || (pe && (eq0 + __builtin_popcount(mh & ltm) < quota0)); eq0 += __builtin_popcount(mh); }
            const unsigned long long ms = __builtin_amdgcn_ballot_w64(sel_); const unsigned mh2 = hh ? (unsigned)(ms >> 32) : (unsigned)ms;
            const int pos = base0 + __builtin_popcount(mh2 & ltm); if (sel_ && pos < KSEL) selp0[pos] = (unsigned short)(32 * i + r); base0 += __builtin_popcount(mh2);
        } }
    if (item >= 0) gu_item_finish(c, (LAS float*)(c.lds + (wv < 7 ? 65536 + wv * 8448 : 133120)), item, tv);
}
__device__ __forceinline__ void p2_indexer_topk(const Ctx& c) {
    for (int pu = c.bid; pu < 256; pu += c.G) {
        const int b = pu >> 5, j = pu & 31;
#pragma unroll 1
        for (int q = 0; q < 4; ++q) p2_unit(c, b, q == 0 ? j : (q == 1 ? 63 - j : (q == 2 ? 64 + j : 127 - j)), c.G == 256 ? q * 2048 + c.bid * NWAVES + c.wave : -1);
    }
}


typedef short s16x4 __attribute__((ext_vector_type(4)));
constexpr int DSA_WS_OFF = 131072 + 2048;
constexpr int DSA_BIAS_OFF = 131072 + 2048 + 10240;
__device__ __forceinline__ void p3a_dsa(const Ctx& c) {
    const int lane = c.lane, wv = c.wave, l15 = lane & 15, g4 = lane >> 4;
    LAS unsigned char* kvb = c.lds + wv * 16384;
    LAS unsigned char* wsb = c.lds + DSA_WS_OFF + wv * 1280;
    LAS float* biasL = (LAS float*)(c.lds + DSA_BIAS_OFF);
    for (int i = c.tid; i < 129 * 8; i += NTHR) biasL[i] = ((const float*)(c.ws + WS_BIAS))[i];
    __syncthreads();
    const int prow = (l15 & 3) | ((l15 & 4) << 1) | ((l15 & 8) >> 1);
    const int rowx = ((prow & 3) << 2) | (prow >> 2);
    const unsigned qk_off = (unsigned)(256 * prow + 16 * (g4 ^ (rowx & 3))), qk_sx = (unsigned)(rowx >> 2);
    const int grow = 8 * (g4 & 1) + 4 * (g4 >> 1);
    const int trow = grow + (l15 >> 2), trx = ((trow & 3) << 2) | ((trow >> 2) & 3);
    const unsigned tr_off = (unsigned)(256 * trow + 16 * (((lane & 3) >> 1) ^ (trx & 1)) + 8 * (lane & 1)), tr_mx = (unsigned)(trx >> 1);
    const bf16* ckv = (const bf16*)(c.ws + WS_CKV);
    const float bfar = biasL[128 * 8 + (l15 & 7)];
    float bmax = 0.f;
    for (int d = 0; d <= 128; ++d) bmax = fmaxf(bmax, fabsf(biasL[d * 8 + (l15 & 7)]));
    const float kvmax = 11.313708499f * 1.004f * wave_max(fmaxf(fabsf(c.kv_g[2 * lane]), fabsf(c.kv_g[2 * lane + 1])));
    unsigned trm[8];
#pragma unroll
    for (int m = 0; m < 8; ++m) trm[m] = tr_off + 32u * ((unsigned)m ^ tr_mx);
    const int gw = c.bid * NWAVES + wv, NGW = c.G * NWAVES;
    const int eit0 = (c.G == 256 ? 32 * 256 : 0) + gw;
    if (wv < 4) for (int eit = eit0; eit < P0_EXPERT_ITEMS; eit += NGW) p0_expert_item(c, (LAS float*)kvb, eit);
    asm volatile("s_waitcnt lgkmcnt(0)" ::: "memory");
#define DSA_LOADQ(n_, raw_, qf_) do { raw_ = *(const v2u*)((const unsigned short*)(c.ws + WS_SEL) + (size_t)(n_) * KSEL + 4 * lane); \
        const s16x8* qp_ = (const s16x8*)((const bf16*)(c.ws + WS_QLAT) + (size_t)(n_) * 1024 + (l15 & 7) * 128 + 8 * g4); \
        _Pragma("unroll") for (int s_ = 0; s_ < 4; ++s_) qf_[s_] = qp_[4 * s_]; } while (0)
#define DSA_PREP(n_, raw_, qf_, sl_, t_, cnt_, nch_, nfar_, mref_) do { t_ = (n_) & 2047; cnt_ = (t_ + 1 < KSEL) ? t_ + 1 : KSEL; nch_ = (cnt_ + 31) >> 5; \
        { const int i0 = 4 * lane, lim = t_ - 128; \
          raw_.x = (i0 < cnt_ ? (raw_.x & 0xffffu) : 0u) | (i0 + 1 < cnt_ ? (raw_.x & 0xffff0000u) : 0u); raw_.y = (i0 + 2 < cnt_ ? (raw_.y & 0xffffu) : 0u) | (i0 + 3 < cnt_ ? (raw_.y & 0xffff0000u) : 0u); \
          *(LAS v2u*)(wsb + (sl_) * 512 + 8 * lane) = raw_; \
          const int e0 = (i0 < cnt_ && (int)(raw_.x & 0xffffu) <= lim) ? 1 : 0, e1 = (i0 + 1 < cnt_ && (int)(raw_.x >> 16) <= lim) ? 1 : 0, e2 = (i0 + 2 < cnt_ && (int)(raw_.y & 0xffffu) <= lim) ? 1 : 0, e3 = (i0 + 3 < cnt_ && (int)(raw_.y >> 16) <= lim) ? 1 : 0; \
          int nf = e0 + e1 + e2 + e3; nf += DPP_I(nf, 0xB1); nf += DPP_I(nf, 0x4E); nf += DPP_I(nf, 0x141); nf += DPP_I(nf, 0x140); nf = x16_sumi(nf); { unsigned xa, xb; swap32((unsigned)nf, xa, xb); nf = (int)(xa + xb); } \
          nfar_ = __builtin_amdgcn_readfirstlane(nf) >> 5; } \
        { float q2 = 0.f; \
          _Pragma("unroll") for (int s_ = 0; s_ < 4; ++s_) { if (l15 >= 8) qf_[s_] = (s16x8){0, 0, 0, 0, 0, 0, 0, 0}; \
              _Pragma("unroll") for (int e = 0; e < 8; ++e) { const float qv = bf2f((unsigned)(unsigned short)qf_[s_][e]); q2 += qv * qv; } } \
          q2 = x16_sum(q2); q2 = x32_sum(q2); mref_ = sqrtf(q2) * kvmax + bmax; } } while (0)
#define DSA_ISSUE(ch_, bi_, k8_, sl_, n_, t_, cnt_, nfar_) do { const bf16* ckb_ = ckv + (size_t)((n_) >> 11) * SEQ * 128; \
            _Pragma("unroll") for (int u = 0; u < 8; ++u) { const unsigned kw = u < 2 ? k8_.x : (u < 4 ? k8_.y : (u < 6 ? k8_.z : k8_.w)); const unsigned key = (u & 1) ? (kw >> 16) : (kw & 0xffffu); \
                const int chl = l15 ^ ((g4 << 2) | (u & 3)); \
                __builtin_amdgcn_global_load_lds((const unsigned*)((const char*)ckb_ + (size_t)(unsigned)(key * 256u + (unsigned)chl * 16u)), (LAS unsigned*)(kvb + (bi_) * 8192 + u * 1024), 16, 0, 0); } \
            if ((ch_) >= (nfar_) && lane < 32) { const int kap = 32 * (ch_) + 8 * (lane & 3) + (lane >> 2); const int key = *(const LAS unsigned short*)(wsb + (sl_) * 512 + 2 * kap); int dd = (t_) - key; dd = dd > 128 ? 128 : dd; dd = kap < (cnt_) ? dd : 255; \
                *(LAS unsigned short*)(wsb + 1024 + (bi_) * 64 + 2 * lane) = (unsigned short)dd; } } while (0)
    const bool mixq = (NGW == SEQ);
#define DSA_QIDX(i_) (mixq ? ((i_) * SEQ + ((gw + 293 * (i_)) & (SEQ - 1))) : (gw + (i_) * NGW))
    const int nq = mixq ? BATCH : (NTOK - gw + NGW - 1) / NGW;
    int qi = 0, n = DSA_QIDX(0), sl = 0, b0 = 0, t = 0, cnt = 0, nch = 0, nfar = 0; float Mref = 0.f;
    s16x8 qf[4]; v2u rawn; s16x8 qfn[4];
    if (nq > 0) { v2u raw0; DSA_LOADQ(n, raw0, qf); DSA_PREP(n, raw0, qf, 0, t, cnt, nch, nfar, Mref);
        asm volatile("s_waitcnt lgkmcnt(0)" ::: "memory");
        const v4u k80 = *(const LAS v4u*)(wsb + (8 * g4) * 2); DSA_ISSUE(0, 0, k80, 0, n, t, cnt, nfar); }
    for (; qi < nq; ++qi) {
        const bool has_next = qi + 1 < nq; const int nn = has_next ? DSA_QIDX(qi + 1) : n;
        if (has_next) DSA_LOADQ(nn, rawn, qfn);
        int tn = 0, cntn = 0, nchn = 0, nfarn = 0; float Mrefn = 0.f;
        f32x4 O[8];
#pragma unroll
        for (int m = 0; m < 8; ++m) O[m] = (f32x4){0.f, 0.f, 0.f, 0.f};
        float l_run = 0.f;
        v4u k8n = *(const LAS v4u*)(wsb + sl * 512 + (32 * (nch > 1 ? 1 : 0) + 8 * g4) * 2);
        for (int ch = 0; ch < nch; ++ch) {
            const int bi = (b0 + ch) & 1;
            asm volatile("s_waitcnt lgkmcnt(0)" ::: "memory");
            if (ch + 1 < nch) { const v4u k8 = k8n; k8n = *(const LAS v4u*)(wsb + sl * 512 + (32 * (ch + 2 < 8 ? ch + 2 : 7) + 8 * g4) * 2);
                DSA_ISSUE(ch + 1, bi ^ 1, k8, sl, n, t, cnt, nfar); asm volatile("s_waitcnt vmcnt(8)" ::: "memory"); }
            else if (has_next) { DSA_PREP(nn, rawn, qfn, sl ^ 1, tn, cntn, nchn, nfarn, Mrefn);
                asm volatile("s_waitcnt lgkmcnt(0)" ::: "memory");
                const v4u k8 = *(const LAS v4u*)(wsb + (sl ^ 1) * 512 + (8 * g4) * 2);
                DSA_ISSUE(0, bi ^ 1, k8, sl ^ 1, nn, tn, cntn, nfarn); asm volatile("s_waitcnt vmcnt(8)" ::: "memory"); }
            else asm volatile("s_waitcnt vmcnt(0)" ::: "memory");
            const LAS unsigned char* kb_ = kvb + bi * 8192;
            f32x4 S[2];
#pragma unroll
            for (int T = 0; T < 2; ++T) { f32x4 a4 = {0.f, 0.f, 0.f, 0.f};
#pragma unroll
                for (int s_ = 0; s_ < 4; ++s_) { const s16x8 a = *(const LAS s16x8*)(kb_ + qk_off + 4096 * T + 64 * ((unsigned)s_ ^ qk_sx)); a4 = __builtin_amdgcn_mfma_f32_16x16x32_bf16(a, qf[s_], a4, 0, 0, 0); }
                S[T] = a4; }
            if (ch < nfar) {
#pragma unroll
                for (int T = 0; T < 2; ++T)
#pragma unroll
                    for (int r_ = 0; r_ < 4; ++r_) S[T][r_] = S[T][r_] + (bfar - Mref);
            } else
#pragma unroll
            for (int T = 0; T < 2; ++T) { const v2u d4 = *(const LAS v2u*)(wsb + 1024 + bi * 64 + 2 * (16 * T + grow));
#pragma unroll
                for (int r_ = 0; r_ < 4; ++r_) { const unsigned dw = r_ < 2 ? d4.x : d4.y; const unsigned dd = (r_ & 1) ? (dw >> 16) : (dw & 0xffffu);
                    const float bsv = biasL[(dd > 128u ? 128u : dd) * 8 + (l15 & 7)]; S[T][r_] = (dd == 255u) ? -INFINITY : S[T][r_] + (bsv - Mref); } }
#pragma unroll
            for (int T = 0; T < 2; ++T)
#pragma unroll
                for (int r_ = 0; r_ < 4; ++r_) { const float pv = __expf(S[T][r_]); S[T][r_] = pv; l_run += pv; }
            s16x8 P;
            { const unsigned p0 = cvt_pk(S[0][0], S[0][1]), p1 = cvt_pk(S[0][2], S[0][3]), p2 = cvt_pk(S[1][0], S[1][1]), p3 = cvt_pk(S[1][2], S[1][3]);
              const v4u pw_ = {p0, p1, p2, p3}; P = __builtin_bit_cast(s16x8, pw_); }
            { const unsigned kba = (unsigned)(size_t)kb_; s16x4 ta[8], tb[8];
#pragma unroll
              for (int m = 0; m < 8; ++m) { const unsigned ad = kba + trm[m];
                  asm volatile("ds_read_b64_tr_b16 %0, %1" : "=v"(ta[m]) : "v"(ad) : "memory"); asm volatile("ds_read_b64_tr_b16 %0, %1 offset:4096" : "=v"(tb[m]) : "v"(ad) : "memory"); }
              asm volatile("s_waitcnt lgkmcnt(8)" ::: "memory"); __builtin_amdgcn_sched_barrier(0);
#pragma unroll
              for (int m = 0; m < 4; ++m) O[m] = __builtin_amdgcn_mfma_f32_16x16x32_bf16(__builtin_shufflevector(ta[m], tb[m], 0, 1, 2, 3, 4, 5, 6, 7), P, O[m], 0, 0, 0);
              asm volatile("s_waitcnt lgkmcnt(0)" ::: "memory"); __builtin_amdgcn_sched_barrier(0);
#pragma unroll
              for (int m = 4; m < 8; ++m) O[m] = __builtin_amdgcn_mfma_f32_16x16x32_bf16(__builtin_shufflevector(ta[m], tb[m], 0, 1, 2, 3, 4, 5, 6, 7), P, O[m], 0, 0, 0); }
        }
        l_run = x16_sum(l_run); l_run = x32_sum(l_run);
        const float inv = 1.0f / fmaxf(l_run, 1e-37f);
        { LAS unsigned char* stg = kvb + ((b0 + nch - 1) & 1) * 8192;
          if (l15 < 8) {
#pragma unroll
              for (int m = 0; m < 8; ++m) *(LAS v2u*)(stg + (l15 * 128 + 16 * m + 4 * g4) * 2) = (v2u){cvt_pk(O[m][0] * inv, O[m][1] * inv), cvt_pk(O[m][2] * inv, O[m][3] * inv)}; }
          asm volatile("s_waitcnt lgkmcnt(0)" ::: "memory");
          const v4u oa = *(const LAS v4u*)(stg + lane * 16), ob = *(const LAS v4u*)(stg + 1024 + lane * 16);
          bf16* op = (bf16*)(c.ws + WS_XB) + (size_t)n * 1024 + lane * 8;
          *(v4u*)op = oa; *(v4u*)(op + 512) = ob; }
        b0 = (b0 + nch) & 1; sl ^= 1; t = tn; cnt = cntn; nch = nchn; nfar = nfarn; Mref = Mrefn; n = nn;
#pragma unroll
        for (int s_ = 0; s_ < 4; ++s_) qf[s_] = qfn[s_];
    }
#undef DSA_QIDX
#undef DSA_LOADQ
#undef DSA_PREP
#undef DSA_ISSUE
    asm volatile("s_waitcnt vmcnt(0) lgkmcnt(0)" ::: "memory");
    if (wv >= 4) for (int eit = eit0; eit < P0_EXPERT_ITEMS; eit += NGW) p0_expert_item(c, (LAS float*)kvb, eit);
    __syncthreads();
}

__device__ __forceinline__ void p3b_swa(const Ctx& c) {
    const int lane = c.lane, wv = c.wave, l15 = lane & 15, g4 = lane >> 4, g = wv & 3, hq = wv >> 2;
    LAS float* biasL = (LAS float*)(c.lds + DSA_BIAS_OFF);
    __syncthreads();
    for (int i = c.tid; i < 128 * 8; i += NTHR) biasL[i] = ((const float*)(c.ws + WS_BIAS) + 129 * 8)[i];
    __syncthreads();
    const unsigned kr_off = (unsigned)(128 * l15), kr_x = (unsigned)(l15 & 7);
    const int vrow = 4 * g4 + (l15 >> 2); const unsigned vr_x = (unsigned)(vrow & 7), vp1 = (unsigned)((lane & 3) >> 1);
    const unsigned vr_off = (unsigned)(128 * vrow + 8 * (lane & 1));
    for (int unit = c.bid; unit < 256; unit += c.G) {
        const int b = unit >> 5, qb = (unit >> 1) & 15, kvh = unit & 1, head = kvh * 4 + g;
        __syncthreads();
#pragma unroll
        for (int j = 0; j < 4; ++j) { const int piece = wv * 4 + j, row = 8 * piece + (lane >> 3), chunk = (lane & 7) ^ (row & 7); int key = (qb - 1) * 128 + row; key = key < 0 ? 0 : key;
            const size_t so = ((size_t)(b * SEQ + key) * 128 + kvh * 64 + chunk * 8);
            __builtin_amdgcn_global_load_lds((const unsigned*)((const bf16*)(c.ws + WS_KB) + so), (LAS unsigned*)(c.lds + piece * 1024), 16, 0, 0);
            __builtin_amdgcn_global_load_lds((const unsigned*)((const bf16*)(c.ws + WS_VB) + so), (LAS unsigned*)(c.lds + 32768 + piece * 1024), 16, 0, 0); }
        float bt[9][4];
#pragma unroll
        for (int ta = 0; ta < 9; ++ta)
#pragma unroll
            for (int r_ = 0; r_ < 4; ++r_) { const int dist = 128 + l15 - 16 * ta - 4 * g4 - r_; bt[ta][r_] = (dist >= 0 && dist < 128) ? biasL[dist * 8 + head] : -INFINITY; }
        const float sink = c.sinks[head];
        asm volatile("s_waitcnt vmcnt(0)" ::: "memory");
        __syncthreads();
#pragma unroll 1
        for (int jj = 0; jj < 4; ++jj) {
            const int j = 4 * hq + jj; const size_t nrow = (size_t)(b * SEQ + qb * 128 + 16 * j + l15);
            bf16* qrow = (bf16*)(c.ws + WS_QB) + nrow * 512 + head * 64;
            const s16x8 q0 = *(const s16x8*)(qrow + 8 * g4), q1 = *(const s16x8*)(qrow + 32 + 8 * g4);
            f32x4 S[9]; float mx = sink;
#pragma unroll
            for (int ta = 0; ta < 9; ++ta) { const int kt = j + ta; const LAS unsigned char* kp = c.lds + kr_off + 2048 * kt;
                f32x4 a4 = {0.f, 0.f, 0.f, 0.f};
                a4 = __builtin_amdgcn_mfma_f32_16x16x32_bf16(*(const LAS s16x8*)(kp + 16 * ((unsigned)g4 ^ kr_x)), q0, a4, 0, 0, 0);
                a4 = __builtin_amdgcn_mfma_f32_16x16x32_bf16(*(const LAS s16x8*)(kp + 16 * ((unsigned)(4 + g4) ^ kr_x)), q1, a4, 0, 0, 0);
                const bool dead = (qb == 0 && kt < 8);
#pragma unroll
                for (int r_ = 0; r_ < 4; ++r_) { const float sv = dead ? -INFINITY : a4[r_] + bt[ta][r_]; a4[r_] = sv; mx = fmaxf(mx, sv); }
                S[ta] = a4; }
            mx = x16_max(mx); mx = x32_max(mx);
            float ps = 0.f;
#pragma unroll
            for (int ta = 0; ta < 9; ++ta)
#pragma unroll
                for (int r_ = 0; r_ < 4; ++r_) { const float pv = __expf(S[ta][r_] - mx); S[ta][r_] = pv; ps += pv; }
            ps = x16_sum(ps); ps = x32_sum(ps);
            const float inv = 1.0f / (ps + __expf(sink - mx));
            f32x4 O[4];
#pragma unroll
            for (int m = 0; m < 4; ++m) O[m] = (f32x4){0.f, 0.f, 0.f, 0.f};
#pragma unroll
            for (int pp = 0; pp < 5; ++pp) {
                const int ta = 2 * pp, tb = 2 * pp + 1;
                v4u pw_; pw_.x = cvt_pk(S[ta][0] * inv, S[ta][1] * inv); pw_.y = cvt_pk(S[ta][2] * inv, S[ta][3] * inv);
                if (tb < 9) { pw_.z = cvt_pk(S[tb < 9 ? tb : 0][0] * inv, S[tb < 9 ? tb : 0][1] * inv); pw_.w = cvt_pk(S[tb < 9 ? tb : 0][2] * inv, S[tb < 9 ? tb : 0][3] * inv); } else { pw_.z = 0u; pw_.w = 0u; }
                const s16x8 P = __builtin_bit_cast(s16x8, pw_);
                const LAS unsigned char* va = c.lds + 32768 + vr_off + 2048 * (j + ta); const LAS unsigned char* vb_ = c.lds + 32768 + vr_off + 2048 * (j + (tb < 9 ? tb : ta));
#pragma unroll
                for (int m = 0; m < 4; ++m) { const unsigned co = 16u * ((unsigned)(2 * m + vp1) ^ vr_x);
                    const s16x4 a0 = __builtin_amdgcn_ds_read_tr16_b64_v4i16((LAS s16x4*)(va + co)), a1 = __builtin_amdgcn_ds_read_tr16_b64_v4i16((LAS s16x4*)(vb_ + co));
                    O[m] = __builtin_amdgcn_mfma_f32_16x16x32_bf16(__builtin_shufflevector(a0, a1, 0, 1, 2, 3, 4, 5, 6, 7), P, O[m], 0, 0, 0); }
            }
#pragma unroll
            for (int m = 0; m < 4; ++m) *(v2u*)(qrow + 16 * m + 4 * g4) = (v2u){cvt_pk(O[m][0], O[m][1]), cvt_pk(O[m][2], O[m][3])};
        }
    }
    __syncthreads();
}

__device__ __forceinline__ void p6_ln_router(const Ctx& c, bf16* x1b) {
    const int lane = c.lane, wv = c.wave, l15 = lane & 15, g4 = lane >> 4;
    LAS unsigned char* XH = c.lds; LAS unsigned char* XL = c.lds + 32768;
    LAS float* PL = (LAS float*)(c.lds + 65536);
    LAS float* LG = (LAS float*)(c.lds + 65536 + 24576);
    const bf16* WH = (const bf16*)(c.ws + WS_WRT); const bf16* WL = WH + 48 * 1024;
    LAS unsigned* PEX = (LAS unsigned*)(c.lds + 65536 + 24576 + 4096);
    LAS unsigned* EB = PEX + 128;
    int nbase = 0;
    s16x8 wbh[4][3], wbl[4][3];
#pragma unroll
    for (int s_ = 0; s_ < 4; ++s_)
#pragma unroll
        for (int nt = 0; nt < 3; ++nt) { const size_t wo = (size_t)(16 * nt + l15) * 1024 + 128 * wv + 32 * s_ + 8 * g4; wbh[s_][nt] = *(const s16x8*)(WH + wo); wbl[s_][nt] = *(const s16x8*)(WL + wo); }
    f32x4 vn[2][4];
    if (c.bid < NTOK / 16) {
#pragma unroll
        for (int q = 0; q < 2; ++q)
#pragma unroll
            for (int j = 0; j < 4; ++j) vn[q][j] = ((const f32x4*)(c.out + (size_t)(c.bid * 16 + 2 * wv + q) * D) + lane)[64 * j]; }
    for (int u = c.bid; u < NTOK / 16; u += c.G) {
        __syncthreads();
#pragma unroll
        for (int q = 0; q < 2; ++q) { const int tk = 2 * wv + q, n = u * 16 + tk;
            f32x4 v[4]; float s = 0.f;
#pragma unroll
            for (int j = 0; j < 4; ++j) { v[j] = vn[q][j]; s += (v[j].x + v[j].y) + (v[j].z + v[j].w); }
            const float mean = wave_sum(s) * (1.f / D); float s2 = 0.f;
#pragma unroll
            for (int j = 0; j < 4; ++j) { v[j] = v[j] - mean; s2 += (v[j].x * v[j].x + v[j].y * v[j].y) + (v[j].z * v[j].z + v[j].w * v[j].w); }
            const float rstd = 1.f / sqrtf(wave_sum(s2) * (1.f / D) + LN_EPS);
#pragma unroll
            for (int j = 0; j < 4; ++j) { const int k0 = 4 * lane + 256 * j;
                const f32x4 g = *(const f32x4*)(c.ln1_g + k0), bb = *(const f32x4*)(c.ln1_b + k0);
                const f32x4 y = v[j] * rstd * g + bb;
                const unsigned h01 = pk2(y.x, y.y), h23 = pk2(y.z, y.w);
                *(v2u*)(x1b + (size_t)n * D + k0) = (v2u){h01, h23};
                const unsigned l01 = pk2(y.x - bflo(h01), y.y - bfhi(h01)), l23 = pk2(y.z - bflo(h23), y.w - bfhi(h23));
                const unsigned off = (unsigned)(tk * 2048 + ((((lane >> 1) + 32 * j) ^ tk) << 4) + 8 * (lane & 1));
                *(LAS v2u*)(XH + off) = (v2u){h01, h23}; *(LAS v2u*)(XL + off) = (v2u){l01, l23}; } }
        if (u + c.G < NTOK / 16) {
#pragma unroll
            for (int q = 0; q < 2; ++q)
#pragma unroll
                for (int j = 0; j < 4; ++j) vn[q][j] = ((const f32x4*)(c.out + (size_t)((u + c.G) * 16 + 2 * wv + q) * D) + lane)[64 * j]; }
        __syncthreads();
        { f32x4 acc[3];
#pragma unroll
          for (int nt = 0; nt < 3; ++nt) acc[nt] = (f32x4){0.f, 0.f, 0.f, 0.f};
#pragma unroll
          for (int s_ = 0; s_ < 4; ++s_) { const int chunk = 4 * (4 * wv + s_) + g4; const unsigned off = (unsigned)(l15 * 2048 + ((chunk ^ l15) << 4));
              const s16x8 ah = *(const LAS s16x8*)(XH + off), al = *(const LAS s16x8*)(XL + off);
#pragma unroll
              for (int nt = 0; nt < 3; ++nt) { const s16x8 bh = wbh[s_][nt], bl = wbl[s_][nt];
                  acc[nt] = __builtin_amdgcn_mfma_f32_16x16x32_bf16(al, bl, acc[nt], 0, 0, 0); acc[nt] = __builtin_amdgcn_mfma_f32_16x16x32_bf16(al, bh, acc[nt], 0, 0, 0);
                  acc[nt] = __builtin_amdgcn_mfma_f32_16x16x32_bf16(ah, bl, acc[nt], 0, 0, 0); acc[nt] = __builtin_amdgcn_mfma_f32_16x16x32_bf16(ah, bh, acc[nt], 0, 0, 0); } }
#pragma unroll
          for (int nt = 0; nt < 3; ++nt)
#pragma unroll
              for (int r_ = 0; r_ < 4; ++r_) PL[(wv * 16 + 4 * g4 + r_) * 48 + 16 * nt + l15] = acc[nt][r_]; }
        __syncthreads();
        for (int i = c.tid; i < 16 * 48; i += NTHR) { float a = 0.f;
#pragma unroll
            for (int w = 0; w < 8; ++w) a += PL[w * 768 + i];
            const int o = i % 48; a += o < 32 ? c.b_router[o] : (o < 36 ? c.b_group[o - 32] : 0.f);
            LG[i] = a; }
        __syncthreads();
        if (c.tid < 16) { const int n = u * 16 + c.tid; const LAS float* lg = LG + c.tid * 48; const int nloc = nbase + 2 * c.tid;
            int gs = 0; float gm = lg[32];
            for (int o = 1; o < 4; ++o) { const float v = lg[32 + o]; if (v > gm) { gm = v; gs = o; } }
            float gsum = 0.f;
            for (int o = 0; o < 4; ++o) gsum += __expf(lg[32 + o] - gm);
            const float gw_ = 1.0f / gsum;
            int i1 = 0; float m1 = lg[gs * 8];
            for (int o = 1; o < 8; ++o) { const float v = lg[gs * 8 + o]; if (v > m1) { m1 = v; i1 = o; } }
            int i2 = -1; float m2 = -INFINITY;
            for (int o = 0; o < 8; ++o) { const float v = lg[gs * 8 + o]; if (o != i1 && v > m2) { m2 = v; i2 = o; } }
            const float e2 = __expf(m2 - m1), w1 = gw_ / (1.0f + e2), w2 = gw_ * e2 / (1.0f + e2);
            const int ex1 = gs * 8 + i1, ex2 = gs * 8 + i2;
            ((unsigned*)(c.ws + WS_PE))[2 * n] = ex1; ((unsigned*)(c.ws + WS_PE))[2 * n + 1] = ex2; ((float*)(c.ws + WS_PW))[2 * n] = w1; ((float*)(c.ws + WS_PW))[2 * n + 1] = w2;
            PEX[nloc] = (unsigned)ex1 | ((unsigned)(2 * n) << 8); PEX[nloc + 1] = (unsigned)ex2 | ((unsigned)(2 * n + 1) << 8); }
        nbase += 32;
        if (nbase == 128 || u + c.G >= NTOK / 16) {
            __syncthreads();
            if (c.tid < 32) { unsigned cntE = 0; for (int j = 0; j < nbase; ++j) cntE += ((PEX[j] & 0xffu) == (unsigned)c.tid) ? 1u : 0u;
                EB[c.tid] = cntE ? atomicAdd(c.ctl + CW_CNT + c.tid, cntE) : 0u; }
            __syncthreads();
            if (c.tid < nbase) { const unsigned rec = PEX[c.tid], e = rec & 0xffu; unsigned rk = 0; for (int j = 0; j < c.tid; ++j) rk += ((PEX[j] & 0xffu) == e) ? 1u : 0u;
                ((unsigned*)(c.ws + WS_LIST))[(size_t)e * 32768 + EB[e] + rk] = rec >> 8; }
            nbase = 0;
        }
    }
    __syncthreads();
}


__device__ __forceinline__ void p9_ln2(const Ctx& c) {
    const int gw = c.bid * NWAVES + c.wave, NGW = c.G * NWAVES;
    f32x4 vn[4]; v2u san[4], sbn[4];
#define P9_LOAD(n_) do { const f32x4* r_ = (const f32x4*)(c.out + (size_t)(n_) * D) + c.lane; \
        _Pragma("unroll") for (int j = 0; j < 4; ++j) { const int k0 = 4 * c.lane + 256 * j; vn[j] = r_[64 * j]; \
            san[j] = *(const v2u*)((const bf16*)(c.ws + WS_SLOT) + (size_t)(2 * (n_)) * D + k0); sbn[j] = *(const v2u*)((const bf16*)(c.ws + WS_SLOT) + (size_t)(2 * (n_) + 1) * D + k0); } } while (0)
    if (gw < NTOK) P9_LOAD(gw);
    for (int n = gw; n < NTOK; n += NGW) {
        f32x4* row = (f32x4*)(c.out + (size_t)n * D) + c.lane;
        f32x4 v[4]; v2u sa[4], sb[4]; float s = 0.f;
#pragma unroll
        for (int j = 0; j < 4; ++j) { v[j] = vn[j]; sa[j] = san[j]; sb[j] = sbn[j]; s += (v[j].x + v[j].y) + (v[j].z + v[j].w); }
        if (n + NGW < NTOK) P9_LOAD(n + NGW);
        const float mean1 = wave_sum(s) * (1.f / D); float q1 = 0.f;
#pragma unroll
        for (int j = 0; j < 4; ++j) { v[j] = v[j] - mean1; q1 += (v[j].x * v[j].x + v[j].y * v[j].y) + (v[j].z * v[j].z + v[j].w * v[j].w); }
        const float rstd1 = 1.f / sqrtf(wave_sum(q1) * (1.f / D) + LN_EPS);
        s = 0.f;
#pragma unroll
        for (int j = 0; j < 4; ++j) { const int k0 = 4 * c.lane + 256 * j; const f32x4 g = *(const f32x4*)(c.ln1_g + k0), bb = *(const f32x4*)(c.ln1_b + k0);
            f32x4 y = (v[j] * rstd1 * g + bb) * ALPHA; y.x += bflo(sa[j].x) + bflo(sb[j].x); y.y += bfhi(sa[j].x) + bfhi(sb[j].x); y.z += bflo(sa[j].y) + bflo(sb[j].y); y.w += bfhi(sa[j].y) + bfhi(sb[j].y);
            v[j] = y; s += (y.x + y.y) + (y.z + y.w); }
        const float mean = wave_sum(s) * (1.f / D); float s2 = 0.f;
#pragma unroll
        for (int j = 0; j < 4; ++j) { v[j] = v[j] - mean; s2 += (v[j].x * v[j].x + v[j].y * v[j].y) + (v[j].z * v[j].z + v[j].w * v[j].w); }
        const float rstd = 1.f / sqrtf(wave_sum(s2) * (1.f / D) + LN_EPS);
#pragma unroll
        for (int j = 0; j < 4; ++j) { const int k0 = 4 * c.lane + 256 * j; const f32x4 g = *(const f32x4*)(c.ln2_g + k0), bb = *(const f32x4*)(c.ln2_b + k0); row[64 * j] = v[j] * rstd * g + bb; }
    }
#undef P9_LOAD
}

namespace pg8 {
typedef short bf16x8 __attribute__((ext_vector_type(8)));
constexpr int BM = 256, BK = 64, HALF = 128, HTB = HALF * BK * 2, STAGE_BYTES = 8 * HTB, NXCD = 8, WGM = 8;
__host__ __device__ __forceinline__ int lds_byte(int r, int c) { const int st = (r >> 4) * 2 + (c >> 5), rr = r & 15, cc = c & 31, ob = rr * 64 + cc * 2; return st * 1024 + (ob ^ (((ob >> 9) & 1) << 5)); }
__host__ __device__ __forceinline__ void stage_rc(int b, int& R, int& C) { const int st = b / 1024, sb = b % 1024, swz = sb ^ (((sb >> 9) & 1) << 5); R = (st >> 1) * 16 + swz / 64; C = (st & 1) * 32 + (swz % 64) / 2; }
__host__ __device__ __forceinline__ int perm32(int rho) { const int n = rho >> 4, i = rho & 15; return 8 * (i >> 2) + 4 * n + (i & 3); }
__device__ __forceinline__ unsigned cvt_pk_bf16(float lo, float hi) { unsigned r; asm volatile("v_cvt_pk_bf16_f32 %0, %1, %2" : "=v"(r) : "v"(lo), "v"(hi)); return r; }

struct Unit { int pm, pn, pb, aux; };

struct StaticOrder {
    int nM, nN, nwg, G, c;
    __device__ void init(int M, int N, int G_, int c_) { nM = M / BM; nN = N / BM; nwg = nM * nN; G = G_; c = c_; }
    __device__ bool next(int i, Unit& u) const {
        const long L = (long)i * G + c; if (L >= nwg) return false;
        int wgid = (int)L; { const int q = nwg / NXCD, r = nwg % NXCD, xcd = wgid % NXCD, off = wgid / NXCD; wgid = (xcd < r ? xcd * (q + 1) : r * (q + 1) + (xcd - r) * q) + off; }
        const int nig = WGM * nN, gid = wgid / nig, fm = gid * WGM, gsz = (nM - fm) < WGM ? (nM - fm) : WGM;
        u.pm = fm + ((wgid % nig) % gsz); u.pn = (wgid % nig) / gsz; u.pb = u.pn; u.aux = 0; return true;
    }
    __device__ __forceinline__ void a_ready(const Unit&) const {}
    __device__ __forceinline__ void done(const Unit&) const {}
};
struct DenseProb {
    static constexpr bool GATHER = false;
    const bf16* A; const bf16* Bt; int K;
    __device__ __forceinline__ const char* a_base(const Unit& u) const { return (const char*)A + (size_t)u.pm * 256 * K * 2; }
    __device__ __forceinline__ const char* b_base(const Unit& u) const { return (const char*)Bt + (size_t)u.pb * 256 * K * 2; }
    __device__ __forceinline__ void a_offs(const Unit&, int R0, int C0, int R1, int C1, unsigned (&o)[2][2]) const {
        o[0][0] = (unsigned)(R0 * K + C0) * 2u; o[0][1] = (unsigned)(R1 * K + C1) * 2u; o[1][0] = o[0][0] + (unsigned)(HALF * K * 2); o[1][1] = o[0][1] + (unsigned)(HALF * K * 2); }
};

template <class Prob, class Epi, class Sched>
__device__ __forceinline__ void gemm_phase(LAS unsigned char* lds, const Prob& P, const Sched& S, const Epi& E) {
    const int tid = threadIdx.x, wid = __builtin_amdgcn_readfirstlane(tid >> 6), lane = tid & 63, wr = wid >> 2, wc = wid & 3, fr = lane & 15, fq = lane >> 4;
    const int K = P.K, nt = K / BK;
    int sR[2], sC[2];
    unsigned offB[2][2], offA[2][2];
#pragma unroll
    for (int i = 0; i < 2; ++i) { stage_rc(tid * 16 + i * 8192, sR[i], sC[i]); const int Rb = Epi::PERM ? ((sR[i] & ~31) + perm32(sR[i] & 31)) : sR[i];
        offB[0][i] = (unsigned)(Rb * K + sC[i]) * 2u; offB[1][i] = offB[0][i] + (unsigned)(HALF * K * 2); }
    const size_t kstep = (size_t)(BK * 2);
    const unsigned ldsw = (unsigned)wid * 1024u;
    const int aoff = lds_byte(wr * 64 + fr, fq * 8), boff = lds_byte(wc * 32 + fr, fq * 8);
#define PG8_SA(b, h) (((b) * 2 + (h)) * HTB)
#define PG8_SB(b, h) ((4 + (b) * 2 + (h)) * HTB)
#define PG8_STAGE(bufoff, gbase, offs) do { _Pragma("unroll") for (int _i = 0; _i < 2; ++_i) \
        __builtin_amdgcn_global_load_lds((const unsigned*)((gbase) + (offs)[_i]), (LAS unsigned*)(lds + (bufoff) + ldsw + _i * 8192), 16, 0, 0); } while (0)
#define PG8_STA(b, h, tau) PG8_STAGE(PG8_SA(b, h), sA + (size_t)(tau) * kstep, offA[h])
#define PG8_STB(b, h, tau) PG8_STAGE(PG8_SB(b, h), sB + (size_t)(tau) * kstep, offB[h])
#define PG8_LDA(dst, b, h) do { _Pragma("unroll") for (int m = 0; m < 4; ++m) _Pragma("unroll") for (int k = 0; k < 2; ++k) dst[m][k] = *(const LAS bf16x8*)(lds + PG8_SA(b, h) + aoff + m * 2048 + k * 1024); } while (0)
#define PG8_LDB(dst, b, h) do { _Pragma("unroll") for (int n = 0; n < 2; ++n) _Pragma("unroll") for (int k = 0; k < 2; ++k) dst[n][k] = *(const LAS bf16x8*)(lds + PG8_SB(b, h) + boff + n * 2048 + k * 1024); } while (0)
#define PG8_MMA(ai, bj, At, Bt) do { __builtin_amdgcn_s_setprio(1); _Pragma("unroll") for (int m = 0; m < 4; ++m) _Pragma("unroll") for (int n = 0; n < 2; ++n) _Pragma("unroll") for (int k = 0; k < 2; ++k) \
        acc[ai][bj][m][n] = __builtin_amdgcn_mfma_f32_16x16x32_bf16(Bt[n][k], At[m][k], acc[ai][bj][m][n], 0, 0, 0); __builtin_amdgcn_s_setprio(0); } while (0)
#define PG8_WAIT_V(n) asm volatile("s_waitcnt vmcnt(" #n ")" ::: "memory")
#define PG8_WAIT_L(n) asm volatile("s_waitcnt lgkmcnt(" #n ")" ::: "memory")
#define PG8_BAR __builtin_amdgcn_s_barrier()
#define PG8_SCHED __builtin_amdgcn_sched_barrier(0)
    Unit cur, nxt; int ui = 0;
    if (!S.next(0, cur)) return;
    f32x4 acc[2][2][4][2];
#pragma unroll
    for (int a = 0; a < 2; ++a)
#pragma unroll
        for (int b = 0; b < 2; ++b)
#pragma unroll
            for (int m = 0; m < 4; ++m)
#pragma unroll
                for (int n = 0; n < 2; ++n) acc[a][b][m][n] = (f32x4){0.f, 0.f, 0.f, 0.f};
    bf16x8 At[4][2], B0[2][2], B1[2][2];
    const char* sA = P.a_base(cur); const char* sB = P.b_base(cur);
    S.a_ready(cur);
    P.a_offs(cur, sR[0], sC[0], sR[1], sC[1], offA);
    PG8_STB(0, 0, 0); PG8_STB(0, 1, 0); PG8_STA(0, 0, 0); PG8_STA(0, 1, 0);
    if (wr == 1) PG8_BAR;
    PG8_WAIT_V(2); PG8_BAR;
    PG8_STB(1, 0, 1); PG8_STA(1, 0, 1); PG8_STB(1, 1, 1);
    PG8_WAIT_V(6); PG8_BAR;
    for (;;) {
        const bool has_next = S.next(ui + 1, nxt);
        unsigned nOffA[2][2];
        if (Prob::GATHER) { if (has_next) P.a_offs(nxt, sR[0], sC[0], sR[1], sC[1], nOffA); else {
#pragma unroll
            for (int h = 0; h < 2; ++h)
#pragma unroll
                for (int i = 0; i < 2; ++i) nOffA[h][i] = offA[h][i]; } }
        const char* nA = has_next ? P.a_base(nxt) : sA; const char* nB = has_next ? P.b_base(nxt) : sB;
        for (int t = 0; t < nt; t += 2) {
            const bool last = (t == nt - 2);
            if (last && has_next) S.a_ready(nxt);
            PG8_LDB(B0, 0, 0); PG8_LDB(B1, 0, 1); PG8_SCHED; PG8_LDA(At, 0, 0); PG8_STA(1, 1, t + 1);
            PG8_WAIT_V(8); PG8_WAIT_L(0); PG8_BAR; PG8_MMA(0, 0, At, B0); PG8_MMA(0, 1, At, B1); PG8_BAR; PG8_SCHED;
            if (last) {
                sA = nA - (size_t)nt * kstep; sB = nB - (size_t)nt * kstep;
                if (Prob::GATHER) {
#pragma unroll
                    for (int h = 0; h < 2; ++h)
#pragma unroll
                        for (int i = 0; i < 2; ++i) offA[h][i] = nOffA[h][i]; }
            }
            PG8_LDA(At, 0, 1); PG8_STB(0, 0, t + 2); PG8_STB(0, 1, t + 2); PG8_STA(0, 0, t + 2);
            PG8_WAIT_V(8); PG8_WAIT_L(0); PG8_BAR; PG8_MMA(1, 0, At, B0); PG8_MMA(1, 1, At, B1); PG8_BAR; PG8_SCHED;
            PG8_LDB(B0, 1, 0); PG8_LDB(B1, 1, 1); PG8_SCHED; PG8_LDA(At, 1, 0); PG8_STA(0, 1, t + 2);
            PG8_WAIT_V(8); PG8_WAIT_L(0); PG8_BAR; PG8_MMA(0, 0, At, B0); PG8_MMA(0, 1, At, B1); PG8_BAR; PG8_SCHED;
            PG8_LDA(At, 1, 1); PG8_STB(1, 0, t + 3); PG8_STB(1, 1, t + 3); PG8_STA(1, 0, t + 3);
            PG8_WAIT_V(8); PG8_WAIT_L(0); PG8_BAR; PG8_MMA(1, 0, At, B0); PG8_MMA(1, 1, At, B1); PG8_BAR; PG8_SCHED;
        }
        if (wr == 0) PG8_BAR;
        E(acc, cur, wr, wc, fr, fq); S.done(cur);
        if (!has_next) break;
#pragma unroll
        for (int a = 0; a < 2; ++a)
#pragma unroll
            for (int b = 0; b < 2; ++b)
#pragma unroll
                for (int m = 0; m < 4; ++m)
#pragma unroll
                    for (int n = 0; n < 2; ++n) acc[a][b][m][n] = (f32x4){0.f, 0.f, 0.f, 0.f};
        cur = nxt; ++ui; sA = nA; sB = nB;
        if (wr == 1) PG8_BAR;
    }
    PG8_WAIT_V(0);
    PG8_BAR;
#undef PG8_SA
#undef PG8_SB
#undef PG8_STAGE
#undef PG8_STA
#undef PG8_STB
#undef PG8_LDA
#undef PG8_LDB
#undef PG8_MMA
#undef PG8_WAIT_V
#undef PG8_WAIT_L
#undef PG8_BAR
#undef PG8_SCHED
}

template <class Epi, class Sched>
__device__ __forceinline__ void gemm_phase_dual(LAS unsigned char* lds, const bf16* A1, const bf16* Bt1, int K1, const bf16* A2, const bf16* Bt2, int K2, const Sched& S, const Epi& E) {
    const int tid = threadIdx.x, wid = __builtin_amdgcn_readfirstlane(tid >> 6), lane = tid & 63, wr = wid >> 2, wc = wid & 3, fr = lane & 15, fq = lane >> 4;
    const int nt1 = K1 / BK, nt = (K1 + K2) / BK;
    unsigned offB1[2][2], offA1[2][2]; const unsigned dK2 = (unsigned)(2 * (K2 - K1));
#pragma unroll
    for (int i = 0; i < 2; ++i) { int R, C; stage_rc(tid * 16 + i * 8192, R, C); const int Rb = (R & ~31) + perm32(R & 31);
        offA1[0][i] = (unsigned)(R * K1 + C) * 2u; offA1[1][i] = offA1[0][i] + (unsigned)(HALF * K1 * 2); offB1[0][i] = (unsigned)(Rb * K1 + C) * 2u; offB1[1][i] = offB1[0][i] + (unsigned)(HALF * K1 * 2); }
    const size_t kstep = (size_t)(BK * 2);
    const unsigned ldsw = (unsigned)wid * 1024u;
    const int aoff = lds_byte(wr * 64 + fr, fq * 8), boff = lds_byte(wc * 32 + fr, fq * 8);
#define PG8_SA(b, h) (((b) * 2 + (h)) * HTB)
#define PG8_SB(b, h) ((4 + (b) * 2 + (h)) * HTB)
#define PG8_STX(bufoff, tau, g1, g2, o1, o2) do { const int _t = (tau); const bool _s2 = _t >= nt1; const long long _d = _s2 ? (long long)((g2) - (g1)) - (long long)nt1 * (long long)kstep : 0ll; const char* _g = (g1) + (size_t)_t * kstep + _d; \
        _Pragma("unroll") for (int _i = 0; _i < 2; ++_i) { const unsigned _o = (o1)[_i] + (_s2 ? ((o1)[_i] >> 11) * dK2 : 0u); \
        __builtin_amdgcn_global_load_lds((const unsigned*)(_g + _o), (LAS unsigned*)(lds + (bufoff) + ldsw + _i * 8192), 16, 0, 0); } } while (0)
#define PG8_STA(b, h, tau) PG8_STX(PG8_SA(b, h), tau, sA1, sA2, offA1[h], 0)
#define PG8_STB(b, h, tau) PG8_STX(PG8_SB(b, h), tau, sB1, sB2, offB1[h], 0)
#define PG8_LDA(dst, b, h) do { _Pragma("unroll") for (int m = 0; m < 4; ++m) _Pragma("unroll") for (int k = 0; k < 2; ++k) dst[m][k] = *(const LAS bf16x8*)(lds + PG8_SA(b, h) + aoff + m * 2048 + k * 1024); } while (0)
#define PG8_LDB(dst, b, h) do { _Pragma("unroll") for (int n = 0; n < 2; ++n) _Pragma("unroll") for (int k = 0; k < 2; ++k) dst[n][k] = *(const LAS bf16x8*)(lds + PG8_SB(b, h) + boff + n * 2048 + k * 1024); } while (0)
#define PG8_MMA(ai, bj, At, Bt) do { __builtin_amdgcn_s_setprio(1); _Pragma("unroll") for (int m = 0; m < 4; ++m) _Pragma("unroll") for (int n = 0; n < 2; ++n) _Pragma("unroll") for (int k = 0; k < 2; ++k) \
        acc[ai][bj][m][n] = __builtin_amdgcn_mfma_f32_16x16x32_bf16(Bt[n][k], At[m][k], acc[ai][bj][m][n], 0, 0, 0); __builtin_amdgcn_s_setprio(0); } while (0)
#define PG8_WAIT_V(n) asm volatile("s_waitcnt vmcnt(" #n ")" ::: "memory")
#define PG8_WAIT_L(n) asm volatile("s_waitcnt lgkmcnt(" #n ")" ::: "memory")
#define PG8_BAR __builtin_amdgcn_s_barrier()
#define PG8_SCHED __builtin_amdgcn_sched_barrier(0)
    Unit cur, nxt; int ui = 0;
    if (!S.next(0, cur)) return;
    f32x4 acc[2][2][4][2];
#pragma unroll
    for (int a = 0; a < 2; ++a)
#pragma unroll
        for (int b = 0; b < 2; ++b)
#pragma unroll
            for (int m = 0; m < 4; ++m)
#pragma unroll
                for (int n = 0; n < 2; ++n) acc[a][b][m][n] = (f32x4){0.f, 0.f, 0.f, 0.f};
    bf16x8 At[4][2], B0[2][2], B1[2][2];
    const char* sA1 = (const char*)A1 + (size_t)cur.pm * 256 * K1 * 2; const char* sB1 = (const char*)Bt1 + (size_t)cur.pn * 256 * K1 * 2;
    const char* sA2 = (const char*)A2 + (size_t)cur.pm * 256 * K2 * 2; const char* sB2 = (const char*)Bt2 + (size_t)cur.pn * 256 * K2 * 2;
    PG8_STB(0, 0, 0); PG8_STB(0, 1, 0); PG8_STA(0, 0, 0); PG8_STA(0, 1, 0);
    if (wr == 1) PG8_BAR;
    PG8_WAIT_V(2); PG8_BAR;
    PG8_STB(1, 0, 1); PG8_STA(1, 0, 1); PG8_STB(1, 1, 1);
    PG8_WAIT_V(6); PG8_BAR;
    for (;;) {
        const bool has_next = S.next(ui + 1, nxt);
        const int npm = has_next ? nxt.pm : cur.pm, npn = has_next ? nxt.pn : cur.pn;
        const char* nA1 = (const char*)A1 + (size_t)npm * 256 * K1 * 2; const char* nB1 = (const char*)Bt1 + (size_t)npn * 256 * K1 * 2;
        const char* nA2 = (const char*)A2 + (size_t)npm * 256 * K2 * 2; const char* nB2 = (const char*)Bt2 + (size_t)npn * 256 * K2 * 2;
        for (int t = 0; t < nt; t += 2) {
            const bool last = (t == nt - 2);
            const int t2 = last ? 0 : t + 2, t3 = last ? 1 : t + 3;
            if (t == nt1) { E.mid(acc, cur, wr, wc, fr, fq); PG8_SCHED; }
            PG8_LDB(B0, 0, 0); PG8_LDB(B1, 0, 1); PG8_SCHED; PG8_LDA(At, 0, 0); PG8_STA(1, 1, t + 1);
            PG8_WAIT_V(8); PG8_WAIT_L(0); PG8_BAR; PG8_MMA(0, 0, At, B0); PG8_MMA(0, 1, At, B1); PG8_BAR; PG8_SCHED;
            if (last) { sA1 = nA1; sB1 = nB1; sA2 = nA2; sB2 = nB2; }
            PG8_LDA(At, 0, 1); PG8_STB(0, 0, t2); PG8_STB(0, 1, t2); PG8_STA(0, 0, t2);
            PG8_WAIT_V(8); PG8_WAIT_L(0); PG8_BAR; PG8_MMA(1, 0, At, B0); PG8_MMA(1, 1, At, B1); PG8_BAR; PG8_SCHED;
            PG8_LDB(B0, 1, 0); PG8_LDB(B1, 1, 1); PG8_SCHED; PG8_LDA(At, 1, 0); PG8_STA(0, 1, t2);
            PG8_WAIT_V(8); PG8_WAIT_L(0); PG8_BAR; PG8_MMA(0, 0, At, B0); PG8_MMA(0, 1, At, B1); PG8_BAR; PG8_SCHED;
            PG8_LDA(At, 1, 1); PG8_STB(1, 0, t3); PG8_STB(1, 1, t3); PG8_STA(1, 0, t3);
            PG8_WAIT_V(8); PG8_WAIT_L(0); PG8_BAR; PG8_MMA(1, 0, At, B0); PG8_MMA(1, 1, At, B1); PG8_BAR; PG8_SCHED;
        }
        if (wr == 0) PG8_BAR;
        E(acc, cur, wr, wc, fr, fq);
        if (!has_next) break;
#pragma unroll
        for (int a = 0; a < 2; ++a)
#pragma unroll
            for (int b = 0; b < 2; ++b)
#pragma unroll
                for (int m = 0; m < 4; ++m)
#pragma unroll
                    for (int n = 0; n < 2; ++n) acc[a][b][m][n] = (f32x4){0.f, 0.f, 0.f, 0.f};
        cur = nxt; ++ui;
        if (wr == 1) PG8_BAR;
    }
    PG8_WAIT_V(0);
    PG8_BAR;
#undef PG8_SA
#undef PG8_SB
#undef PG8_STX
#undef PG8_STA
#undef PG8_STB
#undef PG8_LDA
#undef PG8_LDB
#undef PG8_MMA
#undef PG8_WAIT_V
#undef PG8_WAIT_L
#undef PG8_BAR
#undef PG8_SCHED
}
__device__ __forceinline__ v4u pack8(f32x4 v0, f32x4 v1) { v4u w; w.x = cvt_pk_bf16(v0[0], v0[1]); w.y = cvt_pk_bf16(v0[2], v0[3]); w.z = cvt_pk_bf16(v1[0], v1[1]); w.w = cvt_pk_bf16(v1[2], v1[3]); return w; }
__device__ __forceinline__ float sigm(float v) { return __builtin_amdgcn_rcpf(1.0f + __expf(-v)); }

struct EpiMergedDual {
    static constexpr bool PERM = true;
    const bf16* ga; const bf16* gb; bf16* merged;
    __device__ __forceinline__ void mid(f32x4 (&acc)[2][2][4][2], const Unit& u, int wr, int wc, int fr, int fq) const {
        int row0 = u.pm * BM + wr * 64 + fr; const int col0 = u.pn * BM + wc * 32 + 8 * fq;
        asm volatile("" : "+v"(row0));
#pragma unroll
        for (int ai = 0; ai < 2; ++ai)
#pragma unroll
            for (int m = 0; m < 4; ++m) { const size_t o = (size_t)(row0 + ai * HALF + m * 16) * 1024 + col0;
#pragma unroll
                for (int bj = 0; bj < 2; ++bj) { const v4u a = *(const v4u*)(ga + o + bj * HALF), b = *(const v4u*)(gb + o + bj * HALF);
                    f32x4 r0 = {bflo(a.x) * __builtin_amdgcn_rcpf(bflo(b.x)), bfhi(a.x) * __builtin_amdgcn_rcpf(bfhi(b.x)), bflo(a.y) * __builtin_amdgcn_rcpf(bflo(b.y)), bfhi(a.y) * __builtin_amdgcn_rcpf(bfhi(b.y))};
                    f32x4 r1 = {bflo(a.z) * __builtin_amdgcn_rcpf(bflo(b.z)), bfhi(a.z) * __builtin_amdgcn_rcpf(bfhi(b.z)), bflo(a.w) * __builtin_amdgcn_rcpf(bflo(b.w)), bfhi(a.w) * __builtin_amdgcn_rcpf(bfhi(b.w))};
                    acc[ai][bj][m][0] = acc[ai][bj][m][0] * r0; acc[ai][bj][m][1] = acc[ai][bj][m][1] * r1; }
                asm volatile("" ::: "memory"); }
    }
    __device__ __forceinline__ void operator()(const f32x4 (&acc)[2][2][4][2], const Unit& u, int wr, int wc, int fr, int fq) const {
        int row0 = u.pm * BM + wr * 64 + fr; const int col0 = u.pn * BM + wc * 32 + 8 * fq;
        asm volatile("" : "+v"(row0));
#pragma unroll
        for (int ai = 0; ai < 2; ++ai)
#pragma unroll
            for (int m = 0; m < 4; ++m) { const size_t o = (size_t)(row0 + ai * HALF + m * 16) * 1024 + col0;
#pragma unroll
                for (int bj = 0; bj < 2; ++bj) { const v4u g = *(const v4u*)(gb + o + bj * HALF);
                    f32x4 g0 = {bflo(g.x), bfhi(g.x), bflo(g.y), bfhi(g.y)}, g1 = {bflo(g.z), bfhi(g.z), bflo(g.w), bfhi(g.w)};
                    *(v4u*)(merged + o + bj * HALF) = pack8(g0 * acc[ai][bj][m][0], g1 * acc[ai][bj][m][1]); } }
    }
};
struct EpiProj {
    static constexpr bool PERM = true;
    unsigned char* ws;
    __device__ __forceinline__ void operator()(const f32x4 (&acc)[2][2][4][2], const Unit& u, int wr, int wc, int fr, int fq) const {
        const int row0 = u.pm * BM + wr * 64 + fr, cw = wc * 32 + 8 * fq, pn = u.pn;
        if (pn == 4) {
#pragma unroll
            for (int ai = 0; ai < 2; ++ai)
#pragma unroll
                for (int m = 0; m < 4; ++m) { const size_t row = (size_t)(row0 + ai * HALF + m * 16);
                    float* cr = (float*)(ws + WS_CKVRAW) + row * 128 + cw; *(f32x4*)cr = acc[ai][0][m][0]; *(f32x4*)(cr + 4) = acc[ai][0][m][1];
                    if (cw < 64) *(v4u*)((bf16*)(ws + WS_KIDX) + ((((row >> 4) * 8 + (cw >> 3)) * 16 + (row & 15)) << 3)) = pack8(acc[ai][1][m][0], acc[ai][1][m][1]);
                    else if (cw == 64) { float* wr_ = (float*)(ws + WS_WIDX) + row * 8; *(f32x4*)wr_ = acc[ai][1][m][0] * IDXW_SCALE; *(f32x4*)(wr_ + 4) = acc[ai][1][m][1] * IDXW_SCALE; } }
            return;
        }
        bf16* base; int ld, c0; float sc = 1.f; bool sg = false;
        if (pn < 4) { base = (bf16*)(ws + WS_QLAT); ld = 1024; c0 = pn * 256; sc = ATT_SCALE; }
        else if (pn < 7) { base = (bf16*)(ws + WS_QIDX); ld = 512; c0 = (pn - 5) * 256; }
        else if (pn < 9) { base = (bf16*)(ws + WS_QB); ld = 512; c0 = (pn - 7) * 256; sc = 0.125f; }
        else if (pn == 9) { base = (bf16*)(ws + WS_KB); ld = 128; c0 = 0; }
        else if (pn < 14) { base = (bf16*)(ws + WS_GA); ld = 1024; c0 = (pn - 10) * 256; sg = true; }
        else { base = (bf16*)(ws + WS_GB); ld = 1024; c0 = (pn - 14) * 256; sg = true; }
        const size_t bjstep = (pn == 9) ? (size_t)(WS_VB - WS_KB) / 2 : (size_t)HALF;
#pragma unroll
        for (int ai = 0; ai < 2; ++ai)
#pragma unroll
            for (int m = 0; m < 4; ++m) { bf16* rowp = base + (size_t)(row0 + ai * HALF + m * 16) * ld + c0 + cw;
#pragma unroll
                for (int bj = 0; bj < 2; ++bj) { f32x4 v0 = acc[ai][bj][m][0], v1 = acc[ai][bj][m][1];
                    if (sg) {
#pragma unroll
                        for (int j = 0; j < 4; ++j) { v0[j] = sigm(v0[j]); v1[j] = sigm(v1[j]); } }
                    else { v0 = v0 * sc; v1 = v1 * sc; }
                    *(v4u*)(rowp + bj * bjstep) = pack8(v0, v1); } }
    }
};
struct EpiWoutM {
    static constexpr bool PERM = true;
    const float* x; float* out;
    __device__ __forceinline__ void operator()(const f32x4 (&acc)[2][2][4][2], const Unit& u, int wr, int wc, int fr, int fq) const {
        const int row0 = u.pm * BM + wr * 64 + fr, col0 = u.pn * BM + wc * 32 + 8 * fq;
#pragma unroll
        for (int ai = 0; ai < 2; ++ai)
#pragma unroll
            for (int m = 0; m < 4; ++m) { const size_t o = (size_t)(row0 + ai * HALF + m * 16) * 1024 + col0;
#pragma unroll
                for (int bj = 0; bj < 2; ++bj) { const f32x4 x0 = *(const f32x4*)(x + o + bj * HALF), x1 = *(const f32x4*)(x + o + bj * HALF + 4);
                    *(f32x4*)(out + o + bj * HALF) = x0 * ALPHA + acc[ai][bj][m][0]; *(f32x4*)(out + o + bj * HALF + 4) = x1 * ALPHA + acc[ai][bj][m][1]; } }
    }
};
constexpr int MOE_TB_OFF = 131072 + 1024;
constexpr int CW_RDY = 16384;
constexpr int CW_TMO = 8;
struct MoeOrder {
    const LAS int* tb; int npn, G, c; unsigned* ctl;
    __device__ bool next(int i, Unit& u) const {
        const int L = i * G + c; if (L >= tb[32] * npn) return false;
        const int rt = L / npn, pn = L - rt * npn; int e = 0;
        for (int j = 1; j < 32; ++j) e = (tb[j] <= rt) ? j : e;
        u.pm = rt; u.pn = pn; u.pb = e * npn + pn; u.aux = e; return true;
    }
    __device__ __forceinline__ void a_ready(const Unit&) const {}
    __device__ __forceinline__ void done(const Unit& u) const {
        asm volatile("s_waitcnt vmcnt(0)" ::: "memory");
        if ((threadIdx.x & 63) == 0) __hip_atomic_fetch_add(ctl + CW_RDY + 64 * u.pm, 1u, __ATOMIC_RELAXED, __HIP_MEMORY_SCOPE_AGENT);
    }
};
struct MoeDownOrder {
    const LAS int* tb; int G, c; unsigned* ctl;
    __device__ bool next(int i, Unit& u) const {
        const int nT = tb[32], nD = 4 * nT; int R = 2 * nT - G; R = R < 0 ? 0 : (R > G ? G : R);
        int L;
        if (c >= R) { L = (i < 4) ? i * (G - R) + (c - R) : 4 * (G - R) + (i - 4) * G + c; }
        else { L = 4 * (G - R) + i * G + c; }
        if (L >= nD) return false;
        const int rt = L >> 2, pn = L & 3; int e = 0;
        for (int j = 1; j < 32; ++j) e = (tb[j] <= rt) ? j : e;
        u.pm = rt; u.pn = pn; u.pb = e * 4 + pn; u.aux = e; return true;
    }
    __device__ __forceinline__ void a_ready(const Unit& u) const {
        if (threadIdx.x < 64) {
            unsigned* w = ctl + CW_RDY + 64 * u.pm; unsigned sp = 0;
            while ((unsigned)__builtin_amdgcn_readfirstlane(__hip_atomic_load(w, __ATOMIC_RELAXED, __HIP_MEMORY_SCOPE_AGENT)) < 16u) {
                __builtin_amdgcn_s_sleep(2);
                if ((++sp & 1023u) == 0u) { if (__hip_atomic_load(ctl + CW_TMO, __ATOMIC_RELAXED, __HIP_MEMORY_SCOPE_AGENT) != 0u) break;
                    if (sp > (1u << 22)) { __hip_atomic_store(ctl + CW_TMO, 1u, __ATOMIC_RELAXED, __HIP_MEMORY_SCOPE_AGENT); break; } } }
            __builtin_amdgcn_fence(__ATOMIC_ACQUIRE, "agent");
            asm volatile("s_waitcnt vmcnt(0)" ::: "memory");
        }
        asm volatile("" ::: "memory"); __builtin_amdgcn_s_barrier(); asm volatile("" ::: "memory");
    }
    __device__ __forceinline__ void done(const Unit&) const {}
};
struct GatherProb {
    static constexpr bool GATHER = true;
    const bf16* A; const bf16* Bt; int K; const LAS int* tb; const unsigned* list;
    __device__ __forceinline__ const char* a_base(const Unit&) const { return (const char*)A; }
    __device__ __forceinline__ const char* b_base(const Unit& u) const { return (const char*)Bt + (size_t)u.pb * 256 * K * 2; }
    __device__ __forceinline__ void a_offs(const Unit& u, int R0, int C0, int R1, int C1, unsigned (&o)[2][2]) const {
        const int e = u.aux, lbase = (u.pm - tb[e]) * 256, cnt = tb[64 + e];
        const unsigned* le = list + (size_t)e * 32768;
#pragma unroll
        for (int h = 0; h < 2; ++h) { const int l0 = lbase + h * HALF + R0, l1 = lbase + h * HALF + R1;
            const unsigned t0 = l0 < cnt ? (le[l0] >> 1) : 0u, t1 = l1 < cnt ? (le[l1] >> 1) : 0u;
            o[h][0] = (t0 * (unsigned)K + (unsigned)C0) * 2u; o[h][1] = (t1 * (unsigned)K + (unsigned)C1) * 2u; }
    }
};
struct EpiGU {
    static constexpr bool PERM = true;
    bf16* hbuf;
    __device__ __forceinline__ void operator()(const f32x4 (&acc)[2][2][4][2], const Unit& u, int wr, int wc, int fr, int fq) const {
        const int row0 = u.pm * BM + wr * 64 + fr, col0 = u.pn * HALF + wc * 32 + 8 * fq;
#pragma unroll
        for (int ai = 0; ai < 2; ++ai)
#pragma unroll
            for (int m = 0; m < 4; ++m) { f32x4 h0, h1;
#pragma unroll
                for (int j = 0; j < 4; ++j) { const float g0 = acc[ai][0][m][0][j], g1 = acc[ai][0][m][1][j];
                    h0[j] = g0 * sigm(g0) * acc[ai][1][m][0][j]; h1[j] = g1 * sigm(g1) * acc[ai][1][m][1][j]; }
                { const v4u hv = pack8(h0, h1); bf16* hp = hbuf + (size_t)(row0 + ai * HALF + m * 16) * 256 + col0;
                  asm volatile("global_store_dwordx4 %0, %1, off sc1\n\ts_nop 1" :: "v"(hp), "v"(hv) : "memory"); } }
    }
};
struct EpiDown {
    static constexpr bool PERM = true;
    bf16* slot; const LAS int* tb; const unsigned* list; const float* pw;
    __device__ __forceinline__ void operator()(const f32x4 (&acc)[2][2][4][2], const Unit& u, int wr, int wc, int fr, int fq) const {
        const int e = u.aux, lbase = (u.pm - tb[e]) * 256 + wr * 64 + fr, cnt = tb[64 + e], col0 = u.pn * BM + wc * 32 + 8 * fq;
        const unsigned* le = list + (size_t)e * 32768;
#pragma unroll
        for (int ai = 0; ai < 2; ++ai)
#pragma unroll
            for (int m = 0; m < 4; ++m) { const int l = lbase + ai * HALF + m * 16;
                if (l < cnt) { const unsigned pair = le[l]; const float w = pw[pair]; bf16* rowp = slot + (size_t)pair * 1024 + col0;
#pragma unroll
                    for (int bj = 0; bj < 2; ++bj) *(v4u*)(rowp + bj * HALF) = pack8(acc[ai][bj][m][0] * w, acc[ai][bj][m][1] * w); } }
    }
};
}

struct Args { const float* in[20]; float* out; unsigned char* ws; int ph_lo, ph_hi; };
__global__ void __launch_bounds__(NTHR, 2) fwd_kernel(Args args) {
    extern __shared__ __attribute__((aligned(16))) unsigned char lds_raw[];
    Ctx c;
    c.lds = (LAS unsigned char*)lds_raw;
    c.tid = threadIdx.x; c.lane = c.tid & 63; c.wave = __builtin_amdgcn_readfirstlane(c.tid >> 6); c.bid = blockIdx.x; c.G = gridDim.x;
    c.x = args.in[0]; c.w_in = args.in[1]; c.kv_g = args.in[2]; c.w_uv = args.in[3]; c.w_a = args.in[4]; c.sinks = args.in[5]; c.w_b = args.in[6]; c.w_out = args.in[7]; c.rel_bias = args.in[8];
    c.ln1_g = args.in[9]; c.ln1_b = args.in[10]; c.w_group = args.in[11]; c.b_group = args.in[12]; c.w_router = args.in[13]; c.b_router = args.in[14]; c.w_gate = args.in[15]; c.w_up = args.in[16]; c.w_down = args.in[17];
    c.ln2_g = args.in[18]; c.ln2_b = args.in[19]; c.out = args.out; c.ws = args.ws; unsigned char* ws = args.ws;
    c.ctl = (unsigned*)(ws + WS_CTL);
    volatile LAS unsigned* MISC = (volatile LAS unsigned*)(c.lds + MISC_OFF);
    if (c.tid < 32) MISC[c.tid] = 0u;
    __syncthreads();
    XcdBarrier bar; bar.bar = c.ctl + CW_BAR; bar.x = 0; bar.st = nullptr;
    if (MK_N_LAUNCHES == 1) bar = xcd_barrier_post(c.ctl + CW_BAR, MISC + 8);
    const int lo = args.ph_lo, hi = args.ph_hi;
#define IN(k) (lo <= (k) && (k) < hi)
#define SEAM(k) do { if (IN(k) && IN((k) + 1)) xcd_barrier(bar); } while (0)
    bf16* merged = ((bf16*)(c.ws + WS_QLAT)); bf16* x1b = ((bf16*)(c.ws + WS_XB));

    if (IN(0)) { p0_prologue(c); } SEAM(0);
    if (IN(1)) { pg8::DenseProb P{(const bf16*)(c.ws + WS_XB), (const bf16*)(c.ws + WS_WIN), 1024}; pg8::StaticOrder S; S.init(NTOK, NPROJ, c.G, c.bid); pg8::EpiProj E{c.ws};
        pg8::gemm_phase(c.lds, P, S, E); } SEAM(1);
    if (IN(2)) { p_rmsnorm(c); __syncthreads(); p2_indexer_topk(c); } SEAM(2);
    if (IN(3)) { p3a_dsa(c); p3b_swa(c); } SEAM(3);
    if (IN(4)) { pg8::StaticOrder S; S.init(NTOK, 1024, c.G, c.bid); pg8::EpiMergedDual E{(const bf16*)(c.ws + WS_GA), (const bf16*)(c.ws + WS_GB), merged};
        pg8::gemm_phase_dual(c.lds, (const bf16*)(c.ws + WS_XB), (const bf16*)(c.ws + WS_WC), 1024, (const bf16*)(c.ws + WS_QB), (const bf16*)(c.ws + WS_WB), 512, S, E); } SEAM(4);
    if (IN(5)) { pg8::DenseProb P{(const bf16*)merged, (const bf16*)(c.ws + WS_WO), 1024}; pg8::StaticOrder S; S.init(NTOK, 1024, c.G, c.bid); pg8::EpiWoutM E{c.x, c.out};
        pg8::gemm_phase(c.lds, P, S, E); } SEAM(5);
    if (IN(6)) { p6_ln_router(c, x1b); } SEAM(6);
    LAS int* tb = (LAS int*)(c.lds + pg8::MOE_TB_OFF);
    if (IN(7) || IN(8)) {
        if (c.tid < 32) tb[64 + c.tid] = (int)__hip_atomic_load(c.ctl + CW_CNT + c.tid, __ATOMIC_RELAXED, __HIP_MEMORY_SCOPE_AGENT);
        __syncthreads();
        if (c.tid == 0) { int a = 0; for (int e = 0; e < 32; ++e) { tb[e] = a; a += (tb[64 + e] + 255) >> 8; } tb[32] = a; }
        __syncthreads();
    }
    if (IN(7)) { pg8::GatherProb P{(const bf16*)x1b, (const bf16*)(c.ws + WS_WGU), 1024, tb, (const unsigned*)(c.ws + WS_LIST)}; pg8::MoeOrder S{tb, 2, c.G, c.bid, c.ctl}; pg8::EpiGU E{(bf16*)(c.ws + WS_QLAT)};
        pg8::gemm_phase(c.lds, P, S, E); }
    if (MK_N_LAUNCHES != 1) SEAM(7);
    if (IN(8)) { pg8::DenseProb P{(const bf16*)(c.ws + WS_QLAT), (const bf16*)(c.ws + WS_WD), 256}; pg8::MoeDownOrder S{tb, c.G, c.bid, c.ctl};
        pg8::EpiDown E{(bf16*)(c.ws + WS_SLOT), tb, (const unsigned*)(c.ws + WS_LIST), (const float*)(c.ws + WS_PW)};
        pg8::gemm_phase(c.lds, P, S, E); } SEAM(8);
    if (IN(9)) { p9_ln2(c); }
#undef IN
#undef SEAM
}

extern "C" void kernel_launch(void* const* d_in, const int* in_sizes, int n_in, void* d_out, int out_size, void* d_ws, size_t ws_size, hipStream_t stream) {
    static int grid = 0;
    if (grid == 0) {
        if (n_in != 20 || out_size != NTOK * D || ws_size < WS_END) { fprintf(stderr, "kernel_launch: unexpected shapes (n_in %d out %d ws %zu)\n", n_in, out_size, ws_size); grid = -1; return; }
        int dev = 0, cus = 0, per_cu = 0;
        if (hipGetDevice(&dev) != hipSuccess || hipDeviceGetAttribute(&cus, hipDeviceAttributeMultiprocessorCount, dev) != hipSuccess) { grid = -1; return; }
        if (hipFuncSetAttribute((const void*)fwd_kernel, hipFuncAttributeMaxDynamicSharedMemorySize, LDS_BYTES) != hipSuccess) { fprintf(stderr, "kernel_launch: hipFuncSetAttribute failed\n"); grid = -1; return; }
        if (hipOccupancyMaxActiveBlocksPerMultiprocessor(&per_cu, (const void*)fwd_kernel, NTHR, LDS_BYTES) != hipSuccess || per_cu < 1) { fprintf(stderr, "kernel_launch: occupancy query says %d\n", per_cu); }
        (void)hipGetLastError();
        grid = cus;
    }
    if (grid < 0) return;
    if (hipMemsetAsync((char*)d_ws + WS_CTL, 0, CTL_ZERO_BYTES, stream) != hipSuccess) return;
    Args a{};
    for (int i = 0; i < 20; ++i) a.in[i] = (const float*)d_in[i];
    a.out = (float*)d_out; a.ws = (unsigned char*)d_ws;
    if (MK_N_LAUNCHES == 1) { a.ph_lo = 0; a.ph_hi = NPHASE; hipLaunchKernelGGL(fwd_kernel, dim3(grid), dim3(NTHR), LDS_BYTES, stream, a); }
    else { for (int p = 0; p < NPHASE; ++p) { a.ph_lo = p; a.ph_hi = p + 1; hipLaunchKernelGGL(fwd_kernel, dim3(grid), dim3(NTHR), LDS_BYTES, stream, a); } }
}
```

```cpp
#include <hip/hip_runtime.h>
#include <cstdio>
#include <cstdint>

#ifndef MK_N_LAUNCHES
#define MK_N_LAUNCHES 1
#endif

constexpr int D = 1024, BATCH = 8, SEQ = 2048, NTOK = BATCH * SEQ;
constexpr int A_HEADS = 8, A_LAT = 128, IDX_HEADS = 8, IDX_DIM = 64, KSEL = 256;
constexpr int B_HEADS = 8, B_HD = 64, WINDOW = 128;
constexpr int NEXP = 32, EPG = 8, NGRP = 4, DEXP = 256;
constexpr int IN_WIDTH = 4552, NPROJ = 4608;
constexpr float ALPHA = 1.189207115002721f;
constexpr float LN_EPS = 1e-5f, RMS_EPS = 1e-6f;
constexpr float ATT_SCALE = 0.08838834764831845f;
constexpr float IDXW_SCALE = 0.125f * 0.35355339059327373f;
constexpr int NPHASE = 10;

constexpr size_t MiB = 1u << 20;
constexpr size_t WS_CTL = 0, CTL_ZERO_BYTES = 128 * 1024;
constexpr size_t WS_WIN = 1 * MiB;
constexpr size_t WS_SEL = 1 * MiB;
constexpr size_t WS_WC = 10 * MiB;
constexpr size_t WS_WB = 12 * MiB;
constexpr size_t WS_WO = 13 * MiB;
constexpr size_t WS_WIDX = 15 * MiB;
constexpr size_t WS_BIAS = 16 * MiB;
constexpr size_t WS_PE = 16 * MiB + 64 * 1024;
constexpr size_t WS_PW = 16 * MiB + 256 * 1024;
constexpr size_t WS_WGU = 17 * MiB;
constexpr size_t WS_WD = 49 * MiB;
constexpr size_t WS_XB = 65 * MiB;
constexpr size_t WS_QLAT = 97 * MiB;
constexpr size_t WS_CKV = 129 * MiB;
constexpr size_t WS_KIDX = 133 * MiB;
constexpr size_t WS_QIDX = 135 * MiB;
constexpr size_t WS_QB = 151 * MiB;
constexpr size_t WS_KB = 167 * MiB;
constexpr size_t WS_VB = 171 * MiB;
constexpr size_t WS_GA = 175 * MiB;
constexpr size_t WS_GB = 207 * MiB;
constexpr size_t WS_CKVRAW = 239 * MiB;
constexpr size_t WS_LIST = 247 * MiB;
constexpr size_t WS_SLOT = 129 * MiB;
constexpr size_t WS_END = 252 * MiB;
constexpr int CW_CNT = 64;
constexpr int CW_BAR = 4096;

constexpr int NWAVES = 8, NTHR = 512;
constexpr int LDS_BYTES = 155648;
constexpr int MISC_OFF = 131072 + 320;

#define GAS __attribute__((address_space(1)))
#define LAS __attribute__((address_space(3)))
typedef unsigned short bf16;
typedef unsigned v4u __attribute__((ext_vector_type(4)));
typedef unsigned v2u __attribute__((ext_vector_type(2)));
typedef float f32x4 __attribute__((ext_vector_type(4)));

__device__ __forceinline__ float bf2f(unsigned v) { return __builtin_bit_cast(float, v << 16); }
__device__ __forceinline__ float bflo(unsigned v) { return __builtin_bit_cast(float, v << 16); }
__device__ __forceinline__ float bfhi(unsigned v) { return __builtin_bit_cast(float, v & 0xffff0000u); }
__device__ __forceinline__ unsigned f2bf(float f) { unsigned u = __builtin_bit_cast(unsigned, f); return (u + 0x7fffu + ((u >> 16) & 1u)) >> 16; }
__device__ __forceinline__ unsigned cvt_pk(float lo, float hi) { unsigned r; asm volatile("v_cvt_pk_bf16_f32 %0, %1, %2" : "=v"(r) : "v"(lo), "v"(hi)); return r; }
__device__ __forceinline__ unsigned pk2(float lo, float hi) { return f2bf(lo) | (f2bf(hi) << 16); }
__device__ __forceinline__ float wave_sum(float v) {
#pragma unroll
    for (int o = 1; o < 64; o <<= 1) v += __shfl_xor(v, o);
    return v;
}
__device__ __forceinline__ float wave_max(float v) {
#pragma unroll
    for (int o = 1; o < 64; o <<= 1) v = fmaxf(v, __shfl_xor(v, o));
    return v;
}

typedef unsigned u2v __attribute__((ext_vector_type(2)));
#define DPP_I(v, ctrl) __builtin_amdgcn_update_dpp(0, (v), (ctrl), 0xf, 0xf, true)
#define DPP_F(v, ctrl) __builtin_bit_cast(float, __builtin_amdgcn_update_dpp(0, __builtin_bit_cast(int, (v)), (ctrl), 0xf, 0xf, true))
__device__ __forceinline__ void swap16(unsigned a, unsigned& x, unsigned& y) { auto r = __builtin_amdgcn_permlane16_swap(a, a, false, false); x = r[0]; y = r[1]; }
__device__ __forceinline__ void swap32(unsigned a, unsigned& x, unsigned& y) { auto r = __builtin_amdgcn_permlane32_swap(a, a, false, false); x = r[0]; y = r[1]; }
__device__ __forceinline__ float x16_sum(float v) { unsigned x, y; swap16(__builtin_bit_cast(unsigned, v), x, y); return __builtin_bit_cast(float, x) + __builtin_bit_cast(float, y); }
__device__ __forceinline__ float x16_max(float v) { unsigned x, y; swap16(__builtin_bit_cast(unsigned, v), x, y); return fmaxf(__builtin_bit_cast(float, x), __builtin_bit_cast(float, y)); }
__device__ __forceinline__ float x16_min(float v) { unsigned x, y; swap16(__builtin_bit_cast(unsigned, v), x, y); return fminf(__builtin_bit_cast(float, x), __builtin_bit_cast(float, y)); }
__device__ __forceinline__ int x16_sumi(int v) { unsigned x, y; swap16((unsigned)v, x, y); return (int)(x + y); }
__device__ __forceinline__ float x32_sum(float v) { unsigned x, y; swap32(__builtin_bit_cast(unsigned, v), x, y); return __builtin_bit_cast(float, x) + __builtin_bit_cast(float, y); }
__device__ __forceinline__ float x32_max(float v) { unsigned x, y; swap32(__builtin_bit_cast(unsigned, v), x, y); return fmaxf(__builtin_bit_cast(float, x), __builtin_bit_cast(float, y)); }

#define XB_TMO      128
#define XB_XCNT(j)  (256  + 64 * (j))
#define XB_XSUB(j)  (1280 + 64 * (j))
#define XB_XGEN(j)  (2304 + 64 * (j))
#define XB_TOP      3328
#define XB_TOPGEN   3392
#define XCD_BAR_WORDS 3456
#define XB_SPIN_CAP (1u << 22)

__device__ __forceinline__ unsigned xb_ld(unsigned* p)              { return __hip_atomic_load(p, __ATOMIC_RELAXED, __HIP_MEMORY_SCOPE_AGENT); }
__device__ __forceinline__ unsigned xb_add(unsigned* p, unsigned v) { return __hip_atomic_fetch_add(p, v, __ATOMIC_RELAXED, __HIP_MEMORY_SCOPE_AGENT); }
__device__ __forceinline__ unsigned xb_xcc_id() { return (unsigned)__builtin_amdgcn_s_getreg((3 << 11) | 20) & 0xFu; }
#define XB_SPIN(cond, bar) do { unsigned _sp = 0; while (cond) { __builtin_amdgcn_s_sleep(1); \
    if ((++_sp & 255u) == 0u) { if (xb_ld(&(bar)[XB_TMO])) break; if (_sp > XB_SPIN_CAP) { atomicAdd(&(bar)[XB_TMO], 1u); break; } } } } while (0)

struct XcdBarrier { unsigned* bar; unsigned x; volatile LAS unsigned* st; };

__device__ __forceinline__ XcdBarrier xcd_barrier_post(unsigned* bar, volatile LAS unsigned* st) {
    XcdBarrier b; b.bar = bar; b.x = xb_xcc_id(); b.st = st;
    if (threadIdx.x == 0) (void)xb_add(&bar[XB_XCNT(b.x)], 1u);
    return b;
}
__device__ __forceinline__ void xcd_barrier_complete(unsigned* bar, unsigned x, unsigned& nloc, unsigned& nx) {
    const unsigned G = gridDim.x * gridDim.y * gridDim.z;
    unsigned sum, cnt, mine, sp = 0u;
    for (;;) {
        sum = 0u; cnt = 0u; mine = 0u;
#pragma unroll
        for (unsigned j = 0; j < 16; ++j) { const unsigned c = xb_ld(&bar[XB_XCNT(j)]); sum += c; cnt += (c > 0u) ? 1u : 0u; mine = (j == x) ? c : mine; }
        if (sum == G) break;
        __builtin_amdgcn_s_sleep(1);
        if ((++sp & 255u) == 0u) { if (xb_ld(&bar[XB_TMO])) break; if (sp > XB_SPIN_CAP) { atomicAdd(&bar[XB_TMO], 1u); break; } }
    }
    nloc = mine > 0u ? mine : 1u; nx = cnt > 0u ? cnt : 1u;
}
__device__ __forceinline__ void xcd_barrier(const XcdBarrier& b) {
    asm volatile("s_waitcnt vmcnt(0)" ::: "memory");
    __syncthreads();
    if (threadIdx.x == 0) {
        unsigned* bar = b.bar;
        __builtin_amdgcn_s_waitcnt(0);
        unsigned nloc = b.st[0], nx = b.st[1];
        if (nloc == 0u) { xcd_barrier_complete(bar, b.x, nloc, nx); b.st[0] = nloc; b.st[1] = nx; }
        const unsigned old = xb_add(&bar[XB_XSUB(b.x)], 1u);
        const unsigned gen = old / nloc;
        if (old + 1u == (gen + 1u) * nloc) {
            __builtin_amdgcn_fence(__ATOMIC_RELEASE, "agent");
            asm volatile("s_waitcnt vmcnt(0)" ::: "memory");
            const unsigned og = xb_add(&bar[XB_TOP], 1u);
            const unsigned tg = og / nx;
            if (og + 1u == (tg + 1u) * nx) xb_add(&bar[XB_TOPGEN], 1u);
            else XB_SPIN(xb_ld(&bar[XB_TOPGEN]) == tg, bar);
            __builtin_amdgcn_fence(__ATOMIC_ACQUIRE, "agent");
            xb_add(&bar[XB_XGEN(b.x)], 1u);
            asm volatile("s_waitcnt vmcnt(0)" ::: "memory");
        } else {
            XB_SPIN(xb_ld(&bar[XB_XGEN(b.x)]) == gen, bar);
            __builtin_amdgcn_fence(__ATOMIC_ACQUIRE, "agent");
            asm volatile("s_waitcnt vmcnt(0)" ::: "memory");
        }
    }
    __syncthreads();
}

struct Ctx {
    const float *x, *w_in, *kv_g, *w_uv, *w_a, *sinks, *w_b, *w_out, *rel_bias, *ln1_g, *ln1_b, *w_group, *b_group, *w_router, *b_router, *w_gate, *w_up, *w_down, *ln2_g, *ln2_b;
    float* out;
    unsigned char* ws;
    unsigned* ctl;
    __device__ __forceinline__ bf16* P(size_t off) const { return (bf16*)(ws + off); }
    LAS unsigned char* lds;
    int tid, lane, wave, bid, G;
};

__device__ __forceinline__ int proj_src_col(int j) {
    if (j < 1024) return j;
    if (j < 1152) return j;
    if (j < 1216) return 1664 + (j - 1152);
    if (j < 1224) return 1728 + (j - 1216);
    if (j < 1280) return -1;
    if (j < 1792) return 1152 + (j - 1280);
    if (j < 2304) return 1736 + (j - 1792);
    if (j < 2432) return 2248 + (j - 2304);
    if (j < 2560) return 2376 + (j - 2432);
    if (j < 3584) return 2504 + (j - 2560);
    return 3528 + (j - 3584);
}
__device__ __forceinline__ float sigmoidf_(float v) { return 1.0f / (1.0f + __expf(-v)); }

template <class Src> __device__ __forceinline__ void titem_load(const Ctx& c, const Src& src, int k0, int n0, f32x4 (&tv)[8]) {
    const int kr = c.lane >> 3, n4 = (c.lane & 7) * 4;
#pragma unroll
    for (int i = 0; i < 8; ++i) tv[i] = src.v4(k0 + 8 * i + kr, n0 + n4);
}
__device__ __forceinline__ void titem_finish(const Ctx& c, LAS float* scr, const f32x4 (&tv)[8], bf16* dst, int dstK, int k0, int n0) {
    const int lane = c.lane, kr = lane >> 3, n4 = (lane & 7) * 4;
#pragma unroll
    for (int i = 0; i < 8; ++i) { LAS float* d = scr + (8 * i + kr) * 33 + n4; d[0] = tv[i].x; d[1] = tv[i].y; d[2] = tv[i].z; d[3] = tv[i].w; }
    asm volatile("s_waitcnt lgkmcnt(0)" ::: "memory");
    const int cc = lane & 7;
#pragma unroll
    for (int j = 0; j < 4; ++j) { const int n = (lane >> 3) + 8 * j; const LAS float* q = scr + (8 * cc) * 33 + n;
        v4u o; o.x = pk2(q[0 * 33], q[1 * 33]); o.y = pk2(q[2 * 33], q[3 * 33]); o.z = pk2(q[4 * 33], q[5 * 33]); o.w = pk2(q[6 * 33], q[7 * 33]);
        *(v4u*)(dst + (size_t)(n0 + n) * dstK + k0 + 8 * cc) = o; }
    asm volatile("s_waitcnt lgkmcnt(0)" ::: "memory");
}
template <class Src> __device__ __forceinline__ void transpose_item(const Ctx& c, LAS float* scr, const Src& src, bf16* dst, int dstK, int k0, int n0) {
    f32x4 tv[8]; titem_load(c, src, k0, n0, tv); titem_finish(c, scr, tv, dst, dstK, k0, n0);
}
struct SrcWin { const float* w; __device__ __forceinline__ f32x4 v4(int k, int n) const { const int s = proj_src_col(n); return s < 0 ? (f32x4){0.f, 0.f, 0.f, 0.f} : *(const f32x4*)(w + (size_t)k * IN_WIDTH + s); } };
struct SrcPlain { const float* w; int N; __device__ __forceinline__ f32x4 v4(int k, int n) const { return *(const f32x4*)(w + (size_t)k * N + n); } };
struct SrcShift { const float* w; int N; int shift; __device__ __forceinline__ f32x4 v4(int k, int n) const { return *(const f32x4*)(w + (size_t)k * N + n + shift); } };

__device__ __forceinline__ float t5_bias_bucket(int dist) {
    if (dist < 16) return (float)dist;
    int b = 16 + (int)(logf((float)dist / 16.0f) / logf(8.0f) * 16.0f);
    return (float)(b < 31 ? b : 31);
}
constexpr int P0_EXPERT_ITEMS = 32 * 256 + 32 * 128;
__device__ __forceinline__ void p0_expert_item(const Ctx& c, LAS float* scr, int r) {
    constexpr int I_GU = 32 * 256;
    if (r < I_GU) { const int e = r / 256, q = r % 256, n0 = (q / 16) * 32, half = (n0 >> 7) & 1, col0 = (n0 >> 8) * 128 + (n0 & 127);
        if (half) { SrcShift s_{c.w_up + (size_t)e * 1024 * 256, DEXP, col0 - n0}; transpose_item(c, scr, s_, (bf16*)(c.ws + WS_WGU) + (size_t)e * 512 * 1024, 1024, (q % 16) * 64, n0); }
        else { SrcShift s_{c.w_gate + (size_t)e * 1024 * 256, DEXP, col0 - n0}; transpose_item(c, scr, s_, (bf16*)(c.ws + WS_WGU) + (size_t)e * 512 * 1024, 1024, (q % 16) * 64, n0); }
        return; }
    r -= I_GU;
    { const int e = r / 128, q = r % 128; SrcPlain s_{c.w_down + (size_t)e * 256 * 1024, 1024};
        transpose_item(c, scr, s_, (bf16*)(c.ws + WS_WD) + (size_t)e * 1024 * 256, 256, (q % 4) * 64, (q / 4) * 32); }
}
__device__ __forceinline__ void ex_item_load(const Ctx& c, int r, f32x4 (&tv)[8]) {
    constexpr int I_GU = 32 * 256;
    if (r < I_GU) { const int e = r / 256, q = r % 256, n0 = (q / 16) * 32, half = (n0 >> 7) & 1, col0 = (n0 >> 8) * 128 + (n0 & 127);
        if (half) { SrcShift s_{c.w_up + (size_t)e * 1024 * 256, DEXP, col0 - n0}; titem_load(c, s_, (q % 16) * 64, n0, tv); }
        else { SrcShift s_{c.w_gate + (size_t)e * 1024 * 256, DEXP, col0 - n0}; titem_load(c, s_, (q % 16) * 64, n0, tv); } }
    else { r -= I_GU; const int e = r / 128, q = r % 128; SrcPlain s_{c.w_down + (size_t)e * 256 * 1024, 1024}; titem_load(c, s_, (q % 4) * 64, (q / 4) * 32, tv); }
}
__device__ __forceinline__ void ex_item_finish(const Ctx& c, LAS float* scr, int r, const f32x4 (&tv)[8]) {
    constexpr int I_GU = 32 * 256;
    if (r < I_GU) { const int e = r / 256, q = r % 256; titem_finish(c, scr, tv, (bf16*)(c.ws + WS_WGU) + (size_t)e * 512 * 1024, 1024, (q % 16) * 64, (q / 16) * 32); }
    else { r -= I_GU; const int e = r / 128, q = r % 128; titem_finish(c, scr, tv, (bf16*)(c.ws + WS_WD) + (size_t)e * 1024 * 256, 256, (q % 4) * 64, (q / 4) * 32); }
}
constexpr size_t WS_WRT = 16 * MiB + 512 * 1024;
__device__ __forceinline__ void p0_prologue(const Ctx& c) {
    { const size_t n8 = (size_t)NTOK * D / 8; const f32x4* xs = (const f32x4*)c.x; v4u* xd = (v4u*)((bf16*)(c.ws + WS_XB));
      const size_t st = (size_t)c.G * NTHR;
      size_t i = (size_t)c.bid * NTHR + c.tid;
      for (; i + 3 * st < n8; i += 4 * st) { f32x4 a[4], b[4];
#pragma unroll
          for (int u = 0; u < 4; ++u) { a[u] = xs[2 * (i + u * st)]; b[u] = xs[2 * (i + u * st) + 1]; }
#pragma unroll
          for (int u = 0; u < 4; ++u) { v4u o; o.x = pk2(a[u].x, a[u].y); o.y = pk2(a[u].z, a[u].w); o.z = pk2(b[u].x, b[u].y); o.w = pk2(b[u].z, b[u].w); xd[i + u * st] = o; } }
      for (; i < n8; i += st) { const f32x4 a = xs[2 * i], b = xs[2 * i + 1]; v4u o; o.x = pk2(a.x, a.y); o.y = pk2(a.z, a.w); o.z = pk2(b.x, b.y); o.w = pk2(b.z, b.w); xd[i] = o; } }
    { LAS float* scr = (LAS float*)(c.lds + c.wave * 8704);
      constexpr int I_WIN = 16 * 144, I_WB = 8 * 32, I_WO = 16 * 32, I_ALL = I_WIN + I_WB + I_WO;
      for (int it = c.bid * NWAVES + c.wave; it < I_ALL; it += c.G * NWAVES) {
        int r = it;
        if (r < I_WIN) { SrcWin s_{c.w_in}; transpose_item(c, scr, s_, (bf16*)(c.ws + WS_WIN), 1024, (r % 16) * 64, (r / 16) * 32); continue; } r -= I_WIN;
        if (r < I_WB) { SrcPlain s_{c.w_b, 1024}; transpose_item(c, scr, s_, (bf16*)(c.ws + WS_WB), 512, (r % 8) * 64, (r / 8) * 32); continue; } r -= I_WB;
        { SrcPlain s_{c.w_out, 1024}; transpose_item(c, scr, s_, (bf16*)(c.ws + WS_WO), 1024, (r % 16) * 64, (r / 16) * 32); }
      } }
    __syncthreads();
    { LAS float* tile = (LAS float*)c.lds; LAS float* Us = tile + 64 * 65; LAS float* As = Us + 64 * 65;
      for (int tI = c.bid; tI < 256; tI += c.G) { const int k0 = (tI & 15) * 64, n0 = (tI >> 4) * 64, h = k0 >> 7;
        const int r = c.tid >> 6, cc = c.tid & 63;
#pragma unroll
        for (int pI = 0; pI < 8; ++pI) { const int kk = pI * 8 + r; Us[kk * 65 + cc] = c.w_uv[(size_t)(k0 + kk) * 64 + cc]; As[kk * 65 + cc] = c.w_a[(size_t)(h * 64 + kk) * 1024 + n0 + cc]; }
        __syncthreads();
#pragma unroll
        for (int pI = 0; pI < 8; ++pI) { const int kk = pI * 8 + r; float a = 0.f;
#pragma unroll 16
            for (int d = 0; d < 64; ++d) a += Us[kk * 65 + d] * As[d * 65 + cc];
            tile[kk * 65 + cc] = a; }
        __syncthreads();
        const int nl = c.tid >> 3, kc = c.tid & 7; v4u o;
        o.x = pk2(tile[(8 * kc + 0) * 65 + nl], tile[(8 * kc + 1) * 65 + nl]); o.y = pk2(tile[(8 * kc + 2) * 65 + nl], tile[(8 * kc + 3) * 65 + nl]);
        o.z = pk2(tile[(8 * kc + 4) * 65 + nl], tile[(8 * kc + 5) * 65 + nl]); o.w = pk2(tile[(8 * kc + 6) * 65 + nl], tile[(8 * kc + 7) * 65 + nl]);
        *(v4u*)((bf16*)(c.ws + WS_WC) + (size_t)(n0 + nl) * 1024 + k0 + 8 * kc) = o;
        __syncthreads(); } }
    for (int i = c.bid * NTHR + c.tid; i < 48 * 1024; i += c.G * NTHR) { const int o = i >> 10, k = i & 1023;
        const float v = o < 32 ? c.w_router[(size_t)k * 32 + o] : (o < 36 ? c.w_group[(size_t)k * 4 + (o - 32)] : 0.f);
        const unsigned hi = f2bf(v); const float rem = v - bf2f(hi);
        ((bf16*)(c.ws + WS_WRT))[i] = (bf16)hi; ((bf16*)(c.ws + WS_WRT))[48 * 1024 + i] = (bf16)f2bf(rem); }
    if (c.bid == 0) { for (int i = c.tid; i < 129 * 8; i += NTHR) { const int d = i >> 3, h = i & 7; const int b = (int)t5_bias_bucket(d);
            ((float*)(c.ws + WS_BIAS))[i] = c.rel_bias[b * 16 + h]; ((float*)(c.ws + WS_BIAS) + 129 * 8)[i] = c.rel_bias[b * 16 + 8 + h]; } }
}


__device__ __forceinline__ void p_rmsnorm(const Ctx& c) {
    const int gw = c.bid * NWAVES + c.wave, NGW = c.G * NWAVES, l15 = c.lane & 15, g4 = c.lane >> 4;
    const f32x4 g0 = *(const f32x4*)(c.kv_g + 8 * l15), g1 = *(const f32x4*)(c.kv_g + 8 * l15 + 4);
    for (int r = 4 * gw + g4; r < NTOK; r += 4 * NGW) {
        const float* src = (const float*)(c.ws + WS_CKVRAW) + (size_t)r * 128 + 8 * l15;
        const f32x4 a = *(const f32x4*)src, b = *(const f32x4*)(src + 4);
        float ss = (a.x * a.x + a.y * a.y) + (a.z * a.z + a.w * a.w) + (b.x * b.x + b.y * b.y) + (b.z * b.z + b.w * b.w);
        ss += DPP_F(ss, 0xB1); ss += DPP_F(ss, 0x4E); ss += DPP_F(ss, 0x141); ss += DPP_F(ss, 0x140);
        const float rs = 1.0f / sqrtf(ss * (1.0f / 128.0f) + RMS_EPS);
        v4u o; o.x = pk2(a.x * rs * g0.x, a.y * rs * g0.y); o.y = pk2(a.z * rs * g0.z, a.w * rs * g0.w); o.z = pk2(b.x * rs * g1.x, b.y * rs * g1.y); o.w = pk2(b.z * rs * g1.z, b.w * rs * g1.w);
        *(v4u*)((bf16*)(c.ws + WS_CKV) + (size_t)r * 128 + 8 * l15) = o;
    }
}


typedef float f32x16 __attribute__((ext_vector_type(16)));
typedef short s16x8 __attribute__((ext_vector_type(8)));
__device__ __forceinline__ float half_min(float v) {
    v = fminf(v, DPP_F(v, 0xB1)); v = fminf(v, DPP_F(v, 0x4E)); v = fminf(v, DPP_F(v, 0x141)); v = fminf(v, DPP_F(v, 0x140)); return x16_min(v); }
__device__ __forceinline__ float half_max(float v) {
    v = fmaxf(v, DPP_F(v, 0xB1)); v = fmaxf(v, DPP_F(v, 0x4E)); v = fmaxf(v, DPP_F(v, 0x141)); v = fmaxf(v, DPP_F(v, 0x140)); return x16_max(v); }
__device__ __forceinline__ int half_sum(int v) {
    v += DPP_I(v, 0xB1); v += DPP_I(v, 0x4E); v += DPP_I(v, 0x141); v += DPP_I(v, 0x140); return x16_sumi(v); }
struct P2B { s16x8 b[8]; };
__device__ __forceinline__ P2B p2_ld4(const LAS unsigned char* kb_, int tb) { P2B r;
#pragma unroll
    for (int u = 0; u < 4; ++u) { r.b[2 * u] = *(const LAS s16x8*)(kb_ + (tb + u) * 2048); r.b[2 * u + 1] = *(const LAS s16x8*)(kb_ + (tb + u) * 2048 + 1024); }
    return r; }
__device__ __forceinline__ float p2_relu(float x) { const int xi = __builtin_bit_cast(int, x); return __builtin_bit_cast(float, xi > 0 ? xi : 0); }
__device__ __forceinline__ float p2_wsum(const f32x4 a, const f32x4 w) {
    float p = fmaf(w.x, p2_relu(a[0]), 0.f); p = fmaf(w.y, p2_relu(a[1]), p); p = fmaf(w.z, p2_relu(a[2]), p); return fmaf(w.w, p2_relu(a[3]), p); }
__device__ __forceinline__ void p2_score4(const P2B& B, const s16x8 a0, const s16x8 a1, const f32x4 wq, float& r0, float& r1) {
    f32x4 acc[4];
#pragma unroll
    for (int u = 0; u < 4; ++u) { const f32x4 z = {0.f, 0.f, 0.f, 0.f}; acc[u] = __builtin_amdgcn_mfma_f32_16x16x32_bf16(a0, B.b[2 * u], z, 0, 0, 0); }
#pragma unroll
    for (int u = 0; u < 4; ++u) acc[u] = __builtin_amdgcn_mfma_f32_16x16x32_bf16(a1, B.b[2 * u + 1], acc[u], 0, 0, 0);
    const float p0 = p2_wsum(acc[0], wq), p1 = p2_wsum(acc[1], wq), p2 = p2_wsum(acc[2], wq), p3 = p2_wsum(acc[3], wq);
    { auto s_ = __builtin_amdgcn_permlane16_swap(__builtin_bit_cast(unsigned, p0), __builtin_bit_cast(unsigned, p1), false, false); const unsigned x_ = s_[0], y_ = s_[1];
      r0 = __builtin_bit_cast(float, x_) + __builtin_bit_cast(float, y_); }
    { auto s_ = __builtin_amdgcn_permlane16_swap(__builtin_bit_cast(unsigned, p2), __builtin_bit_cast(unsigned, p3), false, false); const unsigned x_ = s_[0], y_ = s_[1];
      r1 = __builtin_bit_cast(float, x_) + __builtin_bit_cast(float, y_); }
}
__device__ __forceinline__ void p2_unit(const Ctx& c, int b, int blk, int item, int item2) {
    LAS unsigned char* kst = c.lds;
    const int lane = c.lane, wv = c.wave, r = lane & 31, hh = lane >> 5, g4 = lane >> 4, c16 = lane & 15;
    const int t0 = blk * 16 + 2 * wv, n0 = b * SEQ + t0, ntile = blk + 1, nst = (ntile + 15) >> 4;
    const unsigned char* ksrc = c.ws + WS_KIDX + (size_t)(b * 128) * 2048;
#define P2_ISSUE(st) do { _Pragma("unroll") for (int _j = 0; _j < 4; ++_j) \
        __builtin_amdgcn_global_load_lds((const unsigned*)(ksrc + (size_t)(st) * 32768 + (_j * 512 + c.tid) * 16), (LAS unsigned*)(kst + ((st) & 1) * 32768 + (_j * 512 + wv * 64) * 16), 16, 0, 0); } while (0)
    P2_ISSUE(0);
    s16x8 af[2];
    { const bf16* qp = (const bf16*)(c.ws + WS_QIDX) + (size_t)(n0 + (c16 >> 3)) * 512 + (c16 & 7) * 64 + 8 * g4;
      af[0] = *(const s16x8*)qp; af[1] = *(const s16x8*)(qp + 32); }
    const f32x4 wq = *(const f32x4*)((const float*)(c.ws + WS_WIDX) + (size_t)(n0 + hh) * 8 + 4 * (g4 & 1));
    asm volatile("" :: "v"(af[0]), "v"(af[1]), "v"(wq));
    float sc0[64];
#pragma unroll
    for (int i = 0; i < 64; ++i) sc0[i] = -INFINITY;
    const int lim0 = 2 * wv + hh;
    const int lastst = blk >> 4;
    const int limt = (blk - (g4 & 1)) - ((c16 <= lim0) ? 0 : 1);
#pragma unroll
    for (int st = 0; st < 8; ++st) {
        if (st <= lastst) {
            if (st < lastst) { P2_ISSUE(st + 1); asm volatile("s_waitcnt vmcnt(4)" ::: "memory"); }
            else asm volatile("s_waitcnt vmcnt(0)" ::: "memory");
            __builtin_amdgcn_s_barrier();
            const LAS unsigned char* kb_ = kst + (st & 1) * 32768 + lane * 16;
            if (st < lastst) {
                P2B Ba = p2_ld4(kb_, 0), Bb = p2_ld4(kb_, 4);
                p2_score4(Ba, af[0], af[1], wq, sc0[st * 8 + 0], sc0[st * 8 + 1]); __builtin_amdgcn_sched_barrier(0);
                Ba = p2_ld4(kb_, 8);
                p2_score4(Bb, af[0], af[1], wq, sc0[st * 8 + 2], sc0[st * 8 + 3]); __builtin_amdgcn_sched_barrier(0);
                Bb = p2_ld4(kb_, 12);
                p2_score4(Ba, af[0], af[1], wq, sc0[st * 8 + 4], sc0[st * 8 + 5]); __builtin_amdgcn_sched_barrier(0);
                p2_score4(Bb, af[0], af[1], wq, sc0[st * 8 + 6], sc0[st * 8 + 7]);
            } else {
#pragma unroll
                for (int g = 0; g < 4; ++g) if (st * 16 + 4 * g <= blk) {
                    const P2B B = p2_ld4(kb_, 4 * g);
                    float r0, r1; p2_score4(B, af[0], af[1], wq, r0, r1);
                    sc0[st * 8 + 2 * g] = (st * 16 + 4 * g <= limt) ? r0 : -INFINITY;
                    sc0[st * 8 + 2 * g + 1] = (st * 16 + 4 * g + 2 <= limt) ? r1 : -INFINITY;
                    __builtin_amdgcn_sched_barrier(0);
                }
            }
            asm volatile("s_waitcnt lgkmcnt(0)" ::: "memory");
            __builtin_amdgcn_s_barrier();
        }
    }
#undef P2_ISSUE
    f32x4 tv[8];
    LAS float* iscr = (LAS float*)(c.lds + (wv < 7 ? 65536 + wv * 8448 : 133120));
    if (item >= 0) ex_item_load(c, item, tv);
    const int nreg = (ntile + 1) >> 1;
    float thr0 = -INFINITY; int quota0 = 0;
    if (blk >= 16) {
        float mn0 = INFINITY, mx0 = -INFINITY; int cp = 0, cn = 0;
#pragma unroll
        for (int g = 0; g < 4; ++g) if (nreg > 16 * g) {
#pragma unroll
            for (int i = 16 * g; i < 16 * g + 16; ++i) { mx0 = fmaxf(mx0, sc0[i]); mn0 = fminf(mn0, sc0[i] == -INFINITY ? INFINITY : sc0[i]); cp += (sc0[i] > 0.f) ? 1 : 0; cn += (sc0[i] >= 0.f) ? 1 : 0; } }
        mn0 = half_min(mn0); mx0 = half_max(mx0); cp = half_sum(cp); cn = half_sum(cn);
        float lo0, hi0; int chi0, clo0; bool done0 = false;
        if (cp <= KSEL && cn >= KSEL) { done0 = true; thr0 = 0.f; quota0 = KSEL - cp; lo0 = hi0 = 0.f; chi0 = 0; clo0 = KSEL + 1; }
        else if (cp > KSEL) { lo0 = 0.f; clo0 = cn; hi0 = mx0 + fabsf(mx0) * 1e-6f + 1e-30f; chi0 = 0; }
        else { lo0 = mn0; clo0 = t0 + hh + 1; hi0 = 0.f; chi0 = cn; }
        for (int it = 0; it < 200; ++it) {
            if (__builtin_amdgcn_ballot_w64(!done0) == 0ull) break;
            const float half_ = 0.5f * (lo0 + hi0);
            float mid0 = half_;
            if (!(it & 1)) { const float fr_ = ((float)(clo0 - KSEL) + 0.5f) / (float)(clo0 - chi0); const float mi = lo0 + (hi0 - lo0) * fr_; mid0 = (mi > lo0 && mi < hi0) ? mi : half_; }
            unsigned sa = 0u, sb = 0u; int nproc = 0;
#pragma unroll
            for (int g = 0; g < 4; ++g) if (nreg > 16 * g) { nproc += 16;
#pragma unroll
                for (int i = 16 * g; i < 16 * g + 16; ++i) { const unsigned tb_ = __builtin_bit_cast(unsigned, sc0[i] - mid0);
                    if (g < 2) sa = __builtin_amdgcn_alignbit(sa, tb_, 31); else sb = __builtin_amdgcn_alignbit(sb, tb_, 31); } }
            int c0 = half_sum(nproc - __builtin_popcount(sa) - __builtin_popcount(sb));
            if (!done0) { if (c0 == KSEL) { done0 = true; thr0 = mid0; quota0 = KSEL; } else if (mid0 <= lo0 || mid0 >= hi0) { done0 = true; thr0 = lo0; quota0 = KSEL - chi0; } else if (c0 > KSEL) { lo0 = mid0; clo0 = c0; } else { hi0 = mid0; chi0 = c0; } }
        }
        if (!done0) { thr0 = lo0; quota0 = KSEL - chi0; }
    }
    if (item >= 0) ex_item_finish(c, iscr, item, tv);
    if (item2 >= 0) ex_item_load(c, item2, tv);
    unsigned short* selp0 = (unsigned short*)(c.ws + WS_SEL) + (size_t)(n0 + hh) * KSEL;
    int base0 = 0, eq0 = 0; const unsigned ltm = (1u << r) - 1u;
#pragma unroll
    for (int g = 0; g < 4; ++g) if (nreg > 16 * g) {
#pragma unroll
        for (int i = 16 * g; i < 16 * g + 16; ++i) {
            bool sel_ = sc0[i] > thr0; const bool pe = sc0[i] == thr0; const unsigned long long me = __builtin_amdgcn_ballot_w64(pe);
            if (me) { const unsigned mh = hh ? (unsigned)(me >> 32) : (unsigned)me; sel_ = sel_ || (pe && (eq0 + __builtin_popcount(mh & ltm) < quota0)); eq0 += __builtin_popcount(mh); }
            const unsigned long long ms = __builtin_amdgcn_ballot_w64(sel_); const unsigned mh2 = hh ? (unsigned)(ms >> 32) : (unsigned)ms;
            const int pos = base0 + __builtin_popcount(mh2 & ltm); if (sel_ && pos < KSEL) selp0[pos] = (unsigned short)(32 * i + r); base0 += __builtin_popcount(mh2);
        } }
    if (item2 >= 0) ex_item_finish(c, iscr, item2, tv);
}
__device__ __forceinline__ void p2_indexer_topk(const Ctx& c) {
    for (int pu = c.bid; pu < 256; pu += c.G) {
        const int b = pu >> 5, j = pu & 31;
#pragma unroll 1
        for (int q = 0; q < 4; ++q) p2_unit(c, b, q == 0 ? j : (q == 1 ? 63 - j : (q == 2 ? 64 + j : 127 - j)), c.G == 256 ? q * 2048 + c.bid * NWAVES + c.wave : -1, (c.G == 256 && q < 2) ? (4 + q) * 2048 + c.bid * NWAVES + c.wave : -1);
    }
}


typedef short s16x4 __attribute__((ext_vector_type(4)));
constexpr int DSA_WS_OFF = 131072 + 2048;
constexpr int DSA_BIAS_OFF = 131072 + 2048 + 10240;
__device__ __forceinline__ void p3a_dsa(const Ctx& c) {
    const int lane = c.lane, wv = c.wave, l15 = lane & 15, g4 = lane >> 4;
    LAS unsigned char* kvb = c.lds + wv * 16384;
    LAS unsigned char* wsb = c.lds + DSA_WS_OFF + wv * 1280;
    LAS float* biasL = (LAS float*)(c.lds + DSA_BIAS_OFF);
    for (int i = c.tid; i < 129 * 8; i += NTHR) biasL[i] = ((const float*)(c.ws + WS_BIAS))[i];
    __syncthreads();
    const int prow = (l15 & 3) | ((l15 & 4) << 1) | ((l15 & 8) >> 1);
    const int rowx = ((prow & 3) << 2) | (prow >> 2);
    const unsigned qk_off = (unsigned)(256 * prow + 16 * (g4 ^ (rowx & 3))), qk_sx = (unsigned)(rowx >> 2);
    const int grow = 8 * (g4 & 1) + 4 * (g4 >> 1);
    const int trow = grow + (l15 >> 2), trx = ((trow & 3) << 2) | ((trow >> 2) & 3);
    const unsigned tr_off = (unsigned)(256 * trow + 16 * (((lane & 3) >> 1) ^ (trx & 1)) + 8 * (lane & 1)), tr_mx = (unsigned)(trx >> 1);
    const bf16* ckv = (const bf16*)(c.ws + WS_CKV);
    const float bfar = biasL[128 * 8 + (l15 & 7)];
    float bmax = 0.f;
    for (int d = 0; d <= 128; ++d) bmax = fmaxf(bmax, fabsf(biasL[d * 8 + (l15 & 7)]));
    const float kvmax = 11.313708499f * 1.004f * wave_max(fmaxf(fabsf(c.kv_g[2 * lane]), fabsf(c.kv_g[2 * lane + 1])));
    unsigned trm[8];
#pragma unroll
    for (int m = 0; m < 8; ++m) trm[m] = tr_off + 32u * ((unsigned)m ^ tr_mx);
    const int gw = c.bid * NWAVES + wv, NGW = c.G * NWAVES;
    const int eit0 = (c.G == 256 ? P0_EXPERT_ITEMS : 0) + gw;
    if (wv < 4) for (int eit = eit0; eit < P0_EXPERT_ITEMS; eit += NGW) p0_expert_item(c, (LAS float*)kvb, eit);
    asm volatile("s_waitcnt lgkmcnt(0)" ::: "memory");
#define DSA_LOADQ(n_, raw_, qf_) do { raw_ = *(const v2u*)((const unsigned short*)(c.ws + WS_SEL) + (size_t)(n_) * KSEL + 4 * lane); \
        const s16x8* qp_ = (const s16x8*)((const bf16*)(c.ws + WS_QLAT) + (size_t)(n_) * 1024 + (l15 & 7) * 128 + 8 * g4); \
        _Pragma("unroll") for (int s_ = 0; s_ < 4; ++s_) qf_[s_] = qp_[4 * s_]; } while (0)
#define DSA_PREP(n_, raw_, qf_, sl_, t_, cnt_, nch_, nfar_, mref_) do { t_ = (n_) & 2047; cnt_ = (t_ + 1 < KSEL) ? t_ + 1 : KSEL; nch_ = (cnt_ + 31) >> 5; \
        { const int i0 = 4 * lane, lim = t_ - 128; \
          raw_.x = (i0 < cnt_ ? (raw_.x & 0xffffu) : 0u) | (i0 + 1 < cnt_ ? (raw_.x & 0xffff0000u) : 0u); raw_.y = (i0 + 2 < cnt_ ? (raw_.y & 0xffffu) : 0u) | (i0 + 3 < cnt_ ? (raw_.y & 0xffff0000u) : 0u); \
          *(LAS v2u*)(wsb + (sl_) * 512 + 8 * lane) = raw_; \
          const int e0 = (i0 < cnt_ && (int)(raw_.x & 0xffffu) <= lim) ? 1 : 0, e1 = (i0 + 1 < cnt_ && (int)(raw_.x >> 16) <= lim) ? 1 : 0, e2 = (i0 + 2 < cnt_ && (int)(raw_.y & 0xffffu) <= lim) ? 1 : 0, e3 = (i0 + 3 < cnt_ && (int)(raw_.y >> 16) <= lim) ? 1 : 0; \
          int nf = e0 + e1 + e2 + e3; nf += DPP_I(nf, 0xB1); nf += DPP_I(nf, 0x4E); nf += DPP_I(nf, 0x141); nf += DPP_I(nf, 0x140); nf = x16_sumi(nf); { unsigned xa, xb; swap32((unsigned)nf, xa, xb); nf = (int)(xa + xb); } \
          nfar_ = __builtin_amdgcn_readfirstlane(nf) >> 5; } \
        { float q2 = 0.f; \
          _Pragma("unroll") for (int s_ = 0; s_ < 4; ++s_) { if (l15 >= 8) qf_[s_] = (s16x8){0, 0, 0, 0, 0, 0, 0, 0}; \
              _Pragma("unroll") for (int e = 0; e < 8; ++e) { const float qv = bf2f((unsigned)(unsigned short)qf_[s_][e]); q2 += qv * qv; } } \
          q2 = x16_sum(q2); q2 = x32_sum(q2); mref_ = sqrtf(q2) * kvmax + bmax; } } while (0)
#define DSA_ISSUE(ch_, bi_, k8_, sl_, n_, t_, cnt_, nfar_) do { const bf16* ckb_ = ckv + (size_t)((n_) >> 11) * SEQ * 128; \
            _Pragma("unroll") for (int u = 0; u < 8; ++u) { const unsigned kw = u < 2 ? k8_.x : (u < 4 ? k8_.y : (u < 6 ? k8_.z : k8_.w)); const unsigned key = (u & 1) ? (kw >> 16) : (kw & 0xffffu); \
                const int chl = l15 ^ ((g4 << 2) | (u & 3)); \
                __builtin_amdgcn_global_load_lds((const unsigned*)((const char*)ckb_ + (size_t)(unsigned)(key * 256u + (unsigned)chl * 16u)), (LAS unsigned*)(kvb + (bi_) * 8192 + u * 1024), 16, 0, 0); } \
            if ((ch_) >= (nfar_) && lane < 32) { const int kap = 32 * (ch_) + 8 * (lane & 3) + (lane >> 2); const int key = *(const LAS unsigned short*)(wsb + (sl_) * 512 + 2 * kap); int dd = (t_) - key; dd = dd > 128 ? 128 : dd; dd = kap < (cnt_) ? dd : 255; \
                *(LAS unsigned short*)(wsb + 1024 + (bi_) * 64 + 2 * lane) = (unsigned short)dd; } } while (0)
    const bool mixq = (NGW == SEQ);
#define DSA_QIDX(i_) (mixq ? ((i_) * SEQ + ((gw + 293 * (i_)) & (SEQ - 1))) : (gw + (i_) * NGW))
    const int nq = mixq ? BATCH : (NTOK - gw + NGW - 1) / NGW;
    int qi = 0, n = DSA_QIDX(0), sl = 0, b0 = 0, t = 0, cnt = 0, nch = 0, nfar = 0; float Mref = 0.f;
    s16x8 qf[4]; v2u rawn; s16x8 qfn[4];
    if (nq > 0) { v2u raw0; DSA_LOADQ(n, raw0, qf); DSA_PREP(n, raw0, qf, 0, t, cnt, nch, nfar, Mref);
        asm volatile("s_waitcnt lgkmcnt(0)" ::: "memory");
        const v4u k80 = *(const LAS v4u*)(wsb + (8 * g4) * 2); DSA_ISSUE(0, 0, k80, 0, n, t, cnt, nfar); }
    for (; qi < nq; ++qi) {
        const bool has_next = qi + 1 < nq; const int nn = has_next ? DSA_QIDX(qi + 1) : n;
        if (has_next) DSA_LOADQ(nn, rawn, qfn);
        int tn = 0, cntn = 0, nchn = 0, nfarn = 0; float Mrefn = 0.f;
        f32x4 O[8];
#pragma unroll
        for (int m = 0; m < 8; ++m) O[m] = (f32x4){0.f, 0.f, 0.f, 0.f};
        float l_run = 0.f;
        v4u k8n = *(const LAS v4u*)(wsb + sl * 512 + (32 * (nch > 1 ? 1 : 0) + 8 * g4) * 2);
        for (int ch = 0; ch < nch; ++ch) {
            const int bi = (b0 + ch) & 1;
            asm volatile("s_waitcnt lgkmcnt(0)" ::: "memory");
            if (ch + 1 < nch) { const v4u k8 = k8n; k8n = *(const LAS v4u*)(wsb + sl * 512 + (32 * (ch + 2 < 8 ? ch + 2 : 7) + 8 * g4) * 2);
                DSA_ISSUE(ch + 1, bi ^ 1, k8, sl, n, t, cnt, nfar); asm volatile("s_waitcnt vmcnt(8)" ::: "memory"); }
            else if (has_next) { DSA_PREP(nn, rawn, qfn, sl ^ 1, tn, cntn, nchn, nfarn, Mrefn);
                asm volatile("s_waitcnt lgkmcnt(0)" ::: "memory");
                const v4u k8 = *(const LAS v4u*)(wsb + (sl ^ 1) * 512 + (8 * g4) * 2);
                DSA_ISSUE(0, bi ^ 1, k8, sl ^ 1, nn, tn, cntn, nfarn); asm volatile("s_waitcnt vmcnt(8)" ::: "memory"); }
            else asm volatile("s_waitcnt vmcnt(0)" ::: "memory");
            const LAS unsigned char* kb_ = kvb + bi * 8192;
            f32x4 S[2];
#pragma unroll
            for (int T = 0; T < 2; ++T) { f32x4 a4 = {0.f, 0.f, 0.f, 0.f};
#pragma unroll
                for (int s_ = 0; s_ < 4; ++s_) { const s16x8 a = *(const LAS s16x8*)(kb_ + qk_off + 4096 * T + 64 * ((unsigned)s_ ^ qk_sx)); a4 = __builtin_amdgcn_mfma_f32_16x16x32_bf16(a, qf[s_], a4, 0, 0, 0); }
                S[T] = a4; }
            if (ch < nfar) {
#pragma unroll
                for (int T = 0; T < 2; ++T)
#pragma unroll
                    for (int r_ = 0; r_ < 4; ++r_) S[T][r_] = S[T][r_] + (bfar - Mref);
            } else
#pragma unroll
            for (int T = 0; T < 2; ++T) { const v2u d4 = *(const LAS v2u*)(wsb + 1024 + bi * 64 + 2 * (16 * T + grow));
#pragma unroll
                for (int r_ = 0; r_ < 4; ++r_) { const unsigned dw = r_ < 2 ? d4.x : d4.y; const unsigned dd = (r_ & 1) ? (dw >> 16) : (dw & 0xffffu);
                    const float bsv = biasL[(dd > 128u ? 128u : dd) * 8 + (l15 & 7)]; S[T][r_] = (dd == 255u) ? -INFINITY : S[T][r_] + (bsv - Mref); } }
#pragma unroll
            for (int T = 0; T < 2; ++T)
#pragma unroll
                for (int r_ = 0; r_ < 4; ++r_) { const float pv = __expf(S[T][r_]); S[T][r_] = pv; l_run += pv; }
            s16x8 P;
            { const unsigned p0 = cvt_pk(S[0][0], S[0][1]), p1 = cvt_pk(S[0][2], S[0][3]), p2 = cvt_pk(S[1][0], S[1][1]), p3 = cvt_pk(S[1][2], S[1][3]);
              const v4u pw_ = {p0, p1, p2, p3}; P = __builtin_bit_cast(s16x8, pw_); }
            { const unsigned kba = (unsigned)(size_t)kb_; s16x4 ta[8], tb[8];
#pragma unroll
              for (int m = 0; m < 8; ++m) { const unsigned ad = kba + trm[m];
                  asm volatile("ds_read_b64_tr_b16 %0, %1" : "=v"(ta[m]) : "v"(ad) : "memory"); asm volatile("ds_read_b64_tr_b16 %0, %1 offset:4096" : "=v"(tb[m]) : "v"(ad) : "memory"); }
              asm volatile("s_waitcnt lgkmcnt(8)" ::: "memory"); __builtin_amdgcn_sched_barrier(0);
#pragma unroll
              for (int m = 0; m < 4; ++m) O[m] = __builtin_amdgcn_mfma_f32_16x16x32_bf16(__builtin_shufflevector(ta[m], tb[m], 0, 1, 2, 3, 4, 5, 6, 7), P, O[m], 0, 0, 0);
              asm volatile("s_waitcnt lgkmcnt(0)" ::: "memory"); __builtin_amdgcn_sched_barrier(0);
#pragma unroll
              for (int m = 4; m < 8; ++m) O[m] = __builtin_amdgcn_mfma_f32_16x16x32_bf16(__builtin_shufflevector(ta[m], tb[m], 0, 1, 2, 3, 4, 5, 6, 7), P, O[m], 0, 0, 0); }
        }
        l_run = x16_sum(l_run); l_run = x32_sum(l_run);
        const float inv = 1.0f / fmaxf(l_run, 1e-37f);
        { LAS unsigned char* stg = kvb + ((b0 + nch - 1) & 1) * 8192;
          if (l15 < 8) {
#pragma unroll
              for (int m = 0; m < 8; ++m) *(LAS v2u*)(stg + (l15 * 128 + 16 * m + 4 * g4) * 2) = (v2u){cvt_pk(O[m][0] * inv, O[m][1] * inv), cvt_pk(O[m][2] * inv, O[m][3] * inv)}; }
          asm volatile("s_waitcnt lgkmcnt(0)" ::: "memory");
          const v4u oa = *(const LAS v4u*)(stg + lane * 16), ob = *(const LAS v4u*)(stg + 1024 + lane * 16);
          bf16* op = (bf16*)(c.ws + WS_XB) + (size_t)n * 1024 + lane * 8;
          *(v4u*)op = oa; *(v4u*)(op + 512) = ob; }
        b0 = (b0 + nch) & 1; sl ^= 1; t = tn; cnt = cntn; nch = nchn; nfar = nfarn; Mref = Mrefn; n = nn;
#pragma unroll
        for (int s_ = 0; s_ < 4; ++s_) qf[s_] = qfn[s_];
    }
#undef DSA_QIDX
#undef DSA_LOADQ
#undef DSA_PREP
#undef DSA_ISSUE
    asm volatile("s_waitcnt vmcnt(0) lgkmcnt(0)" ::: "memory");
    if (wv >= 4) for (int eit = eit0; eit < P0_EXPERT_ITEMS; eit += NGW) p0_expert_item(c, (LAS float*)kvb, eit);
    __syncthreads();
}

__device__ __forceinline__ void p3b_swa(const Ctx& c) {
    const int lane = c.lane, wv = c.wave, l15 = lane & 15, g4 = lane >> 4, g = wv & 3, hq = wv >> 2;
    LAS float* biasL = (LAS float*)(c.lds + DSA_BIAS_OFF);
    __syncthreads();
    for (int i = c.tid; i < 128 * 8; i += NTHR) biasL[i] = ((const float*)(c.ws + WS_BIAS) + 129 * 8)[i];
    __syncthreads();
    const unsigned kr_off = (unsigned)(128 * l15), kr_x = (unsigned)(l15 & 7);
    const int vrow = 4 * g4 + (l15 >> 2); const unsigned vr_x = (unsigned)(vrow & 7), vp1 = (unsigned)((lane & 3) >> 1);
    const unsigned vr_off = (unsigned)(128 * vrow + 8 * (lane & 1));
    for (int unit = c.bid; unit < 256; unit += c.G) {
        const int b = unit >> 5, qb = (unit >> 1) & 15, kvh = unit & 1, head = kvh * 4 + g;
        __syncthreads();
#pragma unroll
        for (int j = 0; j < 4; ++j) { const int piece = wv * 4 + j, row = 8 * piece + (lane >> 3), chunk = (lane & 7) ^ (row & 7); int key = (qb - 1) * 128 + row; key = key < 0 ? 0 : key;
            const size_t so = ((size_t)(b * SEQ + key) * 128 + kvh * 64 + chunk * 8);
            __builtin_amdgcn_global_load_lds((const unsigned*)((const bf16*)(c.ws + WS_KB) + so), (LAS unsigned*)(c.lds + piece * 1024), 16, 0, 0);
            __builtin_amdgcn_global_load_lds((const unsigned*)((const bf16*)(c.ws + WS_VB) + so), (LAS unsigned*)(c.lds + 32768 + piece * 1024), 16, 0, 0); }
        float bt[9][4];
#pragma unroll
        for (int ta = 0; ta < 9; ++ta)
#pragma unroll
            for (int r_ = 0; r_ < 4; ++r_) { const int dist = 128 + l15 - 16 * ta - 4 * g4 - r_; bt[ta][r_] = (dist >= 0 && dist < 128) ? biasL[dist * 8 + head] : -INFINITY; }
        const float sink = c.sinks[head];
        asm volatile("s_waitcnt vmcnt(0)" ::: "memory");
        __syncthreads();
#pragma unroll 1
        for (int jj = 0; jj < 4; ++jj) {
            const int j = 4 * hq + jj; const size_t nrow = (size_t)(b * SEQ + qb * 128 + 16 * j + l15);
            bf16* qrow = (bf16*)(c.ws + WS_QB) + nrow * 512 + head * 64;
            const s16x8 q0 = *(const s16x8*)(qrow + 8 * g4), q1 = *(const s16x8*)(qrow + 32 + 8 * g4);
            f32x4 S[9]; float mx = sink;
#pragma unroll
            for (int ta = 0; ta < 9; ++ta) { const int kt = j + ta; const LAS unsigned char* kp = c.lds + kr_off + 2048 * kt;
                f32x4 a4 = {0.f, 0.f, 0.f, 0.f};
                a4 = __builtin_amdgcn_mfma_f32_16x16x32_bf16(*(const LAS s16x8*)(kp + 16 * ((unsigned)g4 ^ kr_x)), q0, a4, 0, 0, 0);
                a4 = __builtin_amdgcn_mfma_f32_16x16x32_bf16(*(const LAS s16x8*)(kp + 16 * ((unsigned)(4 + g4) ^ kr_x)), q1, a4, 0, 0, 0);
                const bool dead = (qb == 0 && kt < 8);
#pragma unroll
                for (int r_ = 0; r_ < 4; ++r_) { const float sv = dead ? -INFINITY : a4[r_] + bt[ta][r_]; a4[r_] = sv; mx = fmaxf(mx, sv); }
                S[ta] = a4; }
            mx = x16_max(mx); mx = x32_max(mx);
            float ps = 0.f;
#pragma unroll
            for (int ta = 0; ta < 9; ++ta)
#pragma unroll
                for (int r_ = 0; r_ < 4; ++r_) { const float pv = __expf(S[ta][r_] - mx); S[ta][r_] = pv; ps += pv; }
            ps = x16_sum(ps); ps = x32_sum(ps);
            const float inv = 1.0f / (ps + __expf(sink - mx));
            f32x4 O[4];
#pragma unroll
            for (int m = 0; m < 4; ++m) O[m] = (f32x4){0.f, 0.f, 0.f, 0.f};
#pragma unroll
            for (int pp = 0; pp < 5; ++pp) {
                const int ta = 2 * pp, tb = 2 * pp + 1;
                v4u pw_; pw_.x = cvt_pk(S[ta][0] * inv, S[ta][1] * inv); pw_.y = cvt_pk(S[ta][2] * inv, S[ta][3] * inv);
                if (tb < 9) { pw_.z = cvt_pk(S[tb < 9 ? tb : 0][0] * inv, S[tb < 9 ? tb : 0][1] * inv); pw_.w = cvt_pk(S[tb < 9 ? tb : 0][2] * inv, S[tb < 9 ? tb : 0][3] * inv); } else { pw_.z = 0u; pw_.w = 0u; }
                const s16x8 P = __builtin_bit_cast(s16x8, pw_);
                const LAS unsigned char* va = c.lds + 32768 + vr_off + 2048 * (j + ta); const LAS unsigned char* vb_ = c.lds + 32768 + vr_off + 2048 * (j + (tb < 9 ? tb : ta));
#pragma unroll
                for (int m = 0; m < 4; ++m) { const unsigned co = 16u * ((unsigned)(2 * m + vp1) ^ vr_x);
                    const s16x4 a0 = __builtin_amdgcn_ds_read_tr16_b64_v4i16((LAS s16x4*)(va + co)), a1 = __builtin_amdgcn_ds_read_tr16_b64_v4i16((LAS s16x4*)(vb_ + co));
                    O[m] = __builtin_amdgcn_mfma_f32_16x16x32_bf16(__builtin_shufflevector(a0, a1, 0, 1, 2, 3, 4, 5, 6, 7), P, O[m], 0, 0, 0); }
            }
#pragma unroll
            for (int m = 0; m < 4; ++m) *(v2u*)(qrow + 16 * m + 4 * g4) = (v2u){cvt_pk(O[m][0], O[m][1]), cvt_pk(O[m][2], O[m][3])};
        }
    }
    __syncthreads();
}

__device__ __forceinline__ void p6_ln_router(const Ctx& c, bf16* x1b) {
    const int lane = c.lane, wv = c.wave, l15 = lane & 15, g4 = lane >> 4;
    LAS unsigned char* XH = c.lds; LAS unsigned char* XL = c.lds + 32768;
    LAS float* PL = (LAS float*)(c.lds + 65536);
    LAS float* LG = (LAS float*)(c.lds + 65536 + 24576);
    const bf16* WH = (const bf16*)(c.ws + WS_WRT); const bf16* WL = WH + 48 * 1024;
    LAS unsigned* PEX = (LAS unsigned*)(c.lds + 65536 + 24576 + 4096);
    LAS unsigned* EB = PEX + 128;
    int nbase = 0;
    s16x8 wbh[4][3], wbl[4][3];
#pragma unroll
    for (int s_ = 0; s_ < 4; ++s_)
#pragma unroll
        for (int nt = 0; nt < 3; ++nt) { const size_t wo = (size_t)(16 * nt + l15) * 1024 + 128 * wv + 32 * s_ + 8 * g4; wbh[s_][nt] = *(const s16x8*)(WH + wo); wbl[s_][nt] = *(const s16x8*)(WL + wo); }
    f32x4 vn[2][4];
    if (c.bid < NTOK / 16) {
#pragma unroll
        for (int q = 0; q < 2; ++q)
#pragma unroll
            for (int j = 0; j < 4; ++j) vn[q][j] = ((const f32x4*)(c.out + (size_t)(c.bid * 16 + 2 * wv + q) * D) + lane)[64 * j]; }
    for (int u = c.bid; u < NTOK / 16; u += c.G) {
        __syncthreads();
#pragma unroll
        for (int q = 0; q < 2; ++q) { const int tk = 2 * wv + q, n = u * 16 + tk;
            f32x4 v[4]; float s = 0.f;
#pragma unroll
            for (int j = 0; j < 4; ++j) { v[j] = vn[q][j]; s += (v[j].x + v[j].y) + (v[j].z + v[j].w); }
            const float mean = wave_sum(s) * (1.f / D); float s2 = 0.f;
#pragma unroll
            for (int j = 0; j < 4; ++j) { v[j] = v[j] - mean; s2 += (v[j].x * v[j].x + v[j].y * v[j].y) + (v[j].z * v[j].z + v[j].w * v[j].w); }
            const float rstd = 1.f / sqrtf(wave_sum(s2) * (1.f / D) + LN_EPS);
#pragma unroll
            for (int j = 0; j < 4; ++j) { const int k0 = 4 * lane + 256 * j;
                const f32x4 g = *(const f32x4*)(c.ln1_g + k0), bb = *(const f32x4*)(c.ln1_b + k0);
                const f32x4 y = v[j] * rstd * g + bb;
                const unsigned h01 = pk2(y.x, y.y), h23 = pk2(y.z, y.w);
                *(v2u*)(x1b + (size_t)n * D + k0) = (v2u){h01, h23};
                const unsigned l01 = pk2(y.x - bflo(h01), y.y - bfhi(h01)), l23 = pk2(y.z - bflo(h23), y.w - bfhi(h23));
                const unsigned off = (unsigned)(tk * 2048 + ((((lane >> 1) + 32 * j) ^ tk) << 4) + 8 * (lane & 1));
                *(LAS v2u*)(XH + off) = (v2u){h01, h23}; *(LAS v2u*)(XL + off) = (v2u){l01, l23}; } }
        if (u + c.G < NTOK / 16) {
#pragma unroll
            for (int q = 0; q < 2; ++q)
#pragma unroll
                for (int j = 0; j < 4; ++j) vn[q][j] = ((const f32x4*)(c.out + (size_t)((u + c.G) * 16 + 2 * wv + q) * D) + lane)[64 * j]; }
        __syncthreads();
        { f32x4 acc[3];
#pragma unroll
          for (int nt = 0; nt < 3; ++nt) acc[nt] = (f32x4){0.f, 0.f, 0.f, 0.f};
#pragma unroll
          for (int s_ = 0; s_ < 4; ++s_) { const int chunk = 4 * (4 * wv + s_) + g4; const unsigned off = (unsigned)(l15 * 2048 + ((chunk ^ l15) << 4));
              const s16x8 ah = *(const LAS s16x8*)(XH + off), al = *(const LAS s16x8*)(XL + off);
#pragma unroll
              for (int nt = 0; nt < 3; ++nt) { const s16x8 bh = wbh[s_][nt], bl = wbl[s_][nt];
                  acc[nt] = __builtin_amdgcn_mfma_f32_16x16x32_bf16(al, bl, acc[nt], 0, 0, 0); acc[nt] = __builtin_amdgcn_mfma_f32_16x16x32_bf16(al, bh, acc[nt], 0, 0, 0);
                  acc[nt] = __builtin_amdgcn_mfma_f32_16x16x32_bf16(ah, bl, acc[nt], 0, 0, 0); acc[nt] = __builtin_amdgcn_mfma_f32_16x16x32_bf16(ah, bh, acc[nt], 0, 0, 0); } }
#pragma unroll
          for (int nt = 0; nt < 3; ++nt)
#pragma unroll
              for (int r_ = 0; r_ < 4; ++r_) PL[(wv * 16 + 4 * g4 + r_) * 48 + 16 * nt + l15] = acc[nt][r_]; }
        __syncthreads();
        for (int i = c.tid; i < 16 * 48; i += NTHR) { float a = 0.f;
#pragma unroll
            for (int w = 0; w < 8; ++w) a += PL[w * 768 + i];
            const int o = i % 48; a += o < 32 ? c.b_router[o] : (o < 36 ? c.b_group[o - 32] : 0.f);
            LG[i] = a; }
        __syncthreads();
        if (c.tid < 16) { const int n = u * 16 + c.tid; const LAS float* lg = LG + c.tid * 48; const int nloc = nbase + 2 * c.tid;
            int gs = 0; float gm = lg[32];
            for (int o = 1; o < 4; ++o) { const float v = lg[32 + o]; if (v > gm) { gm = v; gs = o; } }
            float gsum = 0.f;
            for (int o = 0; o < 4; ++o) gsum += __expf(lg[32 + o] - gm);
            const float gw_ = 1.0f / gsum;
            int i1 = 0; float m1 = lg[gs * 8];
            for (int o = 1; o < 8; ++o) { const float v = lg[gs * 8 + o]; if (v > m1) { m1 = v; i1 = o; } }
            int i2 = -1; float m2 = -INFINITY;
            for (int o = 0; o < 8; ++o) { const float v = lg[gs * 8 + o]; if (o != i1 && v > m2) { m2 = v; i2 = o; } }
            const float e2 = __expf(m2 - m1), w1 = gw_ / (1.0f + e2), w2 = gw_ * e2 / (1.0f + e2);
            const int ex1 = gs * 8 + i1, ex2 = gs * 8 + i2;
            ((unsigned*)(c.ws + WS_PE))[2 * n] = ex1; ((unsigned*)(c.ws + WS_PE))[2 * n + 1] = ex2; ((float*)(c.ws + WS_PW))[2 * n] = w1; ((float*)(c.ws + WS_PW))[2 * n + 1] = w2;
            PEX[nloc] = (unsigned)ex1 | ((unsigned)(2 * n) << 8); PEX[nloc + 1] = (unsigned)ex2 | ((unsigned)(2 * n + 1) << 8); }
        nbase += 32;
        if (nbase == 128 || u + c.G >= NTOK / 16) {
            __syncthreads();
            if (c.tid < 32) { unsigned cntE = 0; for (int j = 0; j < nbase; ++j) cntE += ((PEX[j] & 0xffu) == (unsigned)c.tid) ? 1u : 0u;
                EB[c.tid] = cntE ? atomicAdd(c.ctl + CW_CNT + c.tid, cntE) : 0u; }
            __syncthreads();
            if (c.tid < nbase) { const unsigned rec = PEX[c.tid], e = rec & 0xffu; unsigned rk = 0; for (int j = 0; j < c.tid; ++j) rk += ((PEX[j] & 0xffu) == e) ? 1u : 0u;
                ((unsigned*)(c.ws + WS_LIST))[(size_t)e * 32768 + EB[e] + rk] = rec >> 8; }
            nbase = 0;
        }
    }
    __syncthreads();
}


__device__ __forceinline__ void p9_ln2(const Ctx& c) {
    const int gw = c.bid * NWAVES + c.wave, NGW = c.G * NWAVES;
    f32x4 vn[4]; v2u san[4], sbn[4];
#define P9_LOAD(n_) do { const f32x4* r_ = (const f32x4*)(c.out + (size_t)(n_) * D) + c.lane; \
        _Pragma("unroll") for (int j = 0; j < 4; ++j) { const int k0 = 4 * c.lane + 256 * j; vn[j] = r_[64 * j]; \
            san[j] = *(const v2u*)((const bf16*)(c.ws + WS_SLOT) + (size_t)(2 * (n_)) * D + k0); sbn[j] = *(const v2u*)((const bf16*)(c.ws + WS_SLOT) + (size_t)(2 * (n_) + 1) * D + k0); } } while (0)
    if (gw < NTOK) P9_LOAD(gw);
    for (int n = gw; n < NTOK; n += NGW) {
        f32x4* row = (f32x4*)(c.out + (size_t)n * D) + c.lane;
        f32x4 v[4]; v2u sa[4], sb[4]; float s = 0.f;
#pragma unroll
        for (int j = 0; j < 4; ++j) { v[j] = vn[j]; sa[j] = san[j]; sb[j] = sbn[j]; s += (v[j].x + v[j].y) + (v[j].z + v[j].w); }
        if (n + NGW < NTOK) P9_LOAD(n + NGW);
        const float mean1 = wave_sum(s) * (1.f / D); float q1 = 0.f;
#pragma unroll
        for (int j = 0; j < 4; ++j) { v[j] = v[j] - mean1; q1 += (v[j].x * v[j].x + v[j].y * v[j].y) + (v[j].z * v[j].z + v[j].w * v[j].w); }
        const float rstd1 = 1.f / sqrtf(wave_sum(q1) * (1.f / D) + LN_EPS);
        s = 0.f;
#pragma unroll
        for (int j = 0; j < 4; ++j) { const int k0 = 4 * c.lane + 256 * j; const f32x4 g = *(const f32x4*)(c.ln1_g + k0), bb = *(const f32x4*)(c.ln1_b + k0);
            f32x4 y = (v[j] * rstd1 * g + bb) * ALPHA; y.x += bflo(sa[j].x) + bflo(sb[j].x); y.y += bfhi(sa[j].x) + bfhi(sb[j].x); y.z += bflo(sa[j].y) + bflo(sb[j].y); y.w += bfhi(sa[j].y) + bfhi(sb[j].y);
            v[j] = y; s += (y.x + y.y) + (y.z + y.w); }
        const float mean = wave_sum(s) * (1.f / D); float s2 = 0.f;
#pragma unroll
        for (int j = 0; j < 4; ++j) { v[j] = v[j] - mean; s2 += (v[j].x * v[j].x + v[j].y * v[j].y) + (v[j].z * v[j].z + v[j].w * v[j].w); }
        const float rstd = 1.f / sqrtf(wave_sum(s2) * (1.f / D) + LN_EPS);
#pragma unroll
        for (int j = 0; j < 4; ++j) { const int k0 = 4 * c.lane + 256 * j; const f32x4 g = *(const f32x4*)(c.ln2_g + k0), bb = *(const f32x4*)(c.ln2_b + k0); row[64 * j] = v[j] * rstd * g + bb; }
    }
#undef P9_LOAD
}

namespace pg8 {
typedef short bf16x8 __attribute__((ext_vector_type(8)));
constexpr int BM = 256, BK = 64, HALF = 128, HTB = HALF * BK * 2, STAGE_BYTES = 8 * HTB, NXCD = 8, WGM = 8;
__host__ __device__ __forceinline__ int lds_byte(int r, int c) { const int st = (r >> 4) * 2 + (c >> 5), rr = r & 15, cc = c & 31, ob = rr * 64 + cc * 2; return st * 1024 + (ob ^ (((ob >> 9) & 1) << 5)); }
__host__ __device__ __forceinline__ void stage_rc(int b, int& R, int& C) { const int st = b / 1024, sb = b % 1024, swz = sb ^ (((sb >> 9) & 1) << 5); R = (st >> 1) * 16 + swz / 64; C = (st & 1) * 32 + (swz % 64) / 2; }
__host__ __device__ __forceinline__ int perm32(int rho) { const int n = rho >> 4, i = rho & 15; return 8 * (i >> 2) + 4 * n + (i & 3); }
__device__ __forceinline__ unsigned cvt_pk_bf16(float lo, float hi) { unsigned r; asm volatile("v_cvt_pk_bf16_f32 %0, %1, %2" : "=v"(r) : "v"(lo), "v"(hi)); return r; }

struct Unit { int pm, pn, pb, aux; };

struct StaticOrder {
    int nM, nN, nwg, G, c;
    __device__ void init(int M, int N, int G_, int c_) { nM = M / BM; nN = N / BM; nwg = nM * nN; G = G_; c = c_; }
    __device__ bool next(int i, Unit& u) const {
        const long L = (long)i * G + c; if (L >= nwg) return false;
        int wgid = (int)L; { const int q = nwg / NXCD, r = nwg % NXCD, xcd = wgid % NXCD, off = wgid / NXCD; wgid = (xcd < r ? xcd * (q + 1) : r * (q + 1) + (xcd - r) * q) + off; }
        const int nig = WGM * nN, gid = wgid / nig, fm = gid * WGM, gsz = (nM - fm) < WGM ? (nM - fm) : WGM;
        u.pm = fm + ((wgid % nig) % gsz); u.pn = (wgid % nig) / gsz; u.pb = u.pn; u.aux = 0; return true;
    }
    __device__ __forceinline__ void a_ready(const Unit&) const {}
    __device__ __forceinline__ void done(const Unit&) const {}
};
struct DenseProb {
    static constexpr bool GATHER = false;
    const bf16* A; const bf16* Bt; int K;
    __device__ __forceinline__ const char* a_base(const Unit& u) const { return (const char*)A + (size_t)u.pm * 256 * K * 2; }
    __device__ __forceinline__ const char* b_base(const Unit& u) const { return (const char*)Bt + (size_t)u.pb * 256 * K * 2; }
    __device__ __forceinline__ void a_offs(const Unit&, int R0, int C0, int R1, int C1, unsigned (&o)[2][2]) const {
        o[0][0] = (unsigned)(R0 * K + C0) * 2u; o[0][1] = (unsigned)(R1 * K + C1) * 2u; o[1][0] = o[0][0] + (unsigned)(HALF * K * 2); o[1][1] = o[0][1] + (unsigned)(HALF * K * 2); }
};

template <class Prob, class Epi, class Sched>
__device__ __forceinline__ void gemm_phase(LAS unsigned char* lds, const Prob& P, const Sched& S, const Epi& E) {
    const int tid = threadIdx.x, wid = __builtin_amdgcn_readfirstlane(tid >> 6), lane = tid & 63, wr = wid >> 2, wc = wid & 3, fr = lane & 15, fq = lane >> 4;
    const int K = P.K, nt = K / BK;
    int sR[2], sC[2];
    unsigned offB[2][2], offA[2][2];
#pragma unroll
    for (int i = 0; i < 2; ++i) { stage_rc(tid * 16 + i * 8192, sR[i], sC[i]); const int Rb = Epi::PERM ? ((sR[i] & ~31) + perm32(sR[i] & 31)) : sR[i];
        offB[0][i] = (unsigned)(Rb * K + sC[i]) * 2u; offB[1][i] = offB[0][i] + (unsigned)(HALF * K * 2); }
    const size_t kstep = (size_t)(BK * 2);
    const unsigned ldsw = (unsigned)wid * 1024u;
    const int aoff = lds_byte(wr * 64 + fr, fq * 8), boff = lds_byte(wc * 32 + fr, fq * 8);
#define PG8_SA(b, h) (((b) * 2 + (h)) * HTB)
#define PG8_SB(b, h) ((4 + (b) * 2 + (h)) * HTB)
#define PG8_STAGE(bufoff, gbase, offs) do { _Pragma("unroll") for (int _i = 0; _i < 2; ++_i) \
        __builtin_amdgcn_global_load_lds((const unsigned*)((gbase) + (offs)[_i]), (LAS unsigned*)(lds + (bufoff) + ldsw + _i * 8192), 16, 0, 0); } while (0)
#define PG8_STA(b, h, tau) PG8_STAGE(PG8_SA(b, h), sA + (size_t)(tau) * kstep, offA[h])
#define PG8_STB(b, h, tau) PG8_STAGE(PG8_SB(b, h), sB + (size_t)(tau) * kstep, offB[h])
#define PG8_LDA(dst, b, h) do { _Pragma("unroll") for (int m = 0; m < 4; ++m) _Pragma("unroll") for (int k = 0; k < 2; ++k) dst[m][k] = *(const LAS bf16x8*)(lds + PG8_SA(b, h) + aoff + m * 2048 + k * 1024); } while (0)
#define PG8_LDB(dst, b, h) do { _Pragma("unroll") for (int n = 0; n < 2; ++n) _Pragma("unroll") for (int k = 0; k < 2; ++k) dst[n][k] = *(const LAS bf16x8*)(lds + PG8_SB(b, h) + boff + n * 2048 + k * 1024); } while (0)
#define PG8_MMA(ai, bj, At, Bt) do { __builtin_amdgcn_s_setprio(1); _Pragma("unroll") for (int m = 0; m < 4; ++m) _Pragma("unroll") for (int n = 0; n < 2; ++n) _Pragma("unroll") for (int k = 0; k < 2; ++k) \
        acc[ai][bj][m][n] = __builtin_amdgcn_mfma_f32_16x16x32_bf16(Bt[n][k], At[m][k], acc[ai][bj][m][n], 0, 0, 0); __builtin_amdgcn_s_setprio(0); } while (0)
#define PG8_WAIT_V(n) asm volatile("s_waitcnt vmcnt(" #n ")" ::: "memory")
#define PG8_WAIT_L(n) asm volatile("s_waitcnt lgkmcnt(" #n ")" ::: "memory")
#define PG8_BAR __builtin_amdgcn_s_barrier()
#define PG8_SCHED __builtin_amdgcn_sched_barrier(0)
    Unit cur, nxt; int ui = 0;
    if (!S.next(0, cur)) return;
    f32x4 acc[2][2][4][2];
#pragma unroll
    for (int a = 0; a < 2; ++a)
#pragma unroll
        for (int b = 0; b < 2; ++b)
#pragma unroll
            for (int m = 0; m < 4; ++m)
#pragma unroll
                for (int n = 0; n < 2; ++n) acc[a][b][m][n] = (f32x4){0.f, 0.f, 0.f, 0.f};
    bf16x8 At[4][2], B0[2][2], B1[2][2];
    const char* sA = P.a_base(cur); const char* sB = P.b_base(cur);
    S.a_ready(cur);
    P.a_offs(cur, sR[0], sC[0], sR[1], sC[1], offA);
    PG8_STB(0, 0, 0); PG8_STB(0, 1, 0); PG8_STA(0, 0, 0); PG8_STA(0, 1, 0);
    if (wr == 1) PG8_BAR;
    PG8_WAIT_V(2); PG8_BAR;
    PG8_STB(1, 0, 1); PG8_STA(1, 0, 1); PG8_STB(1, 1, 1);
    PG8_WAIT_V(6); PG8_BAR;
    for (;;) {
        const bool has_next = S.next(ui + 1, nxt);
        unsigned nOffA[2][2];
        if (Prob::GATHER) { if (has_next) P.a_offs(nxt, sR[0], sC[0], sR[1], sC[1], nOffA); else {
#pragma unroll
            for (int h = 0; h < 2; ++h)
#pragma unroll
                for (int i = 0; i < 2; ++i) nOffA[h][i] = offA[h][i]; } }
        const char* nA = has_next ? P.a_base(nxt) : sA; const char* nB = has_next ? P.b_base(nxt) : sB;
        for (int t = 0; t < nt; t += 2) {
            const bool last = (t == nt - 2);
            if (last && has_next) S.a_ready(nxt);
            PG8_LDB(B0, 0, 0); PG8_LDB(B1, 0, 1); PG8_SCHED; PG8_LDA(At, 0, 0); PG8_STA(1, 1, t + 1);
            PG8_WAIT_V(8); PG8_WAIT_L(0); PG8_BAR; PG8_MMA(0, 0, At, B0); PG8_MMA(0, 1, At, B1); PG8_BAR; PG8_SCHED;
            if (last) {
                sA = nA - (size_t)nt * kstep; sB = nB - (size_t)nt * kstep;
                if (Prob::GATHER) {
#pragma unroll
                    for (int h = 0; h < 2; ++h)
#pragma unroll
                        for (int i = 0; i < 2; ++i) offA[h][i] = nOffA[h][i]; }
            }
            PG8_LDA(At, 0, 1); PG8_STB(0, 0, t + 2); PG8_STB(0, 1, t + 2); PG8_STA(0, 0, t + 2);
            PG8_WAIT_V(8); PG8_WAIT_L(0); PG8_BAR; PG8_MMA(1, 0, At, B0); PG8_MMA(1, 1, At, B1); PG8_BAR; PG8_SCHED;
            PG8_LDB(B0, 1, 0); PG8_LDB(B1, 1, 1); PG8_SCHED; PG8_LDA(At, 1, 0); PG8_STA(0, 1, t + 2);
            PG8_WAIT_V(8); PG8_WAIT_L(0); PG8_BAR; PG8_MMA(0, 0, At, B0); PG8_MMA(0, 1, At, B1); PG8_BAR; PG8_SCHED;
            PG8_LDA(At, 1, 1); PG8_STB(1, 0, t + 3); PG8_STB(1, 1, t + 3); PG8_STA(1, 0, t + 3);
            PG8_WAIT_V(8); PG8_WAIT_L(0); PG8_BAR; PG8_MMA(1, 0, At, B0); PG8_MMA(1, 1, At, B1); PG8_BAR; PG8_SCHED;
        }
        if (wr == 0) PG8_BAR;
        E(acc, cur, wr, wc, fr, fq); S.done(cur);
        if (!has_next) break;
#pragma unroll
        for (int a = 0; a < 2; ++a)
#pragma unroll
            for (int b = 0; b < 2; ++b)
#pragma unroll
                for (int m = 0; m < 4; ++m)
#pragma unroll
                    for (int n = 0; n < 2; ++n) acc[a][b][m][n] = (f32x4){0.f, 0.f, 0.f, 0.f};
        cur = nxt; ++ui; sA = nA; sB = nB;
        if (wr == 1) PG8_BAR;
    }
    PG8_WAIT_V(0);
    PG8_BAR;
#undef PG8_SA
#undef PG8_SB
#undef PG8_STAGE
#undef PG8_STA
#undef PG8_STB
#undef PG8_LDA
#undef PG8_LDB
#undef PG8_MMA
#undef PG8_WAIT_V
#undef PG8_WAIT_L
#undef PG8_BAR
#undef PG8_SCHED
}

template <class Epi, class Sched>
__device__ __forceinline__ void gemm_phase_dual(LAS unsigned char* lds, const bf16* A1, const bf16* Bt1, int K1, const bf16* A2, const bf16* Bt2, int K2, const Sched& S, const Epi& E) {
    const int tid = threadIdx.x, wid = __builtin_amdgcn_readfirstlane(tid >> 6), lane = tid & 63, wr = wid >> 2, wc = wid & 3, fr = lane & 15, fq = lane >> 4;
    const int nt1 = K1 / BK, nt = (K1 + K2) / BK;
    unsigned offB1[2][2], offA1[2][2]; const unsigned dK2 = (unsigned)(2 * (K2 - K1));
#pragma unroll
    for (int i = 0; i < 2; ++i) { int R, C; stage_rc(tid * 16 + i * 8192, R, C); const int Rb = (R & ~31) + perm32(R & 31);
        offA1[0][i] = (unsigned)(R * K1 + C) * 2u; offA1[1][i] = offA1[0][i] + (unsigned)(HALF * K1 * 2); offB1[0][i] = (unsigned)(Rb * K1 + C) * 2u; offB1[1][i] = offB1[0][i] + (unsigned)(HALF * K1 * 2); }
    const size_t kstep = (size_t)(BK * 2);
    const unsigned ldsw = (unsigned)wid * 1024u;
    const int aoff = lds_byte(wr * 64 + fr, fq * 8), boff = lds_byte(wc * 32 + fr, fq * 8);
#define PG8_SA(b, h) (((b) * 2 + (h)) * HTB)
#define PG8_SB(b, h) ((4 + (b) * 2 + (h)) * HTB)
#define PG8_STX(bufoff, tau, g1, g2, o1, o2) do { const int _t = (tau); const bool _s2 = _t >= nt1; const long long _d = _s2 ? (long long)((g2) - (g1)) - (long long)nt1 * (long long)kstep : 0ll; const char* _g = (g1) + (size_t)_t * kstep + _d; \
        _Pragma("unroll") for (int _i = 0; _i < 2; ++_i) { const unsigned _o = (o1)[_i] + (_s2 ? ((o1)[_i] >> 11) * dK2 : 0u); \
        __builtin_amdgcn_global_load_lds((const unsigned*)(_g + _o), (LAS unsigned*)(lds + (bufoff) + ldsw + _i * 8192), 16, 0, 0); } } while (0)
#define PG8_STA(b, h, tau) PG8_STX(PG8_SA(b, h), tau, sA1, sA2, offA1[h], 0)
#define PG8_STB(b, h, tau) PG8_STX(PG8_SB(b, h), tau, sB1, sB2, offB1[h], 0)
#define PG8_LDA(dst, b, h) do { _Pragma("unroll") for (int m = 0; m < 4; ++m) _Pragma("unroll") for (int k = 0; k < 2; ++k) dst[m][k] = *(const LAS bf16x8*)(lds + PG8_SA(b, h) + aoff + m * 2048 + k * 1024); } while (0)
#define PG8_LDB(dst, b, h) do { _Pragma("unroll") for (int n = 0; n < 2; ++n) _Pragma("unroll") for (int k = 0; k < 2; ++k) dst[n][k] = *(const LAS bf16x8*)(lds + PG8_SB(b, h) + boff + n * 2048 + k * 1024); } while (0)
#define PG8_MMA(ai, bj, At, Bt) do { __builtin_amdgcn_s_setprio(1); _Pragma("unroll") for (int m = 0; m < 4; ++m) _Pragma("unroll") for (int n = 0; n < 2; ++n) _Pragma("unroll") for (int k = 0; k < 2; ++k) \
        acc[ai][bj][m][n] = __builtin_amdgcn_mfma_f32_16x16x32_bf16(Bt[n][k], At[m][k], acc[ai][bj][m][n], 0, 0, 0); __builtin_amdgcn_s_setprio(0); } while (0)
#define PG8_WAIT_V(n) asm volatile("s_waitcnt vmcnt(" #n ")" ::: "memory")
#define PG8_WAIT_L(n) asm volatile("s_waitcnt lgkmcnt(" #n ")" ::: "memory")
#define PG8_BAR __builtin_amdgcn_s_barrier()
#define PG8_SCHED __builtin_amdgcn_sched_barrier(0)
    Unit cur, nxt; int ui = 0;
    if (!S.next(0, cur)) return;
    f32x4 acc[2][2][4][2];
#pragma unroll
    for (int a = 0; a < 2; ++a)
#pragma unroll
        for (int b = 0; b < 2; ++b)
#pragma unroll
            for (int m = 0; m < 4; ++m)
#pragma unroll
                for (int n = 0; n < 2; ++n) acc[a][b][m][n] = (f32x4){0.f, 0.f, 0.f, 0.f};
    bf16x8 At[4][2], B0[2][2], B1[2][2];
    const char* sA1 = (const char*)A1 + (size_t)cur.pm * 256 * K1 * 2; const char* sB1 = (const char*)Bt1 + (size_t)cur.pn * 256 * K1 * 2;
    const char* sA2 = (const char*)A2 + (size_t)cur.pm * 256 * K2 * 2; const char* sB2 = (const char*)Bt2 + (size_t)cur.pn * 256 * K2 * 2;
    PG8_STB(0, 0, 0); PG8_STB(0, 1, 0); PG8_STA(0, 0, 0); PG8_STA(0, 1, 0);
    if (wr == 1) PG8_BAR;
    PG8_WAIT_V(2); PG8_BAR;
    PG8_STB(1, 0, 1); PG8_STA(1, 0, 1); PG8_STB(1, 1, 1);
    PG8_WAIT_V(6); PG8_BAR;
    for (;;) {
        const bool has_next = S.next(ui + 1, nxt);
        const int npm = has_next ? nxt.pm : cur.pm, npn = has_next ? nxt.pn : cur.pn;
        const char* nA1 = (const char*)A1 + (size_t)npm * 256 * K1 * 2; const char* nB1 = (const char*)Bt1 + (size_t)npn * 256 * K1 * 2;
        const char* nA2 = (const char*)A2 + (size_t)npm * 256 * K2 * 2; const char* nB2 = (const char*)Bt2 + (size_t)npn * 256 * K2 * 2;
        for (int t = 0; t < nt; t += 2) {
            const bool last = (t == nt - 2);
            const int t2 = last ? 0 : t + 2, t3 = last ? 1 : t + 3;
            if (t == nt1) { E.mid(acc, cur, wr, wc, fr, fq); PG8_SCHED; }
            PG8_LDB(B0, 0, 0); PG8_LDB(B1, 0, 1); PG8_SCHED; PG8_LDA(At, 0, 0); PG8_STA(1, 1, t + 1);
            PG8_WAIT_V(8); PG8_WAIT_L(0); PG8_BAR; PG8_MMA(0, 0, At, B0); PG8_MMA(0, 1, At, B1); PG8_BAR; PG8_SCHED;
            if (last) { sA1 = nA1; sB1 = nB1; sA2 = nA2; sB2 = nB2; }
            PG8_LDA(At, 0, 1); PG8_STB(0, 0, t2); PG8_STB(0, 1, t2); PG8_STA(0, 0, t2);
            PG8_WAIT_V(8); PG8_WAIT_L(0); PG8_BAR; PG8_MMA(1, 0, At, B0); PG8_MMA(1, 1, At, B1); PG8_BAR; PG8_SCHED;
            PG8_LDB(B0, 1, 0); PG8_LDB(B1, 1, 1); PG8_SCHED; PG8_LDA(At, 1, 0); PG8_STA(0, 1, t2);
            PG8_WAIT_V(8); PG8_WAIT_L(0); PG8_BAR; PG8_MMA(0, 0, At, B0); PG8_MMA(0, 1, At, B1); PG8_BAR; PG8_SCHED;
            PG8_LDA(At, 1, 1); PG8_STB(1, 0, t3); PG8_STB(1, 1, t3); PG8_STA(1, 0, t3);
            PG8_WAIT_V(8); PG8_WAIT_L(0); PG8_BAR; PG8_MMA(1, 0, At, B0); PG8_MMA(1, 1, At, B1); PG8_BAR; PG8_SCHED;
        }
        if (wr == 0) PG8_BAR;
        E(acc, cur, wr, wc, fr, fq);
        if (!has_next) break;
#pragma unroll
        for (int a = 0; a < 2; ++a)
#pragma unroll
            for (int b = 0; b < 2; ++b)
#pragma unroll
                for (int m = 0; m < 4; ++m)
#pragma unroll
                    for (int n = 0; n < 2; ++n) acc[a][b][m][n] = (f32x4){0.f, 0.f, 0.f, 0.f};
        cur = nxt; ++ui;
        if (wr == 1) PG8_BAR;
    }
    PG8_WAIT_V(0);
    PG8_BAR;
#undef PG8_SA
#undef PG8_SB
#undef PG8_STX
#undef PG8_STA
#undef PG8_STB
#undef PG8_LDA
#undef PG8_LDB
#undef PG8_MMA
#undef PG8_WAIT_V
#undef PG8_WAIT_L
#undef PG8_BAR
#undef PG8_SCHED
}
__device__ __forceinline__ v4u pack8(f32x4 v0, f32x4 v1) { v4u w; w.x = cvt_pk_bf16(v0[0], v0[1]); w.y = cvt_pk_bf16(v0[2], v0[3]); w.z = cvt_pk_bf16(v1[0], v1[1]); w.w = cvt_pk_bf16(v1[2], v1[3]); return w; }
__device__ __forceinline__ float sigm(float v) { return __builtin_amdgcn_rcpf(1.0f + __expf(-v)); }

struct EpiMergedDual {
    static constexpr bool PERM = true;
    const bf16* ga; const bf16* gb; bf16* merged;
    __device__ __forceinline__ void mid(f32x4 (&acc)[2][2][4][2], const Unit& u, int wr, int wc, int fr, int fq) const {
        int row0 = u.pm * BM + wr * 64 + fr; const int col0 = u.pn * BM + wc * 32 + 8 * fq;
        asm volatile("" : "+v"(row0));
#pragma unroll
        for (int ai = 0; ai < 2; ++ai)
#pragma unroll
            for (int m = 0; m < 4; ++m) { const size_t o = (size_t)(row0 + ai * HALF + m * 16) * 1024 + col0;
#pragma unroll
                for (int bj = 0; bj < 2; ++bj) { const v4u a = *(const v4u*)(ga + o + bj * HALF), b = *(const v4u*)(gb + o + bj * HALF);
                    f32x4 r0 = {bflo(a.x) * __builtin_amdgcn_rcpf(bflo(b.x)), bfhi(a.x) * __builtin_amdgcn_rcpf(bfhi(b.x)), bflo(a.y) * __builtin_amdgcn_rcpf(bflo(b.y)), bfhi(a.y) * __builtin_amdgcn_rcpf(bfhi(b.y))};
                    f32x4 r1 = {bflo(a.z) * __builtin_amdgcn_rcpf(bflo(b.z)), bfhi(a.z) * __builtin_amdgcn_rcpf(bfhi(b.z)), bflo(a.w) * __builtin_amdgcn_rcpf(bflo(b.w)), bfhi(a.w) * __builtin_amdgcn_rcpf(bfhi(b.w))};
                    acc[ai][bj][m][0] = acc[ai][bj][m][0] * r0; acc[ai][bj][m][1] = acc[ai][bj][m][1] * r1; }
                asm volatile("" ::: "memory"); }
    }
    __device__ __forceinline__ void operator()(const f32x4 (&acc)[2][2][4][2], const Unit& u, int wr, int wc, int fr, int fq) const {
        int row0 = u.pm * BM + wr * 64 + fr; const int col0 = u.pn * BM + wc * 32 + 8 * fq;
        asm volatile("" : "+v"(row0));
#pragma unroll
        for (int ai = 0; ai < 2; ++ai)
#pragma unroll
            for (int m = 0; m < 4; ++m) { const size_t o = (size_t)(row0 + ai * HALF + m * 16) * 1024 + col0;
#pragma unroll
                for (int bj = 0; bj < 2; ++bj) { const v4u g = *(const v4u*)(gb + o + bj * HALF);
                    f32x4 g0 = {bflo(g.x), bfhi(g.x), bflo(g.y), bfhi(g.y)}, g1 = {bflo(g.z), bfhi(g.z), bflo(g.w), bfhi(g.w)};
                    *(v4u*)(merged + o + bj * HALF) = pack8(g0 * acc[ai][bj][m][0], g1 * acc[ai][bj][m][1]); } }
    }
};
struct EpiProj {
    static constexpr bool PERM = true;
    unsigned char* ws;
    __device__ __forceinline__ void operator()(const f32x4 (&acc)[2][2][4][2], const Unit& u, int wr, int wc, int fr, int fq) const {
        const int row0 = u.pm * BM + wr * 64 + fr, cw = wc * 32 + 8 * fq, pn = u.pn;
        if (pn == 4) {
#pragma unroll
            for (int ai = 0; ai < 2; ++ai)
#pragma unroll
                for (int m = 0; m < 4; ++m) { const size_t row = (size_t)(row0 + ai * HALF + m * 16);
                    float* cr = (float*)(ws + WS_CKVRAW) + row * 128 + cw; *(f32x4*)cr = acc[ai][0][m][0]; *(f32x4*)(cr + 4) = acc[ai][0][m][1];
                    if (cw < 64) *(v4u*)((bf16*)(ws + WS_KIDX) + ((((row >> 4) * 8 + (cw >> 3)) * 16 + (row & 15)) << 3)) = pack8(acc[ai][1][m][0], acc[ai][1][m][1]);
                    else if (cw == 64) { float* wr_ = (float*)(ws + WS_WIDX) + row * 8; *(f32x4*)wr_ = acc[ai][1][m][0] * IDXW_SCALE; *(f32x4*)(wr_ + 4) = acc[ai][1][m][1] * IDXW_SCALE; } }
            return;
        }
        bf16* base; int ld, c0; float sc = 1.f; bool sg = false;
        if (pn < 4) { base = (bf16*)(ws + WS_QLAT); ld = 1024; c0 = pn * 256; sc = ATT_SCALE; }
        else if (pn < 7) { base = (bf16*)(ws + WS_QIDX); ld = 512; c0 = (pn - 5) * 256; }
        else if (pn < 9) { base = (bf16*)(ws + WS_QB); ld = 512; c0 = (pn - 7) * 256; sc = 0.125f; }
        else if (pn == 9) { base = (bf16*)(ws + WS_KB); ld = 128; c0 = 0; }
        else if (pn < 14) { base = (bf16*)(ws + WS_GA); ld = 1024; c0 = (pn - 10) * 256; sg = true; }
        else { base = (bf16*)(ws + WS_GB); ld = 1024; c0 = (pn - 14) * 256; sg = true; }
        const size_t bjstep = (pn == 9) ? (size_t)(WS_VB - WS_KB) / 2 : (size_t)HALF;
#pragma unroll
        for (int ai = 0; ai < 2; ++ai)
#pragma unroll
            for (int m = 0; m < 4; ++m) { bf16* rowp = base + (size_t)(row0 + ai * HALF + m * 16) * ld + c0 + cw;
#pragma unroll
                for (int bj = 0; bj < 2; ++bj) { f32x4 v0 = acc[ai][bj][m][0], v1 = acc[ai][bj][m][1];
                    if (sg) {
#pragma unroll
                        for (int j = 0; j < 4; ++j) { v0[j] = sigm(v0[j]); v1[j] = sigm(v1[j]); } }
                    else { v0 = v0 * sc; v1 = v1 * sc; }
                    *(v4u*)(rowp + bj * bjstep) = pack8(v0, v1); } }
    }
};
struct EpiWoutM {
    static constexpr bool PERM = true;
    const float* x; float* out;
    __device__ __forceinline__ void operator()(const f32x4 (&acc)[2][2][4][2], const Unit& u, int wr, int wc, int fr, int fq) const {
        const int row0 = u.pm * BM + wr * 64 + fr, col0 = u.pn * BM + wc * 32 + 8 * fq;
#pragma unroll
        for (int ai = 0; ai < 2; ++ai)
#pragma unroll
            for (int m = 0; m < 4; ++m) { const size_t o = (size_t)(row0 + ai * HALF + m * 16) * 1024 + col0;
#pragma unroll
                for (int bj = 0; bj < 2; ++bj) { const f32x4 x0 = *(const f32x4*)(x + o + bj * HALF), x1 = *(const f32x4*)(x + o + bj * HALF + 4);
                    *(f32x4*)(out + o + bj * HALF) = x0 * ALPHA + acc[ai][bj][m][0]; *(f32x4*)(out + o + bj * HALF + 4) = x1 * ALPHA + acc[ai][bj][m][1]; } }
    }
};
constexpr int MOE_TB_OFF = 131072 + 1024;
constexpr int CW_RDY = 16384;
constexpr int CW_TMO = 8;
struct MoeOrder {
    const LAS int* tb; int npn, G, c; unsigned* ctl;
    __device__ bool next(int i, Unit& u) const {
        const int L = i * G + c; if (L >= tb[32] * npn) return false;
        const int rt = L / npn, pn = L - rt * npn; int e = 0;
        for (int j = 1; j < 32; ++j) e = (tb[j] <= rt) ? j : e;
        u.pm = rt; u.pn = pn; u.pb = e * npn + pn; u.aux = e; return true;
    }
    __device__ __forceinline__ void a_ready(const Unit&) const {}
    __device__ __forceinline__ void done(const Unit& u) const {
        asm volatile("s_waitcnt vmcnt(0)" ::: "memory");
        if ((threadIdx.x & 63) == 0) __hip_atomic_fetch_add(ctl + CW_RDY + 64 * u.pm, 1u, __ATOMIC_RELAXED, __HIP_MEMORY_SCOPE_AGENT);
    }
};
struct MoeDownOrder {
    const LAS int* tb; int G, c; unsigned* ctl;
    __device__ bool next(int i, Unit& u) const {
        const int nT = tb[32], nD = 4 * nT; int R = 2 * nT - G; R = R < 0 ? 0 : (R > G ? G : R);
        int L;
        if (c >= R) { L = (i < 4) ? i * (G - R) + (c - R) : 4 * (G - R) + (i - 4) * G + c; }
        else { L = 4 * (G - R) + i * G + c; }
        if (L >= nD) return false;
        const int rt = L >> 2, pn = L & 3; int e = 0;
        for (int j = 1; j < 32; ++j) e = (tb[j] <= rt) ? j : e;
        u.pm = rt; u.pn = pn; u.pb = e * 4 + pn; u.aux = e; return true;
    }
    __device__ __forceinline__ void a_ready(const Unit& u) const {
        if (threadIdx.x < 64) {
            unsigned* w = ctl + CW_RDY + 64 * u.pm; unsigned sp = 0;
            while ((unsigned)__builtin_amdgcn_readfirstlane(__hip_atomic_load(w, __ATOMIC_RELAXED, __HIP_MEMORY_SCOPE_AGENT)) < 16u) {
                __builtin_amdgcn_s_sleep(2);
                if ((++sp & 1023u) == 0u) { if (__hip_atomic_load(ctl + CW_TMO, __ATOMIC_RELAXED, __HIP_MEMORY_SCOPE_AGENT) != 0u) break;
                    if (sp > (1u << 22)) { __hip_atomic_store(ctl + CW_TMO, 1u, __ATOMIC_RELAXED, __HIP_MEMORY_SCOPE_AGENT); break; } } }
            __builtin_amdgcn_fence(__ATOMIC_ACQUIRE, "agent");
            asm volatile("s_waitcnt vmcnt(0)" ::: "memory");
        }
        asm volatile("" ::: "memory"); __builtin_amdgcn_s_barrier(); asm volatile("" ::: "memory");
    }
    __device__ __forceinline__ void done(const Unit&) const {}
};
struct GatherProb {
    static constexpr bool GATHER = true;
    const bf16* A; const bf16* Bt; int K; const LAS int* tb; const unsigned* list;
    __device__ __forceinline__ const char* a_base(const Unit&) const { return (const char*)A; }
    __device__ __forceinline__ const char* b_base(const Unit& u) const { return (const char*)Bt + (size_t)u.pb * 256 * K * 2; }
    __device__ __forceinline__ void a_offs(const Unit& u, int R0, int C0, int R1, int C1, unsigned (&o)[2][2]) const {
        const int e = u.aux, lbase = (u.pm - tb[e]) * 256, cnt = tb[64 + e];
        const unsigned* le = list + (size_t)e * 32768;
#pragma unroll
        for (int h = 0; h < 2; ++h) { const int l0 = lbase + h * HALF + R0, l1 = lbase + h * HALF + R1;
            const unsigned t0 = l0 < cnt ? (le[l0] >> 1) : 0u, t1 = l1 < cnt ? (le[l1] >> 1) : 0u;
            o[h][0] = (t0 * (unsigned)K + (unsigned)C0) * 2u; o[h][1] = (t1 * (unsigned)K + (unsigned)C1) * 2u; }
    }
};
struct EpiGU {
    static constexpr bool PERM = true;
    bf16* hbuf;
    __device__ __forceinline__ void operator()(const f32x4 (&acc)[2][2][4][2], const Unit& u, int wr, int wc, int fr, int fq) const {
        const int row0 = u.pm * BM + wr * 64 + fr, col0 = u.pn * HALF + wc * 32 + 8 * fq;
#pragma unroll
        for (int ai = 0; ai < 2; ++ai)
#pragma unroll
            for (int m = 0; m < 4; ++m) { f32x4 h0, h1;
#pragma unroll
                for (int j = 0; j < 4; ++j) { const float g0 = acc[ai][0][m][0][j], g1 = acc[ai][0][m][1][j];
                    h0[j] = g0 * sigm(g0) * acc[ai][1][m][0][j]; h1[j] = g1 * sigm(g1) * acc[ai][1][m][1][j]; }
                { const v4u hv = pack8(h0, h1); bf16* hp = hbuf + (size_t)(row0 + ai * HALF + m * 16) * 256 + col0;
                  asm volatile("global_store_dwordx4 %0, %1, off sc1\n\ts_nop 1" :: "v"(hp), "v"(hv) : "memory"); } }
    }
};
struct EpiDown {
    static constexpr bool PERM = true;
    bf16* slot; const LAS int* tb; const unsigned* list; const float* pw;
    __device__ __forceinline__ void operator()(const f32x4 (&acc)[2][2][4][2], const Unit& u, int wr, int wc, int fr, int fq) const {
        const int e = u.aux, lbase = (u.pm - tb[e]) * 256 + wr * 64 + fr, cnt = tb[64 + e], col0 = u.pn * BM + wc * 32 + 8 * fq;
        const unsigned* le = list + (size_t)e * 32768;
#pragma unroll
        for (int ai = 0; ai < 2; ++ai)
#pragma unroll
            for (int m = 0; m < 4; ++m) { const int l = lbase + ai * HALF + m * 16;
                if (l < cnt) { const unsigned pair = le[l]; const float w = pw[pair]; bf16* rowp = slot + (size_t)pair * 1024 + col0;
#pragma unroll
                    for (int bj = 0; bj < 2; ++bj) *(v4u*)(rowp + bj * HALF) = pack8(acc[ai][bj][m][0] * w, acc[ai][bj][m][1] * w); } }
    }
};
}

struct Args { const float* in[20]; float* out; unsigned char* ws; int ph_lo, ph_hi; };
__global__ void __launch_bounds__(NTHR, 2) fwd_kernel(Args args) {
    extern __shared__ __attribute__((aligned(16))) unsigned char lds_raw[];
    Ctx c;
    c.lds = (LAS unsigned char*)lds_raw;
    c.tid = threadIdx.x; c.lane = c.tid & 63; c.wave = __builtin_amdgcn_readfirstlane(c.tid >> 6); c.bid = blockIdx.x; c.G = gridDim.x;
    c.x = args.in[0]; c.w_in = args.in[1]; c.kv_g = args.in[2]; c.w_uv = args.in[3]; c.w_a = args.in[4]; c.sinks = args.in[5]; c.w_b = args.in[6]; c.w_out = args.in[7]; c.rel_bias = args.in[8];
    c.ln1_g = args.in[9]; c.ln1_b = args.in[10]; c.w_group = args.in[11]; c.b_group = args.in[12]; c.w_router = args.in[13]; c.b_router = args.in[14]; c.w_gate = args.in[15]; c.w_up = args.in[16]; c.w_down = args.in[17];
    c.ln2_g = args.in[18]; c.ln2_b = args.in[19]; c.out = args.out; c.ws = args.ws; unsigned char* ws = args.ws;
    c.ctl = (unsigned*)(ws + WS_CTL);
    volatile LAS unsigned* MISC = (volatile LAS unsigned*)(c.lds + MISC_OFF);
    if (c.tid < 32) MISC[c.tid] = 0u;
    __syncthreads();
    XcdBarrier bar; bar.bar = c.ctl + CW_BAR; bar.x = 0; bar.st = nullptr;
    if (MK_N_LAUNCHES == 1) bar = xcd_barrier_post(c.ctl + CW_BAR, MISC + 8);
    const int lo = args.ph_lo, hi = args.ph_hi;
#define IN(k) (lo <= (k) && (k) < hi)
#define SEAM(k) do { if (IN(k) && IN((k) + 1)) xcd_barrier(bar); } while (0)
    bf16* merged = ((bf16*)(c.ws + WS_QLAT)); bf16* x1b = ((bf16*)(c.ws + WS_XB));

    if (IN(0)) { p0_prologue(c); } SEAM(0);
    if (IN(1)) { pg8::DenseProb P{(const bf16*)(c.ws + WS_XB), (const bf16*)(c.ws + WS_WIN), 1024}; pg8::StaticOrder S; S.init(NTOK, NPROJ, c.G, c.bid); pg8::EpiProj E{c.ws};
        pg8::gemm_phase(c.lds, P, S, E); } SEAM(1);
    if (IN(2)) { p_rmsnorm(c); __syncthreads(); p2_indexer_topk(c); } SEAM(2);
    if (IN(3)) { p3a_dsa(c); p3b_swa(c); } SEAM(3);
    if (IN(4)) { pg8::StaticOrder S; S.init(NTOK, 1024, c.G, c.bid); pg8::EpiMergedDual E{(const bf16*)(c.ws + WS_GA), (const bf16*)(c.ws + WS_GB), merged};
        pg8::gemm_phase_dual(c.lds, (const bf16*)(c.ws + WS_XB), (const bf16*)(c.ws + WS_WC), 1024, (const bf16*)(c.ws + WS_QB), (const bf16*)(c.ws + WS_WB), 512, S, E); } SEAM(4);
    if (IN(5)) { pg8::DenseProb P{(const bf16*)merged, (const bf16*)(c.ws + WS_WO), 1024}; pg8::StaticOrder S; S.init(NTOK, 1024, c.G, c.bid); pg8::EpiWoutM E{c.x, c.out};
        pg8::gemm_phase(c.lds, P, S, E); } SEAM(5);
    if (IN(6)) { p6_ln_router(c, x1b); } SEAM(6);
    LAS int* tb = (LAS int*)(c.lds + pg8::MOE_TB_OFF);
    if (IN(7) || IN(8)) {
        if (c.tid < 32) tb[64 + c.tid] = (int)__hip_atomic_load(c.ctl + CW_CNT + c.tid, __ATOMIC_RELAXED, __HIP_MEMORY_SCOPE_AGENT);
        __syncthreads();
        if (c.tid == 0) { int a = 0; for (int e = 0; e < 32; ++e) { tb[e] = a; a += (tb[64 + e] + 255) >> 8; } tb[32] = a; }
        __syncthreads();
    }
    if (IN(7)) { pg8::GatherProb P{(const bf16*)x1b, (const bf16*)(c.ws + WS_WGU), 1024, tb, (const unsigned*)(c.ws + WS_LIST)}; pg8::MoeOrder S{tb, 2, c.G, c.bid, c.ctl}; pg8::EpiGU E{(bf16*)(c.ws + WS_QLAT)};
        pg8::gemm_phase(c.lds, P, S, E); }
    if (MK_N_LAUNCHES != 1) SEAM(7);
    if (IN(8)) { pg8::DenseProb P{(const bf16*)(c.ws + WS_QLAT), (const bf16*)(c.ws + WS_WD), 256}; pg8::MoeDownOrder S{tb, c.G, c.bid, c.ctl};
        pg8::EpiDown E{(bf16*)(c.ws + WS_SLOT), tb, (const unsigned*)(c.ws + WS_LIST), (const float*)(c.ws + WS_PW)};
        pg8::gemm_phase(c.lds, P, S, E); } SEAM(8);
    if (IN(9)) { p9_ln2(c); }
#undef IN
#undef SEAM
}

extern "C" void kernel_launch(void* const* d_in, const int* in_sizes, int n_in, void* d_out, int out_size, void* d_ws, size_t ws_size, hipStream_t stream) {
    static int grid = 0;
    if (grid == 0) {
        if (n_in != 20 || out_size != NTOK * D || ws_size < WS_END) { fprintf(stderr, "kernel_launch: unexpected shapes (n_in %d out %d ws %zu)\n", n_in, out_size, ws_size); grid = -1; return; }
        int dev = 0, cus = 0, per_cu = 0;
        if (hipGetDevice(&dev) != hipSuccess || hipDeviceGetAttribute(&cus, hipDeviceAttributeMultiprocessorCount, dev) != hipSuccess) { grid = -1; return; }
        if (hipFuncSetAttribute((const void*)fwd_kernel, hipFuncAttributeMaxDynamicSharedMemorySize, LDS_BYTES) != hipSuccess) { fprintf(stderr, "kernel_launch: hipFuncSetAttribute failed\n"); grid = -1; return; }
        if (hipOccupancyMaxActiveBlocksPerMultiprocessor(&per_cu, (const void*)fwd_kernel, NTHR, LDS_BYTES) != hipSuccess || per_cu < 1) { fprintf(stderr, "kernel_launch: occupancy query says %d\n", per_cu); }
        (void)hipGetLastError();
        grid = cus;
    }
    if (grid < 0) return;
    if (hipMemsetAsync((char*)d_ws + WS_CTL, 0, CTL_ZERO_BYTES, stream) != hipSuccess) return;
    Args a{};
    for (int i = 0; i < 20; ++i) a.in[i] = (const float*)d_in[i];
    a.out = (float*)d_out; a.ws = (unsigned char*)d_ws;
    if (MK_N_LAUNCHES == 1) { a.ph_lo = 0; a.ph_hi = NPHASE; hipLaunchKernelGGL(fwd_kernel, dim3(grid), dim3(NTHR), LDS_BYTES, stream, a); }
    else { for (int p = 0; p < NPHASE; ++p) { a.ph_lo = p; a.ph_hi = p + 1; hipLaunchKernelGGL(fwd_kernel, dim3(grid), dim3(NTHR), LDS_BYTES, stream, a); } }
}
```

```cpp
#include <hip/hip_runtime.h>
#include <cstdio>
#include <cstdint>

#ifndef MK_N_LAUNCHES
#define MK_N_LAUNCHES 1
#endif

constexpr int D = 1024, BATCH = 8, SEQ = 2048, NTOK = BATCH * SEQ;
constexpr int A_HEADS = 8, A_LAT = 128, IDX_HEADS = 8, IDX_DIM = 64, KSEL = 256;
constexpr int B_HEADS = 8, B_HD = 64, WINDOW = 128;
constexpr int NEXP = 32, EPG = 8, NGRP = 4, DEXP = 256;
constexpr int IN_WIDTH = 4552, NPROJ = 4608;
constexpr float ALPHA = 1.189207115002721f;
constexpr float LN_EPS = 1e-5f, RMS_EPS = 1e-6f;
constexpr float ATT_SCALE = 0.08838834764831845f;
constexpr float IDXW_SCALE = 0.125f * 0.35355339059327373f;
constexpr int NPHASE = 10;

constexpr size_t MiB = 1u << 20;
constexpr size_t WS_CTL = 0, CTL_ZERO_BYTES = 128 * 1024;
constexpr size_t WS_WIN = 1 * MiB;
constexpr size_t WS_SEL = 1 * MiB;
constexpr size_t WS_WC = 10 * MiB;
constexpr size_t WS_WB = 12 * MiB;
constexpr size_t WS_WO = 13 * MiB;
constexpr size_t WS_WIDX = 15 * MiB;
constexpr size_t WS_BIAS = 16 * MiB;
constexpr size_t WS_PE = 16 * MiB + 64 * 1024;
constexpr size_t WS_PW = 16 * MiB + 256 * 1024;
constexpr size_t WS_WGU = 17 * MiB;
constexpr size_t WS_WD = 49 * MiB;
constexpr size_t WS_XB = 65 * MiB;
constexpr size_t WS_QLAT = 97 * MiB;
constexpr size_t WS_CKV = 129 * MiB;
constexpr size_t WS_KIDX = 133 * MiB;
constexpr size_t WS_QIDX = 135 * MiB;
constexpr size_t WS_QB = 151 * MiB;
constexpr size_t WS_KB = 167 * MiB;
constexpr size_t WS_VB = 171 * MiB;
constexpr size_t WS_GA = 175 * MiB;
constexpr size_t WS_GB = 207 * MiB;
constexpr size_t WS_H1B = WS_GB;
constexpr size_t WS_CKVRAW = 239 * MiB;
constexpr size_t WS_LIST = 247 * MiB;
constexpr size_t WS_SLOT = 129 * MiB;
constexpr size_t WS_END = 252 * MiB;
constexpr int CW_CNT = 64;
constexpr int CW_BAR = 4096;

constexpr int NWAVES = 8, NTHR = 512;
constexpr int LDS_BYTES = 155648;
constexpr int MISC_OFF = 131072 + 320;

#define GAS __attribute__((address_space(1)))
#define LAS __attribute__((address_space(3)))
typedef unsigned short bf16;
typedef unsigned v4u __attribute__((ext_vector_type(4)));
typedef unsigned v2u __attribute__((ext_vector_type(2)));
typedef float f32x4 __attribute__((ext_vector_type(4)));

__device__ __forceinline__ float bf2f(unsigned v) { return __builtin_bit_cast(float, v << 16); }
__device__ __forceinline__ float bflo(unsigned v) { return __builtin_bit_cast(float, v << 16); }
__device__ __forceinline__ float bfhi(unsigned v) { return __builtin_bit_cast(float, v & 0xffff0000u); }
__device__ __forceinline__ unsigned f2bf(float f) { unsigned u = __builtin_bit_cast(unsigned, f); return (u + 0x7fffu + ((u >> 16) & 1u)) >> 16; }
__device__ __forceinline__ unsigned cvt_pk(float lo, float hi) { unsigned r; asm volatile("v_cvt_pk_bf16_f32 %0, %1, %2" : "=v"(r) : "v"(lo), "v"(hi)); return r; }
__device__ __forceinline__ unsigned pk2(float lo, float hi) { return f2bf(lo) | (f2bf(hi) << 16); }
__device__ __forceinline__ float wave_sum(float v) {
#pragma unroll
    for (int o = 1; o < 64; o <<= 1) v += __shfl_xor(v, o);
    return v;
}
__device__ __forceinline__ float wave_max(float v) {
#pragma unroll
    for (int o = 1; o < 64; o <<= 1) v = fmaxf(v, __shfl_xor(v, o));
    return v;
}

typedef unsigned u2v __attribute__((ext_vector_type(2)));
#define DPP_I(v, ctrl) __builtin_amdgcn_update_dpp(0, (v), (ctrl), 0xf, 0xf, true)
#define DPP_F(v, ctrl) __builtin_bit_cast(float, __builtin_amdgcn_update_dpp(0, __builtin_bit_cast(int, (v)), (ctrl), 0xf, 0xf, true))
__device__ __forceinline__ void swap16(unsigned a, unsigned& x, unsigned& y) { auto r = __builtin_amdgcn_permlane16_swap(a, a, false, false); x = r[0]; y = r[1]; }
__device__ __forceinline__ void swap32(unsigned a, unsigned& x, unsigned& y) { auto r = __builtin_amdgcn_permlane32_swap(a, a, false, false); x = r[0]; y = r[1]; }
__device__ __forceinline__ float x16_sum(float v) { unsigned x, y; swap16(__builtin_bit_cast(unsigned, v), x, y); return __builtin_bit_cast(float, x) + __builtin_bit_cast(float, y); }
__device__ __forceinline__ float x16_max(float v) { unsigned x, y; swap16(__builtin_bit_cast(unsigned, v), x, y); return fmaxf(__builtin_bit_cast(float, x), __builtin_bit_cast(float, y)); }
__device__ __forceinline__ float x16_min(float v) { unsigned x, y; swap16(__builtin_bit_cast(unsigned, v), x, y); return fminf(__builtin_bit_cast(float, x), __builtin_bit_cast(float, y)); }
__device__ __forceinline__ int x16_sumi(int v) { unsigned x, y; swap16((unsigned)v, x, y); return (int)(x + y); }
__device__ __forceinline__ float x32_sum(float v) { unsigned x, y; swap32(__builtin_bit_cast(unsigned, v), x, y); return __builtin_bit_cast(float, x) + __builtin_bit_cast(float, y); }
__device__ __forceinline__ float x32_max(float v) { unsigned x, y; swap32(__builtin_bit_cast(unsigned, v), x, y); return fmaxf(__builtin_bit_cast(float, x), __builtin_bit_cast(float, y)); }

#define XB_TMO      128
#define XB_XCNT(j)  (256  + 64 * (j))
#define XB_XSUB(j)  (1280 + 64 * (j))
#define XB_XGEN(j)  (2304 + 64 * (j))
#define XB_TOP      3328
#define XB_TOPGEN   3392
#define XCD_BAR_WORDS 3456
#define XB_SPIN_CAP (1u << 22)

__device__ __forceinline__ unsigned xb_ld(unsigned* p)              { return __hip_atomic_load(p, __ATOMIC_RELAXED, __HIP_MEMORY_SCOPE_AGENT); }
__device__ __forceinline__ unsigned xb_add(unsigned* p, unsigned v) { return __hip_atomic_fetch_add(p, v, __ATOMIC_RELAXED, __HIP_MEMORY_SCOPE_AGENT); }
__device__ __forceinline__ unsigned xb_xcc_id() { return (unsigned)__builtin_amdgcn_s_getreg((3 << 11) | 20) & 0xFu; }
#define XB_SPIN(cond, bar) do { unsigned _sp = 0; while (cond) { __builtin_amdgcn_s_sleep(1); \
    if ((++_sp & 255u) == 0u) { if (xb_ld(&(bar)[XB_TMO])) break; if (_sp > XB_SPIN_CAP) { atomicAdd(&(bar)[XB_TMO], 1u); break; } } } } while (0)

struct XcdBarrier { unsigned* bar; unsigned x; volatile LAS unsigned* st; };

__device__ __forceinline__ XcdBarrier xcd_barrier_post(unsigned* bar, volatile LAS unsigned* st) {
    XcdBarrier b; b.bar = bar; b.x = xb_xcc_id(); b.st = st;
    if (threadIdx.x == 0) (void)xb_add(&bar[XB_XCNT(b.x)], 1u);
    return b;
}
__device__ __forceinline__ void xcd_barrier_complete(unsigned* bar, unsigned x, unsigned& nloc, unsigned& nx) {
    const unsigned G = gridDim.x * gridDim.y * gridDim.z;
    unsigned sum, cnt, mine, sp = 0u;
    for (;;) {
        sum = 0u; cnt = 0u; mine = 0u;
#pragma unroll
        for (unsigned j = 0; j < 16; ++j) { const unsigned c = xb_ld(&bar[XB_XCNT(j)]); sum += c; cnt += (c > 0u) ? 1u : 0u; mine = (j == x) ? c : mine; }
        if (sum == G) break;
        __builtin_amdgcn_s_sleep(1);
        if ((++sp & 255u) == 0u) { if (xb_ld(&bar[XB_TMO])) break; if (sp > XB_SPIN_CAP) { atomicAdd(&bar[XB_TMO], 1u); break; } }
    }
    nloc = mine > 0u ? mine : 1u; nx = cnt > 0u ? cnt : 1u;
}
__device__ __forceinline__ void xcd_barrier(const XcdBarrier& b) {
    asm volatile("s_waitcnt vmcnt(0)" ::: "memory");
    __syncthreads();
    if (threadIdx.x == 0) {
        unsigned* bar = b.bar;
        __builtin_amdgcn_s_waitcnt(0);
        unsigned nloc = b.st[0], nx = b.st[1];
        if (nloc == 0u) { xcd_barrier_complete(bar, b.x, nloc, nx); b.st[0] = nloc; b.st[1] = nx; }
        const unsigned old = xb_add(&bar[XB_XSUB(b.x)], 1u);
        const unsigned gen = old / nloc;
        if (old + 1u == (gen + 1u) * nloc) {
            __builtin_amdgcn_fence(__ATOMIC_RELEASE, "agent");
            asm volatile("s_waitcnt vmcnt(0)" ::: "memory");
            const unsigned og = xb_add(&bar[XB_TOP], 1u);
            const unsigned tg = og / nx;
            if (og + 1u == (tg + 1u) * nx) xb_add(&bar[XB_TOPGEN], 1u);
            else XB_SPIN(xb_ld(&bar[XB_TOPGEN]) == tg, bar);
            __builtin_amdgcn_fence(__ATOMIC_ACQUIRE, "agent");
            xb_add(&bar[XB_XGEN(b.x)], 1u);
            asm volatile("s_waitcnt vmcnt(0)" ::: "memory");
        } else {
            XB_SPIN(xb_ld(&bar[XB_XGEN(b.x)]) == gen, bar);
            __builtin_amdgcn_fence(__ATOMIC_ACQUIRE, "agent");
            asm volatile("s_waitcnt vmcnt(0)" ::: "memory");
        }
    }
    __syncthreads();
}

struct Ctx {
    const float *x, *w_in, *kv_g, *w_uv, *w_a, *sinks, *w_b, *w_out, *rel_bias, *ln1_g, *ln1_b, *w_group, *b_group, *w_router, *b_router, *w_gate, *w_up, *w_down, *ln2_g, *ln2_b;
    float* out;
    unsigned char* ws;
    unsigned* ctl;
    __device__ __forceinline__ bf16* P(size_t off) const { return (bf16*)(ws + off); }
    LAS unsigned char* lds;
    int tid, lane, wave, bid, G;
};

__device__ __forceinline__ int proj_src_col(int j) {
    if (j < 1024) return j;
    if (j < 1152) return j;
    if (j < 1216) return 1664 + (j - 1152);
    if (j < 1224) return 1728 + (j - 1216);
    if (j < 1280) return -1;
    if (j < 1792) return 1152 + (j - 1280);
    if (j < 2304) return 1736 + (j - 1792);
    if (j < 2432) return 2248 + (j - 2304);
    if (j < 2560) return 2376 + (j - 2432);
    if (j < 3584) return 2504 + (j - 2560);
    return 3528 + (j - 3584);
}
__device__ __forceinline__ float sigmoidf_(float v) { return 1.0f / (1.0f + __expf(-v)); }

template <class Src> __device__ __forceinline__ void titem_load(const Ctx& c, const Src& src, int k0, int n0, f32x4 (&tv)[8]) {
    const int kr = c.lane >> 3, n4 = (c.lane & 7) * 4;
#pragma unroll
    for (int i = 0; i < 8; ++i) tv[i] = src.v4(k0 + 8 * i + kr, n0 + n4);
}
__device__ __forceinline__ void titem_finish(const Ctx& c, LAS float* scr, const f32x4 (&tv)[8], bf16* dst, int dstK, int k0, int n0) {
    const int lane = c.lane, kr = lane >> 3, n4 = (lane & 7) * 4;
#pragma unroll
    for (int i = 0; i < 8; ++i) { LAS float* d = scr + (8 * i + kr) * 33 + n4; d[0] = tv[i].x; d[1] = tv[i].y; d[2] = tv[i].z; d[3] = tv[i].w; }
    asm volatile("s_waitcnt lgkmcnt(0)" ::: "memory");
    const int cc = lane & 7;
#pragma unroll
    for (int j = 0; j < 4; ++j) { const int n = (lane >> 3) + 8 * j; const LAS float* q = scr + (8 * cc) * 33 + n;
        v4u o; o.x = pk2(q[0 * 33], q[1 * 33]); o.y = pk2(q[2 * 33], q[3 * 33]); o.z = pk2(q[4 * 33], q[5 * 33]); o.w = pk2(q[6 * 33], q[7 * 33]);
        *(v4u*)(dst + (size_t)(n0 + n) * dstK + k0 + 8 * cc) = o; }
    asm volatile("s_waitcnt lgkmcnt(0)" ::: "memory");
}
template <class Src> __device__ __forceinline__ void transpose_item(const Ctx& c, LAS float* scr, const Src& src, bf16* dst, int dstK, int k0, int n0) {
    f32x4 tv[8]; titem_load(c, src, k0, n0, tv); titem_finish(c, scr, tv, dst, dstK, k0, n0);
}
struct SrcWin { const float* w; __device__ __forceinline__ f32x4 v4(int k, int n) const { const int s = proj_src_col(n); return s < 0 ? (f32x4){0.f, 0.f, 0.f, 0.f} : *(const f32x4*)(w + (size_t)k * IN_WIDTH + s); } };
struct SrcPlain { const float* w; int N; __device__ __forceinline__ f32x4 v4(int k, int n) const { return *(const f32x4*)(w + (size_t)k * N + n); } };
struct SrcShift { const float* w; int N; int shift; __device__ __forceinline__ f32x4 v4(int k, int n) const { return *(const f32x4*)(w + (size_t)k * N + n + shift); } };

__device__ __forceinline__ float t5_bias_bucket(int dist) {
    if (dist < 16) return (float)dist;
    int b = 16 + (int)(logf((float)dist / 16.0f) / logf(8.0f) * 16.0f);
    return (float)(b < 31 ? b : 31);
}
constexpr int P0_EXPERT_ITEMS = 32 * 256 + 32 * 128;
__device__ __forceinline__ void p0_expert_item(const Ctx& c, LAS float* scr, int r) {
    constexpr int I_GU = 32 * 256;
    if (r < I_GU) { const int e = r / 256, q = r % 256, n0 = (q / 16) * 32, half = (n0 >> 7) & 1, col0 = (n0 >> 8) * 128 + (n0 & 127);
        if (half) { SrcShift s_{c.w_up + (size_t)e * 1024 * 256, DEXP, col0 - n0}; transpose_item(c, scr, s_, (bf16*)(c.ws + WS_WGU) + (size_t)e * 512 * 1024, 1024, (q % 16) * 64, n0); }
        else { SrcShift s_{c.w_gate + (size_t)e * 1024 * 256, DEXP, col0 - n0}; transpose_item(c, scr, s_, (bf16*)(c.ws + WS_WGU) + (size_t)e * 512 * 1024, 1024, (q % 16) * 64, n0); }
        return; }
    r -= I_GU;
    { const int e = r / 128, q = r % 128; SrcPlain s_{c.w_down + (size_t)e * 256 * 1024, 1024};
        transpose_item(c, scr, s_, (bf16*)(c.ws + WS_WD) + (size_t)e * 1024 * 256, 256, (q % 4) * 64, (q / 4) * 32); }
}
__device__ __forceinline__ void ex_item_load(const Ctx& c, int r, f32x4 (&tv)[8]) {
    constexpr int I_GU = 32 * 256;
    if (r < I_GU) { const int e = r / 256, q = r % 256, n0 = (q / 16) * 32, half = (n0 >> 7) & 1, col0 = (n0 >> 8) * 128 + (n0 & 127);
        if (half) { SrcShift s_{c.w_up + (size_t)e * 1024 * 256, DEXP, col0 - n0}; titem_load(c, s_, (q % 16) * 64, n0, tv); }
        else { SrcShift s_{c.w_gate + (size_t)e * 1024 * 256, DEXP, col0 - n0}; titem_load(c, s_, (q % 16) * 64, n0, tv); } }
    else { r -= I_GU; const int e = r / 128, q = r % 128; SrcPlain s_{c.w_down + (size_t)e * 256 * 1024, 1024}; titem_load(c, s_, (q % 4) * 64, (q / 4) * 32, tv); }
}
__device__ __forceinline__ void ex_item_finish(const Ctx& c, LAS float* scr, int r, const f32x4 (&tv)[8]) {
    constexpr int I_GU = 32 * 256;
    if (r < I_GU) { const int e = r / 256, q = r % 256; titem_finish(c, scr, tv, (bf16*)(c.ws + WS_WGU) + (size_t)e * 512 * 1024, 1024, (q % 16) * 64, (q / 16) * 32); }
    else { r -= I_GU; const int e = r / 128, q = r % 128; titem_finish(c, scr, tv, (bf16*)(c.ws + WS_WD) + (size_t)e * 1024 * 256, 256, (q % 4) * 64, (q / 4) * 32); }
}
constexpr size_t WS_WRT = 16 * MiB + 512 * 1024;
__device__ __forceinline__ void p0_prologue(const Ctx& c) {
    { const size_t n8 = (size_t)NTOK * D / 8; const f32x4* xs = (const f32x4*)c.x; v4u* xd = (v4u*)((bf16*)(c.ws + WS_XB));
      const size_t st = (size_t)c.G * NTHR;
      size_t i = (size_t)c.bid * NTHR + c.tid;
      for (; i + 3 * st < n8; i += 4 * st) { f32x4 a[4], b[4];
#pragma unroll
          for (int u = 0; u < 4; ++u) { a[u] = xs[2 * (i + u * st)]; b[u] = xs[2 * (i + u * st) + 1]; }
#pragma unroll
          for (int u = 0; u < 4; ++u) { v4u o; o.x = pk2(a[u].x, a[u].y); o.y = pk2(a[u].z, a[u].w); o.z = pk2(b[u].x, b[u].y); o.w = pk2(b[u].z, b[u].w); xd[i + u * st] = o; } }
      for (; i < n8; i += st) { const f32x4 a = xs[2 * i], b = xs[2 * i + 1]; v4u o; o.x = pk2(a.x, a.y); o.y = pk2(a.z, a.w); o.z = pk2(b.x, b.y); o.w = pk2(b.z, b.w); xd[i] = o; } }
    { LAS float* scr = (LAS float*)(c.lds + c.wave * 8704);
      constexpr int I_WIN = 16 * 144, I_WB = 8 * 32, I_WO = 16 * 32, I_ALL = I_WIN + I_WB + I_WO;
      for (int it = c.bid * NWAVES + c.wave; it < I_ALL; it += c.G * NWAVES) {
        int r = it;
        if (r < I_WIN) { SrcWin s_{c.w_in}; transpose_item(c, scr, s_, (bf16*)(c.ws + WS_WIN), 1024, (r % 16) * 64, (r / 16) * 32); continue; } r -= I_WIN;
        if (r < I_WB) { SrcPlain s_{c.w_b, 1024}; transpose_item(c, scr, s_, (bf16*)(c.ws + WS_WB), 512, (r % 8) * 64, (r / 8) * 32); continue; } r -= I_WB;
        { SrcPlain s_{c.w_out, 1024}; transpose_item(c, scr, s_, (bf16*)(c.ws + WS_WO), 1024, (r % 16) * 64, (r / 16) * 32); }
      } }
    __syncthreads();
    { LAS float* tile = (LAS float*)c.lds; LAS float* Us = tile + 64 * 65; LAS float* As = Us + 64 * 65;
      for (int tI = c.bid; tI < 256; tI += c.G) { const int k0 = (tI & 15) * 64, n0 = (tI >> 4) * 64, h = k0 >> 7;
        const int r = c.tid >> 6, cc = c.tid & 63;
#pragma unroll
        for (int pI = 0; pI < 8; ++pI) { const int kk = pI * 8 + r; Us[kk * 65 + cc] = c.w_uv[(size_t)(k0 + kk) * 64 + cc]; As[kk * 65 + cc] = c.w_a[(size_t)(h * 64 + kk) * 1024 + n0 + cc]; }
        __syncthreads();
#pragma unroll
        for (int pI = 0; pI < 8; ++pI) { const int kk = pI * 8 + r; float a = 0.f;
#pragma unroll 16
            for (int d = 0; d < 64; ++d) a += Us[kk * 65 + d] * As[d * 65 + cc];
            tile[kk * 65 + cc] = a; }
        __syncthreads();
        const int nl = c.tid >> 3, kc = c.tid & 7; v4u o;
        o.x = pk2(tile[(8 * kc + 0) * 65 + nl], tile[(8 * kc + 1) * 65 + nl]); o.y = pk2(tile[(8 * kc + 2) * 65 + nl], tile[(8 * kc + 3) * 65 + nl]);
        o.z = pk2(tile[(8 * kc + 4) * 65 + nl], tile[(8 * kc + 5) * 65 + nl]); o.w = pk2(tile[(8 * kc + 6) * 65 + nl], tile[(8 * kc + 7) * 65 + nl]);
        *(v4u*)((bf16*)(c.ws + WS_WC) + (size_t)(n0 + nl) * 1024 + k0 + 8 * kc) = o;
        __syncthreads(); } }
    for (int i = c.bid * NTHR + c.tid; i < 48 * 1024; i += c.G * NTHR) { const int o = i >> 10, k = i & 1023;
        const float v = o < 32 ? c.w_router[(size_t)k * 32 + o] : (o < 36 ? c.w_group[(size_t)k * 4 + (o - 32)] : 0.f);
        const unsigned hi = f2bf(v); const float rem = v - bf2f(hi);
        ((bf16*)(c.ws + WS_WRT))[i] = (bf16)hi; ((bf16*)(c.ws + WS_WRT))[48 * 1024 + i] = (bf16)f2bf(rem); }
    if (c.bid == 0) { for (int i = c.tid; i < 129 * 8; i += NTHR) { const int d = i >> 3, h = i & 7; const int b = (int)t5_bias_bucket(d);
            ((float*)(c.ws + WS_BIAS))[i] = c.rel_bias[b * 16 + h]; ((float*)(c.ws + WS_BIAS) + 129 * 8)[i] = c.rel_bias[b * 16 + 8 + h]; } }
}


__device__ __forceinline__ void p_rmsnorm(const Ctx& c) {
    const int gw = c.bid * NWAVES + c.wave, NGW = c.G * NWAVES, l15 = c.lane & 15, g4 = c.lane >> 4;
    const f32x4 g0 = *(const f32x4*)(c.kv_g + 8 * l15), g1 = *(const f32x4*)(c.kv_g + 8 * l15 + 4);
    for (int r = 4 * gw + g4; r < NTOK; r += 4 * NGW) {
        const float* src = (const float*)(c.ws + WS_CKVRAW) + (size_t)r * 128 + 8 * l15;
        const f32x4 a = *(const f32x4*)src, b = *(const f32x4*)(src + 4);
        float ss = (a.x * a.x + a.y * a.y) + (a.z * a.z + a.w * a.w) + (b.x * b.x + b.y * b.y) + (b.z * b.z + b.w * b.w);
        ss += DPP_F(ss, 0xB1); ss += DPP_F(ss, 0x4E); ss += DPP_F(ss, 0x141); ss += DPP_F(ss, 0x140);
        const float rs = 1.0f / sqrtf(ss * (1.0f / 128.0f) + RMS_EPS);
        v4u o; o.x = pk2(a.x * rs * g0.x, a.y * rs * g0.y); o.y = pk2(a.z * rs * g0.z, a.w * rs * g0.w); o.z = pk2(b.x * rs * g1.x, b.y * rs * g1.y); o.w = pk2(b.z * rs * g1.z, b.w * rs * g1.w);
        *(v4u*)((bf16*)(c.ws + WS_CKV) + (size_t)r * 128 + 8 * l15) = o;
    }
}


typedef float f32x16 __attribute__((ext_vector_type(16)));
typedef short s16x8 __attribute__((ext_vector_type(8)));
__device__ __forceinline__ float half_min(float v) {
    v = fminf(v, DPP_F(v, 0xB1)); v = fminf(v, DPP_F(v, 0x4E)); v = fminf(v, DPP_F(v, 0x141)); v = fminf(v, DPP_F(v, 0x140)); return x16_min(v); }
__device__ __forceinline__ float half_max(float v) {
    v = fmaxf(v, DPP_F(v, 0xB1)); v = fmaxf(v, DPP_F(v, 0x4E)); v = fmaxf(v, DPP_F(v, 0x141)); v = fmaxf(v, DPP_F(v, 0x140)); return x16_max(v); }
__device__ __forceinline__ int half_sum(int v) {
    v += DPP_I(v, 0xB1); v += DPP_I(v, 0x4E); v += DPP_I(v, 0x141); v += DPP_I(v, 0x140); return x16_sumi(v); }
struct P2B { s16x8 b[8]; };
__device__ __forceinline__ P2B p2_ld4(const LAS unsigned char* kb_, int tb) { P2B r;
#pragma unroll
    for (int u = 0; u < 4; ++u) { r.b[2 * u] = *(const LAS s16x8*)(kb_ + (tb + u) * 2048); r.b[2 * u + 1] = *(const LAS s16x8*)(kb_ + (tb + u) * 2048 + 1024); }
    return r; }
__device__ __forceinline__ float p2_relu(float x) { const int xi = __builtin_bit_cast(int, x); return __builtin_bit_cast(float, xi > 0 ? xi : 0); }
__device__ __forceinline__ float p2_wsum(const f32x4 a, const f32x4 w) {
    float p = fmaf(w.x, p2_relu(a[0]), 0.f); p = fmaf(w.y, p2_relu(a[1]), p); p = fmaf(w.z, p2_relu(a[2]), p); return fmaf(w.w, p2_relu(a[3]), p); }
__device__ __forceinline__ void p2_score4(const P2B& B, const s16x8 a0, const s16x8 a1, const f32x4 wq, float& r0, float& r1) {
    f32x4 acc[4];
#pragma unroll
    for (int u = 0; u < 4; ++u) { const f32x4 z = {0.f, 0.f, 0.f, 0.f}; acc[u] = __builtin_amdgcn_mfma_f32_16x16x32_bf16(a0, B.b[2 * u], z, 0, 0, 0); }
#pragma unroll
    for (int u = 0; u < 4; ++u) acc[u] = __builtin_amdgcn_mfma_f32_16x16x32_bf16(a1, B.b[2 * u + 1], acc[u], 0, 0, 0);
    const float p0 = p2_wsum(acc[0], wq), p1 = p2_wsum(acc[1], wq), p2 = p2_wsum(acc[2], wq), p3 = p2_wsum(acc[3], wq);
    { auto s_ = __builtin_amdgcn_permlane16_swap(__builtin_bit_cast(unsigned, p0), __builtin_bit_cast(unsigned, p1), false, false); const unsigned x_ = s_[0], y_ = s_[1];
      r0 = __builtin_bit_cast(float, x_) + __builtin_bit_cast(float, y_); }
    { auto s_ = __builtin_amdgcn_permlane16_swap(__builtin_bit_cast(unsigned, p2), __builtin_bit_cast(unsigned, p3), false, false); const unsigned x_ = s_[0], y_ = s_[1];
      r1 = __builtin_bit_cast(float, x_) + __builtin_bit_cast(float, y_); }
}
__device__ __forceinline__ void p2_unit(const Ctx& c, int b, int blk, int item, int item2) {
    LAS unsigned char* kst = c.lds;
    const int lane = c.lane, wv = c.wave, r = lane & 31, hh = lane >> 5, g4 = lane >> 4, c16 = lane & 15;
    const int t0 = blk * 16 + 2 * wv, n0 = b * SEQ + t0, ntile = blk + 1, nst = (ntile + 15) >> 4;
    const unsigned char* ksrc = c.ws + WS_KIDX + (size_t)(b * 128) * 2048;
#define P2_ISSUE(st) do { _Pragma("unroll") for (int _j = 0; _j < 4; ++_j) \
        __builtin_amdgcn_global_load_lds((const unsigned*)(ksrc + (size_t)(st) * 32768 + (_j * 512 + c.tid) * 16), (LAS unsigned*)(kst + ((st) & 1) * 32768 + (_j * 512 + wv * 64) * 16), 16, 0, 0); } while (0)
    P2_ISSUE(0);
    s16x8 af[2];
    { const bf16* qp = (const bf16*)(c.ws + WS_QIDX) + (size_t)(n0 + (c16 >> 3)) * 512 + (c16 & 7) * 64 + 8 * g4;
      af[0] = *(const s16x8*)qp; af[1] = *(const s16x8*)(qp + 32); }
    const f32x4 wq = *(const f32x4*)((const float*)(c.ws + WS_WIDX) + (size_t)(n0 + hh) * 8 + 4 * (g4 & 1));
    asm volatile("" :: "v"(af[0]), "v"(af[1]), "v"(wq));
    float sc0[64];
#pragma unroll
    for (int i = 0; i < 64; ++i) sc0[i] = -INFINITY;
    const int lim0 = 2 * wv + hh;
    const int lastst = blk >> 4;
    const int limt = (blk - (g4 & 1)) - ((c16 <= lim0) ? 0 : 1);
#pragma unroll
    for (int st = 0; st < 8; ++st) {
        if (st <= lastst) {
            if (st < lastst) { P2_ISSUE(st + 1); asm volatile("s_waitcnt vmcnt(4)" ::: "memory"); }
            else asm volatile("s_waitcnt vmcnt(0)" ::: "memory");
            __builtin_amdgcn_s_barrier();
            const LAS unsigned char* kb_ = kst + (st & 1) * 32768 + lane * 16;
            if (st < lastst) {
                P2B Ba = p2_ld4(kb_, 0), Bb = p2_ld4(kb_, 4);
                p2_score4(Ba, af[0], af[1], wq, sc0[st * 8 + 0], sc0[st * 8 + 1]); __builtin_amdgcn_sched_barrier(0);
                Ba = p2_ld4(kb_, 8);
                p2_score4(Bb, af[0], af[1], wq, sc0[st * 8 + 2], sc0[st * 8 + 3]); __builtin_amdgcn_sched_barrier(0);
                Bb = p2_ld4(kb_, 12);
                p2_score4(Ba, af[0], af[1], wq, sc0[st * 8 + 4], sc0[st * 8 + 5]); __builtin_amdgcn_sched_barrier(0);
                p2_score4(Bb, af[0], af[1], wq, sc0[st * 8 + 6], sc0[st * 8 + 7]);
            } else {
#pragma unroll
                for (int g = 0; g < 4; ++g) if (st * 16 + 4 * g <= blk) {
                    const P2B B = p2_ld4(kb_, 4 * g);
                    float r0, r1; p2_score4(B, af[0], af[1], wq, r0, r1);
                    sc0[st * 8 + 2 * g] = (st * 16 + 4 * g <= limt) ? r0 : -INFINITY;
                    sc0[st * 8 + 2 * g + 1] = (st * 16 + 4 * g + 2 <= limt) ? r1 : -INFINITY;
                    __builtin_amdgcn_sched_barrier(0);
                }
            }
            asm volatile("s_waitcnt lgkmcnt(0)" ::: "memory");
            __builtin_amdgcn_s_barrier();
        }
    }
#undef P2_ISSUE
    f32x4 tv[8];
    LAS float* iscr = (LAS float*)(c.lds + (wv < 7 ? 65536 + wv * 8448 : 133120));
    if (item >= 0) ex_item_load(c, item, tv);
    const int nreg = (ntile + 1) >> 1;
    float thr0 = -INFINITY; int quota0 = 0;
    if (blk >= 16) {
        float mn0 = INFINITY, mx0 = -INFINITY; int cp = 0, cn = 0;
#pragma unroll
        for (int g = 0; g < 4; ++g) if (nreg > 16 * g) {
#pragma unroll
            for (int i = 16 * g; i < 16 * g + 16; ++i) { mx0 = fmaxf(mx0, sc0[i]); mn0 = fminf(mn0, sc0[i] == -INFINITY ? INFINITY : sc0[i]); cp += (sc0[i] > 0.f) ? 1 : 0; cn += (sc0[i] >= 0.f) ? 1 : 0; } }
        mn0 = half_min(mn0); mx0 = half_max(mx0); cp = half_sum(cp); cn = half_sum(cn);
        float lo0, hi0; int chi0, clo0; bool done0 = false;
        if (cp <= KSEL && cn >= KSEL) { done0 = true; thr0 = 0.f; quota0 = KSEL - cp; lo0 = hi0 = 0.f; chi0 = 0; clo0 = KSEL + 1; }
        else if (cp > KSEL) { lo0 = 0.f; clo0 = cn; hi0 = mx0 + fabsf(mx0) * 1e-6f + 1e-30f; chi0 = 0; }
        else { lo0 = mn0; clo0 = t0 + hh + 1; hi0 = 0.f; chi0 = cn; }
        for (int it = 0; it < 200; ++it) {
            if (__builtin_amdgcn_ballot_w64(!done0) == 0ull) break;
            const float half_ = 0.5f * (lo0 + hi0);
            float mid0 = half_;
            if (!(it & 1)) { const float fr_ = ((float)(clo0 - KSEL) + 0.5f) / (float)(clo0 - chi0); const float mi = lo0 + (hi0 - lo0) * fr_; mid0 = (mi > lo0 && mi < hi0) ? mi : half_; }
            unsigned sa = 0u, sb = 0u; int nproc = 0;
#pragma unroll
            for (int g = 0; g < 4; ++g) if (nreg > 16 * g) { nproc += 16;
#pragma unroll
                for (int i = 16 * g; i < 16 * g + 16; ++i) { const unsigned tb_ = __builtin_bit_cast(unsigned, sc0[i] - mid0);
                    if (g < 2) sa = __builtin_amdgcn_alignbit(sa, tb_, 31); else sb = __builtin_amdgcn_alignbit(sb, tb_, 31); } }
            int c0 = half_sum(nproc - __builtin_popcount(sa) - __builtin_popcount(sb));
            if (!done0) { if (c0 == KSEL) { done0 = true; thr0 = mid0; quota0 = KSEL; } else if (mid0 <= lo0 || mid0 >= hi0) { done0 = true; thr0 = lo0; quota0 = KSEL - chi0; } else if (c0 > KSEL) { lo0 = mid0; clo0 = c0; } else { hi0 = mid0; chi0 = c0; } }
        }
        if (!done0) { thr0 = lo0; quota0 = KSEL - chi0; }
    }
    if (item >= 0) ex_item_finish(c, iscr, item, tv);
    if (item2 >= 0) ex_item_load(c, item2, tv);
    unsigned short* selp0 = (unsigned short*)(c.ws + WS_SEL) + (size_t)(n0 + hh) * KSEL;
    int base0 = 0, eq0 = 0; const unsigned ltm = (1u << r) - 1u;
#pragma unroll
    for (int g = 0; g < 4; ++g) if (nreg > 16 * g) {
#pragma unroll
        for (int i = 16 * g; i < 16 * g + 16; ++i) {
            bool sel_ = sc0[i] > thr0; const bool pe = sc0[i] == thr0; const unsigned long long me = __builtin_amdgcn_ballot_w64(pe);
            if (me) { const unsigned mh = hh ? (unsigned)(me >> 32) : (unsigned)me; sel_ = sel_ || (pe && (eq0 + __builtin_popcount(mh & ltm) < quota0)); eq0 += __builtin_popcount(mh); }
            const unsigned long long ms = __builtin_amdgcn_ballot_w64(sel_); const unsigned mh2 = hh ? (unsigned)(ms >> 32) : (unsigned)ms;
            const int pos = base0 + __builtin_popcount(mh2 & ltm); if (sel_ && pos < KSEL) selp0[pos] = (unsigned short)(32 * i + r); base0 += __builtin_popcount(mh2);
        } }
    if (item2 >= 0) ex_item_finish(c, iscr, item2, tv);
}
__device__ __forceinline__ void p2_indexer_topk(const Ctx& c) {
    for (int pu = c.bid; pu < 256; pu += c.G) {
        const int b = pu >> 5, j = pu & 31;
#pragma unroll 1
        for (int q = 0; q < 4; ++q) p2_unit(c, b, q == 0 ? j : (q == 1 ? 63 - j : (q == 2 ? 64 + j : 127 - j)), c.G == 256 ? q * 2048 + c.bid * NWAVES + c.wave : -1, (c.G == 256 && q < 2) ? (4 + q) * 2048 + c.bid * NWAVES + c.wave : -1);
    }
}


typedef short s16x4 __attribute__((ext_vector_type(4)));
constexpr int DSA_WS_OFF = 131072 + 2048;
constexpr int DSA_BIAS_OFF = 131072 + 2048 + 10240;
__device__ __forceinline__ void p3a_dsa(const Ctx& c) {
    const int lane = c.lane, wv = c.wave, l15 = lane & 15, g4 = lane >> 4;
    LAS unsigned char* kvb = c.lds + wv * 16384;
    LAS unsigned char* wsb = c.lds + DSA_WS_OFF + wv * 1280;
    LAS float* biasL = (LAS float*)(c.lds + DSA_BIAS_OFF);
    for (int i = c.tid; i < 129 * 8; i += NTHR) biasL[i] = ((const float*)(c.ws + WS_BIAS))[i];
    __syncthreads();
    const int prow = (l15 & 3) | ((l15 & 4) << 1) | ((l15 & 8) >> 1);
    const int rowx = ((prow & 3) << 2) | (prow >> 2);
    const unsigned qk_off = (unsigned)(256 * prow + 16 * (g4 ^ (rowx & 3))), qk_sx = (unsigned)(rowx >> 2);
    const int grow = 8 * (g4 & 1) + 4 * (g4 >> 1);
    const int trow = grow + (l15 >> 2), trx = ((trow & 3) << 2) | ((trow >> 2) & 3);
    const unsigned tr_off = (unsigned)(256 * trow + 16 * (((lane & 3) >> 1) ^ (trx & 1)) + 8 * (lane & 1)), tr_mx = (unsigned)(trx >> 1);
    const bf16* ckv = (const bf16*)(c.ws + WS_CKV);
    const float bfar = biasL[128 * 8 + (l15 & 7)];
    float bmax = 0.f;
    for (int d = 0; d <= 128; ++d) bmax = fmaxf(bmax, fabsf(biasL[d * 8 + (l15 & 7)]));
    const float kvmax = 11.313708499f * 1.004f * wave_max(fmaxf(fabsf(c.kv_g[2 * lane]), fabsf(c.kv_g[2 * lane + 1])));
    unsigned trm[8];
#pragma unroll
    for (int m = 0; m < 8; ++m) trm[m] = tr_off + 32u * ((unsigned)m ^ tr_mx);
    const int gw = c.bid * NWAVES + wv, NGW = c.G * NWAVES;
    const int eit0 = (c.G == 256 ? P0_EXPERT_ITEMS : 0) + gw;
    if (wv < 4) for (int eit = eit0; eit < P0_EXPERT_ITEMS; eit += NGW) p0_expert_item(c, (LAS float*)kvb, eit);
    asm volatile("s_waitcnt lgkmcnt(0)" ::: "memory");
#define DSA_LOADQ(n_, raw_, qf_) do { raw_ = *(const v2u*)((const unsigned short*)(c.ws + WS_SEL) + (size_t)(n_) * KSEL + 4 * lane); \
        const s16x8* qp_ = (const s16x8*)((const bf16*)(c.ws + WS_QLAT) + (size_t)(n_) * 1024 + (l15 & 7) * 128 + 8 * g4); \
        _Pragma("unroll") for (int s_ = 0; s_ < 4; ++s_) qf_[s_] = qp_[4 * s_]; } while (0)
#define DSA_PREP(n_, raw_, qf_, sl_, t_, cnt_, nch_, nfar_, mref_) do { t_ = (n_) & 2047; cnt_ = (t_ + 1 < KSEL) ? t_ + 1 : KSEL; nch_ = (cnt_ + 31) >> 5; \
        { const int i0 = 4 * lane, lim = t_ - 128; \
          raw_.x = (i0 < cnt_ ? (raw_.x & 0xffffu) : 0u) | (i0 + 1 < cnt_ ? (raw_.x & 0xffff0000u) : 0u); raw_.y = (i0 + 2 < cnt_ ? (raw_.y & 0xffffu) : 0u) | (i0 + 3 < cnt_ ? (raw_.y & 0xffff0000u) : 0u); \
          *(LAS v2u*)(wsb + (sl_) * 512 + 8 * lane) = raw_; \
          const int e0 = (i0 < cnt_ && (int)(raw_.x & 0xffffu) <= lim) ? 1 : 0, e1 = (i0 + 1 < cnt_ && (int)(raw_.x >> 16) <= lim) ? 1 : 0, e2 = (i0 + 2 < cnt_ && (int)(raw_.y & 0xffffu) <= lim) ? 1 : 0, e3 = (i0 + 3 < cnt_ && (int)(raw_.y >> 16) <= lim) ? 1 : 0; \
          int nf = e0 + e1 + e2 + e3; nf += DPP_I(nf, 0xB1); nf += DPP_I(nf, 0x4E); nf += DPP_I(nf, 0x141); nf += DPP_I(nf, 0x140); nf = x16_sumi(nf); { unsigned xa, xb; swap32((unsigned)nf, xa, xb); nf = (int)(xa + xb); } \
          nfar_ = __builtin_amdgcn_readfirstlane(nf) >> 5; } \
        { float q2 = 0.f; \
          _Pragma("unroll") for (int s_ = 0; s_ < 4; ++s_) { if (l15 >= 8) qf_[s_] = (s16x8){0, 0, 0, 0, 0, 0, 0, 0}; \
              _Pragma("unroll") for (int e = 0; e < 8; ++e) { const float qv = bf2f((unsigned)(unsigned short)qf_[s_][e]); q2 += qv * qv; } } \
          q2 = x16_sum(q2); q2 = x32_sum(q2); mref_ = sqrtf(q2) * kvmax + bmax; } } while (0)
#define DSA_ISSUE(ch_, bi_, k8_, sl_, n_, t_, cnt_, nfar_) do { const bf16* ckb_ = ckv + (size_t)((n_) >> 11) * SEQ * 128; \
            _Pragma("unroll") for (int u = 0; u < 8; ++u) { const unsigned kw = u < 2 ? k8_.x : (u < 4 ? k8_.y : (u < 6 ? k8_.z : k8_.w)); const unsigned key = (u & 1) ? (kw >> 16) : (kw & 0xffffu); \
                const int chl = l15 ^ ((g4 << 2) | (u & 3)); \
                __builtin_amdgcn_global_load_lds((const unsigned*)((const char*)ckb_ + (size_t)(unsigned)(key * 256u + (unsigned)chl * 16u)), (LAS unsigned*)(kvb + (bi_) * 8192 + u * 1024), 16, 0, 0); } \
            if ((ch_) >= (nfar_) && lane < 32) { const int kap = 32 * (ch_) + 8 * (lane & 3) + (lane >> 2); const int key = *(const LAS unsigned short*)(wsb + (sl_) * 512 + 2 * kap); int dd = (t_) - key; dd = dd > 128 ? 128 : dd; dd = kap < (cnt_) ? dd : 255; \
                *(LAS unsigned short*)(wsb + 1024 + (bi_) * 64 + 2 * lane) = (unsigned short)dd; } } while (0)
    const bool mixq = (NGW == SEQ);
#define DSA_QIDX(i_) (mixq ? ((i_) * SEQ + ((gw + 293 * (i_)) & (SEQ - 1))) : (gw + (i_) * NGW))
    const int nq = mixq ? BATCH : (NTOK - gw + NGW - 1) / NGW;
    int qi = 0, n = DSA_QIDX(0), sl = 0, b0 = 0, t = 0, cnt = 0, nch = 0, nfar = 0; float Mref = 0.f;
    s16x8 qf[4]; v2u rawn; s16x8 qfn[4];
    if (nq > 0) { v2u raw0; DSA_LOADQ(n, raw0, qf); DSA_PREP(n, raw0, qf, 0, t, cnt, nch, nfar, Mref);
        asm volatile("s_waitcnt lgkmcnt(0)" ::: "memory");
        const v4u k80 = *(const LAS v4u*)(wsb + (8 * g4) * 2); DSA_ISSUE(0, 0, k80, 0, n, t, cnt, nfar); }
    for (; qi < nq; ++qi) {
        const bool has_next = qi + 1 < nq; const int nn = has_next ? DSA_QIDX(qi + 1) : n;
        if (has_next) DSA_LOADQ(nn, rawn, qfn);
        int tn = 0, cntn = 0, nchn = 0, nfarn = 0; float Mrefn = 0.f;
        f32x4 O[8];
#pragma unroll
        for (int m = 0; m < 8; ++m) O[m] = (f32x4){0.f, 0.f, 0.f, 0.f};
        float l_run = 0.f;
        v4u k8n = *(const LAS v4u*)(wsb + sl * 512 + (32 * (nch > 1 ? 1 : 0) + 8 * g4) * 2);
        for (int ch = 0; ch < nch; ++ch) {
            const int bi = (b0 + ch) & 1;
            asm volatile("s_waitcnt lgkmcnt(0)" ::: "memory");
            if (ch + 1 < nch) { const v4u k8 = k8n; k8n = *(const LAS v4u*)(wsb + sl * 512 + (32 * (ch + 2 < 8 ? ch + 2 : 7) + 8 * g4) * 2);
                DSA_ISSUE(ch + 1, bi ^ 1, k8, sl, n, t, cnt, nfar); asm volatile("s_waitcnt vmcnt(8)" ::: "memory"); }
            else if (has_next) { DSA_PREP(nn, rawn, qfn, sl ^ 1, tn, cntn, nchn, nfarn, Mrefn);
                asm volatile("s_waitcnt lgkmcnt(0)" ::: "memory");
                const v4u k8 = *(const LAS v4u*)(wsb + (sl ^ 1) * 512 + (8 * g4) * 2);
                DSA_ISSUE(0, bi ^ 1, k8, sl ^ 1, nn, tn, cntn, nfarn); asm volatile("s_waitcnt vmcnt(8)" ::: "memory"); }
            else asm volatile("s_waitcnt vmcnt(0)" ::: "memory");
            const LAS unsigned char* kb_ = kvb + bi * 8192;
            f32x4 S[2];
#pragma unroll
            for (int T = 0; T < 2; ++T) { f32x4 a4 = {0.f, 0.f, 0.f, 0.f};
#pragma unroll
                for (int s_ = 0; s_ < 4; ++s_) { const s16x8 a = *(const LAS s16x8*)(kb_ + qk_off + 4096 * T + 64 * ((unsigned)s_ ^ qk_sx)); a4 = __builtin_amdgcn_mfma_f32_16x16x32_bf16(a, qf[s_], a4, 0, 0, 0); }
                S[T] = a4; }
            if (ch < nfar) {
#pragma unroll
                for (int T = 0; T < 2; ++T)
#pragma unroll
                    for (int r_ = 0; r_ < 4; ++r_) S[T][r_] = S[T][r_] + (bfar - Mref);
            } else
#pragma unroll
            for (int T = 0; T < 2; ++T) { const v2u d4 = *(const LAS v2u*)(wsb + 1024 + bi * 64 + 2 * (16 * T + grow));
#pragma unroll
                for (int r_ = 0; r_ < 4; ++r_) { const unsigned dw = r_ < 2 ? d4.x : d4.y; const unsigned dd = (r_ & 1) ? (dw >> 16) : (dw & 0xffffu);
                    const float bsv = biasL[(dd > 128u ? 128u : dd) * 8 + (l15 & 7)]; S[T][r_] = (dd == 255u) ? -INFINITY : S[T][r_] + (bsv - Mref); } }
#pragma unroll
            for (int T = 0; T < 2; ++T)
#pragma unroll
                for (int r_ = 0; r_ < 4; ++r_) { const float pv = __expf(S[T][r_]); S[T][r_] = pv; l_run += pv; }
            s16x8 P;
            { const unsigned p0 = cvt_pk(S[0][0], S[0][1]), p1 = cvt_pk(S[0][2], S[0][3]), p2 = cvt_pk(S[1][0], S[1][1]), p3 = cvt_pk(S[1][2], S[1][3]);
              const v4u pw_ = {p0, p1, p2, p3}; P = __builtin_bit_cast(s16x8, pw_); }
            { const unsigned kba = (unsigned)(size_t)kb_; s16x4 ta[8], tb[8];
#pragma unroll
              for (int m = 0; m < 8; ++m) { const unsigned ad = kba + trm[m];
                  asm volatile("ds_read_b64_tr_b16 %0, %1" : "=v"(ta[m]) : "v"(ad) : "memory"); asm volatile("ds_read_b64_tr_b16 %0, %1 offset:4096" : "=v"(tb[m]) : "v"(ad) : "memory"); }
              asm volatile("s_waitcnt lgkmcnt(8)" ::: "memory"); __builtin_amdgcn_sched_barrier(0);
#pragma unroll
              for (int m = 0; m < 4; ++m) O[m] = __builtin_amdgcn_mfma_f32_16x16x32_bf16(__builtin_shufflevector(ta[m], tb[m], 0, 1, 2, 3, 4, 5, 6, 7), P, O[m], 0, 0, 0);
              asm volatile("s_waitcnt lgkmcnt(0)" ::: "memory"); __builtin_amdgcn_sched_barrier(0);
#pragma unroll
              for (int m = 4; m < 8; ++m) O[m] = __builtin_amdgcn_mfma_f32_16x16x32_bf16(__builtin_shufflevector(ta[m], tb[m], 0, 1, 2, 3, 4, 5, 6, 7), P, O[m], 0, 0, 0); }
        }
        l_run = x16_sum(l_run); l_run = x32_sum(l_run);
        const float inv = 1.0f / fmaxf(l_run, 1e-37f);
        { LAS unsigned char* stg = kvb + ((b0 + nch - 1) & 1) * 8192;
          if (l15 < 8) {
#pragma unroll
              for (int m = 0; m < 8; ++m) *(LAS v2u*)(stg + (l15 * 128 + 16 * m + 4 * g4) * 2) = (v2u){cvt_pk(O[m][0] * inv, O[m][1] * inv), cvt_pk(O[m][2] * inv, O[m][3] * inv)}; }
          asm volatile("s_waitcnt lgkmcnt(0)" ::: "memory");
          const v4u oa = *(const LAS v4u*)(stg + lane * 16), ob = *(const LAS v4u*)(stg + 1024 + lane * 16);
          bf16* op = (bf16*)(c.ws + WS_XB) + (size_t)n * 1024 + lane * 8;
          *(v4u*)op = oa; *(v4u*)(op + 512) = ob; }
        b0 = (b0 + nch) & 1; sl ^= 1; t = tn; cnt = cntn; nch = nchn; nfar = nfarn; Mref = Mrefn; n = nn;
#pragma unroll
        for (int s_ = 0; s_ < 4; ++s_) qf[s_] = qfn[s_];
    }
#undef DSA_QIDX
#undef DSA_LOADQ
#undef DSA_PREP
#undef DSA_ISSUE
    asm volatile("s_waitcnt vmcnt(0) lgkmcnt(0)" ::: "memory");
    if (wv >= 4) for (int eit = eit0; eit < P0_EXPERT_ITEMS; eit += NGW) p0_expert_item(c, (LAS float*)kvb, eit);
    __syncthreads();
}

__device__ __forceinline__ void p3b_swa(const Ctx& c) {
    const int lane = c.lane, wv = c.wave, l15 = lane & 15, g4 = lane >> 4, g = wv & 3, hq = wv >> 2;
    LAS float* biasL = (LAS float*)(c.lds + DSA_BIAS_OFF);
    __syncthreads();
    for (int i = c.tid; i < 128 * 8; i += NTHR) biasL[i] = ((const float*)(c.ws + WS_BIAS) + 129 * 8)[i];
    __syncthreads();
    const unsigned kr_off = (unsigned)(128 * l15), kr_x = (unsigned)(l15 & 7);
    const int vrow = 4 * g4 + (l15 >> 2); const unsigned vr_x = (unsigned)(vrow & 7), vp1 = (unsigned)((lane & 3) >> 1);
    const unsigned vr_off = (unsigned)(128 * vrow + 8 * (lane & 1));
    for (int unit = c.bid; unit < 256; unit += c.G) {
        const int b = unit >> 5, qb = (unit >> 1) & 15, kvh = unit & 1, head = kvh * 4 + g;
        __syncthreads();
#pragma unroll
        for (int j = 0; j < 4; ++j) { const int piece = wv * 4 + j, row = 8 * piece + (lane >> 3), chunk = (lane & 7) ^ (row & 7); int key = (qb - 1) * 128 + row; key = key < 0 ? 0 : key;
            const size_t so = ((size_t)(b * SEQ + key) * 128 + kvh * 64 + chunk * 8);
            __builtin_amdgcn_global_load_lds((const unsigned*)((const bf16*)(c.ws + WS_KB) + so), (LAS unsigned*)(c.lds + piece * 1024), 16, 0, 0);
            __builtin_amdgcn_global_load_lds((const unsigned*)((const bf16*)(c.ws + WS_VB) + so), (LAS unsigned*)(c.lds + 32768 + piece * 1024), 16, 0, 0); }
        float bt[9][4];
#pragma unroll
        for (int ta = 0; ta < 9; ++ta)
#pragma unroll
            for (int r_ = 0; r_ < 4; ++r_) { const int dist = 128 + l15 - 16 * ta - 4 * g4 - r_; bt[ta][r_] = (dist >= 0 && dist < 128) ? biasL[dist * 8 + head] : -INFINITY; }
        const float sink = c.sinks[head];
        asm volatile("s_waitcnt vmcnt(0)" ::: "memory");
        __syncthreads();
#pragma unroll 1
        for (int jj = 0; jj < 4; ++jj) {
            const int j = 4 * hq + jj; const size_t nrow = (size_t)(b * SEQ + qb * 128 + 16 * j + l15);
            bf16* qrow = (bf16*)(c.ws + WS_QB) + nrow * 512 + head * 64;
            const s16x8 q0 = *(const s16x8*)(qrow + 8 * g4), q1 = *(const s16x8*)(qrow + 32 + 8 * g4);
            f32x4 S[9]; float mx = sink;
#pragma unroll
            for (int ta = 0; ta < 9; ++ta) { const int kt = j + ta; const LAS unsigned char* kp = c.lds + kr_off + 2048 * kt;
                f32x4 a4 = {0.f, 0.f, 0.f, 0.f};
                a4 = __builtin_amdgcn_mfma_f32_16x16x32_bf16(*(const LAS s16x8*)(kp + 16 * ((unsigned)g4 ^ kr_x)), q0, a4, 0, 0, 0);
                a4 = __builtin_amdgcn_mfma_f32_16x16x32_bf16(*(const LAS s16x8*)(kp + 16 * ((unsigned)(4 + g4) ^ kr_x)), q1, a4, 0, 0, 0);
                const bool dead = (qb == 0 && kt < 8);
#pragma unroll
                for (int r_ = 0; r_ < 4; ++r_) { const float sv = dead ? -INFINITY : a4[r_] + bt[ta][r_]; a4[r_] = sv; mx = fmaxf(mx, sv); }
                S[ta] = a4; }
            mx = x16_max(mx); mx = x32_max(mx);
            float ps = 0.f;
#pragma unroll
            for (int ta = 0; ta < 9; ++ta)
#pragma unroll
                for (int r_ = 0; r_ < 4; ++r_) { const float pv = __expf(S[ta][r_] - mx); S[ta][r_] = pv; ps += pv; }
            ps = x16_sum(ps); ps = x32_sum(ps);
            const float inv = 1.0f / (ps + __expf(sink - mx));
            f32x4 O[4];
#pragma unroll
            for (int m = 0; m < 4; ++m) O[m] = (f32x4){0.f, 0.f, 0.f, 0.f};
#pragma unroll
            for (int pp = 0; pp < 5; ++pp) {
                const int ta = 2 * pp, tb = 2 * pp + 1;
                v4u pw_; pw_.x = cvt_pk(S[ta][0] * inv, S[ta][1] * inv); pw_.y = cvt_pk(S[ta][2] * inv, S[ta][3] * inv);
                if (tb < 9) { pw_.z = cvt_pk(S[tb < 9 ? tb : 0][0] * inv, S[tb < 9 ? tb : 0][1] * inv); pw_.w = cvt_pk(S[tb < 9 ? tb : 0][2] * inv, S[tb < 9 ? tb : 0][3] * inv); } else { pw_.z = 0u; pw_.w = 0u; }
                const s16x8 P = __builtin_bit_cast(s16x8, pw_);
                const LAS unsigned char* va = c.lds + 32768 + vr_off + 2048 * (j + ta); const LAS unsigned char* vb_ = c.lds + 32768 + vr_off + 2048 * (j + (tb < 9 ? tb : ta));
#pragma unroll
                for (int m = 0; m < 4; ++m) { const unsigned co = 16u * ((unsigned)(2 * m + vp1) ^ vr_x);
                    const s16x4 a0 = __builtin_amdgcn_ds_read_tr16_b64_v4i16((LAS s16x4*)(va + co)), a1 = __builtin_amdgcn_ds_read_tr16_b64_v4i16((LAS s16x4*)(vb_ + co));
                    O[m] = __builtin_amdgcn_mfma_f32_16x16x32_bf16(__builtin_shufflevector(a0, a1, 0, 1, 2, 3, 4, 5, 6, 7), P, O[m], 0, 0, 0); }
            }
#pragma unroll
            for (int m = 0; m < 4; ++m) *(v2u*)(qrow + 16 * m + 4 * g4) = (v2u){cvt_pk(O[m][0], O[m][1]), cvt_pk(O[m][2], O[m][3])};
        }
    }
    __syncthreads();
}

__device__ __forceinline__ void p6_ln_router(const Ctx& c, bf16* x1b) {
    const int lane = c.lane, wv = c.wave, l15 = lane & 15, g4 = lane >> 4;
    LAS unsigned char* XH = c.lds; LAS unsigned char* XL = c.lds + 32768;
    LAS float* PL = (LAS float*)(c.lds + 65536);
    LAS float* LG = (LAS float*)(c.lds + 65536 + 24576);
    const bf16* WH = (const bf16*)(c.ws + WS_WRT); const bf16* WL = WH + 48 * 1024;
    LAS unsigned* PEX = (LAS unsigned*)(c.lds + 65536 + 24576 + 4096);
    LAS unsigned* EB = PEX + 128;
    int nbase = 0;
    s16x8 wbh[4][3], wbl[4][3];
#pragma unroll
    for (int s_ = 0; s_ < 4; ++s_)
#pragma unroll
        for (int nt = 0; nt < 3; ++nt) { const size_t wo = (size_t)(16 * nt + l15) * 1024 + 128 * wv + 32 * s_ + 8 * g4; wbh[s_][nt] = *(const s16x8*)(WH + wo); wbl[s_][nt] = *(const s16x8*)(WL + wo); }
    v2u vn[2][4];
    const bf16* h1b = (const bf16*)(c.ws + WS_H1B);
    if (c.bid < NTOK / 16) {
#pragma unroll
        for (int q = 0; q < 2; ++q)
#pragma unroll
            for (int j = 0; j < 4; ++j) vn[q][j] = ((const v2u*)(h1b + (size_t)(c.bid * 16 + 2 * wv + q) * D) + lane)[64 * j]; }
    for (int u = c.bid; u < NTOK / 16; u += c.G) {
        __syncthreads();
#pragma unroll
        for (int q = 0; q < 2; ++q) { const int tk = 2 * wv + q, n = u * 16 + tk;
            f32x4 v[4]; float s = 0.f;
#pragma unroll
            for (int j = 0; j < 4; ++j) { v[j] = (f32x4){bflo(vn[q][j].x), bfhi(vn[q][j].x), bflo(vn[q][j].y), bfhi(vn[q][j].y)}; s += (v[j].x + v[j].y) + (v[j].z + v[j].w); }
            const float mean = wave_sum(s) * (1.f / D); float s2 = 0.f;
#pragma unroll
            for (int j = 0; j < 4; ++j) { v[j] = v[j] - mean; s2 += (v[j].x * v[j].x + v[j].y * v[j].y) + (v[j].z * v[j].z + v[j].w * v[j].w); }
            const float rstd = 1.f / sqrtf(wave_sum(s2) * (1.f / D) + LN_EPS);
#pragma unroll
            for (int j = 0; j < 4; ++j) { const int k0 = 4 * lane + 256 * j;
                const f32x4 g = *(const f32x4*)(c.ln1_g + k0), bb = *(const f32x4*)(c.ln1_b + k0);
                const f32x4 y = v[j] * rstd * g + bb;
                const unsigned h01 = pk2(y.x, y.y), h23 = pk2(y.z, y.w);
                *(v2u*)(x1b + (size_t)n * D + k0) = (v2u){h01, h23};
                const unsigned l01 = pk2(y.x - bflo(h01), y.y - bfhi(h01)), l23 = pk2(y.z - bflo(h23), y.w - bfhi(h23));
                const unsigned off = (unsigned)(tk * 2048 + ((((lane >> 1) + 32 * j) ^ tk) << 4) + 8 * (lane & 1));
                *(LAS v2u*)(XH + off) = (v2u){h01, h23}; *(LAS v2u*)(XL + off) = (v2u){l01, l23}; } }
        if (u + c.G < NTOK / 16) {
#pragma unroll
            for (int q = 0; q < 2; ++q)
#pragma unroll
                for (int j = 0; j < 4; ++j) vn[q][j] = ((const v2u*)(h1b + (size_t)((u + c.G) * 16 + 2 * wv + q) * D) + lane)[64 * j]; }
        __syncthreads();
        { f32x4 acc[3];
#pragma unroll
          for (int nt = 0; nt < 3; ++nt) acc[nt] = (f32x4){0.f, 0.f, 0.f, 0.f};
#pragma unroll
          for (int s_ = 0; s_ < 4; ++s_) { const int chunk = 4 * (4 * wv + s_) + g4; const unsigned off = (unsigned)(l15 * 2048 + ((chunk ^ l15) << 4));
              const s16x8 ah = *(const LAS s16x8*)(XH + off), al = *(const LAS s16x8*)(XL + off);
#pragma unroll
              for (int nt = 0; nt < 3; ++nt) { const s16x8 bh = wbh[s_][nt], bl = wbl[s_][nt];
                  acc[nt] = __builtin_amdgcn_mfma_f32_16x16x32_bf16(al, bl, acc[nt], 0, 0, 0); acc[nt] = __builtin_amdgcn_mfma_f32_16x16x32_bf16(al, bh, acc[nt], 0, 0, 0);
                  acc[nt] = __builtin_amdgcn_mfma_f32_16x16x32_bf16(ah, bl, acc[nt], 0, 0, 0); acc[nt] = __builtin_amdgcn_mfma_f32_16x16x32_bf16(ah, bh, acc[nt], 0, 0, 0); } }
#pragma unroll
          for (int nt = 0; nt < 3; ++nt)
#pragma unroll
              for (int r_ = 0; r_ < 4; ++r_) PL[(wv * 16 + 4 * g4 + r_) * 48 + 16 * nt + l15] = acc[nt][r_]; }
        __syncthreads();
        for (int i = c.tid; i < 16 * 48; i += NTHR) { float a = 0.f;
#pragma unroll
            for (int w = 0; w < 8; ++w) a += PL[w * 768 + i];
            const int o = i % 48; a += o < 32 ? c.b_router[o] : (o < 36 ? c.b_group[o - 32] : 0.f);
            LG[i] = a; }
        __syncthreads();
        if (c.tid < 16) { const int n = u * 16 + c.tid; const LAS float* lg = LG + c.tid * 48; const int nloc = nbase + 2 * c.tid;
            int gs = 0; float gm = lg[32];
            for (int o = 1; o < 4; ++o) { const float v = lg[32 + o]; if (v > gm) { gm = v; gs = o; } }
            float gsum = 0.f;
            for (int o = 0; o < 4; ++o) gsum += __expf(lg[32 + o] - gm);
            const float gw_ = 1.0f / gsum;
            int i1 = 0; float m1 = lg[gs * 8];
            for (int o = 1; o < 8; ++o) { const float v = lg[gs * 8 + o]; if (v > m1) { m1 = v; i1 = o; } }
            int i2 = -1; float m2 = -INFINITY;
            for (int o = 0; o < 8; ++o) { const float v = lg[gs * 8 + o]; if (o != i1 && v > m2) { m2 = v; i2 = o; } }
            const float e2 = __expf(m2 - m1), w1 = gw_ / (1.0f + e2), w2 = gw_ * e2 / (1.0f + e2);
            const int ex1 = gs * 8 + i1, ex2 = gs * 8 + i2;
            ((unsigned*)(c.ws + WS_PE))[2 * n] = ex1; ((unsigned*)(c.ws + WS_PE))[2 * n + 1] = ex2; ((float*)(c.ws + WS_PW))[2 * n] = w1; ((float*)(c.ws + WS_PW))[2 * n + 1] = w2;
            PEX[nloc] = (unsigned)ex1 | ((unsigned)(2 * n) << 8); PEX[nloc + 1] = (unsigned)ex2 | ((unsigned)(2 * n + 1) << 8); }
        nbase += 32;
        if (nbase == 128 || u + c.G >= NTOK / 16) {
            __syncthreads();
            if (c.tid < 32) { unsigned cntE = 0; for (int j = 0; j < nbase; ++j) cntE += ((PEX[j] & 0xffu) == (unsigned)c.tid) ? 1u : 0u;
                EB[c.tid] = cntE ? atomicAdd(c.ctl + CW_CNT + c.tid, cntE) : 0u; }
            __syncthreads();
            if (c.tid < nbase) { const unsigned rec = PEX[c.tid], e = rec & 0xffu; unsigned rk = 0; for (int j = 0; j < c.tid; ++j) rk += ((PEX[j] & 0xffu) == e) ? 1u : 0u;
                ((unsigned*)(c.ws + WS_LIST))[(size_t)e * 32768 + EB[e] + rk] = rec >> 8; }
            nbase = 0;
        }
    }
    __syncthreads();
}


__device__ __forceinline__ void p9_ln2(const Ctx& c) {
    const int gw = c.bid * NWAVES + c.wave, NGW = c.G * NWAVES;
    v2u xn[4], san[4], sbn[4];
#define P9_LOAD(n_) do { _Pragma("unroll") for (int j = 0; j < 4; ++j) { const int k0 = 4 * c.lane + 256 * j; xn[j] = *(const v2u*)((const bf16*)(c.ws + WS_XB) + (size_t)(n_) * D + k0); \
            san[j] = *(const v2u*)((const bf16*)(c.ws + WS_SLOT) + (size_t)(2 * (n_)) * D + k0); sbn[j] = *(const v2u*)((const bf16*)(c.ws + WS_SLOT) + (size_t)(2 * (n_) + 1) * D + k0); } } while (0)
    if (gw < NTOK) P9_LOAD(gw);
    for (int n = gw; n < NTOK; n += NGW) {
        f32x4* row = (f32x4*)(c.out + (size_t)n * D) + c.lane;
        f32x4 v[4]; float s = 0.f;
#pragma unroll
        for (int j = 0; j < 4; ++j) { f32x4 y;
            y.x = bflo(xn[j].x) * ALPHA + (bflo(san[j].x) + bflo(sbn[j].x)); y.y = bfhi(xn[j].x) * ALPHA + (bfhi(san[j].x) + bfhi(sbn[j].x));
            y.z = bflo(xn[j].y) * ALPHA + (bflo(san[j].y) + bflo(sbn[j].y)); y.w = bfhi(xn[j].y) * ALPHA + (bfhi(san[j].y) + bfhi(sbn[j].y));
            v[j] = y; s += (y.x + y.y) + (y.z + y.w); }
        if (n + NGW < NTOK) P9_LOAD(n + NGW);
        const float mean = wave_sum(s) * (1.f / D); float s2 = 0.f;
#pragma unroll
        for (int j = 0; j < 4; ++j) { v[j] = v[j] - mean; s2 += (v[j].x * v[j].x + v[j].y * v[j].y) + (v[j].z * v[j].z + v[j].w * v[j].w); }
        const float rstd = 1.f / sqrtf(wave_sum(s2) * (1.f / D) + LN_EPS);
#pragma unroll
        for (int j = 0; j < 4; ++j) { const int k0 = 4 * c.lane + 256 * j; const f32x4 g = *(const f32x4*)(c.ln2_g + k0), bb = *(const f32x4*)(c.ln2_b + k0); row[64 * j] = v[j] * rstd * g + bb; }
    }
#undef P9_LOAD
}

namespace pg8 {
typedef short bf16x8 __attribute__((ext_vector_type(8)));
constexpr int BM = 256, BK = 64, HALF = 128, HTB = HALF * BK * 2, STAGE_BYTES = 8 * HTB, NXCD = 8, WGM = 8;
__host__ __device__ __forceinline__ int lds_byte(int r, int c) { const int st = (r >> 4) * 2 + (c >> 5), rr = r & 15, cc = c & 31, ob = rr * 64 + cc * 2; return st * 1024 + (ob ^ (((ob >> 9) & 1) << 5)); }
__host__ __device__ __forceinline__ void stage_rc(int b, int& R, int& C) { const int st = b / 1024, sb = b % 1024, swz = sb ^ (((sb >> 9) & 1) << 5); R = (st >> 1) * 16 + swz / 64; C = (st & 1) * 32 + (swz % 64) / 2; }
__host__ __device__ __forceinline__ int perm32(int rho) { const int n = rho >> 4, i = rho & 15; return 8 * (i >> 2) + 4 * n + (i & 3); }
__device__ __forceinline__ unsigned cvt_pk_bf16(float lo, float hi) { unsigned r; asm volatile("v_cvt_pk_bf16_f32 %0, %1, %2" : "=v"(r) : "v"(lo), "v"(hi)); return r; }

struct Unit { int pm, pn, pb, aux; };

struct StaticOrder {
    int nM, nN, nwg, G, c;
    __device__ void init(int M, int N, int G_, int c_) { nM = M / BM; nN = N / BM; nwg = nM * nN; G = G_; c = c_; }
    __device__ bool next(int i, Unit& u) const {
        const long L = (long)i * G + c; if (L >= nwg) return false;
        int wgid = (int)L; { const int q = nwg / NXCD, r = nwg % NXCD, xcd = wgid % NXCD, off = wgid / NXCD; wgid = (xcd < r ? xcd * (q + 1) : r * (q + 1) + (xcd - r) * q) + off; }
        const int nig = WGM * nN, gid = wgid / nig, fm = gid * WGM, gsz = (nM - fm) < WGM ? (nM - fm) : WGM;
        u.pm = fm + ((wgid % nig) % gsz); u.pn = (wgid % nig) / gsz; u.pb = u.pn; u.aux = 0; return true;
    }
    __device__ __forceinline__ void a_ready(const Unit&) const {}
    __device__ __forceinline__ void done(const Unit&) const {}
};
struct DenseProb {
    static constexpr bool GATHER = false;
    const bf16* A; const bf16* Bt; int K;
    __device__ __forceinline__ const char* a_base(const Unit& u) const { return (const char*)A + (size_t)u.pm * 256 * K * 2; }
    __device__ __forceinline__ const char* b_base(const Unit& u) const { return (const char*)Bt + (size_t)u.pb * 256 * K * 2; }
    __device__ __forceinline__ void a_offs(const Unit&, int R0, int C0, int R1, int C1, unsigned (&o)[2][2]) const {
        o[0][0] = (unsigned)(R0 * K + C0) * 2u; o[0][1] = (unsigned)(R1 * K + C1) * 2u; o[1][0] = o[0][0] + (unsigned)(HALF * K * 2); o[1][1] = o[0][1] + (unsigned)(HALF * K * 2); }
};

template <class Prob, class Epi, class Sched>
__device__ __forceinline__ void gemm_phase(LAS unsigned char* lds, const Prob& P, const Sched& S, const Epi& E) {
    const int tid = threadIdx.x, wid = __builtin_amdgcn_readfirstlane(tid >> 6), lane = tid & 63, wr = wid >> 2, wc = wid & 3, fr = lane & 15, fq = lane >> 4;
    const int K = P.K, nt = K / BK;
    int sR[2], sC[2];
    unsigned offB[2][2], offA[2][2];
#pragma unroll
    for (int i = 0; i < 2; ++i) { stage_rc(tid * 16 + i * 8192, sR[i], sC[i]); const int Rb = Epi::PERM ? ((sR[i] & ~31) + perm32(sR[i] & 31)) : sR[i];
        offB[0][i] = (unsigned)(Rb * K + sC[i]) * 2u; offB[1][i] = offB[0][i] + (unsigned)(HALF * K * 2); }
    const size_t kstep = (size_t)(BK * 2);
    const unsigned ldsw = (unsigned)wid * 1024u;
    const int aoff = lds_byte(wr * 64 + fr, fq * 8), boff = lds_byte(wc * 32 + fr, fq * 8);
#define PG8_SA(b, h) (((b) * 2 + (h)) * HTB)
#define PG8_SB(b, h) ((4 + (b) * 2 + (h)) * HTB)
#define PG8_STAGE(bufoff, gbase, offs) do { _Pragma("unroll") for (int _i = 0; _i < 2; ++_i) \
        __builtin_amdgcn_global_load_lds((const unsigned*)((gbase) + (offs)[_i]), (LAS unsigned*)(lds + (bufoff) + ldsw + _i * 8192), 16, 0, 0); } while (0)
#define PG8_STA(b, h, tau) PG8_STAGE(PG8_SA(b, h), sA + (size_t)(tau) * kstep, offA[h])
#define PG8_STB(b, h, tau) PG8_STAGE(PG8_SB(b, h), sB + (size_t)(tau) * kstep, offB[h])
#define PG8_LDA(dst, b, h) do { _Pragma("unroll") for (int m = 0; m < 4; ++m) _Pragma("unroll") for (int k = 0; k < 2; ++k) dst[m][k] = *(const LAS bf16x8*)(lds + PG8_SA(b, h) + aoff + m * 2048 + k * 1024); } while (0)
#define PG8_LDB(dst, b, h) do { _Pragma("unroll") for (int n = 0; n < 2; ++n) _Pragma("unroll") for (int k = 0; k < 2; ++k) dst[n][k] = *(const LAS bf16x8*)(lds + PG8_SB(b, h) + boff + n * 2048 + k * 1024); } while (0)
#define PG8_MMA(ai, bj, At, Bt) do { __builtin_amdgcn_s_setprio(1); _Pragma("unroll") for (int m = 0; m < 4; ++m) _Pragma("unroll") for (int n = 0; n < 2; ++n) _Pragma("unroll") for (int k = 0; k < 2; ++k) \
        acc[ai][bj][m][n] = __builtin_amdgcn_mfma_f32_16x16x32_bf16(Bt[n][k], At[m][k], acc[ai][bj][m][n], 0, 0, 0); __builtin_amdgcn_s_setprio(0); } while (0)
#define PG8_WAIT_V(n) asm volatile("s_waitcnt vmcnt(" #n ")" ::: "memory")
#define PG8_WAIT_L(n) asm volatile("s_waitcnt lgkmcnt(" #n ")" ::: "memory")
#define PG8_BAR __builtin_amdgcn_s_barrier()
#define PG8_SCHED __builtin_amdgcn_sched_barrier(0)
    Unit cur, nxt; int ui = 0;
    if (!S.next(0, cur)) return;
    f32x4 acc[2][2][4][2];
#pragma unroll
    for (int a = 0; a < 2; ++a)
#pragma unroll
        for (int b = 0; b < 2; ++b)
#pragma unroll
            for (int m = 0; m < 4; ++m)
#pragma unroll
                for (int n = 0; n < 2; ++n) acc[a][b][m][n] = (f32x4){0.f, 0.f, 0.f, 0.f};
    bf16x8 At[4][2], B0[2][2], B1[2][2];
    const char* sA = P.a_base(cur); const char* sB = P.b_base(cur);
    S.a_ready(cur);
    P.a_offs(cur, sR[0], sC[0], sR[1], sC[1], offA);
    PG8_STB(0, 0, 0); PG8_STB(0, 1, 0); PG8_STA(0, 0, 0); PG8_STA(0, 1, 0);
    if (wr == 1) PG8_BAR;
    PG8_WAIT_V(2); PG8_BAR;
    PG8_STB(1, 0, 1); PG8_STA(1, 0, 1); PG8_STB(1, 1, 1);
    PG8_WAIT_V(6); PG8_BAR;
    for (;;) {
        const bool has_next = S.next(ui + 1, nxt);
        unsigned nOffA[2][2];
        if (Prob::GATHER) { if (has_next) P.a_offs(nxt, sR[0], sC[0], sR[1], sC[1], nOffA); else {
#pragma unroll
            for (int h = 0; h < 2; ++h)
#pragma unroll
                for (int i = 0; i < 2; ++i) nOffA[h][i] = offA[h][i]; } }
        const char* nA = has_next ? P.a_base(nxt) : sA; const char* nB = has_next ? P.b_base(nxt) : sB;
        for (int t = 0; t < nt; t += 2) {
            const bool last = (t == nt - 2);
            if (last && has_next) S.a_ready(nxt);
            PG8_LDB(B0, 0, 0); PG8_LDB(B1, 0, 1); PG8_SCHED; PG8_LDA(At, 0, 0); PG8_STA(1, 1, t + 1);
            PG8_WAIT_V(8); PG8_WAIT_L(0); PG8_BAR; PG8_MMA(0, 0, At, B0); PG8_MMA(0, 1, At, B1); PG8_BAR; PG8_SCHED;
            if (last) {
                sA = nA - (size_t)nt * kstep; sB = nB - (size_t)nt * kstep;
                if (Prob::GATHER) {
#pragma unroll
                    for (int h = 0; h < 2; ++h)
#pragma unroll
                        for (int i = 0; i < 2; ++i) offA[h][i] = nOffA[h][i]; }
            }
            PG8_LDA(At, 0, 1); PG8_STB(0, 0, t + 2); PG8_STB(0, 1, t + 2); PG8_STA(0, 0, t + 2);
            PG8_WAIT_V(8); PG8_WAIT_L(0); PG8_BAR; PG8_MMA(1, 0, At, B0); PG8_MMA(1, 1, At, B1); PG8_BAR; PG8_SCHED;
            PG8_LDB(B0, 1, 0); PG8_LDB(B1, 1, 1); PG8_SCHED; PG8_LDA(At, 1, 0); PG8_STA(0, 1, t + 2);
            PG8_WAIT_V(8); PG8_WAIT_L(0); PG8_BAR; PG8_MMA(0, 0, At, B0); PG8_MMA(0, 1, At, B1); PG8_BAR; PG8_SCHED;
            PG8_LDA(At, 1, 1); PG8_STB(1, 0, t + 3); PG8_STB(1, 1, t + 3); PG8_STA(1, 0, t + 3);
            PG8_WAIT_V(8); PG8_WAIT_L(0); PG8_BAR; PG8_MMA(1, 0, At, B0); PG8_MMA(1, 1, At, B1); PG8_BAR; PG8_SCHED;
        }
        if (wr == 0) PG8_BAR;
        E(acc, cur, wr, wc, fr, fq); S.done(cur);
        if (!has_next) break;
#pragma unroll
        for (int a = 0; a < 2; ++a)
#pragma unroll
            for (int b = 0; b < 2; ++b)
#pragma unroll
                for (int m = 0; m < 4; ++m)
#pragma unroll
                    for (int n = 0; n < 2; ++n) acc[a][b][m][n] = (f32x4){0.f, 0.f, 0.f, 0.f};
        cur = nxt; ++ui; sA = nA; sB = nB;
        if (wr == 1) PG8_BAR;
    }
    PG8_WAIT_V(0);
    PG8_BAR;
#undef PG8_SA
#undef PG8_SB
#undef PG8_STAGE
#undef PG8_STA
#undef PG8_STB
#undef PG8_LDA
#undef PG8_LDB
#undef PG8_MMA
#undef PG8_WAIT_V
#undef PG8_WAIT_L
#undef PG8_BAR
#undef PG8_SCHED
}

template <class Epi, class Sched>
__device__ __forceinline__ void gemm_phase_dual(LAS unsigned char* lds, const bf16* A1, const bf16* Bt1, int K1, const bf16* A2, const bf16* Bt2, int K2, const Sched& S, const Epi& E) {
    const int tid = threadIdx.x, wid = __builtin_amdgcn_readfirstlane(tid >> 6), lane = tid & 63, wr = wid >> 2, wc = wid & 3, fr = lane & 15, fq = lane >> 4;
    const int nt1 = K1 / BK, nt = (K1 + K2) / BK;
    unsigned offB1[2][2], offA1[2][2]; const unsigned dK2 = (unsigned)(2 * (K2 - K1));
#pragma unroll
    for (int i = 0; i < 2; ++i) { int R, C; stage_rc(tid * 16 + i * 8192, R, C); const int Rb = (R & ~31) + perm32(R & 31);
        offA1[0][i] = (unsigned)(R * K1 + C) * 2u; offA1[1][i] = offA1[0][i] + (unsigned)(HALF * K1 * 2); offB1[0][i] = (unsigned)(Rb * K1 + C) * 2u; offB1[1][i] = offB1[0][i] + (unsigned)(HALF * K1 * 2); }
    const size_t kstep = (size_t)(BK * 2);
    const unsigned ldsw = (unsigned)wid * 1024u;
    const int aoff = lds_byte(wr * 64 + fr, fq * 8), boff = lds_byte(wc * 32 + fr, fq * 8);
#define PG8_SA(b, h) (((b) * 2 + (h)) * HTB)
#define PG8_SB(b, h) ((4 + (b) * 2 + (h)) * HTB)
#define PG8_STX(bufoff, tau, g1, g2, o1, o2) do { const int _t = (tau); const bool _s2 = _t >= nt1; const long long _d = _s2 ? (long long)((g2) - (g1)) - (long long)nt1 * (long long)kstep : 0ll; const char* _g = (g1) + (size_t)_t * kstep + _d; \
        _Pragma("unroll") for (int _i = 0; _i < 2; ++_i) { const unsigned _o = (o1)[_i] + (_s2 ? ((o1)[_i] >> 11) * dK2 : 0u); \
        __builtin_amdgcn_global_load_lds((const unsigned*)(_g + _o), (LAS unsigned*)(lds + (bufoff) + ldsw + _i * 8192), 16, 0, 0); } } while (0)
#define PG8_STA(b, h, tau) PG8_STX(PG8_SA(b, h), tau, sA1, sA2, offA1[h], 0)
#define PG8_STB(b, h, tau) PG8_STX(PG8_SB(b, h), tau, sB1, sB2, offB1[h], 0)
#define PG8_LDA(dst, b, h) do { _Pragma("unroll") for (int m = 0; m < 4; ++m) _Pragma("unroll") for (int k = 0; k < 2; ++k) dst[m][k] = *(const LAS bf16x8*)(lds + PG8_SA(b, h) + aoff + m * 2048 + k * 1024); } while (0)
#define PG8_LDB(dst, b, h) do { _Pragma("unroll") for (int n = 0; n < 2; ++n) _Pragma("unroll") for (int k = 0; k < 2; ++k) dst[n][k] = *(const LAS bf16x8*)(lds + PG8_SB(b, h) + boff + n * 2048 + k * 1024); } while (0)
#define PG8_MMA(ai, bj, At, Bt) do { __builtin_amdgcn_s_setprio(1); _Pragma("unroll") for (int m = 0; m < 4; ++m) _Pragma("unroll") for (int n = 0; n < 2; ++n) _Pragma("unroll") for (int k = 0; k < 2; ++k) \
        acc[ai][bj][m][n] = __builtin_amdgcn_mfma_f32_16x16x32_bf16(Bt[n][k], At[m][k], acc[ai][bj][m][n], 0, 0, 0); __builtin_amdgcn_s_setprio(0); } while (0)
#define PG8_WAIT_V(n) asm volatile("s_waitcnt vmcnt(" #n ")" ::: "memory")
#define PG8_WAIT_L(n) asm volatile("s_waitcnt lgkmcnt(" #n ")" ::: "memory")
#define PG8_BAR __builtin_amdgcn_s_barrier()
#define PG8_SCHED __builtin_amdgcn_sched_barrier(0)
    Unit cur, nxt; int ui = 0;
    if (!S.next(0, cur)) return;
    f32x4 acc[2][2][4][2];
#pragma unroll
    for (int a = 0; a < 2; ++a)
#pragma unroll
        for (int b = 0; b < 2; ++b)
#pragma unroll
            for (int m = 0; m < 4; ++m)
#pragma unroll
                for (int n = 0; n < 2; ++n) acc[a][b][m][n] = (f32x4){0.f, 0.f, 0.f, 0.f};
    bf16x8 At[4][2], B0[2][2], B1[2][2];
    const char* sA1 = (const char*)A1 + (size_t)cur.pm * 256 * K1 * 2; const char* sB1 = (const char*)Bt1 + (size_t)cur.pn * 256 * K1 * 2;
    const char* sA2 = (const char*)A2 + (size_t)cur.pm * 256 * K2 * 2; const char* sB2 = (const char*)Bt2 + (size_t)cur.pn * 256 * K2 * 2;
    PG8_STB(0, 0, 0); PG8_STB(0, 1, 0); PG8_STA(0, 0, 0); PG8_STA(0, 1, 0);
    if (wr == 1) PG8_BAR;
    PG8_WAIT_V(2); PG8_BAR;
    PG8_STB(1, 0, 1); PG8_STA(1, 0, 1); PG8_STB(1, 1, 1);
    PG8_WAIT_V(6); PG8_BAR;
    for (;;) {
        const bool has_next = S.next(ui + 1, nxt);
        const int npm = has_next ? nxt.pm : cur.pm, npn = has_next ? nxt.pn : cur.pn;
        const char* nA1 = (const char*)A1 + (size_t)npm * 256 * K1 * 2; const char* nB1 = (const char*)Bt1 + (size_t)npn * 256 * K1 * 2;
        const char* nA2 = (const char*)A2 + (size_t)npm * 256 * K2 * 2; const char* nB2 = (const char*)Bt2 + (size_t)npn * 256 * K2 * 2;
        for (int t = 0; t < nt; t += 2) {
            const bool last = (t == nt - 2);
            const int t2 = last ? 0 : t + 2, t3 = last ? 1 : t + 3;
            if (t == nt1) { E.mid(acc, cur, wr, wc, fr, fq); PG8_SCHED; }
            PG8_LDB(B0, 0, 0); PG8_LDB(B1, 0, 1); PG8_SCHED; PG8_LDA(At, 0, 0); PG8_STA(1, 1, t + 1);
            PG8_WAIT_V(8); PG8_WAIT_L(0); PG8_BAR; PG8_MMA(0, 0, At, B0); PG8_MMA(0, 1, At, B1); PG8_BAR; PG8_SCHED;
            if (last) { sA1 = nA1; sB1 = nB1; sA2 = nA2; sB2 = nB2; }
            PG8_LDA(At, 0, 1); PG8_STB(0, 0, t2); PG8_STB(0, 1, t2); PG8_STA(0, 0, t2);
            PG8_WAIT_V(8); PG8_WAIT_L(0); PG8_BAR; PG8_MMA(1, 0, At, B0); PG8_MMA(1, 1, At, B1); PG8_BAR; PG8_SCHED;
            PG8_LDB(B0, 1, 0); PG8_LDB(B1, 1, 1); PG8_SCHED; PG8_LDA(At, 1, 0); PG8_STA(0, 1, t2);
            PG8_WAIT_V(8); PG8_WAIT_L(0); PG8_BAR; PG8_MMA(0, 0, At, B0); PG8_MMA(0, 1, At, B1); PG8_BAR; PG8_SCHED;
            PG8_LDA(At, 1, 1); PG8_STB(1, 0, t3); PG8_STB(1, 1, t3); PG8_STA(1, 0, t3);
            PG8_WAIT_V(8); PG8_WAIT_L(0); PG8_BAR; PG8_MMA(1, 0, At, B0); PG8_MMA(1, 1, At, B1); PG8_BAR; PG8_SCHED;
        }
        if (wr == 0) PG8_BAR;
        E(acc, cur, wr, wc, fr, fq);
        if (!has_next) break;
#pragma unroll
        for (int a = 0; a < 2; ++a)
#pragma unroll
            for (int b = 0; b < 2; ++b)
#pragma unroll
                for (int m = 0; m < 4; ++m)
#pragma unroll
                    for (int n = 0; n < 2; ++n) acc[a][b][m][n] = (f32x4){0.f, 0.f, 0.f, 0.f};
        cur = nxt; ++ui;
        if (wr == 1) PG8_BAR;
    }
    PG8_WAIT_V(0);
    PG8_BAR;
#undef PG8_SA
#undef PG8_SB
#undef PG8_STX
#undef PG8_STA
#undef PG8_STB
#undef PG8_LDA
#undef PG8_LDB
#undef PG8_MMA
#undef PG8_WAIT_V
#undef PG8_WAIT_L
#undef PG8_BAR
#undef PG8_SCHED
}
__device__ __forceinline__ v4u pack8(f32x4 v0, f32x4 v1) { v4u w; w.x = cvt_pk_bf16(v0[0], v0[1]); w.y = cvt_pk_bf16(v0[2], v0[3]); w.z = cvt_pk_bf16(v1[0], v1[1]); w.w = cvt_pk_bf16(v1[2], v1[3]); return w; }
__device__ __forceinline__ float sigm(float v) { return __builtin_amdgcn_rcpf(1.0f + __expf(-v)); }

struct EpiMergedDual {
    static constexpr bool PERM = true;
    const bf16* ga; const bf16* gb; bf16* merged;
    __device__ __forceinline__ void mid(f32x4 (&acc)[2][2][4][2], const Unit& u, int wr, int wc, int fr, int fq) const {
        int row0 = u.pm * BM + wr * 64 + fr; const int col0 = u.pn * BM + wc * 32 + 8 * fq;
        asm volatile("" : "+v"(row0));
#pragma unroll
        for (int ai = 0; ai < 2; ++ai)
#pragma unroll
            for (int m = 0; m < 4; ++m) { const size_t o = (size_t)(row0 + ai * HALF + m * 16) * 1024 + col0;
#pragma unroll
                for (int bj = 0; bj < 2; ++bj) { const v4u a = *(const v4u*)(ga + o + bj * HALF), b = *(const v4u*)(gb + o + bj * HALF);
                    f32x4 r0 = {bflo(a.x) * __builtin_amdgcn_rcpf(bflo(b.x)), bfhi(a.x) * __builtin_amdgcn_rcpf(bfhi(b.x)), bflo(a.y) * __builtin_amdgcn_rcpf(bflo(b.y)), bfhi(a.y) * __builtin_amdgcn_rcpf(bfhi(b.y))};
                    f32x4 r1 = {bflo(a.z) * __builtin_amdgcn_rcpf(bflo(b.z)), bfhi(a.z) * __builtin_amdgcn_rcpf(bfhi(b.z)), bflo(a.w) * __builtin_amdgcn_rcpf(bflo(b.w)), bfhi(a.w) * __builtin_amdgcn_rcpf(bfhi(b.w))};
                    acc[ai][bj][m][0] = acc[ai][bj][m][0] * r0; acc[ai][bj][m][1] = acc[ai][bj][m][1] * r1; }
                asm volatile("" ::: "memory"); }
    }
    __device__ __forceinline__ void operator()(const f32x4 (&acc)[2][2][4][2], const Unit& u, int wr, int wc, int fr, int fq) const {
        int row0 = u.pm * BM + wr * 64 + fr; const int col0 = u.pn * BM + wc * 32 + 8 * fq;
        asm volatile("" : "+v"(row0));
#pragma unroll
        for (int ai = 0; ai < 2; ++ai)
#pragma unroll
            for (int m = 0; m < 4; ++m) { const size_t o = (size_t)(row0 + ai * HALF + m * 16) * 1024 + col0;
#pragma unroll
                for (int bj = 0; bj < 2; ++bj) { const v4u g = *(const v4u*)(gb + o + bj * HALF);
                    f32x4 g0 = {bflo(g.x), bfhi(g.x), bflo(g.y), bfhi(g.y)}, g1 = {bflo(g.z), bfhi(g.z), bflo(g.w), bfhi(g.w)};
                    *(v4u*)(merged + o + bj * HALF) = pack8(g0 * acc[ai][bj][m][0], g1 * acc[ai][bj][m][1]); } }
    }
};
struct EpiProj {
    static constexpr bool PERM = true;
    unsigned char* ws;
    __device__ __forceinline__ void operator()(const f32x4 (&acc)[2][2][4][2], const Unit& u, int wr, int wc, int fr, int fq) const {
        const int row0 = u.pm * BM + wr * 64 + fr, cw = wc * 32 + 8 * fq, pn = u.pn;
        if (pn == 4) {
#pragma unroll
            for (int ai = 0; ai < 2; ++ai)
#pragma unroll
                for (int m = 0; m < 4; ++m) { const size_t row = (size_t)(row0 + ai * HALF + m * 16);
                    float* cr = (float*)(ws + WS_CKVRAW) + row * 128 + cw; *(f32x4*)cr = acc[ai][0][m][0]; *(f32x4*)(cr + 4) = acc[ai][0][m][1];
                    if (cw < 64) *(v4u*)((bf16*)(ws + WS_KIDX) + ((((row >> 4) * 8 + (cw >> 3)) * 16 + (row & 15)) << 3)) = pack8(acc[ai][1][m][0], acc[ai][1][m][1]);
                    else if (cw == 64) { float* wr_ = (float*)(ws + WS_WIDX) + row * 8; *(f32x4*)wr_ = acc[ai][1][m][0] * IDXW_SCALE; *(f32x4*)(wr_ + 4) = acc[ai][1][m][1] * IDXW_SCALE; } }
            return;
        }
        bf16* base; int ld, c0; float sc = 1.f; bool sg = false;
        if (pn < 4) { base = (bf16*)(ws + WS_QLAT); ld = 1024; c0 = pn * 256; sc = ATT_SCALE; }
        else if (pn < 7) { base = (bf16*)(ws + WS_QIDX); ld = 512; c0 = (pn - 5) * 256; }
        else if (pn < 9) { base = (bf16*)(ws + WS_QB); ld = 512; c0 = (pn - 7) * 256; sc = 0.125f; }
        else if (pn == 9) { base = (bf16*)(ws + WS_KB); ld = 128; c0 = 0; }
        else if (pn < 14) { base = (bf16*)(ws + WS_GA); ld = 1024; c0 = (pn - 10) * 256; sg = true; }
        else { base = (bf16*)(ws + WS_GB); ld = 1024; c0 = (pn - 14) * 256; sg = true; }
        const size_t bjstep = (pn == 9) ? (size_t)(WS_VB - WS_KB) / 2 : (size_t)HALF;
#pragma unroll
        for (int ai = 0; ai < 2; ++ai)
#pragma unroll
            for (int m = 0; m < 4; ++m) { bf16* rowp = base + (size_t)(row0 + ai * HALF + m * 16) * ld + c0 + cw;
#pragma unroll
                for (int bj = 0; bj < 2; ++bj) { f32x4 v0 = acc[ai][bj][m][0], v1 = acc[ai][bj][m][1];
                    if (sg) {
#pragma unroll
                        for (int j = 0; j < 4; ++j) { v0[j] = sigm(v0[j]); v1[j] = sigm(v1[j]); } }
                    else { v0 = v0 * sc; v1 = v1 * sc; }
                    *(v4u*)(rowp + bj * bjstep) = pack8(v0, v1); } }
    }
};
struct EpiWoutM {
    static constexpr bool PERM = true;
    const float* x; bf16* h1b;
    __device__ __forceinline__ void operator()(const f32x4 (&acc)[2][2][4][2], const Unit& u, int wr, int wc, int fr, int fq) const {
        const int row0 = u.pm * BM + wr * 64 + fr, col0 = u.pn * BM + wc * 32 + 8 * fq;
#pragma unroll
        for (int ai = 0; ai < 2; ++ai)
#pragma unroll
            for (int m = 0; m < 4; ++m) { const size_t o = (size_t)(row0 + ai * HALF + m * 16) * 1024 + col0;
#pragma unroll
                for (int bj = 0; bj < 2; ++bj) { const f32x4 x0 = *(const f32x4*)(x + o + bj * HALF), x1 = *(const f32x4*)(x + o + bj * HALF + 4);
                    *(v4u*)(h1b + o + bj * HALF) = pack8(x0 * ALPHA + acc[ai][bj][m][0], x1 * ALPHA + acc[ai][bj][m][1]); } }
    }
};
constexpr int MOE_TB_OFF = 131072 + 1024;
constexpr int CW_RDY = 16384;
constexpr int CW_TMO = 8;
struct MoeOrder {
    const LAS int* tb; int npn, G, c; unsigned* ctl;
    __device__ bool next(int i, Unit& u) const {
        const int L = i * G + c; if (L >= tb[32] * npn) return false;
        const int rt = L / npn, pn = L - rt * npn; int e = 0;
        for (int j = 1; j < 32; ++j) e = (tb[j] <= rt) ? j : e;
        u.pm = rt; u.pn = pn; u.pb = e * npn + pn; u.aux = e; return true;
    }
    __device__ __forceinline__ void a_ready(const Unit&) const {}
    __device__ __forceinline__ void done(const Unit& u) const {
        asm volatile("s_waitcnt vmcnt(0)" ::: "memory");
        if ((threadIdx.x & 63) == 0) __hip_atomic_fetch_add(ctl + CW_RDY + 64 * u.pm, 1u, __ATOMIC_RELAXED, __HIP_MEMORY_SCOPE_AGENT);
    }
};
struct MoeDownOrder {
    const LAS int* tb; int G, c; unsigned* ctl;
    __device__ bool next(int i, Unit& u) const {
        const int nT = tb[32], nD = 4 * nT; int R = 2 * nT - G; R = R < 0 ? 0 : (R > G ? G : R);
        int L;
        if (c >= R) { L = (i < 4) ? i * (G - R) + (c - R) : 4 * (G - R) + (i - 4) * G + c; }
        else { L = 4 * (G - R) + i * G + c; }
        if (L >= nD) return false;
        const int rt = L >> 2, pn = L & 3; int e = 0;
        for (int j = 1; j < 32; ++j) e = (tb[j] <= rt) ? j : e;
        u.pm = rt; u.pn = pn; u.pb = e * 4 + pn; u.aux = e; return true;
    }
    __device__ __forceinline__ void a_ready(const Unit& u) const {
        if (threadIdx.x < 64) {
            unsigned* w = ctl + CW_RDY + 64 * u.pm; unsigned sp = 0;
            while ((unsigned)__builtin_amdgcn_readfirstlane(__hip_atomic_load(w, __ATOMIC_RELAXED, __HIP_MEMORY_SCOPE_AGENT)) < 16u) {
                __builtin_amdgcn_s_sleep(2);
                if ((++sp & 1023u) == 0u) { if (__hip_atomic_load(ctl + CW_TMO, __ATOMIC_RELAXED, __HIP_MEMORY_SCOPE_AGENT) != 0u) break;
                    if (sp > (1u << 22)) { __hip_atomic_store(ctl + CW_TMO, 1u, __ATOMIC_RELAXED, __HIP_MEMORY_SCOPE_AGENT); break; } } }
            __builtin_amdgcn_fence(__ATOMIC_ACQUIRE, "agent");
            asm volatile("s_waitcnt vmcnt(0)" ::: "memory");
        }
        asm volatile("" ::: "memory"); __builtin_amdgcn_s_barrier(); asm volatile("" ::: "memory");
    }
    __device__ __forceinline__ void done(const Unit&) const {}
};
struct GatherProb {
    static constexpr bool GATHER = true;
    const bf16* A; const bf16* Bt; int K; const LAS int* tb; const unsigned* list;
    __device__ __forceinline__ const char* a_base(const Unit&) const { return (const char*)A; }
    __device__ __forceinline__ const char* b_base(const Unit& u) const { return (const char*)Bt + (size_t)u.pb * 256 * K * 2; }
    __device__ __forceinline__ void a_offs(const Unit& u, int R0, int C0, int R1, int C1, unsigned (&o)[2][2]) const {
        const int e = u.aux, lbase = (u.pm - tb[e]) * 256, cnt = tb[64 + e];
        const unsigned* le = list + (size_t)e * 32768;
#pragma unroll
        for (int h = 0; h < 2; ++h) { const int l0 = lbase + h * HALF + R0, l1 = lbase + h * HALF + R1;
            const unsigned t0 = l0 < cnt ? (le[l0] >> 1) : 0u, t1 = l1 < cnt ? (le[l1] >> 1) : 0u;
            o[h][0] = (t0 * (unsigned)K + (unsigned)C0) * 2u; o[h][1] = (t1 * (unsigned)K + (unsigned)C1) * 2u; }
    }
};
struct EpiGU {
    static constexpr bool PERM = true;
    bf16* hbuf;
    __device__ __forceinline__ void operator()(const f32x4 (&acc)[2][2][4][2], const Unit& u, int wr, int wc, int fr, int fq) const {
        const int row0 = u.pm * BM + wr * 64 + fr, col0 = u.pn * HALF + wc * 32 + 8 * fq;
#pragma unroll
        for (int ai = 0; ai < 2; ++ai)
#pragma unroll
            for (int m = 0; m < 4; ++m) { f32x4 h0, h1;
#pragma unroll
                for (int j = 0; j < 4; ++j) { const float g0 = acc[ai][0][m][0][j], g1 = acc[ai][0][m][1][j];
                    h0[j] = g0 * sigm(g0) * acc[ai][1][m][0][j]; h1[j] = g1 * sigm(g1) * acc[ai][1][m][1][j]; }
                { const v4u hv = pack8(h0, h1); bf16* hp = hbuf + (size_t)(row0 + ai * HALF + m * 16) * 256 + col0;
                  asm volatile("global_store_dwordx4 %0, %1, off sc1\n\ts_nop 1" :: "v"(hp), "v"(hv) : "memory"); } }
    }
};
struct EpiDown {
    static constexpr bool PERM = true;
    bf16* slot; const LAS int* tb; const unsigned* list; const float* pw;
    __device__ __forceinline__ void operator()(const f32x4 (&acc)[2][2][4][2], const Unit& u, int wr, int wc, int fr, int fq) const {
        const int e = u.aux, lbase = (u.pm - tb[e]) * 256 + wr * 64 + fr, cnt = tb[64 + e], col0 = u.pn * BM + wc * 32 + 8 * fq;
        const unsigned* le = list + (size_t)e * 32768;
#pragma unroll
        for (int ai = 0; ai < 2; ++ai)
#pragma unroll
            for (int m = 0; m < 4; ++m) { const int l = lbase + ai * HALF + m * 16;
                if (l < cnt) { const unsigned pair = le[l]; const float w = pw[pair]; bf16* rowp = slot + (size_t)pair * 1024 + col0;
#pragma unroll
                    for (int bj = 0; bj < 2; ++bj) *(v4u*)(rowp + bj * HALF) = pack8(acc[ai][bj][m][0] * w, acc[ai][bj][m][1] * w); } }
    }
};
}

struct Args { const float* in[20]; float* out; unsigned char* ws; int ph_lo, ph_hi; };
__global__ void __launch_bounds__(NTHR, 2) fwd_kernel(Args args) {
    extern __shared__ __attribute__((aligned(16))) unsigned char lds_raw[];
    Ctx c;
    c.lds = (LAS unsigned char*)lds_raw;
    c.tid = threadIdx.x; c.lane = c.tid & 63; c.wave = __builtin_amdgcn_readfirstlane(c.tid >> 6); c.bid = blockIdx.x; c.G = gridDim.x;
    c.x = args.in[0]; c.w_in = args.in[1]; c.kv_g = args.in[2]; c.w_uv = args.in[3]; c.w_a = args.in[4]; c.sinks = args.in[5]; c.w_b = args.in[6]; c.w_out = args.in[7]; c.rel_bias = args.in[8];
    c.ln1_g = args.in[9]; c.ln1_b = args.in[10]; c.w_group = args.in[11]; c.b_group = args.in[12]; c.w_router = args.in[13]; c.b_router = args.in[14]; c.w_gate = args.in[15]; c.w_up = args.in[16]; c.w_down = args.in[17];
    c.ln2_g = args.in[18]; c.ln2_b = args.in[19]; c.out = args.out; c.ws = args.ws; unsigned char* ws = args.ws;
    c.ctl = (unsigned*)(ws + WS_CTL);
    volatile LAS unsigned* MISC = (volatile LAS unsigned*)(c.lds + MISC_OFF);
    if (c.tid < 32) MISC[c.tid] = 0u;
    __syncthreads();
    XcdBarrier bar; bar.bar = c.ctl + CW_BAR; bar.x = 0; bar.st = nullptr;
    if (MK_N_LAUNCHES == 1) bar = xcd_barrier_post(c.ctl + CW_BAR, MISC + 8);
    const int lo = args.ph_lo, hi = args.ph_hi;
#define IN(k) (lo <= (k) && (k) < hi)
#define SEAM(k) do { if (IN(k) && IN((k) + 1)) xcd_barrier(bar); } while (0)
    bf16* merged = ((bf16*)(c.ws + WS_QLAT)); bf16* x1b = ((bf16*)(c.ws + WS_XB));

    if (IN(0)) { p0_prologue(c); } SEAM(0);
    if (IN(1)) { pg8::DenseProb P{(const bf16*)(c.ws + WS_XB), (const bf16*)(c.ws + WS_WIN), 1024}; pg8::StaticOrder S; S.init(NTOK, NPROJ, c.G, c.bid); pg8::EpiProj E{c.ws};
        pg8::gemm_phase(c.lds, P, S, E); } SEAM(1);
    if (IN(2)) { p_rmsnorm(c); __syncthreads(); p2_indexer_topk(c); } SEAM(2);
    if (IN(3)) { p3a_dsa(c); p3b_swa(c); } SEAM(3);
    if (IN(4)) { pg8::StaticOrder S; S.init(NTOK, 1024, c.G, c.bid); pg8::EpiMergedDual E{(const bf16*)(c.ws + WS_GA), (const bf16*)(c.ws + WS_GB), merged};
        pg8::gemm_phase_dual(c.lds, (const bf16*)(c.ws + WS_XB), (const bf16*)(c.ws + WS_WC), 1024, (const bf16*)(c.ws + WS_QB), (const bf16*)(c.ws + WS_WB), 512, S, E); } SEAM(4);
    if (IN(5)) { pg8::DenseProb P{(const bf16*)merged, (const bf16*)(c.ws + WS_WO), 1024}; pg8::StaticOrder S; S.init(NTOK, 1024, c.G, c.bid); pg8::EpiWoutM E{c.x, (bf16*)(c.ws + WS_H1B)};
        pg8::gemm_phase(c.lds, P, S, E); } SEAM(5);
    if (IN(6)) { p6_ln_router(c, x1b); } SEAM(6);
    LAS int* tb = (LAS int*)(c.lds + pg8::MOE_TB_OFF);
    if (IN(7) || IN(8)) {
        if (c.tid < 32) tb[64 + c.tid] = (int)__hip_atomic_load(c.ctl + CW_CNT + c.tid, __ATOMIC_RELAXED, __HIP_MEMORY_SCOPE_AGENT);
        __syncthreads();
        if (c.tid == 0) { int a = 0; for (int e = 0; e < 32; ++e) { tb[e] = a; a += (tb[64 + e] + 255) >> 8; } tb[32] = a; }
        __syncthreads();
    }
    if (IN(7)) { pg8::GatherProb P{(const bf16*)x1b, (const bf16*)(c.ws + WS_WGU), 1024, tb, (const unsigned*)(c.ws + WS_LIST)}; pg8::MoeOrder S{tb, 2, c.G, c.bid, c.ctl}; pg8::EpiGU E{(bf16*)(c.ws + WS_QLAT)};
        pg8::gemm_phase(c.lds, P, S, E); }
    if (MK_N_LAUNCHES != 1) SEAM(7);
    if (IN(8)) { pg8::DenseProb P{(const bf16*)(c.ws + WS_QLAT), (const bf16*)(c.ws + WS_WD), 256}; pg8::MoeDownOrder S{tb, c.G, c.bid, c.ctl};
        pg8::EpiDown E{(bf16*)(c.ws + WS_SLOT), tb, (const unsigned*)(c.ws + WS_LIST), (const float*)(c.ws + WS_PW)};
        pg8::gemm_phase(c.lds, P, S, E); } SEAM(8);
    if (IN(9)) { p9_ln2(c); }
#undef IN
#undef SEAM
}

extern "C" void kernel_launch(void* const* d_in, const int* in_sizes, int n_in, void* d_out, int out_size, void* d_ws, size_t ws_size, hipStream_t stream) {
    static int grid = 0;
    if (grid == 0) {
        if (n_in != 20 || out_size != NTOK * D || ws_size < WS_END) { fprintf(stderr, "kernel_launch: unexpected shapes (n_in %d out %d ws %zu)\n", n_in, out_size, ws_size); grid = -1; return; }
        int dev = 0, cus = 0, per_cu = 0;
        if (hipGetDevice(&dev) != hipSuccess || hipDeviceGetAttribute(&cus, hipDeviceAttributeMultiprocessorCount, dev) != hipSuccess) { grid = -1; return; }
        if (hipFuncSetAttribute((const void*)fwd_kernel, hipFuncAttributeMaxDynamicSharedMemorySize, LDS_BYTES) != hipSuccess) { fprintf(stderr, "kernel_launch: hipFuncSetAttribute failed\n"); grid = -1; return; }
        if (hipOccupancyMaxActiveBlocksPerMultiprocessor(&per_cu, (const void*)fwd_kernel, NTHR, LDS_BYTES) != hipSuccess || per_cu < 1) { fprintf(stderr, "kernel_launch: occupancy query says %d\n", per_cu); }
        (void)hipGetLastError();
        grid = cus;
    }
    if (grid < 0) return;
    if (hipMemsetAsync((char*)d_ws + WS_CTL, 0, CTL_ZERO_BYTES, stream) != hipSuccess) return;
    Args a{};
    for (int i = 0; i < 20; ++i) a.in[i] = (const float*)d_in[i];
    a.out = (float*)d_out; a.ws = (unsigned char*)d_ws;
    if (MK_N_LAUNCHES == 1) { a.ph_lo = 0; a.ph_hi = NPHASE; hipLaunchKernelGGL(fwd_kernel, dim3(grid), dim3(NTHR), LDS_BYTES, stream, a); }
    else { for (int p = 0; p < NPHASE; ++p) { a.ph_lo = p; a.ph_hi = p + 1; hipLaunchKernelGGL(fwd_kernel, dim3(grid), dim3(NTHR), LDS_BYTES, stream, a); } }
}
```

```cpp
#include <hip/hip_runtime.h>
#include <cstdio>
#include <cstdint>

#ifndef MK_N_LAUNCHES
#define MK_N_LAUNCHES 1
#endif

constexpr int D = 1024, BATCH = 8, SEQ = 2048, NTOK = BATCH * SEQ;
constexpr int A_HEADS = 8, A_LAT = 128, IDX_HEADS = 8, IDX_DIM = 64, KSEL = 256;
constexpr int B_HEADS = 8, B_HD = 64, WINDOW = 128;
constexpr int NEXP = 32, EPG = 8, NGRP = 4, DEXP = 256;
constexpr int IN_WIDTH = 4552, NPROJ = 4608;
constexpr float ALPHA = 1.189207115002721f;
constexpr float LN_EPS = 1e-5f, RMS_EPS = 1e-6f;
constexpr float ATT_SCALE = 0.08838834764831845f;
constexpr float IDXW_SCALE = 0.125f * 0.35355339059327373f;
constexpr int NPHASE = 10;

constexpr size_t MiB = 1u << 20;
constexpr size_t WS_CTL = 0, CTL_ZERO_BYTES = 128 * 1024;
constexpr size_t WS_WIN = 1 * MiB;
constexpr size_t WS_SEL = 1 * MiB;
constexpr size_t WS_WC = 10 * MiB;
constexpr size_t WS_WB = 12 * MiB;
constexpr size_t WS_WO = 13 * MiB;
constexpr size_t WS_WIDX = 15 * MiB;
constexpr size_t WS_BIAS = 16 * MiB;
constexpr size_t WS_PE = 16 * MiB + 64 * 1024;
constexpr size_t WS_PW = 16 * MiB + 256 * 1024;
constexpr size_t WS_WGU = 17 * MiB;
constexpr size_t WS_WD = 49 * MiB;
constexpr size_t WS_XB = 65 * MiB;
constexpr size_t WS_QLAT = 97 * MiB;
constexpr size_t WS_CKV = 129 * MiB;
constexpr size_t WS_KIDX = 133 * MiB;
constexpr size_t WS_QIDX = 135 * MiB;
constexpr size_t WS_QB = 151 * MiB;
constexpr size_t WS_KB = 167 * MiB;
constexpr size_t WS_VB = 171 * MiB;
constexpr size_t WS_GA = 175 * MiB;
constexpr size_t WS_GB = 207 * MiB;
constexpr size_t WS_H1B = WS_GB;
constexpr size_t WS_CKVRAW = 239 * MiB;
constexpr size_t WS_LIST = 247 * MiB;
constexpr size_t WS_SLOT = 129 * MiB;
constexpr size_t WS_END = 252 * MiB;
constexpr int CW_CNT = 64;
constexpr int CW_BAR = 4096;

constexpr int NWAVES = 8, NTHR = 512;
constexpr int LDS_BYTES = 155648;
constexpr int MISC_OFF = 131072 + 320;

#define GAS __attribute__((address_space(1)))
#define LAS __attribute__((address_space(3)))
typedef unsigned short bf16;
typedef unsigned v4u __attribute__((ext_vector_type(4)));
typedef unsigned v2u __attribute__((ext_vector_type(2)));
typedef float f32x4 __attribute__((ext_vector_type(4)));

__device__ __forceinline__ float bf2f(unsigned v) { return __builtin_bit_cast(float, v << 16); }
__device__ __forceinline__ float bflo(unsigned v) { return __builtin_bit_cast(float, v << 16); }
__device__ __forceinline__ float bfhi(unsigned v) { return __builtin_bit_cast(float, v & 0xffff0000u); }
__device__ __forceinline__ unsigned f2bf(float f) { unsigned u = __builtin_bit_cast(unsigned, f); return (u + 0x7fffu + ((u >> 16) & 1u)) >> 16; }
__device__ __forceinline__ unsigned cvt_pk(float lo, float hi) { unsigned r; asm volatile("v_cvt_pk_bf16_f32 %0, %1, %2" : "=v"(r) : "v"(lo), "v"(hi)); return r; }
__device__ __forceinline__ unsigned pk2(float lo, float hi) { return f2bf(lo) | (f2bf(hi) << 16); }
__device__ __forceinline__ float wave_sum(float v) {
#pragma unroll
    for (int o = 1; o < 64; o <<= 1) v += __shfl_xor(v, o);
    return v;
}
__device__ __forceinline__ float wave_max(float v) {
#pragma unroll
    for (int o = 1; o < 64; o <<= 1) v = fmaxf(v, __shfl_xor(v, o));
    return v;
}

typedef unsigned u2v __attribute__((ext_vector_type(2)));
#define DPP_I(v, ctrl) __builtin_amdgcn_update_dpp(0, (v), (ctrl), 0xf, 0xf, true)
#define DPP_F(v, ctrl) __builtin_bit_cast(float, __builtin_amdgcn_update_dpp(0, __builtin_bit_cast(int, (v)), (ctrl), 0xf, 0xf, true))
__device__ __forceinline__ void swap16(unsigned a, unsigned& x, unsigned& y) { auto r = __builtin_amdgcn_permlane16_swap(a, a, false, false); x = r[0]; y = r[1]; }
__device__ __forceinline__ void swap32(unsigned a, unsigned& x, unsigned& y) { auto r = __builtin_amdgcn_permlane32_swap(a, a, false, false); x = r[0]; y = r[1]; }
__device__ __forceinline__ float x16_sum(float v) { unsigned x, y; swap16(__builtin_bit_cast(unsigned, v), x, y); return __builtin_bit_cast(float, x) + __builtin_bit_cast(float, y); }
__device__ __forceinline__ float x16_max(float v) { unsigned x, y; swap16(__builtin_bit_cast(unsigned, v), x, y); return fmaxf(__builtin_bit_cast(float, x), __builtin_bit_cast(float, y)); }
__device__ __forceinline__ float x16_min(float v) { unsigned x, y; swap16(__builtin_bit_cast(unsigned, v), x, y); return fminf(__builtin_bit_cast(float, x), __builtin_bit_cast(float, y)); }
__device__ __forceinline__ int x16_sumi(int v) { unsigned x, y; swap16((unsigned)v, x, y); return (int)(x + y); }
__device__ __forceinline__ float x32_sum(float v) { unsigned x, y; swap32(__builtin_bit_cast(unsigned, v), x, y); return __builtin_bit_cast(float, x) + __builtin_bit_cast(float, y); }
__device__ __forceinline__ float x32_max(float v) { unsigned x, y; swap32(__builtin_bit_cast(unsigned, v), x, y); return fmaxf(__builtin_bit_cast(float, x), __builtin_bit_cast(float, y)); }

#define XB_TMO      128
#define XB_XCNT(j)  (256  + 64 * (j))
#define XB_XSUB(j)  (1280 + 64 * (j))
#define XB_XGEN(j)  (2304 + 64 * (j))
#define XB_TOP      3328
#define XB_TOPGEN   3392
#define XCD_BAR_WORDS 3456
#define XB_SPIN_CAP (1u << 22)

__device__ __forceinline__ unsigned xb_ld(unsigned* p)              { return __hip_atomic_load(p, __ATOMIC_RELAXED, __HIP_MEMORY_SCOPE_AGENT); }
__device__ __forceinline__ unsigned xb_add(unsigned* p, unsigned v) { return __hip_atomic_fetch_add(p, v, __ATOMIC_RELAXED, __HIP_MEMORY_SCOPE_AGENT); }
__device__ __forceinline__ unsigned xb_xcc_id() { return (unsigned)__builtin_amdgcn_s_getreg((3 << 11) | 20) & 0xFu; }
#define XB_SPIN(cond, bar) do { unsigned _sp = 0; while (cond) { __builtin_amdgcn_s_sleep(1); \
    if ((++_sp & 255u) == 0u) { if (xb_ld(&(bar)[XB_TMO])) break; if (_sp > XB_SPIN_CAP) { atomicAdd(&(bar)[XB_TMO], 1u); break; } } } } while (0)

struct XcdBarrier { unsigned* bar; unsigned x; volatile LAS unsigned* st; };

__device__ __forceinline__ XcdBarrier xcd_barrier_post(unsigned* bar, volatile LAS unsigned* st) {
    XcdBarrier b; b.bar = bar; b.x = xb_xcc_id(); b.st = st;
    if (threadIdx.x == 0) (void)xb_add(&bar[XB_XCNT(b.x)], 1u);
    return b;
}
__device__ __forceinline__ void xcd_barrier_complete(unsigned* bar, unsigned x, unsigned& nloc, unsigned& nx) {
    const unsigned G = gridDim.x * gridDim.y * gridDim.z;
    unsigned sum, cnt, mine, sp = 0u;
    for (;;) {
        sum = 0u; cnt = 0u; mine = 0u;
#pragma unroll
        for (unsigned j = 0; j < 16; ++j) { const unsigned c = xb_ld(&bar[XB_XCNT(j)]); sum += c; cnt += (c > 0u) ? 1u : 0u; mine = (j == x) ? c : mine; }
        if (sum == G) break;
        __builtin_amdgcn_s_sleep(1);
        if ((++sp & 255u) == 0u) { if (xb_ld(&bar[XB_TMO])) break; if (sp > XB_SPIN_CAP) { atomicAdd(&bar[XB_TMO], 1u); break; } }
    }
    nloc = mine > 0u ? mine : 1u; nx = cnt > 0u ? cnt : 1u;
}
__device__ __forceinline__ void xcd_barrier(const XcdBarrier& b) {
    asm volatile("s_waitcnt vmcnt(0)" ::: "memory");
    __syncthreads();
    if (threadIdx.x == 0) {
        unsigned* bar = b.bar;
        __builtin_amdgcn_s_waitcnt(0);
        unsigned nloc = b.st[0], nx = b.st[1];
        if (nloc == 0u) { xcd_barrier_complete(bar, b.x, nloc, nx); b.st[0] = nloc; b.st[1] = nx; }
        const unsigned old = xb_add(&bar[XB_XSUB(b.x)], 1u);
        const unsigned gen = old / nloc;
        if (old + 1u == (gen + 1u) * nloc) {
            __builtin_amdgcn_fence(__ATOMIC_RELEASE, "agent");
            asm volatile("s_waitcnt vmcnt(0)" ::: "memory");
            const unsigned og = xb_add(&bar[XB_TOP], 1u);
            const unsigned tg = og / nx;
            if (og + 1u == (tg + 1u) * nx) xb_add(&bar[XB_TOPGEN], 1u);
            else XB_SPIN(xb_ld(&bar[XB_TOPGEN]) == tg, bar);
            __builtin_amdgcn_fence(__ATOMIC_ACQUIRE, "agent");
            xb_add(&bar[XB_XGEN(b.x)], 1u);
            asm volatile("s_waitcnt vmcnt(0)" ::: "memory");
        } else {
            XB_SPIN(xb_ld(&bar[XB_XGEN(b.x)]) == gen, bar);
            __builtin_amdgcn_fence(__ATOMIC_ACQUIRE, "agent");
            asm volatile("s_waitcnt vmcnt(0)" ::: "memory");
        }
    }
    __syncthreads();
}

struct Ctx {
    const float *x, *w_in, *kv_g, *w_uv, *w_a, *sinks, *w_b, *w_out, *rel_bias, *ln1_g, *ln1_b, *w_group, *b_group, *w_router, *b_router, *w_gate, *w_up, *w_down, *ln2_g, *ln2_b;
    float* out;
    unsigned char* ws;
    unsigned* ctl;
    __device__ __forceinline__ bf16* P(size_t off) const { return (bf16*)(ws + off); }
    LAS unsigned char* lds;
    int tid, lane, wave, bid, G;
};

__device__ __forceinline__ int proj_src_col(int j) {
    if (j < 1024) return j;
    if (j < 1152) return j;
    if (j < 1216) return 1664 + (j - 1152);
    if (j < 1224) return 1728 + (j - 1216);
    if (j < 1280) return -1;
    if (j < 1792) return 1152 + (j - 1280);
    if (j < 2304) return 1736 + (j - 1792);
    if (j < 2432) return 2248 + (j - 2304);
    if (j < 2560) return 2376 + (j - 2432);
    if (j < 3584) return 2504 + (j - 2560);
    return 3528 + (j - 3584);
}
__device__ __forceinline__ float sigmoidf_(float v) { return 1.0f / (1.0f + __expf(-v)); }

template <class Src> __device__ __forceinline__ void titem_load(const Ctx& c, const Src& src, int k0, int n0, f32x4 (&tv)[8]) {
    const int kr = c.lane >> 3, n4 = (c.lane & 7) * 4;
#pragma unroll
    for (int i = 0; i < 8; ++i) tv[i] = src.v4(k0 + 8 * i + kr, n0 + n4);
}
__device__ __forceinline__ void titem_finish(const Ctx& c, LAS float* scr, const f32x4 (&tv)[8], bf16* dst, int dstK, int k0, int n0) {
    const int lane = c.lane, kr = lane >> 3, n4 = (lane & 7) * 4;
#pragma unroll
    for (int i = 0; i < 8; ++i) { LAS float* d = scr + (8 * i + kr) * 33 + n4; d[0] = tv[i].x; d[1] = tv[i].y; d[2] = tv[i].z; d[3] = tv[i].w; }
    asm volatile("s_waitcnt lgkmcnt(0)" ::: "memory");
    const int cc = lane & 7;
#pragma unroll
    for (int j = 0; j < 4; ++j) { const int n = (lane >> 3) + 8 * j; const LAS float* q = scr + (8 * cc) * 33 + n;
        v4u o; o.x = pk2(q[0 * 33], q[1 * 33]); o.y = pk2(q[2 * 33], q[3 * 33]); o.z = pk2(q[4 * 33], q[5 * 33]); o.w = pk2(q[6 * 33], q[7 * 33]);
        *(v4u*)(dst + (size_t)(n0 + n) * dstK + k0 + 8 * cc) = o; }
    asm volatile("s_waitcnt lgkmcnt(0)" ::: "memory");
}
template <class Src> __device__ __forceinline__ void transpose_item(const Ctx& c, LAS float* scr, const Src& src, bf16* dst, int dstK, int k0, int n0) {
    f32x4 tv[8]; titem_load(c, src, k0, n0, tv); titem_finish(c, scr, tv, dst, dstK, k0, n0);
}
struct SrcWin { const float* w; __device__ __forceinline__ f32x4 v4(int k, int n) const { const int s = proj_src_col(n); return s < 0 ? (f32x4){0.f, 0.f, 0.f, 0.f} : *(const f32x4*)(w + (size_t)k * IN_WIDTH + s); } };
struct SrcPlain { const float* w; int N; __device__ __forceinline__ f32x4 v4(int k, int n) const { return *(const f32x4*)(w + (size_t)k * N + n); } };
struct SrcShift { const float* w; int N; int shift; __device__ __forceinline__ f32x4 v4(int k, int n) const { return *(const f32x4*)(w + (size_t)k * N + n + shift); } };

__device__ __forceinline__ float t5_bias_bucket(int dist) {
    if (dist < 16) return (float)dist;
    int b = 16 + (int)(logf((float)dist / 16.0f) / logf(8.0f) * 16.0f);
    return (float)(b < 31 ? b : 31);
}
constexpr int P0_EXPERT_ITEMS = 32 * 256 + 32 * 128;
__device__ __forceinline__ void p0_expert_item(const Ctx& c, LAS float* scr, int r) {
    constexpr int I_GU = 32 * 256;
    if (r < I_GU) { const int e = r / 256, q = r % 256, n0 = (q / 16) * 32, half = (n0 >> 7) & 1, col0 = (n0 >> 8) * 128 + (n0 & 127);
        if (half) { SrcShift s_{c.w_up + (size_t)e * 1024 * 256, DEXP, col0 - n0}; transpose_item(c, scr, s_, (bf16*)(c.ws + WS_WGU) + (size_t)e * 512 * 1024, 1024, (q % 16) * 64, n0); }
        else { SrcShift s_{c.w_gate + (size_t)e * 1024 * 256, DEXP, col0 - n0}; transpose_item(c, scr, s_, (bf16*)(c.ws + WS_WGU) + (size_t)e * 512 * 1024, 1024, (q % 16) * 64, n0); }
        return; }
    r -= I_GU;
    { const int e = r / 128, q = r % 128; SrcPlain s_{c.w_down + (size_t)e * 256 * 1024, 1024};
        transpose_item(c, scr, s_, (bf16*)(c.ws + WS_WD) + (size_t)e * 1024 * 256, 256, (q % 4) * 64, (q / 4) * 32); }
}
__device__ __forceinline__ void ex_item_load(const Ctx& c, int r, f32x4 (&tv)[8]) {
    constexpr int I_GU = 32 * 256;
    const float* base; int ld;
    if (r < I_GU) { const int e = r / 256, q = r % 256, n0 = (q / 16) * 32, half = (n0 >> 7) & 1, col0 = (n0 >> 8) * 128 + (n0 & 127);
        base = (half ? c.w_up : c.w_gate) + (size_t)e * 1024 * 256 + (size_t)((q % 16) * 64) * DEXP + col0; ld = DEXP; }
    else { r -= I_GU; const int e = r / 128, q = r % 128; base = c.w_down + (size_t)e * 256 * 1024 + (size_t)((q % 4) * 64) * 1024 + (q / 4) * 32; ld = 1024; }
    const float* pl = base + (size_t)(c.lane >> 3) * ld + (c.lane & 7) * 4;
#pragma unroll
    for (int i = 0; i < 8; ++i) tv[i] = *(const f32x4*)(pl + (size_t)(8 * i) * ld);
}
__device__ __forceinline__ void ex_item_finish(const Ctx& c, LAS float* scr, int r, const f32x4 (&tv)[8]) {
    constexpr int I_GU = 32 * 256;
    if (r < I_GU) { const int e = r / 256, q = r % 256; titem_finish(c, scr, tv, (bf16*)(c.ws + WS_WGU) + (size_t)e * 512 * 1024, 1024, (q % 16) * 64, (q / 16) * 32); }
    else { r -= I_GU; const int e = r / 128, q = r % 128; titem_finish(c, scr, tv, (bf16*)(c.ws + WS_WD) + (size_t)e * 1024 * 256, 256, (q % 4) * 64, (q / 4) * 32); }
}
constexpr size_t WS_WRT = 16 * MiB + 512 * 1024;
__device__ __forceinline__ void p0_prologue(const Ctx& c) {
    { const size_t n8 = (size_t)NTOK * D / 8; const f32x4* xs = (const f32x4*)c.x; v4u* xd = (v4u*)((bf16*)(c.ws + WS_XB));
      const size_t st = (size_t)c.G * NTHR;
      size_t i = (size_t)c.bid * NTHR + c.tid;
      for (; i + 3 * st < n8; i += 4 * st) { f32x4 a[4], b[4];
#pragma unroll
          for (int u = 0; u < 4; ++u) { a[u] = xs[2 * (i + u * st)]; b[u] = xs[2 * (i + u * st) + 1]; }
#pragma unroll
          for (int u = 0; u < 4; ++u) { v4u o; o.x = pk2(a[u].x, a[u].y); o.y = pk2(a[u].z, a[u].w); o.z = pk2(b[u].x, b[u].y); o.w = pk2(b[u].z, b[u].w); xd[i + u * st] = o; } }
      for (; i < n8; i += st) { const f32x4 a = xs[2 * i], b = xs[2 * i + 1]; v4u o; o.x = pk2(a.x, a.y); o.y = pk2(a.z, a.w); o.z = pk2(b.x, b.y); o.w = pk2(b.z, b.w); xd[i] = o; } }
    { LAS float* scr = (LAS float*)(c.lds + c.wave * 8704);
      constexpr int I_WIN = 16 * 144, I_WB = 8 * 32, I_WO = 16 * 32, I_ALL = I_WIN + I_WB + I_WO;
      for (int it = c.bid * NWAVES + c.wave; it < I_ALL; it += c.G * NWAVES) {
        int r = it;
        if (r < I_WIN) { SrcWin s_{c.w_in}; transpose_item(c, scr, s_, (bf16*)(c.ws + WS_WIN), 1024, (r % 16) * 64, (r / 16) * 32); continue; } r -= I_WIN;
        if (r < I_WB) { SrcPlain s_{c.w_b, 1024}; transpose_item(c, scr, s_, (bf16*)(c.ws + WS_WB), 512, (r % 8) * 64, (r / 8) * 32); continue; } r -= I_WB;
        { SrcPlain s_{c.w_out, 1024}; transpose_item(c, scr, s_, (bf16*)(c.ws + WS_WO), 1024, (r % 16) * 64, (r / 16) * 32); }
      } }
    __syncthreads();
    { LAS float* tile = (LAS float*)c.lds; LAS float* Us = tile + 64 * 65; LAS float* As = Us + 64 * 65;
      for (int tI = c.bid; tI < 256; tI += c.G) { const int k0 = (tI & 15) * 64, n0 = (tI >> 4) * 64, h = k0 >> 7;
        const int r = c.tid >> 6, cc = c.tid & 63;
#pragma unroll
        for (int pI = 0; pI < 8; ++pI) { const int kk = pI * 8 + r; Us[kk * 65 + cc] = c.w_uv[(size_t)(k0 + kk) * 64 + cc]; As[kk * 65 + cc] = c.w_a[(size_t)(h * 64 + kk) * 1024 + n0 + cc]; }
        __syncthreads();
#pragma unroll
        for (int pI = 0; pI < 8; ++pI) { const int kk = pI * 8 + r; float a = 0.f;
#pragma unroll 16
            for (int d = 0; d < 64; ++d) a += Us[kk * 65 + d] * As[d * 65 + cc];
            tile[kk * 65 + cc] = a; }
        __syncthreads();
        const int nl = c.tid >> 3, kc = c.tid & 7; v4u o;
        o.x = pk2(tile[(8 * kc + 0) * 65 + nl], tile[(8 * kc + 1) * 65 + nl]); o.y = pk2(tile[(8 * kc + 2) * 65 + nl], tile[(8 * kc + 3) * 65 + nl]);
        o.z = pk2(tile[(8 * kc + 4) * 65 + nl], tile[(8 * kc + 5) * 65 + nl]); o.w = pk2(tile[(8 * kc + 6) * 65 + nl], tile[(8 * kc + 7) * 65 + nl]);
        *(v4u*)((bf16*)(c.ws + WS_WC) + (size_t)(n0 + nl) * 1024 + k0 + 8 * kc) = o;
        __syncthreads(); } }
    for (int i = c.bid * NTHR + c.tid; i < 48 * 1024; i += c.G * NTHR) { const int o = i >> 10, k = i & 1023;
        const float v = o < 32 ? c.w_router[(size_t)k * 32 + o] : (o < 36 ? c.w_group[(size_t)k * 4 + (o - 32)] : 0.f);
        const unsigned hi = f2bf(v); const float rem = v - bf2f(hi);
        ((bf16*)(c.ws + WS_WRT))[i] = (bf16)hi; ((bf16*)(c.ws + WS_WRT))[48 * 1024 + i] = (bf16)f2bf(rem); }
    if (c.bid == 0) { for (int i = c.tid; i < 129 * 8; i += NTHR) { const int d = i >> 3, h = i & 7; const int b = (int)t5_bias_bucket(d);
            ((float*)(c.ws + WS_BIAS))[i] = c.rel_bias[b * 16 + h]; ((float*)(c.ws + WS_BIAS) + 129 * 8)[i] = c.rel_bias[b * 16 + 8 + h]; } }
}


__device__ __forceinline__ void p_rmsnorm(const Ctx& c) {
    const int gw = c.bid * NWAVES + c.wave, NGW = c.G * NWAVES, l15 = c.lane & 15, g4 = c.lane >> 4;
    const f32x4 g0 = *(const f32x4*)(c.kv_g + 8 * l15), g1 = *(const f32x4*)(c.kv_g + 8 * l15 + 4);
    for (int r = 4 * gw + g4; r < NTOK; r += 4 * NGW) {
        const float* src = (const float*)(c.ws + WS_CKVRAW) + (size_t)r * 128 + 8 * l15;
        const f32x4 a = *(const f32x4*)src, b = *(const f32x4*)(src + 4);
        float ss = (a.x * a.x + a.y * a.y) + (a.z * a.z + a.w * a.w) + (b.x * b.x + b.y * b.y) + (b.z * b.z + b.w * b.w);
        ss += DPP_F(ss, 0xB1); ss += DPP_F(ss, 0x4E); ss += DPP_F(ss, 0x141); ss += DPP_F(ss, 0x140);
        const float rs = 1.0f / sqrtf(ss * (1.0f / 128.0f) + RMS_EPS);
        v4u o; o.x = pk2(a.x * rs * g0.x, a.y * rs * g0.y); o.y = pk2(a.z * rs * g0.z, a.w * rs * g0.w); o.z = pk2(b.x * rs * g1.x, b.y * rs * g1.y); o.w = pk2(b.z * rs * g1.z, b.w * rs * g1.w);
        *(v4u*)((bf16*)(c.ws + WS_CKV) + (size_t)r * 128 + 8 * l15) = o;
    }
}


typedef float f32x16 __attribute__((ext_vector_type(16)));
typedef short s16x8 __attribute__((ext_vector_type(8)));
__device__ __forceinline__ float half_min(float v) {
    v = fminf(v, DPP_F(v, 0xB1)); v = fminf(v, DPP_F(v, 0x4E)); v = fminf(v, DPP_F(v, 0x141)); v = fminf(v, DPP_F(v, 0x140)); return x16_min(v); }
__device__ __forceinline__ float half_max(float v) {
    v = fmaxf(v, DPP_F(v, 0xB1)); v = fmaxf(v, DPP_F(v, 0x4E)); v = fmaxf(v, DPP_F(v, 0x141)); v = fmaxf(v, DPP_F(v, 0x140)); return x16_max(v); }
__device__ __forceinline__ int half_sum(int v) {
    v += DPP_I(v, 0xB1); v += DPP_I(v, 0x4E); v += DPP_I(v, 0x141); v += DPP_I(v, 0x140); return x16_sumi(v); }
struct P2B { s16x8 b[8]; };
__device__ __forceinline__ P2B p2_ld4(const LAS unsigned char* kb_, int tb) { P2B r;
#pragma unroll
    for (int u = 0; u < 4; ++u) { r.b[2 * u] = *(const LAS s16x8*)(kb_ + (tb + u) * 2048); r.b[2 * u + 1] = *(const LAS s16x8*)(kb_ + (tb + u) * 2048 + 1024); }
    return r; }
__device__ __forceinline__ float p2_relu(float x) { const int xi = __builtin_bit_cast(int, x); return __builtin_bit_cast(float, xi > 0 ? xi : 0); }
__device__ __forceinline__ float p2_wsum(const f32x4 a, const f32x4 w) {
    float p = fmaf(w.x, p2_relu(a[0]), 0.f); p = fmaf(w.y, p2_relu(a[1]), p); p = fmaf(w.z, p2_relu(a[2]), p); return fmaf(w.w, p2_relu(a[3]), p); }
__device__ __forceinline__ void p2_score4(const P2B& B, const s16x8 a0, const s16x8 a1, const f32x4 wq, float& r0, float& r1) {
    f32x4 acc[4];
#pragma unroll
    for (int u = 0; u < 4; ++u) { const f32x4 z = {0.f, 0.f, 0.f, 0.f}; acc[u] = __builtin_amdgcn_mfma_f32_16x16x32_bf16(a0, B.b[2 * u], z, 0, 0, 0); }
#pragma unroll
    for (int u = 0; u < 4; ++u) acc[u] = __builtin_amdgcn_mfma_f32_16x16x32_bf16(a1, B.b[2 * u + 1], acc[u], 0, 0, 0);
    const float p0 = p2_wsum(acc[0], wq), p1 = p2_wsum(acc[1], wq), p2 = p2_wsum(acc[2], wq), p3 = p2_wsum(acc[3], wq);
    { auto s_ = __builtin_amdgcn_permlane16_swap(__builtin_bit_cast(unsigned, p0), __builtin_bit_cast(unsigned, p1), false, false); const unsigned x_ = s_[0], y_ = s_[1];
      r0 = __builtin_bit_cast(float, x_) + __builtin_bit_cast(float, y_); }
    { auto s_ = __builtin_amdgcn_permlane16_swap(__builtin_bit_cast(unsigned, p2), __builtin_bit_cast(unsigned, p3), false, false); const unsigned x_ = s_[0], y_ = s_[1];
      r1 = __builtin_bit_cast(float, x_) + __builtin_bit_cast(float, y_); }
}
__device__ __forceinline__ void p2_unit(const Ctx& c, int b, int blk, int item, int item2) {
    LAS unsigned char* kst = c.lds;
    const int lane = c.lane, wv = c.wave, r = lane & 31, hh = lane >> 5, g4 = lane >> 4, c16 = lane & 15;
    const int t0 = blk * 16 + 2 * wv, n0 = b * SEQ + t0, ntile = blk + 1, nst = (ntile + 15) >> 4;
    const unsigned char* ksrc = c.ws + WS_KIDX + (size_t)(b * 128) * 2048;
#define P2_ISSUE(st) do { _Pragma("unroll") for (int _j = 0; _j < 4; ++_j) \
        __builtin_amdgcn_global_load_lds((const unsigned*)(ksrc + (size_t)(st) * 32768 + (_j * 512 + c.tid) * 16), (LAS unsigned*)(kst + ((st) & 1) * 32768 + (_j * 512 + wv * 64) * 16), 16, 0, 0); } while (0)
    P2_ISSUE(0);
    s16x8 af[2];
    { const bf16* qp = (const bf16*)(c.ws + WS_QIDX) + (size_t)(n0 + (c16 >> 3)) * 512 + (c16 & 7) * 64 + 8 * g4;
      af[0] = *(const s16x8*)qp; af[1] = *(const s16x8*)(qp + 32); }
    const f32x4 wq = *(const f32x4*)((const float*)(c.ws + WS_WIDX) + (size_t)(n0 + hh) * 8 + 4 * (g4 & 1));
    asm volatile("" :: "v"(af[0]), "v"(af[1]), "v"(wq));
    float sc0[64];
#pragma unroll
    for (int i = 0; i < 64; ++i) sc0[i] = -INFINITY;
    const int lim0 = 2 * wv + hh;
    const int lastst = blk >> 4;
    const int limt = (blk - (g4 & 1)) - ((c16 <= lim0) ? 0 : 1);
#pragma unroll
    for (int st = 0; st < 8; ++st) {
        if (st <= lastst) {
            if (st < lastst) { P2_ISSUE(st + 1); asm volatile("s_waitcnt vmcnt(4)" ::: "memory"); }
            else asm volatile("s_waitcnt vmcnt(0)" ::: "memory");
            __builtin_amdgcn_s_barrier();
            const LAS unsigned char* kb_ = kst + (st & 1) * 32768 + lane * 16;
            if (st < lastst) {
                P2B Ba = p2_ld4(kb_, 0), Bb = p2_ld4(kb_, 4);
                p2_score4(Ba, af[0], af[1], wq, sc0[st * 8 + 0], sc0[st * 8 + 1]); __builtin_amdgcn_sched_barrier(0);
                Ba = p2_ld4(kb_, 8);
                p2_score4(Bb, af[0], af[1], wq, sc0[st * 8 + 2], sc0[st * 8 + 3]); __builtin_amdgcn_sched_barrier(0);
                Bb = p2_ld4(kb_, 12);
                p2_score4(Ba, af[0], af[1], wq, sc0[st * 8 + 4], sc0[st * 8 + 5]); __builtin_amdgcn_sched_barrier(0);
                p2_score4(Bb, af[0], af[1], wq, sc0[st * 8 + 6], sc0[st * 8 + 7]);
            } else {
#pragma unroll
                for (int g = 0; g < 4; ++g) if (st * 16 + 4 * g <= blk) {
                    const P2B B = p2_ld4(kb_, 4 * g);
                    float r0, r1; p2_score4(B, af[0], af[1], wq, r0, r1);
                    sc0[st * 8 + 2 * g] = (st * 16 + 4 * g <= limt) ? r0 : -INFINITY;
                    sc0[st * 8 + 2 * g + 1] = (st * 16 + 4 * g + 2 <= limt) ? r1 : -INFINITY;
                    __builtin_amdgcn_sched_barrier(0);
                }
            }
            asm volatile("s_waitcnt lgkmcnt(0)" ::: "memory");
            __builtin_amdgcn_s_barrier();
        }
    }
#undef P2_ISSUE
    f32x4 tv[8];
    LAS float* iscr = (LAS float*)(c.lds + (wv < 7 ? 65536 + wv * 8448 : 133120));
    if (item >= 0) ex_item_load(c, item, tv);
    const int nreg = (ntile + 1) >> 1;
    float thr0 = -INFINITY; int quota0 = 0;
    if (blk >= 16) {
        float mn0 = INFINITY, mx0 = -INFINITY; int cp = 0, cn = 0;
#pragma unroll
        for (int g = 0; g < 4; ++g) if (nreg > 16 * g) {
#pragma unroll
            for (int i = 16 * g; i < 16 * g + 16; ++i) { mx0 = fmaxf(mx0, sc0[i]); mn0 = fminf(mn0, sc0[i] == -INFINITY ? INFINITY : sc0[i]); cp += (sc0[i] > 0.f) ? 1 : 0; cn += (sc0[i] >= 0.f) ? 1 : 0; } }
        mn0 = half_min(mn0); mx0 = half_max(mx0); cp = half_sum(cp); cn = half_sum(cn);
        float lo0, hi0; int chi0, clo0; bool done0 = false;
        if (cp <= KSEL && cn >= KSEL) { done0 = true; thr0 = 0.f; quota0 = KSEL - cp; lo0 = hi0 = 0.f; chi0 = 0; clo0 = KSEL + 1; }
        else if (cp > KSEL) { lo0 = 0.f; clo0 = cn; hi0 = mx0 + fabsf(mx0) * 1e-6f + 1e-30f; chi0 = 0; }
        else { lo0 = mn0; clo0 = t0 + hh + 1; hi0 = 0.f; chi0 = cn; }
        for (int it = 0; it < 200; ++it) {
            if (__builtin_amdgcn_ballot_w64(!done0) == 0ull) break;
            const float half_ = 0.5f * (lo0 + hi0);
            float mid0 = half_;
            if (!(it & 1)) { const float fr_ = ((float)(clo0 - KSEL) + 0.5f) / (float)(clo0 - chi0); const float mi = lo0 + (hi0 - lo0) * fr_; mid0 = (mi > lo0 && mi < hi0) ? mi : half_; }
            unsigned sa = 0u, sb = 0u; int nproc = 0;
#pragma unroll
            for (int g = 0; g < 4; ++g) if (nreg > 16 * g) { nproc += 16;
#pragma unroll
                for (int i = 16 * g; i < 16 * g + 16; ++i) { const unsigned tb_ = __builtin_bit_cast(unsigned, sc0[i] - mid0);
                    if (g < 2) sa = __builtin_amdgcn_alignbit(sa, tb_, 31); else sb = __builtin_amdgcn_alignbit(sb, tb_, 31); } }
            int c0 = half_sum(nproc - __builtin_popcount(sa) - __builtin_popcount(sb));
            if (!done0) { if (c0 == KSEL) { done0 = true; thr0 = mid0; quota0 = KSEL; } else if (mid0 <= lo0 || mid0 >= hi0) { done0 = true; thr0 = lo0; quota0 = KSEL - chi0; } else if (c0 > KSEL) { lo0 = mid0; clo0 = c0; } else { hi0 = mid0; chi0 = c0; } }
        }
        if (!done0) { thr0 = lo0; quota0 = KSEL - chi0; }
    }
    if (item >= 0) ex_item_finish(c, iscr, item, tv);
    if (item2 >= 0) ex_item_load(c, item2, tv);
    unsigned short* selp0 = (unsigned short*)(c.ws + WS_SEL) + (size_t)(n0 + hh) * KSEL;
    int base0 = 0, eq0 = 0; const unsigned ltm = (1u << r) - 1u;
#pragma unroll
    for (int g = 0; g < 4; ++g) if (nreg > 16 * g) {
#pragma unroll
        for (int i = 16 * g; i < 16 * g + 16; ++i) {
            bool sel_ = sc0[i] > thr0; const bool pe = sc0[i] == thr0; const unsigned long long me = __builtin_amdgcn_ballot_w64(pe);
            if (me) { const unsigned mh = hh ? (unsigned)(me >> 32) : (unsigned)me; sel_ = sel_ || (pe && (eq0 + __builtin_popcount(mh & ltm) < quota0)); eq0 += __builtin_popcount(mh); }
            const unsigned long long ms = __builtin_amdgcn_ballot_w64(sel_); const unsigned mh2 = hh ? (unsigned)(ms >> 32) : (unsigned)ms;
            const int pos = base0 + __builtin_popcount(mh2 & ltm); if (sel_ && pos < KSEL) selp0[pos] = (unsigned short)(32 * i + r); base0 += __builtin_popcount(mh2);
        } }
    if (item2 >= 0) ex_item_finish(c, iscr, item2, tv);
}
__device__ __forceinline__ void p2_indexer_topk(const Ctx& c) {
    for (int pu = c.bid; pu < 256; pu += c.G) {
        const int b = pu >> 5, j = pu & 31;
#pragma unroll 1
        for (int q = 0; q < 4; ++q) p2_unit(c, b, q == 0 ? j : (q == 1 ? 63 - j : (q == 2 ? 64 + j : 127 - j)), c.G == 256 ? q * 2048 + c.bid * NWAVES + c.wave : -1, (c.G == 256 && q < 2) ? (4 + q) * 2048 + c.bid * NWAVES + c.wave : -1);
    }
}


typedef short s16x4 __attribute__((ext_vector_type(4)));
constexpr int DSA_WS_OFF = 131072 + 2048;
constexpr int DSA_BIAS_OFF = 131072 + 2048 + 10240;
__device__ __forceinline__ void p3a_dsa(const Ctx& c) {
    const int lane = c.lane, wv = c.wave, l15 = lane & 15, g4 = lane >> 4;
    LAS unsigned char* kvb = c.lds + wv * 16384;
    LAS unsigned char* wsb = c.lds + DSA_WS_OFF + wv * 1280;
    LAS float* biasL = (LAS float*)(c.lds + DSA_BIAS_OFF);
    for (int i = c.tid; i < 129 * 8; i += NTHR) biasL[i] = ((const float*)(c.ws + WS_BIAS))[i];
    __syncthreads();
    const int prow = (l15 & 3) | ((l15 & 4) << 1) | ((l15 & 8) >> 1);
    const int rowx = ((prow & 3) << 2) | (prow >> 2);
    const unsigned qk_off = (unsigned)(256 * prow + 16 * (g4 ^ (rowx & 3))), qk_sx = (unsigned)(rowx >> 2);
    const int grow = 8 * (g4 & 1) + 4 * (g4 >> 1);
    const int trow = grow + (l15 >> 2), trx = ((trow & 3) << 2) | ((trow >> 2) & 3);
    const unsigned tr_off = (unsigned)(256 * trow + 16 * (((lane & 3) >> 1) ^ (trx & 1)) + 8 * (lane & 1)), tr_mx = (unsigned)(trx >> 1);
    const bf16* ckv = (const bf16*)(c.ws + WS_CKV);
    const float bfar = biasL[128 * 8 + (l15 & 7)];
    float bmax = 0.f;
    for (int d = 0; d <= 128; ++d) bmax = fmaxf(bmax, fabsf(biasL[d * 8 + (l15 & 7)]));
    const float kvmax = 11.313708499f * 1.004f * wave_max(fmaxf(fabsf(c.kv_g[2 * lane]), fabsf(c.kv_g[2 * lane + 1])));
    unsigned trm[8];
#pragma unroll
    for (int m = 0; m < 8; ++m) trm[m] = tr_off + 32u * ((unsigned)m ^ tr_mx);
    const int gw = c.bid * NWAVES + wv, NGW = c.G * NWAVES;
    const int eit0 = (c.G == 256 ? P0_EXPERT_ITEMS : 0) + gw;
    if (wv < 4) for (int eit = eit0; eit < P0_EXPERT_ITEMS; eit += NGW) p0_expert_item(c, (LAS float*)kvb, eit);
    asm volatile("s_waitcnt lgkmcnt(0)" ::: "memory");
#define DSA_LOADQ(n_, raw_, qf_) do { raw_ = *(const v2u*)((const unsigned short*)(c.ws + WS_SEL) + (size_t)(n_) * KSEL + 4 * lane); \
        const s16x8* qp_ = (const s16x8*)((const bf16*)(c.ws + WS_QLAT) + (size_t)(n_) * 1024 + (l15 & 7) * 128 + 8 * g4); \
        _Pragma("unroll") for (int s_ = 0; s_ < 4; ++s_) qf_[s_] = qp_[4 * s_]; } while (0)
#define DSA_PREP(n_, raw_, qf_, sl_, t_, cnt_, nch_, nfar_, mref_) do { t_ = (n_) & 2047; cnt_ = (t_ + 1 < KSEL) ? t_ + 1 : KSEL; nch_ = (cnt_ + 31) >> 5; \
        { const int i0 = 4 * lane, lim = t_ - 128; \
          raw_.x = (i0 < cnt_ ? (raw_.x & 0xffffu) : 0u) | (i0 + 1 < cnt_ ? (raw_.x & 0xffff0000u) : 0u); raw_.y = (i0 + 2 < cnt_ ? (raw_.y & 0xffffu) : 0u) | (i0 + 3 < cnt_ ? (raw_.y & 0xffff0000u) : 0u); \
          *(LAS v2u*)(wsb + (sl_) * 512 + 8 * lane) = raw_; \
          const int e0 = (i0 < cnt_ && (int)(raw_.x & 0xffffu) <= lim) ? 1 : 0, e1 = (i0 + 1 < cnt_ && (int)(raw_.x >> 16) <= lim) ? 1 : 0, e2 = (i0 + 2 < cnt_ && (int)(raw_.y & 0xffffu) <= lim) ? 1 : 0, e3 = (i0 + 3 < cnt_ && (int)(raw_.y >> 16) <= lim) ? 1 : 0; \
          int nf = e0 + e1 + e2 + e3; nf += DPP_I(nf, 0xB1); nf += DPP_I(nf, 0x4E); nf += DPP_I(nf, 0x141); nf += DPP_I(nf, 0x140); nf = x16_sumi(nf); { unsigned xa, xb; swap32((unsigned)nf, xa, xb); nf = (int)(xa + xb); } \
          nfar_ = __builtin_amdgcn_readfirstlane(nf) >> 5; } \
        { float q2 = 0.f; \
          _Pragma("unroll") for (int s_ = 0; s_ < 4; ++s_) { if (l15 >= 8) qf_[s_] = (s16x8){0, 0, 0, 0, 0, 0, 0, 0}; \
              _Pragma("unroll") for (int e = 0; e < 8; ++e) { const float qv = bf2f((unsigned)(unsigned short)qf_[s_][e]); q2 += qv * qv; } } \
          q2 = x16_sum(q2); q2 = x32_sum(q2); mref_ = sqrtf(q2) * kvmax + bmax; } } while (0)
#define DSA_ISSUE(ch_, bi_, k8_, sl_, n_, t_, cnt_, nfar_) do { const bf16* ckb_ = ckv + (size_t)((n_) >> 11) * SEQ * 128; \
            _Pragma("unroll") for (int u = 0; u < 8; ++u) { const unsigned kw = u < 2 ? k8_.x : (u < 4 ? k8_.y : (u < 6 ? k8_.z : k8_.w)); const unsigned key = (u & 1) ? (kw >> 16) : (kw & 0xffffu); \
                const int chl = l15 ^ ((g4 << 2) | (u & 3)); \
                __builtin_amdgcn_global_load_lds((const unsigned*)((const char*)ckb_ + (size_t)(unsigned)(key * 256u + (unsigned)chl * 16u)), (LAS unsigned*)(kvb + (bi_) * 8192 + u * 1024), 16, 0, 0); } \
            if ((ch_) >= (nfar_) && lane < 32) { const int kap = 32 * (ch_) + 8 * (lane & 3) + (lane >> 2); const int key = *(const LAS unsigned short*)(wsb + (sl_) * 512 + 2 * kap); int dd = (t_) - key; dd = dd > 128 ? 128 : dd; dd = kap < (cnt_) ? dd : 255; \
                *(LAS unsigned short*)(wsb + 1024 + (bi_) * 64 + 2 * lane) = (unsigned short)dd; } } while (0)
    const bool mixq = (NGW == SEQ);
#define DSA_QIDX(i_) (mixq ? ((i_) * SEQ + ((gw + 293 * (i_)) & (SEQ - 1))) : (gw + (i_) * NGW))
    const int nq = mixq ? BATCH : (NTOK - gw + NGW - 1) / NGW;
    int qi = 0, n = DSA_QIDX(0), sl = 0, b0 = 0, t = 0, cnt = 0, nch = 0, nfar = 0; float Mref = 0.f;
    s16x8 qf[4]; v2u rawn; s16x8 qfn[4];
    if (nq > 0) { v2u raw0; DSA_LOADQ(n, raw0, qf); DSA_PREP(n, raw0, qf, 0, t, cnt, nch, nfar, Mref);
        asm volatile("s_waitcnt lgkmcnt(0)" ::: "memory");
        const v4u k80 = *(const LAS v4u*)(wsb + (8 * g4) * 2); DSA_ISSUE(0, 0, k80, 0, n, t, cnt, nfar); }
    for (; qi < nq; ++qi) {
        const bool has_next = qi + 1 < nq; const int nn = has_next ? DSA_QIDX(qi + 1) : n;
        if (has_next) DSA_LOADQ(nn, rawn, qfn);
        int tn = 0, cntn = 0, nchn = 0, nfarn = 0; float Mrefn = 0.f;
        f32x4 O[8];
#pragma unroll
        for (int m = 0; m < 8; ++m) O[m] = (f32x4){0.f, 0.f, 0.f, 0.f};
        float l_run = 0.f;
        v4u k8n = *(const LAS v4u*)(wsb + sl * 512 + (32 * (nch > 1 ? 1 : 0) + 8 * g4) * 2);
        for (int ch = 0; ch < nch; ++ch) {
            const int bi = (b0 + ch) & 1;
            asm volatile("s_waitcnt lgkmcnt(0)" ::: "memory");
            if (ch + 1 < nch) { const v4u k8 = k8n; k8n = *(const LAS v4u*)(wsb + sl * 512 + (32 * (ch + 2 < 8 ? ch + 2 : 7) + 8 * g4) * 2);
                DSA_ISSUE(ch + 1, bi ^ 1, k8, sl, n, t, cnt, nfar); asm volatile("s_waitcnt vmcnt(8)" ::: "memory"); }
            else if (has_next) { DSA_PREP(nn, rawn, qfn, sl ^ 1, tn, cntn, nchn, nfarn, Mrefn);
                asm volatile("s_waitcnt lgkmcnt(0)" ::: "memory");
                const v4u k8 = *(const LAS v4u*)(wsb + (sl ^ 1) * 512 + (8 * g4) * 2);
                DSA_ISSUE(0, bi ^ 1, k8, sl ^ 1, nn, tn, cntn, nfarn); asm volatile("s_waitcnt vmcnt(8)" ::: "memory"); }
            else asm volatile("s_waitcnt vmcnt(0)" ::: "memory");
            const LAS unsigned char* kb_ = kvb + bi * 8192;
            f32x4 S[2];
#pragma unroll
            for (int T = 0; T < 2; ++T) { f32x4 a4 = {0.f, 0.f, 0.f, 0.f};
#pragma unroll
                for (int s_ = 0; s_ < 4; ++s_) { const s16x8 a = *(const LAS s16x8*)(kb_ + qk_off + 4096 * T + 64 * ((unsigned)s_ ^ qk_sx)); a4 = __builtin_amdgcn_mfma_f32_16x16x32_bf16(a, qf[s_], a4, 0, 0, 0); }
                S[T] = a4; }
            if (ch < nfar) {
#pragma unroll
                for (int T = 0; T < 2; ++T)
#pragma unroll
                    for (int r_ = 0; r_ < 4; ++r_) S[T][r_] = S[T][r_] + (bfar - Mref);
            } else
#pragma unroll
            for (int T = 0; T < 2; ++T) { const v2u d4 = *(const LAS v2u*)(wsb + 1024 + bi * 64 + 2 * (16 * T + grow));
#pragma unroll
                for (int r_ = 0; r_ < 4; ++r_) { const unsigned dw = r_ < 2 ? d4.x : d4.y; const unsigned dd = (r_ & 1) ? (dw >> 16) : (dw & 0xffffu);
                    const float bsv = biasL[(dd > 128u ? 128u : dd) * 8 + (l15 & 7)]; S[T][r_] = (dd == 255u) ? -INFINITY : S[T][r_] + (bsv - Mref); } }
#pragma unroll
            for (int T = 0; T < 2; ++T)
#pragma unroll
                for (int r_ = 0; r_ < 4; ++r_) { const float pv = __expf(S[T][r_]); S[T][r_] = pv; l_run += pv; }
            s16x8 P;
            { const unsigned p0 = cvt_pk(S[0][0], S[0][1]), p1 = cvt_pk(S[0][2], S[0][3]), p2 = cvt_pk(S[1][0], S[1][1]), p3 = cvt_pk(S[1][2], S[1][3]);
              const v4u pw_ = {p0, p1, p2, p3}; P = __builtin_bit_cast(s16x8, pw_); }
            { const unsigned kba = (unsigned)(size_t)kb_; s16x4 ta[8], tb[8];
#pragma unroll
              for (int m = 0; m < 8; ++m) { const unsigned ad = kba + trm[m];
                  asm volatile("ds_read_b64_tr_b16 %0, %1" : "=v"(ta[m]) : "v"(ad) : "memory"); asm volatile("ds_read_b64_tr_b16 %0, %1 offset:4096" : "=v"(tb[m]) : "v"(ad) : "memory"); }
              asm volatile("s_waitcnt lgkmcnt(8)" ::: "memory"); __builtin_amdgcn_sched_barrier(0);
#pragma unroll
              for (int m = 0; m < 4; ++m) O[m] = __builtin_amdgcn_mfma_f32_16x16x32_bf16(__builtin_shufflevector(ta[m], tb[m], 0, 1, 2, 3, 4, 5, 6, 7), P, O[m], 0, 0, 0);
              asm volatile("s_waitcnt lgkmcnt(0)" ::: "memory"); __builtin_amdgcn_sched_barrier(0);
#pragma unroll
              for (int m = 4; m < 8; ++m) O[m] = __builtin_amdgcn_mfma_f32_16x16x32_bf16(__builtin_shufflevector(ta[m], tb[m], 0, 1, 2, 3, 4, 5, 6, 7), P, O[m], 0, 0, 0); }
        }
        l_run = x16_sum(l_run); l_run = x32_sum(l_run);
        const float inv = 1.0f / fmaxf(l_run, 1e-37f);
        { LAS unsigned char* stg = kvb + ((b0 + nch - 1) & 1) * 8192;
          if (l15 < 8) {
#pragma unroll
              for (int m = 0; m < 8; ++m) *(LAS v2u*)(stg + (l15 * 128 + 16 * m + 4 * g4) * 2) = (v2u){cvt_pk(O[m][0] * inv, O[m][1] * inv), cvt_pk(O[m][2] * inv, O[m][3] * inv)}; }
          asm volatile("s_waitcnt lgkmcnt(0)" ::: "memory");
          const v4u oa = *(const LAS v4u*)(stg + lane * 16), ob = *(const LAS v4u*)(stg + 1024 + lane * 16);
          bf16* op = (bf16*)(c.ws + WS_XB) + (size_t)n * 1024 + lane * 8;
          *(v4u*)op = oa; *(v4u*)(op + 512) = ob; }
        b0 = (b0 + nch) & 1; sl ^= 1; t = tn; cnt = cntn; nch = nchn; nfar = nfarn; Mref = Mrefn; n = nn;
#pragma unroll
        for (int s_ = 0; s_ < 4; ++s_) qf[s_] = qfn[s_];
    }
#undef DSA_QIDX
#undef DSA_LOADQ
#undef DSA_PREP
#undef DSA_ISSUE
    asm volatile("s_waitcnt vmcnt(0) lgkmcnt(0)" ::: "memory");
    if (wv >= 4) for (int eit = eit0; eit < P0_EXPERT_ITEMS; eit += NGW) p0_expert_item(c, (LAS float*)kvb, eit);
    __syncthreads();
}

__device__ __forceinline__ void p3b_swa(const Ctx& c) {
    const int lane = c.lane, wv = c.wave, l15 = lane & 15, g4 = lane >> 4, g = wv & 3, hq = wv >> 2;
    LAS float* biasL = (LAS float*)(c.lds + DSA_BIAS_OFF);
    __syncthreads();
    for (int i = c.tid; i < 128 * 8; i += NTHR) biasL[i] = ((const float*)(c.ws + WS_BIAS) + 129 * 8)[i];
    __syncthreads();
    const unsigned kr_off = (unsigned)(128 * l15), kr_x = (unsigned)(l15 & 7);
    const int vrow = 4 * g4 + (l15 >> 2); const unsigned vr_x = (unsigned)(vrow & 7), vp1 = (unsigned)((lane & 3) >> 1);
    const unsigned vr_off = (unsigned)(128 * vrow + 8 * (lane & 1));
    for (int unit = c.bid; unit < 256; unit += c.G) {
        const int b = unit >> 5, qb = (unit >> 1) & 15, kvh = unit & 1, head = kvh * 4 + g;
        __syncthreads();
#pragma unroll
        for (int j = 0; j < 4; ++j) { const int piece = wv * 4 + j, row = 8 * piece + (lane >> 3), chunk = (lane & 7) ^ (row & 7); int key = (qb - 1) * 128 + row; key = key < 0 ? 0 : key;
            const size_t so = ((size_t)(b * SEQ + key) * 128 + kvh * 64 + chunk * 8);
            __builtin_amdgcn_global_load_lds((const unsigned*)((const bf16*)(c.ws + WS_KB) + so), (LAS unsigned*)(c.lds + piece * 1024), 16, 0, 0);
            __builtin_amdgcn_global_load_lds((const unsigned*)((const bf16*)(c.ws + WS_VB) + so), (LAS unsigned*)(c.lds + 32768 + piece * 1024), 16, 0, 0); }
        float bt[9][4];
#pragma unroll
        for (int ta = 0; ta < 9; ++ta)
#pragma unroll
            for (int r_ = 0; r_ < 4; ++r_) { const int dist = 128 + l15 - 16 * ta - 4 * g4 - r_; bt[ta][r_] = (dist >= 0 && dist < 128) ? biasL[dist * 8 + head] : -INFINITY; }
        const float sink = c.sinks[head];
        asm volatile("s_waitcnt vmcnt(0)" ::: "memory");
        __syncthreads();
#pragma unroll 1
        for (int jj = 0; jj < 4; ++jj) {
            const int j = 4 * hq + jj; const size_t nrow = (size_t)(b * SEQ + qb * 128 + 16 * j + l15);
            bf16* qrow = (bf16*)(c.ws + WS_QB) + nrow * 512 + head * 64;
            const s16x8 q0 = *(const s16x8*)(qrow + 8 * g4), q1 = *(const s16x8*)(qrow + 32 + 8 * g4);
            f32x4 S[9]; float mx = sink;
#pragma unroll
            for (int ta = 0; ta < 9; ++ta) { const int kt = j + ta; const LAS unsigned char* kp = c.lds + kr_off + 2048 * kt;
                f32x4 a4 = {0.f, 0.f, 0.f, 0.f};
                a4 = __builtin_amdgcn_mfma_f32_16x16x32_bf16(*(const LAS s16x8*)(kp + 16 * ((unsigned)g4 ^ kr_x)), q0, a4, 0, 0, 0);
                a4 = __builtin_amdgcn_mfma_f32_16x16x32_bf16(*(const LAS s16x8*)(kp + 16 * ((unsigned)(4 + g4) ^ kr_x)), q1, a4, 0, 0, 0);
                const bool dead = (qb == 0 && kt < 8);
#pragma unroll
                for (int r_ = 0; r_ < 4; ++r_) { const float sv = dead ? -INFINITY : a4[r_] + bt[ta][r_]; a4[r_] = sv; mx = fmaxf(mx, sv); }
                S[ta] = a4; }
            mx = x16_max(mx); mx = x32_max(mx);
            float ps = 0.f;
#pragma unroll
            for (int ta = 0; ta < 9; ++ta)
#pragma unroll
                for (int r_ = 0; r_ < 4; ++r_) { const float pv = __expf(S[ta][r_] - mx); S[ta][r_] = pv; ps += pv; }
            ps = x16_sum(ps); ps = x32_sum(ps);
            const float inv = 1.0f / (ps + __expf(sink - mx));
            f32x4 O[4];
#pragma unroll
            for (int m = 0; m < 4; ++m) O[m] = (f32x4){0.f, 0.f, 0.f, 0.f};
#pragma unroll
            for (int pp = 0; pp < 5; ++pp) {
                const int ta = 2 * pp, tb = 2 * pp + 1;
                v4u pw_; pw_.x = cvt_pk(S[ta][0] * inv, S[ta][1] * inv); pw_.y = cvt_pk(S[ta][2] * inv, S[ta][3] * inv);
                if (tb < 9) { pw_.z = cvt_pk(S[tb < 9 ? tb : 0][0] * inv, S[tb < 9 ? tb : 0][1] * inv); pw_.w = cvt_pk(S[tb < 9 ? tb : 0][2] * inv, S[tb < 9 ? tb : 0][3] * inv); } else { pw_.z = 0u; pw_.w = 0u; }
                const s16x8 P = __builtin_bit_cast(s16x8, pw_);
                const LAS unsigned char* va = c.lds + 32768 + vr_off + 2048 * (j + ta); const LAS unsigned char* vb_ = c.lds + 32768 + vr_off + 2048 * (j + (tb < 9 ? tb : ta));
#pragma unroll
                for (int m = 0; m < 4; ++m) { const unsigned co = 16u * ((unsigned)(2 * m + vp1) ^ vr_x);
                    const s16x4 a0 = __builtin_amdgcn_ds_read_tr16_b64_v4i16((LAS s16x4*)(va + co)), a1 = __builtin_amdgcn_ds_read_tr16_b64_v4i16((LAS s16x4*)(vb_ + co));
                    O[m] = __builtin_amdgcn_mfma_f32_16x16x32_bf16(__builtin_shufflevector(a0, a1, 0, 1, 2, 3, 4, 5, 6, 7), P, O[m], 0, 0, 0); }
            }
#pragma unroll
            for (int m = 0; m < 4; ++m) *(v2u*)(qrow + 16 * m + 4 * g4) = (v2u){cvt_pk(O[m][0], O[m][1]), cvt_pk(O[m][2], O[m][3])};
        }
    }
    __syncthreads();
}

__device__ __forceinline__ void p6_ln_router(const Ctx& c, bf16* x1b) {
    const int lane = c.lane, wv = c.wave, l15 = lane & 15, g4 = lane >> 4;
    LAS unsigned char* XH = c.lds; LAS unsigned char* XL = c.lds + 32768;
    LAS float* PL = (LAS float*)(c.lds + 65536);
    LAS float* LG = (LAS float*)(c.lds + 65536 + 24576);
    const bf16* WH = (const bf16*)(c.ws + WS_WRT); const bf16* WL = WH + 48 * 1024;
    LAS unsigned* PEX = (LAS unsigned*)(c.lds + 65536 + 24576 + 4096);
    LAS unsigned* EB = PEX + 128;
    int nbase = 0;
    s16x8 wbh[4][3], wbl[4][3];
#pragma unroll
    for (int s_ = 0; s_ < 4; ++s_)
#pragma unroll
        for (int nt = 0; nt < 3; ++nt) { const size_t wo = (size_t)(16 * nt + l15) * 1024 + 128 * wv + 32 * s_ + 8 * g4; wbh[s_][nt] = *(const s16x8*)(WH + wo); wbl[s_][nt] = *(const s16x8*)(WL + wo); }
    v2u vn[2][4];
    const bf16* h1b = (const bf16*)(c.ws + WS_H1B);
    if (c.bid < NTOK / 16) {
#pragma unroll
        for (int q = 0; q < 2; ++q)
#pragma unroll
            for (int j = 0; j < 4; ++j) vn[q][j] = ((const v2u*)(h1b + (size_t)(c.bid * 16 + 2 * wv + q) * D) + lane)[64 * j]; }
    for (int u = c.bid; u < NTOK / 16; u += c.G) {
        __syncthreads();
#pragma unroll
        for (int q = 0; q < 2; ++q) { const int tk = 2 * wv + q, n = u * 16 + tk;
            f32x4 v[4]; float s = 0.f;
#pragma unroll
            for (int j = 0; j < 4; ++j) { v[j] = (f32x4){bflo(vn[q][j].x), bfhi(vn[q][j].x), bflo(vn[q][j].y), bfhi(vn[q][j].y)}; s += (v[j].x + v[j].y) + (v[j].z + v[j].w); }
            const float mean = wave_sum(s) * (1.f / D); float s2 = 0.f;
#pragma unroll
            for (int j = 0; j < 4; ++j) { v[j] = v[j] - mean; s2 += (v[j].x * v[j].x + v[j].y * v[j].y) + (v[j].z * v[j].z + v[j].w * v[j].w); }
            const float rstd = 1.f / sqrtf(wave_sum(s2) * (1.f / D) + LN_EPS);
#pragma unroll
            for (int j = 0; j < 4; ++j) { const int k0 = 4 * lane + 256 * j;
                const f32x4 g = *(const f32x4*)(c.ln1_g + k0), bb = *(const f32x4*)(c.ln1_b + k0);
                const f32x4 y = v[j] * rstd * g + bb;
                const unsigned h01 = pk2(y.x, y.y), h23 = pk2(y.z, y.w);
                *(v2u*)(x1b + (size_t)n * D + k0) = (v2u){h01, h23};
                const unsigned l01 = pk2(y.x - bflo(h01), y.y - bfhi(h01)), l23 = pk2(y.z - bflo(h23), y.w - bfhi(h23));
                const unsigned off = (unsigned)(tk * 2048 + ((((lane >> 1) + 32 * j) ^ tk) << 4) + 8 * (lane & 1));
                *(LAS v2u*)(XH + off) = (v2u){h01, h23}; *(LAS v2u*)(XL + off) = (v2u){l01, l23}; } }
        if (u + c.G < NTOK / 16) {
#pragma unroll
            for (int q = 0; q < 2; ++q)
#pragma unroll
                for (int j = 0; j < 4; ++j) vn[q][j] = ((const v2u*)(h1b + (size_t)((u + c.G) * 16 + 2 * wv + q) * D) + lane)[64 * j]; }
        __syncthreads();
        { f32x4 acc[3];
#pragma unroll
          for (int nt = 0; nt < 3; ++nt) acc[nt] = (f32x4){0.f, 0.f, 0.f, 0.f};
#pragma unroll
          for (int s_ = 0; s_ < 4; ++s_) { const int chunk = 4 * (4 * wv + s_) + g4; const unsigned off = (unsigned)(l15 * 2048 + ((chunk ^ l15) << 4));
              const s16x8 ah = *(const LAS s16x8*)(XH + off), al = *(const LAS s16x8*)(XL + off);
#pragma unroll
              for (int nt = 0; nt < 3; ++nt) { const s16x8 bh = wbh[s_][nt], bl = wbl[s_][nt];
                  acc[nt] = __builtin_amdgcn_mfma_f32_16x16x32_bf16(al, bl, acc[nt], 0, 0, 0); acc[nt] = __builtin_amdgcn_mfma_f32_16x16x32_bf16(al, bh, acc[nt], 0, 0, 0);
                  acc[nt] = __builtin_amdgcn_mfma_f32_16x16x32_bf16(ah, bl, acc[nt], 0, 0, 0); acc[nt] = __builtin_amdgcn_mfma_f32_16x16x32_bf16(ah, bh, acc[nt], 0, 0, 0); } }
#pragma unroll
          for (int nt = 0; nt < 3; ++nt)
#pragma unroll
              for (int r_ = 0; r_ < 4; ++r_) PL[(wv * 16 + 4 * g4 + r_) * 48 + 16 * nt + l15] = acc[nt][r_]; }
        __syncthreads();
        for (int i = c.tid; i < 16 * 48; i += NTHR) { float a = 0.f;
#pragma unroll
            for (int w = 0; w < 8; ++w) a += PL[w * 768 + i];
            const int o = i % 48; a += o < 32 ? c.b_router[o] : (o < 36 ? c.b_group[o - 32] : 0.f);
            LG[i] = a; }
        __syncthreads();
        if (c.tid < 16) { const int n = u * 16 + c.tid; const LAS float* lg = LG + c.tid * 48; const int nloc = nbase + 2 * c.tid;
            int gs = 0; float gm = lg[32];
            for (int o = 1; o < 4; ++o) { const float v = lg[32 + o]; if (v > gm) { gm = v; gs = o; } }
            float gsum = 0.f;
            for (int o = 0; o < 4; ++o) gsum += __expf(lg[32 + o] - gm);
            const float gw_ = 1.0f / gsum;
            int i1 = 0; float m1 = lg[gs * 8];
            for (int o = 1; o < 8; ++o) { const float v = lg[gs * 8 + o]; if (v > m1) { m1 = v; i1 = o; } }
            int i2 = -1; float m2 = -INFINITY;
            for (int o = 0; o < 8; ++o) { const float v = lg[gs * 8 + o]; if (o != i1 && v > m2) { m2 = v; i2 = o; } }
            const float e2 = __expf(m2 - m1), w1 = gw_ / (1.0f + e2), w2 = gw_ * e2 / (1.0f + e2);
            const int ex1 = gs * 8 + i1, ex2 = gs * 8 + i2;
            ((unsigned*)(c.ws + WS_PE))[2 * n] = ex1; ((unsigned*)(c.ws + WS_PE))[2 * n + 1] = ex2; ((float*)(c.ws + WS_PW))[2 * n] = w1; ((float*)(c.ws + WS_PW))[2 * n + 1] = w2;
            PEX[nloc] = (unsigned)ex1 | ((unsigned)(2 * n) << 8); PEX[nloc + 1] = (unsigned)ex2 | ((unsigned)(2 * n + 1) << 8); }
        nbase += 32;
        if (nbase == 128 || u + c.G >= NTOK / 16) {
            __syncthreads();
            if (c.tid < 32) { unsigned cntE = 0; for (int j = 0; j < nbase; ++j) cntE += ((PEX[j] & 0xffu) == (unsigned)c.tid) ? 1u : 0u;
                EB[c.tid] = cntE ? atomicAdd(c.ctl + CW_CNT + c.tid, cntE) : 0u; }
            __syncthreads();
            if (c.tid < nbase) { const unsigned rec = PEX[c.tid], e = rec & 0xffu; unsigned rk = 0; for (int j = 0; j < c.tid; ++j) rk += ((PEX[j] & 0xffu) == e) ? 1u : 0u;
                ((unsigned*)(c.ws + WS_LIST))[(size_t)e * 32768 + EB[e] + rk] = rec >> 8; }
            nbase = 0;
        }
    }
    __syncthreads();
}


__device__ __forceinline__ void p9_ln2(const Ctx& c) {
    const int gw = c.bid * NWAVES + c.wave, NGW = c.G * NWAVES;
    v2u xn[4], san[4], sbn[4];
#define P9_LOAD(n_) do { _Pragma("unroll") for (int j = 0; j < 4; ++j) { const int k0 = 4 * c.lane + 256 * j; xn[j] = *(const v2u*)((const bf16*)(c.ws + WS_XB) + (size_t)(n_) * D + k0); \
            san[j] = *(const v2u*)((const bf16*)(c.ws + WS_SLOT) + (size_t)(2 * (n_)) * D + k0); sbn[j] = *(const v2u*)((const bf16*)(c.ws + WS_SLOT) + (size_t)(2 * (n_) + 1) * D + k0); } } while (0)
    if (gw < NTOK) P9_LOAD(gw);
    for (int n = gw; n < NTOK; n += NGW) {
        f32x4* row = (f32x4*)(c.out + (size_t)n * D) + c.lane;
        f32x4 v[4]; float s = 0.f;
#pragma unroll
        for (int j = 0; j < 4; ++j) { f32x4 y;
            y.x = bflo(xn[j].x) * ALPHA + (bflo(san[j].x) + bflo(sbn[j].x)); y.y = bfhi(xn[j].x) * ALPHA + (bfhi(san[j].x) + bfhi(sbn[j].x));
            y.z = bflo(xn[j].y) * ALPHA + (bflo(san[j].y) + bflo(sbn[j].y)); y.w = bfhi(xn[j].y) * ALPHA + (bfhi(san[j].y) + bfhi(sbn[j].y));
            v[j] = y; s += (y.x + y.y) + (y.z + y.w); }
        if (n + NGW < NTOK) P9_LOAD(n + NGW);
        const float mean = wave_sum(s) * (1.f / D); float s2 = 0.f;
#pragma unroll
        for (int j = 0; j < 4; ++j) { v[j] = v[j] - mean; s2 += (v[j].x * v[j].x + v[j].y * v[j].y) + (v[j].z * v[j].z + v[j].w * v[j].w); }
        const float rstd = 1.f / sqrtf(wave_sum(s2) * (1.f / D) + LN_EPS);
#pragma unroll
        for (int j = 0; j < 4; ++j) { const int k0 = 4 * c.lane + 256 * j; const f32x4 g = *(const f32x4*)(c.ln2_g + k0), bb = *(const f32x4*)(c.ln2_b + k0); row[64 * j] = v[j] * rstd * g + bb; }
    }
#undef P9_LOAD
}

namespace pg8 {
typedef short bf16x8 __attribute__((ext_vector_type(8)));
constexpr int BM = 256, BK = 64, HALF = 128, HTB = HALF * BK * 2, STAGE_BYTES = 8 * HTB, NXCD = 8, WGM = 8;
__host__ __device__ __forceinline__ int lds_byte(int r, int c) { const int st = (r >> 4) * 2 + (c >> 5), rr = r & 15, cc = c & 31, ob = rr * 64 + cc * 2; return st * 1024 + (ob ^ (((ob >> 9) & 1) << 5)); }
__host__ __device__ __forceinline__ void stage_rc(int b, int& R, int& C) { const int st = b / 1024, sb = b % 1024, swz = sb ^ (((sb >> 9) & 1) << 5); R = (st >> 1) * 16 + swz / 64; C = (st & 1) * 32 + (swz % 64) / 2; }
__host__ __device__ __forceinline__ int perm32(int rho) { const int n = rho >> 4, i = rho & 15; return 8 * (i >> 2) + 4 * n + (i & 3); }
__device__ __forceinline__ unsigned cvt_pk_bf16(float lo, float hi) { unsigned r; asm volatile("v_cvt_pk_bf16_f32 %0, %1, %2" : "=v"(r) : "v"(lo), "v"(hi)); return r; }

struct Unit { int pm, pn, pb, aux; };

struct StaticOrder {
    int nM, nN, nwg, G, c;
    __device__ void init(int M, int N, int G_, int c_) { nM = M / BM; nN = N / BM; nwg = nM * nN; G = G_; c = c_; }
    __device__ bool next(int i, Unit& u) const {
        const long L = (long)i * G + c; if (L >= nwg) return false;
        int wgid = (int)L; { const int q = nwg / NXCD, r = nwg % NXCD, xcd = wgid % NXCD, off = wgid / NXCD; wgid = (xcd < r ? xcd * (q + 1) : r * (q + 1) + (xcd - r) * q) + off; }
        const int nig = WGM * nN, gid = wgid / nig, fm = gid * WGM, gsz = (nM - fm) < WGM ? (nM - fm) : WGM;
        u.pm = fm + ((wgid % nig) % gsz); u.pn = (wgid % nig) / gsz; u.pb = u.pn; u.aux = 0; return true;
    }
    __device__ __forceinline__ void a_ready(const Unit&) const {}
    __device__ __forceinline__ void done(const Unit&) const {}
};
struct DenseProb {
    static constexpr bool GATHER = false;
    const bf16* A; const bf16* Bt; int K;
    __device__ __forceinline__ const char* a_base(const Unit& u) const { return (const char*)A + (size_t)u.pm * 256 * K * 2; }
    __device__ __forceinline__ const char* b_base(const Unit& u) const { return (const char*)Bt + (size_t)u.pb * 256 * K * 2; }
    __device__ __forceinline__ void a_offs(const Unit&, int R0, int C0, int R1, int C1, unsigned (&o)[2][2]) const {
        o[0][0] = (unsigned)(R0 * K + C0) * 2u; o[0][1] = (unsigned)(R1 * K + C1) * 2u; o[1][0] = o[0][0] + (unsigned)(HALF * K * 2); o[1][1] = o[0][1] + (unsigned)(HALF * K * 2); }
};

template <class Prob, class Epi, class Sched>
__device__ __forceinline__ void gemm_phase(LAS unsigned char* lds, const Prob& P, const Sched& S, const Epi& E) {
    const int tid = threadIdx.x, wid = __builtin_amdgcn_readfirstlane(tid >> 6), lane = tid & 63, wr = wid >> 2, wc = wid & 3, fr = lane & 15, fq = lane >> 4;
    const int K = P.K, nt = K / BK;
    int sR[2], sC[2];
    unsigned offB[2][2], offA[2][2];
#pragma unroll
    for (int i = 0; i < 2; ++i) { stage_rc(tid * 16 + i * 8192, sR[i], sC[i]); const int Rb = Epi::PERM ? ((sR[i] & ~31) + perm32(sR[i] & 31)) : sR[i];
        offB[0][i] = (unsigned)(Rb * K + sC[i]) * 2u; offB[1][i] = offB[0][i] + (unsigned)(HALF * K * 2); }
    const size_t kstep = (size_t)(BK * 2);
    const unsigned ldsw = (unsigned)wid * 1024u;
    const int aoff = lds_byte(wr * 64 + fr, fq * 8), boff = lds_byte(wc * 32 + fr, fq * 8);
#define PG8_SA(b, h) (((b) * 2 + (h)) * HTB)
#define PG8_SB(b, h) ((4 + (b) * 2 + (h)) * HTB)
#define PG8_STAGE(bufoff, gbase, offs) do { _Pragma("unroll") for (int _i = 0; _i < 2; ++_i) \
        __builtin_amdgcn_global_load_lds((const unsigned*)((gbase) + (offs)[_i]), (LAS unsigned*)(lds + (bufoff) + ldsw + _i * 8192), 16, 0, 0); } while (0)
#define PG8_STA(b, h, tau) PG8_STAGE(PG8_SA(b, h), sA + (size_t)(tau) * kstep, offA[h])
#define PG8_STB(b, h, tau) PG8_STAGE(PG8_SB(b, h), sB + (size_t)(tau) * kstep, offB[h])
#define PG8_LDA(dst, b, h) do { _Pragma("unroll") for (int m = 0; m < 4; ++m) _Pragma("unroll") for (int k = 0; k < 2; ++k) dst[m][k] = *(const LAS bf16x8*)(lds + PG8_SA(b, h) + aoff + m * 2048 + k * 1024); } while (0)
#define PG8_LDB(dst, b, h) do { _Pragma("unroll") for (int n = 0; n < 2; ++n) _Pragma("unroll") for (int k = 0; k < 2; ++k) dst[n][k] = *(const LAS bf16x8*)(lds + PG8_SB(b, h) + boff + n * 2048 + k * 1024); } while (0)
#define PG8_MMA(ai, bj, At, Bt) do { __builtin_amdgcn_s_setprio(1); _Pragma("unroll") for (int m = 0; m < 4; ++m) _Pragma("unroll") for (int n = 0; n < 2; ++n) _Pragma("unroll") for (int k = 0; k < 2; ++k) \
        acc[ai][bj][m][n] = __builtin_amdgcn_mfma_f32_16x16x32_bf16(Bt[n][k], At[m][k], acc[ai][bj][m][n], 0, 0, 0); __builtin_amdgcn_s_setprio(0); } while (0)
#define PG8_WAIT_V(n) asm volatile("s_waitcnt vmcnt(" #n ")" ::: "memory")
#define PG8_WAIT_L(n) asm volatile("s_waitcnt lgkmcnt(" #n ")" ::: "memory")
#define PG8_BAR __builtin_amdgcn_s_barrier()
#define PG8_SCHED __builtin_amdgcn_sched_barrier(0)
    Unit cur, nxt; int ui = 0;
    if (!S.next(0, cur)) return;
    f32x4 acc[2][2][4][2];
#pragma unroll
    for (int a = 0; a < 2; ++a)
#pragma unroll
        for (int b = 0; b < 2; ++b)
#pragma unroll
            for (int m = 0; m < 4; ++m)
#pragma unroll
                for (int n = 0; n < 2; ++n) acc[a][b][m][n] = (f32x4){0.f, 0.f, 0.f, 0.f};
    bf16x8 At[4][2], B0[2][2], B1[2][2];
    const char* sA = P.a_base(cur); const char* sB = P.b_base(cur);
    S.a_ready(cur);
    P.a_offs(cur, sR[0], sC[0], sR[1], sC[1], offA);
    PG8_STB(0, 0, 0); PG8_STB(0, 1, 0); PG8_STA(0, 0, 0); PG8_STA(0, 1, 0);
    if (wr == 1) PG8_BAR;
    PG8_WAIT_V(2); PG8_BAR;
    PG8_STB(1, 0, 1); PG8_STA(1, 0, 1); PG8_STB(1, 1, 1);
    PG8_WAIT_V(6); PG8_BAR;
    for (;;) {
        const bool has_next = S.next(ui + 1, nxt);
        unsigned nOffA[2][2];
        if (Prob::GATHER) { if (has_next) P.a_offs(nxt, sR[0], sC[0], sR[1], sC[1], nOffA); else {
#pragma unroll
            for (int h = 0; h < 2; ++h)
#pragma unroll
                for (int i = 0; i < 2; ++i) nOffA[h][i] = offA[h][i]; } }
        const char* nA = has_next ? P.a_base(nxt) : sA; const char* nB = has_next ? P.b_base(nxt) : sB;
        for (int t = 0; t < nt; t += 2) {
            const bool last = (t == nt - 2);
            if (last && has_next) S.a_ready(nxt);
            PG8_LDB(B0, 0, 0); PG8_LDB(B1, 0, 1); PG8_SCHED; PG8_LDA(At, 0, 0); PG8_STA(1, 1, t + 1);
            PG8_WAIT_V(8); PG8_WAIT_L(0); PG8_BAR; PG8_MMA(0, 0, At, B0); PG8_MMA(0, 1, At, B1); PG8_BAR; PG8_SCHED;
            if (last) {
                sA = nA - (size_t)nt * kstep; sB = nB - (size_t)nt * kstep;
                if (Prob::GATHER) {
#pragma unroll
                    for (int h = 0; h < 2; ++h)
#pragma unroll
                        for (int i = 0; i < 2; ++i) offA[h][i] = nOffA[h][i]; }
            }
            PG8_LDA(At, 0, 1); PG8_STB(0, 0, t + 2); PG8_STB(0, 1, t + 2); PG8_STA(0, 0, t + 2);
            PG8_WAIT_V(8); PG8_WAIT_L(0); PG8_BAR; PG8_MMA(1, 0, At, B0); PG8_MMA(1, 1, At, B1); PG8_BAR; PG8_SCHED;
            PG8_LDB(B0, 1, 0); PG8_LDB(B1, 1, 1); PG8_SCHED; PG8_LDA(At, 1, 0); PG8_STA(0, 1, t + 2);
            PG8_WAIT_V(8); PG8_WAIT_L(0); PG8_BAR; PG8_MMA(0, 0, At, B0); PG8_MMA(0, 1, At, B1); PG8_BAR; PG8_SCHED;
            PG8_LDA(At, 1, 1); PG8_STB(1, 0, t + 3); PG8_STB(1, 1, t + 3); PG8_STA(1, 0, t + 3);
            PG8_WAIT_V(8); PG8_WAIT_L(0); PG8_BAR; PG8_MMA(1, 0, At, B0); PG8_MMA(1, 1, At, B1); PG8_BAR; PG8_SCHED;
        }
        if (wr == 0) PG8_BAR;
        E(acc, cur, wr, wc, fr, fq); S.done(cur);
        if (!has_next) break;
#pragma unroll
        for (int a = 0; a < 2; ++a)
#pragma unroll
            for (int b = 0; b < 2; ++b)
#pragma unroll
                for (int m = 0; m < 4; ++m)
#pragma unroll
                    for (int n = 0; n < 2; ++n) acc[a][b][m][n] = (f32x4){0.f, 0.f, 0.f, 0.f};
        cur = nxt; ++ui; sA = nA; sB = nB;
        if (wr == 1) PG8_BAR;
    }
    PG8_WAIT_V(0);
    PG8_BAR;
#undef PG8_SA
#undef PG8_SB
#undef PG8_STAGE
#undef PG8_STA
#undef PG8_STB
#undef PG8_LDA
#undef PG8_LDB
#undef PG8_MMA
#undef PG8_WAIT_V
#undef PG8_WAIT_L
#undef PG8_BAR
#undef PG8_SCHED
}

template <class Epi, class Sched>
__device__ __forceinline__ void gemm_phase_dual(LAS unsigned char* lds, const bf16* A1, const bf16* Bt1, int K1, const bf16* A2, const bf16* Bt2, int K2, const Sched& S, const Epi& E) {
    const int tid = threadIdx.x, wid = __builtin_amdgcn_readfirstlane(tid >> 6), lane = tid & 63, wr = wid >> 2, wc = wid & 3, fr = lane & 15, fq = lane >> 4;
    const int nt1 = K1 / BK, nt = (K1 + K2) / BK;
    unsigned offB1[2][2], offA1[2][2]; const unsigned dK2 = (unsigned)(2 * (K2 - K1));
#pragma unroll
    for (int i = 0; i < 2; ++i) { int R, C; stage_rc(tid * 16 + i * 8192, R, C); const int Rb = (R & ~31) + perm32(R & 31);
        offA1[0][i] = (unsigned)(R * K1 + C) * 2u; offA1[1][i] = offA1[0][i] + (unsigned)(HALF * K1 * 2); offB1[0][i] = (unsigned)(Rb * K1 + C) * 2u; offB1[1][i] = offB1[0][i] + (unsigned)(HALF * K1 * 2); }
    const size_t kstep = (size_t)(BK * 2);
    const unsigned ldsw = (unsigned)wid * 1024u;
    const int aoff = lds_byte(wr * 64 + fr, fq * 8), boff = lds_byte(wc * 32 + fr, fq * 8);
#define PG8_SA(b, h) (((b) * 2 + (h)) * HTB)
#define PG8_SB(b, h) ((4 + (b) * 2 + (h)) * HTB)
#define PG8_STX(bufoff, tau, g1, g2, o1, o2) do { const int _t = (tau); const bool _s2 = _t >= nt1; const long long _d = _s2 ? (long long)((g2) - (g1)) - (long long)nt1 * (long long)kstep : 0ll; const char* _g = (g1) + (size_t)_t * kstep + _d; \
        _Pragma("unroll") for (int _i = 0; _i < 2; ++_i) { const unsigned _o = (o1)[_i] + (_s2 ? ((o1)[_i] >> 11) * dK2 : 0u); \
        __builtin_amdgcn_global_load_lds((const unsigned*)(_g + _o), (LAS unsigned*)(lds + (bufoff) + ldsw + _i * 8192), 16, 0, 0); } } while (0)
#define PG8_STA(b, h, tau) PG8_STX(PG8_SA(b, h), tau, sA1, sA2, offA1[h], 0)
#define PG8_STB(b, h, tau) PG8_STX(PG8_SB(b, h), tau, sB1, sB2, offB1[h], 0)
#define PG8_LDA(dst, b, h) do { _Pragma("unroll") for (int m = 0; m < 4; ++m) _Pragma("unroll") for (int k = 0; k < 2; ++k) dst[m][k] = *(const LAS bf16x8*)(lds + PG8_SA(b, h) + aoff + m * 2048 + k * 1024); } while (0)
#define PG8_LDB(dst, b, h) do { _Pragma("unroll") for (int n = 0; n < 2; ++n) _Pragma("unroll") for (int k = 0; k < 2; ++k) dst[n][k] = *(const LAS bf16x8*)(lds + PG8_SB(b, h) + boff + n * 2048 + k * 1024); } while (0)
#define PG8_MMA(ai, bj, At, Bt) do { __builtin_amdgcn_s_setprio(1); _Pragma("unroll") for (int m = 0; m < 4; ++m) _Pragma("unroll") for (int n = 0; n < 2; ++n) _Pragma("unroll") for (int k = 0; k < 2; ++k) \
        acc[ai][bj][m][n] = __builtin_amdgcn_mfma_f32_16x16x32_bf16(Bt[n][k], At[m][k], acc[ai][bj][m][n], 0, 0, 0); __builtin_amdgcn_s_setprio(0); } while (0)
#define PG8_WAIT_V(n) asm volatile("s_waitcnt vmcnt(" #n ")" ::: "memory")
#define PG8_WAIT_L(n) asm volatile("s_waitcnt lgkmcnt(" #n ")" ::: "memory")
#define PG8_BAR __builtin_amdgcn_s_barrier()
#define PG8_SCHED __builtin_amdgcn_sched_barrier(0)
    Unit cur, nxt; int ui = 0;
    if (!S.next(0, cur)) return;
    f32x4 acc[2][2][4][2];
#pragma unroll
    for (int a = 0; a < 2; ++a)
#pragma unroll
        for (int b = 0; b < 2; ++b)
#pragma unroll
            for (int m = 0; m < 4; ++m)
#pragma unroll
                for (int n = 0; n < 2; ++n) acc[a][b][m][n] = (f32x4){0.f, 0.f, 0.f, 0.f};
    bf16x8 At[4][2], B0[2][2], B1[2][2];
    const char* sA1 = (const char*)A1 + (size_t)cur.pm * 256 * K1 * 2; const char* sB1 = (const char*)Bt1 + (size_t)cur.pn * 256 * K1 * 2;
    const char* sA2 = (const char*)A2 + (size_t)cur.pm * 256 * K2 * 2; const char* sB2 = (const char*)Bt2 + (size_t)cur.pn * 256 * K2 * 2;
    PG8_STB(0, 0, 0); PG8_STB(0, 1, 0); PG8_STA(0, 0, 0); PG8_STA(0, 1, 0);
    if (wr == 1) PG8_BAR;
    PG8_WAIT_V(2); PG8_BAR;
    PG8_STB(1, 0, 1); PG8_STA(1, 0, 1); PG8_STB(1, 1, 1);
    PG8_WAIT_V(6); PG8_BAR;
    for (;;) {
        const bool has_next = S.next(ui + 1, nxt);
        const int npm = has_next ? nxt.pm : cur.pm, npn = has_next ? nxt.pn : cur.pn;
        const char* nA1 = (const char*)A1 + (size_t)npm * 256 * K1 * 2; const char* nB1 = (const char*)Bt1 + (size_t)npn * 256 * K1 * 2;
        const char* nA2 = (const char*)A2 + (size_t)npm * 256 * K2 * 2; const char* nB2 = (const char*)Bt2 + (size_t)npn * 256 * K2 * 2;
        for (int t = 0; t < nt; t += 2) {
            const bool last = (t == nt - 2);
            const int t2 = last ? 0 : t + 2, t3 = last ? 1 : t + 3;
            if (t == nt1) { E.mid(acc, cur, wr, wc, fr, fq); PG8_SCHED; }
            PG8_LDB(B0, 0, 0); PG8_LDB(B1, 0, 1); PG8_SCHED; PG8_LDA(At, 0, 0); PG8_STA(1, 1, t + 1);
            PG8_WAIT_V(8); PG8_WAIT_L(0); PG8_BAR; PG8_MMA(0, 0, At, B0); PG8_MMA(0, 1, At, B1); PG8_BAR; PG8_SCHED;
            if (last) { sA1 = nA1; sB1 = nB1; sA2 = nA2; sB2 = nB2; }
            PG8_LDA(At, 0, 1); PG8_STB(0, 0, t2); PG8_STB(0, 1, t2); PG8_STA(0, 0, t2);
            PG8_WAIT_V(8); PG8_WAIT_L(0); PG8_BAR; PG8_MMA(1, 0, At, B0); PG8_MMA(1, 1, At, B1); PG8_BAR; PG8_SCHED;
            PG8_LDB(B0, 1, 0); PG8_LDB(B1, 1, 1); PG8_SCHED; PG8_LDA(At, 1, 0); PG8_STA(0, 1, t2);
            PG8_WAIT_V(8); PG8_WAIT_L(0); PG8_BAR; PG8_MMA(0, 0, At, B0); PG8_MMA(0, 1, At, B1); PG8_BAR; PG8_SCHED;
            PG8_LDA(At, 1, 1); PG8_STB(1, 0, t3); PG8_STB(1, 1, t3); PG8_STA(1, 0, t3);
            PG8_WAIT_V(8); PG8_WAIT_L(0); PG8_BAR; PG8_MMA(1, 0, At, B0); PG8_MMA(1, 1, At, B1); PG8_BAR; PG8_SCHED;
        }
        if (wr == 0) PG8_BAR;
        E(acc, cur, wr, wc, fr, fq);
        if (!has_next) break;
#pragma unroll
        for (int a = 0; a < 2; ++a)
#pragma unroll
            for (int b = 0; b < 2; ++b)
#pragma unroll
                for (int m = 0; m < 4; ++m)
#pragma unroll
                    for (int n = 0; n < 2; ++n) acc[a][b][m][n] = (f32x4){0.f, 0.f, 0.f, 0.f};
        cur = nxt; ++ui;
        if (wr == 1) PG8_BAR;
    }
    PG8_WAIT_V(0);
    PG8_BAR;
#undef PG8_SA
#undef PG8_SB
#undef PG8_STX
#undef PG8_STA
#undef PG8_STB
#undef PG8_LDA
#undef PG8_LDB
#undef PG8_MMA
#undef PG8_WAIT_V
#undef PG8_WAIT_L
#undef PG8_BAR
#undef PG8_SCHED
}
__device__ __forceinline__ v4u pack8(f32x4 v0, f32x4 v1) { v4u w; w.x = cvt_pk_bf16(v0[0], v0[1]); w.y = cvt_pk_bf16(v0[2], v0[3]); w.z = cvt_pk_bf16(v1[0], v1[1]); w.w = cvt_pk_bf16(v1[2], v1[3]); return w; }
__device__ __forceinline__ float sigm(float v) { return __builtin_amdgcn_rcpf(1.0f + __expf(-v)); }

struct EpiMergedDual {
    static constexpr bool PERM = true;
    const bf16* ga; const bf16* gb; bf16* merged;
    __device__ __forceinline__ void mid(f32x4 (&acc)[2][2][4][2], const Unit& u, int wr, int wc, int fr, int fq) const {
        int row0 = u.pm * BM + wr * 64 + fr; const int col0 = u.pn * BM + wc * 32 + 8 * fq;
        asm volatile("" : "+v"(row0));
#pragma unroll
        for (int ai = 0; ai < 2; ++ai)
#pragma unroll
            for (int m = 0; m < 4; ++m) { const size_t o = (size_t)(row0 + ai * HALF + m * 16) * 1024 + col0;
#pragma unroll
                for (int bj = 0; bj < 2; ++bj) { const v4u a = *(const v4u*)(ga + o + bj * HALF), b = *(const v4u*)(gb + o + bj * HALF);
                    f32x4 r0 = {bflo(a.x) * __builtin_amdgcn_rcpf(bflo(b.x)), bfhi(a.x) * __builtin_amdgcn_rcpf(bfhi(b.x)), bflo(a.y) * __builtin_amdgcn_rcpf(bflo(b.y)), bfhi(a.y) * __builtin_amdgcn_rcpf(bfhi(b.y))};
                    f32x4 r1 = {bflo(a.z) * __builtin_amdgcn_rcpf(bflo(b.z)), bfhi(a.z) * __builtin_amdgcn_rcpf(bfhi(b.z)), bflo(a.w) * __builtin_amdgcn_rcpf(bflo(b.w)), bfhi(a.w) * __builtin_amdgcn_rcpf(bfhi(b.w))};
                    acc[ai][bj][m][0] = acc[ai][bj][m][0] * r0; acc[ai][bj][m][1] = acc[ai][bj][m][1] * r1; }
                asm volatile("" ::: "memory"); }
    }
    __device__ __forceinline__ void operator()(const f32x4 (&acc)[2][2][4][2], const Unit& u, int wr, int wc, int fr, int fq) const {
        int row0 = u.pm * BM + wr * 64 + fr; const int col0 = u.pn * BM + wc * 32 + 8 * fq;
        asm volatile("" : "+v"(row0));
#pragma unroll
        for (int ai = 0; ai < 2; ++ai)
#pragma unroll
            for (int m = 0; m < 4; ++m) { const size_t o = (size_t)(row0 + ai * HALF + m * 16) * 1024 + col0;
#pragma unroll
                for (int bj = 0; bj < 2; ++bj) { const v4u g = *(const v4u*)(gb + o + bj * HALF);
                    f32x4 g0 = {bflo(g.x), bfhi(g.x), bflo(g.y), bfhi(g.y)}, g1 = {bflo(g.z), bfhi(g.z), bflo(g.w), bfhi(g.w)};
                    *(v4u*)(merged + o + bj * HALF) = pack8(g0 * acc[ai][bj][m][0], g1 * acc[ai][bj][m][1]); } }
    }
};
struct EpiProj {
    static constexpr bool PERM = true;
    unsigned char* ws;
    __device__ __forceinline__ void operator()(const f32x4 (&acc)[2][2][4][2], const Unit& u, int wr, int wc, int fr, int fq) const {
        const int row0 = u.pm * BM + wr * 64 + fr, cw = wc * 32 + 8 * fq, pn = u.pn;
        if (pn == 4) {
#pragma unroll
            for (int ai = 0; ai < 2; ++ai)
#pragma unroll
                for (int m = 0; m < 4; ++m) { const size_t row = (size_t)(row0 + ai * HALF + m * 16);
                    float* cr = (float*)(ws + WS_CKVRAW) + row * 128 + cw; *(f32x4*)cr = acc[ai][0][m][0]; *(f32x4*)(cr + 4) = acc[ai][0][m][1];
                    if (cw < 64) *(v4u*)((bf16*)(ws + WS_KIDX) + ((((row >> 4) * 8 + (cw >> 3)) * 16 + (row & 15)) << 3)) = pack8(acc[ai][1][m][0], acc[ai][1][m][1]);
                    else if (cw == 64) { float* wr_ = (float*)(ws + WS_WIDX) + row * 8; *(f32x4*)wr_ = acc[ai][1][m][0] * IDXW_SCALE; *(f32x4*)(wr_ + 4) = acc[ai][1][m][1] * IDXW_SCALE; } }
            return;
        }
        bf16* base; int ld, c0; float sc = 1.f; bool sg = false;
        if (pn < 4) { base = (bf16*)(ws + WS_QLAT); ld = 1024; c0 = pn * 256; sc = ATT_SCALE; }
        else if (pn < 7) { base = (bf16*)(ws + WS_QIDX); ld = 512; c0 = (pn - 5) * 256; }
        else if (pn < 9) { base = (bf16*)(ws + WS_QB); ld = 512; c0 = (pn - 7) * 256; sc = 0.125f; }
        else if (pn == 9) { base = (bf16*)(ws + WS_KB); ld = 128; c0 = 0; }
        else if (pn < 14) { base = (bf16*)(ws + WS_GA); ld = 1024; c0 = (pn - 10) * 256; sg = true; }
        else { base = (bf16*)(ws + WS_GB); ld = 1024; c0 = (pn - 14) * 256; sg = true; }
        const size_t bjstep = (pn == 9) ? (size_t)(WS_VB - WS_KB) / 2 : (size_t)HALF;
#pragma unroll
        for (int ai = 0; ai < 2; ++ai)
#pragma unroll
            for (int m = 0; m < 4; ++m) { bf16* rowp = base + (size_t)(row0 + ai * HALF + m * 16) * ld + c0 + cw;
#pragma unroll
                for (int bj = 0; bj < 2; ++bj) { f32x4 v0 = acc[ai][bj][m][0], v1 = acc[ai][bj][m][1];
                    if (sg) {
#pragma unroll
                        for (int j = 0; j < 4; ++j) { v0[j] = sigm(v0[j]); v1[j] = sigm(v1[j]); } }
                    else { v0 = v0 * sc; v1 = v1 * sc; }
                    *(v4u*)(rowp + bj * bjstep) = pack8(v0, v1); } }
    }
};
struct EpiWoutM {
    static constexpr bool PERM = true;
    const float* x; bf16* h1b;
    __device__ __forceinline__ void operator()(const f32x4 (&acc)[2][2][4][2], const Unit& u, int wr, int wc, int fr, int fq) const {
        const int row0 = u.pm * BM + wr * 64 + fr, col0 = u.pn * BM + wc * 32 + 8 * fq;
#pragma unroll
        for (int ai = 0; ai < 2; ++ai)
#pragma unroll
            for (int m = 0; m < 4; ++m) { const size_t o = (size_t)(row0 + ai * HALF + m * 16) * 1024 + col0;
#pragma unroll
                for (int bj = 0; bj < 2; ++bj) { const f32x4 x0 = *(const f32x4*)(x + o + bj * HALF), x1 = *(const f32x4*)(x + o + bj * HALF + 4);
                    *(v4u*)(h1b + o + bj * HALF) = pack8(x0 * ALPHA + acc[ai][bj][m][0], x1 * ALPHA + acc[ai][bj][m][1]); } }
    }
};
constexpr int MOE_TB_OFF = 131072 + 1024;
constexpr int CW_RDY = 16384;
constexpr int CW_TMO = 8;
struct MoeOrder {
    const LAS int* tb; int npn, G, c; unsigned* ctl;
    __device__ bool next(int i, Unit& u) const {
        const int L = i * G + c; if (L >= tb[32] * npn) return false;
        const int rt = L / npn, pn = L - rt * npn; int e = 0;
        for (int j = 1; j < 32; ++j) e = (tb[j] <= rt) ? j : e;
        u.pm = rt; u.pn = pn; u.pb = e * npn + pn; u.aux = e; return true;
    }
    __device__ __forceinline__ void a_ready(const Unit&) const {}
    __device__ __forceinline__ void done(const Unit& u) const {
        asm volatile("s_waitcnt vmcnt(0)" ::: "memory");
        if ((threadIdx.x & 63) == 0) __hip_atomic_fetch_add(ctl + CW_RDY + 64 * u.pm, 1u, __ATOMIC_RELAXED, __HIP_MEMORY_SCOPE_AGENT);
    }
};
struct MoeDownOrder {
    const LAS int* tb; int G, c; unsigned* ctl;
    __device__ bool next(int i, Unit& u) const {
        const int nT = tb[32], nD = 4 * nT; int R = 2 * nT - G; R = R < 0 ? 0 : (R > G ? G : R);
        int L;
        if (c >= R) { L = (i < 4) ? i * (G - R) + (c - R) : 4 * (G - R) + (i - 4) * G + c; }
        else { L = 4 * (G - R) + i * G + c; }
        if (L >= nD) return false;
        const int rt = L >> 2, pn = L & 3; int e = 0;
        for (int j = 1; j < 32; ++j) e = (tb[j] <= rt) ? j : e;
        u.pm = rt; u.pn = pn; u.pb = e * 4 + pn; u.aux = e; return true;
    }
    __device__ __forceinline__ void a_ready(const Unit& u) const {
        if (threadIdx.x < 64) {
            unsigned* w = ctl + CW_RDY + 64 * u.pm; unsigned sp = 0;
            while ((unsigned)__builtin_amdgcn_readfirstlane(__hip_atomic_load(w, __ATOMIC_RELAXED, __HIP_MEMORY_SCOPE_AGENT)) < 16u) {
                __builtin_amdgcn_s_sleep(2);
                if ((++sp & 1023u) == 0u) { if (__hip_atomic_load(ctl + CW_TMO, __ATOMIC_RELAXED, __HIP_MEMORY_SCOPE_AGENT) != 0u) break;
                    if (sp > (1u << 22)) { __hip_atomic_store(ctl + CW_TMO, 1u, __ATOMIC_RELAXED, __HIP_MEMORY_SCOPE_AGENT); break; } } }
            __builtin_amdgcn_fence(__ATOMIC_ACQUIRE, "agent");
            asm volatile("s_waitcnt vmcnt(0)" ::: "memory");
        }
        asm volatile("" ::: "memory"); __builtin_amdgcn_s_barrier(); asm volatile("" ::: "memory");
    }
    __device__ __forceinline__ void done(const Unit&) const {}
};
struct GatherProb {
    static constexpr bool GATHER = true;
    const bf16* A; const bf16* Bt; int K; const LAS int* tb; const unsigned* list;
    __device__ __forceinline__ const char* a_base(const Unit&) const { return (const char*)A; }
    __device__ __forceinline__ const char* b_base(const Unit& u) const { return (const char*)Bt + (size_t)u.pb * 256 * K * 2; }
    __device__ __forceinline__ void a_offs(const Unit& u, int R0, int C0, int R1, int C1, unsigned (&o)[2][2]) const {
        const int e = u.aux, lbase = (u.pm - tb[e]) * 256, cnt = tb[64 + e];
        const unsigned* le = list + (size_t)e * 32768;
#pragma unroll
        for (int h = 0; h < 2; ++h) { const int l0 = lbase + h * HALF + R0, l1 = lbase + h * HALF + R1;
            const unsigned t0 = l0 < cnt ? (le[l0] >> 1) : 0u, t1 = l1 < cnt ? (le[l1] >> 1) : 0u;
            o[h][0] = (t0 * (unsigned)K + (unsigned)C0) * 2u; o[h][1] = (t1 * (unsigned)K + (unsigned)C1) * 2u; }
    }
};
struct EpiGU {
    static constexpr bool PERM = true;
    bf16* hbuf;
    __device__ __forceinline__ void operator()(const f32x4 (&acc)[2][2][4][2], const Unit& u, int wr, int wc, int fr, int fq) const {
        const int row0 = u.pm * BM + wr * 64 + fr, col0 = u.pn * HALF + wc * 32 + 8 * fq;
#pragma unroll
        for (int ai = 0; ai < 2; ++ai)
#pragma unroll
            for (int m = 0; m < 4; ++m) { f32x4 h0, h1;
#pragma unroll
                for (int j = 0; j < 4; ++j) { const float g0 = acc[ai][0][m][0][j], g1 = acc[ai][0][m][1][j];
                    h0[j] = g0 * sigm(g0) * acc[ai][1][m][0][j]; h1[j] = g1 * sigm(g1) * acc[ai][1][m][1][j]; }
                { const v4u hv = pack8(h0, h1); bf16* hp = hbuf + (size_t)(row0 + ai * HALF + m * 16) * 256 + col0;
                  asm volatile("global_store_dwordx4 %0, %1, off sc1\n\ts_nop 1" :: "v"(hp), "v"(hv) : "memory"); } }
    }
};
struct EpiDown {
    static constexpr bool PERM = true;
    bf16* slot; const LAS int* tb; const unsigned* list; const float* pw;
    __device__ __forceinline__ void operator()(const f32x4 (&acc)[2][2][4][2], const Unit& u, int wr, int wc, int fr, int fq) const {
        const int e = u.aux, lbase = (u.pm - tb[e]) * 256 + wr * 64 + fr, cnt = tb[64 + e], col0 = u.pn * BM + wc * 32 + 8 * fq;
        const unsigned* le = list + (size_t)e * 32768;
#pragma unroll
        for (int ai = 0; ai < 2; ++ai)
#pragma unroll
            for (int m = 0; m < 4; ++m) { const int l = lbase + ai * HALF + m * 16;
                if (l < cnt) { const unsigned pair = le[l]; const float w = pw[pair]; bf16* rowp = slot + (size_t)pair * 1024 + col0;
#pragma unroll
                    for (int bj = 0; bj < 2; ++bj) *(v4u*)(rowp + bj * HALF) = pack8(acc[ai][bj][m][0] * w, acc[ai][bj][m][1] * w); } }
    }
};
}

struct Args { const float* in[20]; float* out; unsigned char* ws; int ph_lo, ph_hi; };
__global__ void __launch_bounds__(NTHR, 2) fwd_kernel(Args args) {
    extern __shared__ __attribute__((aligned(16))) unsigned char lds_raw[];
    Ctx c;
    c.lds = (LAS unsigned char*)lds_raw;
    c.tid = threadIdx.x; c.lane = c.tid & 63; c.wave = __builtin_amdgcn_readfirstlane(c.tid >> 6); c.bid = blockIdx.x; c.G = gridDim.x;
    c.x = args.in[0]; c.w_in = args.in[1]; c.kv_g = args.in[2]; c.w_uv = args.in[3]; c.w_a = args.in[4]; c.sinks = args.in[5]; c.w_b = args.in[6]; c.w_out = args.in[7]; c.rel_bias = args.in[8];
    c.ln1_g = args.in[9]; c.ln1_b = args.in[10]; c.w_group = args.in[11]; c.b_group = args.in[12]; c.w_router = args.in[13]; c.b_router = args.in[14]; c.w_gate = args.in[15]; c.w_up = args.in[16]; c.w_down = args.in[17];
    c.ln2_g = args.in[18]; c.ln2_b = args.in[19]; c.out = args.out; c.ws = args.ws; unsigned char* ws = args.ws;
    c.ctl = (unsigned*)(ws + WS_CTL);
    volatile LAS unsigned* MISC = (volatile LAS unsigned*)(c.lds + MISC_OFF);
    if (c.tid < 32) MISC[c.tid] = 0u;
    __syncthreads();
    XcdBarrier bar; bar.bar = c.ctl + CW_BAR; bar.x = 0; bar.st = nullptr;
    if (MK_N_LAUNCHES == 1) bar = xcd_barrier_post(c.ctl + CW_BAR, MISC + 8);
    const int lo = args.ph_lo, hi = args.ph_hi;
#define IN(k) (lo <= (k) && (k) < hi)
#define SEAM(k) do { if (IN(k) && IN((k) + 1)) xcd_barrier(bar); } while (0)
    bf16* merged = ((bf16*)(c.ws + WS_QLAT)); bf16* x1b = ((bf16*)(c.ws + WS_XB));

    if (IN(0)) { p0_prologue(c); } SEAM(0);
    if (IN(1)) { pg8::DenseProb P{(const bf16*)(c.ws + WS_XB), (const bf16*)(c.ws + WS_WIN), 1024}; pg8::StaticOrder S; S.init(NTOK, NPROJ, c.G, c.bid); pg8::EpiProj E{c.ws};
        pg8::gemm_phase(c.lds, P, S, E); } SEAM(1);
    if (IN(2)) { p_rmsnorm(c); __syncthreads(); p2_indexer_topk(c); } SEAM(2);
    if (IN(3)) { p3a_dsa(c); p3b_swa(c); } SEAM(3);
    if (IN(4)) { pg8::StaticOrder S; S.init(NTOK, 1024, c.G, c.bid); pg8::EpiMergedDual E{(const bf16*)(c.ws + WS_GA), (const bf16*)(c.ws + WS_GB), merged};
        pg8::gemm_phase_dual(c.lds, (const bf16*)(c.ws + WS_XB), (const bf16*)(c.ws + WS_WC), 1024, (const bf16*)(c.ws + WS_QB), (const bf16*)(c.ws + WS_WB), 512, S, E); } SEAM(4);
    if (IN(5)) { pg8::DenseProb P{(const bf16*)merged, (const bf16*)(c.ws + WS_WO), 1024}; pg8::StaticOrder S; S.init(NTOK, 1024, c.G, c.bid); pg8::EpiWoutM E{c.x, (bf16*)(c.ws + WS_H1B)};
        pg8::gemm_phase(c.lds, P, S, E); } SEAM(5);
    if (IN(6)) { p6_ln_router(c, x1b); } SEAM(6);
    LAS int* tb = (LAS int*)(c.lds + pg8::MOE_TB_OFF);
    if (IN(7) || IN(8)) {
        if (c.tid < 32) tb[64 + c.tid] = (int)__hip_atomic_load(c.ctl + CW_CNT + c.tid, __ATOMIC_RELAXED, __HIP_MEMORY_SCOPE_AGENT);
        __syncthreads();
        if (c.tid == 0) { int a = 0; for (int e = 0; e < 32; ++e) { tb[e] = a; a += (tb[64 + e] + 255) >> 8; } tb[32] = a; }
        __syncthreads();
    }
    if (IN(7)) { pg8::GatherProb P{(const bf16*)x1b, (const bf16*)(c.ws + WS_WGU), 1024, tb, (const unsigned*)(c.ws + WS_LIST)}; pg8::MoeOrder S{tb, 2, c.G, c.bid, c.ctl}; pg8::EpiGU E{(bf16*)(c.ws + WS_QLAT)};
        pg8::gemm_phase(c.lds, P, S, E); }
    if (MK_N_LAUNCHES != 1) SEAM(7);
    if (IN(8)) { pg8::DenseProb P{(const bf16*)(c.ws + WS_QLAT), (const bf16*)(c.ws + WS_WD), 256}; pg8::MoeDownOrder S{tb, c.G, c.bid, c.ctl};
        pg8::EpiDown E{(bf16*)(c.ws + WS_SLOT), tb, (const unsigned*)(c.ws + WS_LIST), (const float*)(c.ws + WS_PW)};
        pg8::gemm_phase(c.lds, P, S, E); } SEAM(8);
    if (IN(9)) { p9_ln2(c); }
#undef IN
#undef SEAM
}

extern "C" void kernel_launch(void* const* d_in, const int* in_sizes, int n_in, void* d_out, int out_size, void* d_ws, size_t ws_size, hipStream_t stream) {
    static int grid = 0;
    if (grid == 0) {
        if (n_in != 20 || out_size != NTOK * D || ws_size < WS_END) { fprintf(stderr, "kernel_launch: unexpected shapes (n_in %d out %d ws %zu)\n", n_in, out_size, ws_size); grid = -1; return; }
        int dev = 0, cus = 0, per_cu = 0;
        if (hipGetDevice(&dev) != hipSuccess || hipDeviceGetAttribute(&cus, hipDeviceAttributeMultiprocessorCount, dev) != hipSuccess) { grid = -1; return; }
        if (hipFuncSetAttribute((const void*)fwd_kernel, hipFuncAttributeMaxDynamicSharedMemorySize, LDS_BYTES) != hipSuccess) { fprintf(stderr, "kernel_launch: hipFuncSetAttribute failed\n"); grid = -1; return; }
        if (hipOccupancyMaxActiveBlocksPerMultiprocessor(&per_cu, (const void*)fwd_kernel, NTHR, LDS_BYTES) != hipSuccess || per_cu < 1) { fprintf(stderr, "kernel_launch: occupancy query says %d\n", per_cu); }
        (void)hipGetLastError();
        grid = cus;
    }
    if (grid < 0) return;
    if (hipMemsetAsync((char*)d_ws + WS_CTL, 0, CTL_ZERO_BYTES, stream) != hipSuccess) return;
    Args a{};
    for (int i = 0; i < 20; ++i) a.in[i] = (const float*)d_in[i];
    a.out = (float*)d_out; a.ws = (unsigned char*)d_ws;
    if (MK_N_LAUNCHES == 1) { a.ph_lo = 0; a.ph_hi = NPHASE; hipLaunchKernelGGL(fwd_kernel, dim3(grid), dim3(NTHR), LDS_BYTES, stream, a); }
    else { for (int p = 0; p < NPHASE; ++p) { a.ph_lo = p; a.ph_hi = p + 1; hipLaunchKernelGGL(fwd_kernel, dim3(grid), dim3(NTHR), LDS_BYTES, stream, a); } }
}
```

```cpp
#include <hip/hip_runtime.h>
#include <cstdio>
#include <cstdint>

#ifndef MK_N_LAUNCHES
#define MK_N_LAUNCHES 1
#endif

constexpr int D = 1024, BATCH = 8, SEQ = 2048, NTOK = BATCH * SEQ;
constexpr int A_HEADS = 8, A_LAT = 128, IDX_HEADS = 8, IDX_DIM = 64, KSEL = 256;
constexpr int B_HEADS = 8, B_HD = 64, WINDOW = 128;
constexpr int NEXP = 32, EPG = 8, NGRP = 4, DEXP = 256;
constexpr int IN_WIDTH = 4552, NPROJ = 4608;
constexpr float ALPHA = 1.189207115002721f;
constexpr float LN_EPS = 1e-5f, RMS_EPS = 1e-6f;
constexpr float ATT_SCALE = 0.08838834764831845f;
constexpr float IDXW_SCALE = 0.125f * 0.35355339059327373f;
constexpr int NPHASE = 10;

constexpr size_t MiB = 1u << 20;
constexpr size_t WS_CTL = 0, CTL_ZERO_BYTES = 128 * 1024;
constexpr size_t WS_WIN = 1 * MiB;
constexpr size_t WS_SEL = 1 * MiB;
constexpr size_t WS_WC = 10 * MiB;
constexpr size_t WS_WB = 12 * MiB;
constexpr size_t WS_WO = 13 * MiB;
constexpr size_t WS_WIDX = 15 * MiB;
constexpr size_t WS_BIAS = 16 * MiB;
constexpr size_t WS_PE = 16 * MiB + 64 * 1024;
constexpr size_t WS_PW = 16 * MiB + 256 * 1024;
constexpr size_t WS_WGU = 17 * MiB;
constexpr size_t WS_WD = 49 * MiB;
constexpr size_t WS_XB = 65 * MiB;
constexpr size_t WS_QLAT = 97 * MiB;
constexpr size_t WS_CKV = 129 * MiB;
constexpr size_t WS_KIDX = 133 * MiB;
constexpr size_t WS_QIDX = 135 * MiB;
constexpr size_t WS_QB = 151 * MiB;
constexpr size_t WS_KB = 167 * MiB;
constexpr size_t WS_VB = 171 * MiB;
constexpr size_t WS_GA = 175 * MiB;
constexpr size_t WS_GB = 207 * MiB;
constexpr size_t WS_H1B = WS_GB;
constexpr size_t WS_CKVRAW = 239 * MiB;
constexpr size_t WS_LIST = 247 * MiB;
constexpr size_t WS_SLOT = 129 * MiB;
constexpr size_t WS_END = 252 * MiB;
constexpr int CW_CNT = 64;
constexpr int CW_BAR = 4096;

constexpr int NWAVES = 8, NTHR = 512;
constexpr int LDS_BYTES = 155648;
constexpr int MISC_OFF = 131072 + 320;

#define GAS __attribute__((address_space(1)))
#define LAS __attribute__((address_space(3)))
typedef unsigned short bf16;
typedef unsigned v4u __attribute__((ext_vector_type(4)));
typedef unsigned v2u __attribute__((ext_vector_type(2)));
typedef float f32x4 __attribute__((ext_vector_type(4)));

__device__ __forceinline__ float bf2f(unsigned v) { return __builtin_bit_cast(float, v << 16); }
__device__ __forceinline__ float bflo(unsigned v) { return __builtin_bit_cast(float, v << 16); }
__device__ __forceinline__ float bfhi(unsigned v) { return __builtin_bit_cast(float, v & 0xffff0000u); }
__device__ __forceinline__ unsigned f2bf(float f) { unsigned u = __builtin_bit_cast(unsigned, f); return (u + 0x7fffu + ((u >> 16) & 1u)) >> 16; }
__device__ __forceinline__ unsigned cvt_pk(float lo, float hi) { unsigned r; asm volatile("v_cvt_pk_bf16_f32 %0, %1, %2" : "=v"(r) : "v"(lo), "v"(hi)); return r; }
__device__ __forceinline__ unsigned pk2(float lo, float hi) { return f2bf(lo) | (f2bf(hi) << 16); }
__device__ __forceinline__ float wave_sum(float v) {
#pragma unroll
    for (int o = 1; o < 64; o <<= 1) v += __shfl_xor(v, o);
    return v;
}
__device__ __forceinline__ float wave_max(float v) {
#pragma unroll
    for (int o = 1; o < 64; o <<= 1) v = fmaxf(v, __shfl_xor(v, o));
    return v;
}

typedef unsigned u2v __attribute__((ext_vector_type(2)));
#define DPP_I(v, ctrl) __builtin_amdgcn_update_dpp(0, (v), (ctrl), 0xf, 0xf, true)
#define DPP_F(v, ctrl) __builtin_bit_cast(float, __builtin_amdgcn_update_dpp(0, __builtin_bit_cast(int, (v)), (ctrl), 0xf, 0xf, true))
__device__ __forceinline__ void swap16(unsigned a, unsigned& x, unsigned& y) { auto r = __builtin_amdgcn_permlane16_swap(a, a, false, false); x = r[0]; y = r[1]; }
__device__ __forceinline__ void swap32(unsigned a, unsigned& x, unsigned& y) { auto r = __builtin_amdgcn_permlane32_swap(a, a, false, false); x = r[0]; y = r[1]; }
__device__ __forceinline__ float x16_sum(float v) { unsigned x, y; swap16(__builtin_bit_cast(unsigned, v), x, y); return __builtin_bit_cast(float, x) + __builtin_bit_cast(float, y); }
__device__ __forceinline__ float x16_max(float v) { unsigned x, y; swap16(__builtin_bit_cast(unsigned, v), x, y); return fmaxf(__builtin_bit_cast(float, x), __builtin_bit_cast(float, y)); }
__device__ __forceinline__ float x16_min(float v) { unsigned x, y; swap16(__builtin_bit_cast(unsigned, v), x, y); return fminf(__builtin_bit_cast(float, x), __builtin_bit_cast(float, y)); }
__device__ __forceinline__ int x16_sumi(int v) { unsigned x, y; swap16((unsigned)v, x, y); return (int)(x + y); }
__device__ __forceinline__ float x32_sum(float v) { unsigned x, y; swap32(__builtin_bit_cast(unsigned, v), x, y); return __builtin_bit_cast(float, x) + __builtin_bit_cast(float, y); }
__device__ __forceinline__ float x32_max(float v) { unsigned x, y; swap32(__builtin_bit_cast(unsigned, v), x, y); return fmaxf(__builtin_bit_cast(float, x), __builtin_bit_cast(float, y)); }

#define XB_TMO      128
#define XB_XCNT(j)  (256  + 64 * (j))
#define XB_XSUB(j)  (1280 + 64 * (j))
#define XB_XGEN(j)  (2304 + 64 * (j))
#define XB_TOP      3328
#define XB_TOPGEN   3392
#define XCD_BAR_WORDS 3456
#define XB_SPIN_CAP (1u << 22)

__device__ __forceinline__ unsigned xb_ld(unsigned* p)              { return __hip_atomic_load(p, __ATOMIC_RELAXED, __HIP_MEMORY_SCOPE_AGENT); }
__device__ __forceinline__ unsigned xb_add(unsigned* p, unsigned v) { return __hip_atomic_fetch_add(p, v, __ATOMIC_RELAXED, __HIP_MEMORY_SCOPE_AGENT); }
__device__ __forceinline__ unsigned xb_xcc_id() { return (unsigned)__builtin_amdgcn_s_getreg((3 << 11) | 20) & 0xFu; }
#define XB_SPIN(cond, bar) do { unsigned _sp = 0; while (cond) { __builtin_amdgcn_s_sleep(1); \
    if ((++_sp & 255u) == 0u) { if (xb_ld(&(bar)[XB_TMO])) break; if (_sp > XB_SPIN_CAP) { atomicAdd(&(bar)[XB_TMO], 1u); break; } } } } while (0)

struct XcdBarrier { unsigned* bar; unsigned x; volatile LAS unsigned* st; };

__device__ __forceinline__ XcdBarrier xcd_barrier_post(unsigned* bar, volatile LAS unsigned* st) {
    XcdBarrier b; b.bar = bar; b.x = xb_xcc_id(); b.st = st;
    if (threadIdx.x == 0) (void)xb_add(&bar[XB_XCNT(b.x)], 1u);
    return b;
}
__device__ __forceinline__ void xcd_barrier_complete(unsigned* bar, unsigned x, unsigned& nloc, unsigned& nx) {
    const unsigned G = gridDim.x * gridDim.y * gridDim.z;
    unsigned sum, cnt, mine, sp = 0u;
    for (;;) {
        sum = 0u; cnt = 0u; mine = 0u;
#pragma unroll
        for (unsigned j = 0; j < 16; ++j) { const unsigned c = xb_ld(&bar[XB_XCNT(j)]); sum += c; cnt += (c > 0u) ? 1u : 0u; mine = (j == x) ? c : mine; }
        if (sum == G) break;
        __builtin_amdgcn_s_sleep(1);
        if ((++sp & 255u) == 0u) { if (xb_ld(&bar[XB_TMO])) break; if (sp > XB_SPIN_CAP) { atomicAdd(&bar[XB_TMO], 1u); break; } }
    }
    nloc = mine > 0u ? mine : 1u; nx = cnt > 0u ? cnt : 1u;
}
__device__ __forceinline__ void xcd_barrier(const XcdBarrier& b) {
    asm volatile("s_waitcnt vmcnt(0)" ::: "memory");
    __syncthreads();
    if (threadIdx.x == 0) {
        unsigned* bar = b.bar;
        __builtin_amdgcn_s_waitcnt(0);
        unsigned nloc = b.st[0], nx = b.st[1];
        if (nloc == 0u) { xcd_barrier_complete(bar, b.x, nloc, nx); b.st[0] = nloc; b.st[1] = nx; }
        const unsigned old = xb_add(&bar[XB_XSUB(b.x)], 1u);
        const unsigned gen = old / nloc;
        if (old + 1u == (gen + 1u) * nloc) {
            __builtin_amdgcn_fence(__ATOMIC_RELEASE, "agent");
            asm volatile("s_waitcnt vmcnt(0)" ::: "memory");
            const unsigned og = xb_add(&bar[XB_TOP], 1u);
            const unsigned tg = og / nx;
            if (og + 1u == (tg + 1u) * nx) xb_add(&bar[XB_TOPGEN], 1u);
            else XB_SPIN(xb_ld(&bar[XB_TOPGEN]) == tg, bar);
            __builtin_amdgcn_fence(__ATOMIC_ACQUIRE, "agent");
            xb_add(&bar[XB_XGEN(b.x)], 1u);
            asm volatile("s_waitcnt vmcnt(0)" ::: "memory");
        } else {
            XB_SPIN(xb_ld(&bar[XB_XGEN(b.x)]) == gen, bar);
            __builtin_amdgcn_fence(__ATOMIC_ACQUIRE, "agent");
            asm volatile("s_waitcnt vmcnt(0)" ::: "memory");
        }
    }
    __syncthreads();
}

struct Ctx {
    const float *x, *w_in, *kv_g, *w_uv, *w_a, *sinks, *w_b, *w_out, *rel_bias, *ln1_g, *ln1_b, *w_group, *b_group, *w_router, *b_router, *w_gate, *w_up, *w_down, *ln2_g, *ln2_b;
    float* out;
    unsigned char* ws;
    unsigned* ctl;
    __device__ __forceinline__ bf16* P(size_t off) const { return (bf16*)(ws + off); }
    LAS unsigned char* lds;
    int tid, lane, wave, bid, G;
};

__device__ __forceinline__ int proj_src_col(int j) {
    if (j < 1024) return j;
    if (j < 1152) return j;
    if (j < 1216) return 1664 + (j - 1152);
    if (j < 1224) return 1728 + (j - 1216);
    if (j < 1280) return -1;
    if (j < 1792) return 1152 + (j - 1280);
    if (j < 2304) return 1736 + (j - 1792);
    if (j < 2432) return 2248 + (j - 2304);
    if (j < 2560) return 2376 + (j - 2432);
    if (j < 3584) return 2504 + (j - 2560);
    return 3528 + (j - 3584);
}
__device__ __forceinline__ float sigmoidf_(float v) { return 1.0f / (1.0f + __expf(-v)); }

template <class Src> __device__ __forceinline__ void titem_load(const Ctx& c, const Src& src, int k0, int n0, f32x4 (&tv)[8]) {
    const int kr = c.lane >> 3, n4 = (c.lane & 7) * 4;
#pragma unroll
    for (int i = 0; i < 8; ++i) tv[i] = src.v4(k0 + 8 * i + kr, n0 + n4);
}
__device__ __forceinline__ void titem_finish(const Ctx& c, LAS float* scr, const f32x4 (&tv)[8], bf16* dst, int dstK, int k0, int n0) {
    const int lane = c.lane, kr = lane >> 3, n4 = (lane & 7) * 4;
#pragma unroll
    for (int i = 0; i < 8; ++i) { LAS float* d = scr + (8 * i + kr) * 33 + n4; d[0] = tv[i].x; d[1] = tv[i].y; d[2] = tv[i].z; d[3] = tv[i].w; }
    asm volatile("s_waitcnt lgkmcnt(0)" ::: "memory");
    const int cc = lane & 7;
#pragma unroll
    for (int j = 0; j < 4; ++j) { const int n = (lane >> 3) + 8 * j; const LAS float* q = scr + (8 * cc) * 33 + n;
        v4u o; o.x = pk2(q[0 * 33], q[1 * 33]); o.y = pk2(q[2 * 33], q[3 * 33]); o.z = pk2(q[4 * 33], q[5 * 33]); o.w = pk2(q[6 * 33], q[7 * 33]);
        *(v4u*)(dst + (size_t)(n0 + n) * dstK + k0 + 8 * cc) = o; }
    asm volatile("s_waitcnt lgkmcnt(0)" ::: "memory");
}
template <class Src> __device__ __forceinline__ void transpose_item(const Ctx& c, LAS float* scr, const Src& src, bf16* dst, int dstK, int k0, int n0) {
    f32x4 tv[8]; titem_load(c, src, k0, n0, tv); titem_finish(c, scr, tv, dst, dstK, k0, n0);
}
struct SrcWin { const float* w; __device__ __forceinline__ f32x4 v4(int k, int n) const { const int s = proj_src_col(n); return s < 0 ? (f32x4){0.f, 0.f, 0.f, 0.f} : *(const f32x4*)(w + (size_t)k * IN_WIDTH + s); } };
struct SrcPlain { const float* w; int N; __device__ __forceinline__ f32x4 v4(int k, int n) const { return *(const f32x4*)(w + (size_t)k * N + n); } };
struct SrcShift { const float* w; int N; int shift; __device__ __forceinline__ f32x4 v4(int k, int n) const { return *(const f32x4*)(w + (size_t)k * N + n + shift); } };

__device__ __forceinline__ float t5_bias_bucket(int dist) {
    if (dist < 16) return (float)dist;
    int b = 16 + (int)(logf((float)dist / 16.0f) / logf(8.0f) * 16.0f);
    return (float)(b < 31 ? b : 31);
}
constexpr int P0_EXPERT_ITEMS = 32 * 256 + 32 * 128;
__device__ __forceinline__ void p0_expert_item(const Ctx& c, LAS float* scr, int r) {
    constexpr int I_GU = 32 * 256;
    if (r < I_GU) { const int e = r / 256, q = r % 256, n0 = (q / 16) * 32, half = (n0 >> 7) & 1, col0 = (n0 >> 8) * 128 + (n0 & 127);
        if (half) { SrcShift s_{c.w_up + (size_t)e * 1024 * 256, DEXP, col0 - n0}; transpose_item(c, scr, s_, (bf16*)(c.ws + WS_WGU) + (size_t)e * 512 * 1024, 1024, (q % 16) * 64, n0); }
        else { SrcShift s_{c.w_gate + (size_t)e * 1024 * 256, DEXP, col0 - n0}; transpose_item(c, scr, s_, (bf16*)(c.ws + WS_WGU) + (size_t)e * 512 * 1024, 1024, (q % 16) * 64, n0); }
        return; }
    r -= I_GU;
    { const int e = r / 128, q = r % 128; SrcPlain s_{c.w_down + (size_t)e * 256 * 1024, 1024};
        transpose_item(c, scr, s_, (bf16*)(c.ws + WS_WD) + (size_t)e * 1024 * 256, 256, (q % 4) * 64, (q / 4) * 32); }
}
__device__ __forceinline__ void ex_item_load(const Ctx& c, int r, f32x4 (&tv)[8]) {
    constexpr int I_GU = 32 * 256;
    const float* base; int ld;
    if (r < I_GU) { const int e = r / 256, q = r % 256, n0 = (q / 16) * 32, half = (n0 >> 7) & 1, col0 = (n0 >> 8) * 128 + (n0 & 127);
        base = (half ? c.w_up : c.w_gate) + (size_t)e * 1024 * 256 + (size_t)((q % 16) * 64) * DEXP + col0; ld = DEXP; }
    else { r -= I_GU; const int e = r / 128, q = r % 128; base = c.w_down + (size_t)e * 256 * 1024 + (size_t)((q % 4) * 64) * 1024 + (q / 4) * 32; ld = 1024; }
    const float* pl = base + (size_t)(c.lane >> 3) * ld + (c.lane & 7) * 4;
#pragma unroll
    for (int i = 0; i < 8; ++i) tv[i] = *(const f32x4*)(pl + (size_t)(8 * i) * ld);
}
__device__ __forceinline__ void ex_item_finish(const Ctx& c, LAS float* scr, int r, const f32x4 (&tv)[8]) {
    constexpr int I_GU = 32 * 256;
    if (r < I_GU) { const int e = r / 256, q = r % 256; titem_finish(c, scr, tv, (bf16*)(c.ws + WS_WGU) + (size_t)e * 512 * 1024, 1024, (q % 16) * 64, (q / 16) * 32); }
    else { r -= I_GU; const int e = r / 128, q = r % 128; titem_finish(c, scr, tv, (bf16*)(c.ws + WS_WD) + (size_t)e * 1024 * 256, 256, (q % 4) * 64, (q / 4) * 32); }
}
constexpr size_t WS_WRT = 16 * MiB + 512 * 1024;
__device__ __forceinline__ void p0_prologue(const Ctx& c) {
    { const size_t n8 = (size_t)NTOK * D / 8; const f32x4* xs = (const f32x4*)c.x; v4u* xd = (v4u*)((bf16*)(c.ws + WS_XB));
      const size_t st = (size_t)c.G * NTHR;
      size_t i = (size_t)c.bid * NTHR + c.tid;
      for (; i + 3 * st < n8; i += 4 * st) { f32x4 a[4], b[4];
#pragma unroll
          for (int u = 0; u < 4; ++u) { a[u] = xs[2 * (i + u * st)]; b[u] = xs[2 * (i + u * st) + 1]; }
#pragma unroll
          for (int u = 0; u < 4; ++u) { v4u o; o.x = pk2(a[u].x, a[u].y); o.y = pk2(a[u].z, a[u].w); o.z = pk2(b[u].x, b[u].y); o.w = pk2(b[u].z, b[u].w); xd[i + u * st] = o; } }
      for (; i < n8; i += st) { const f32x4 a = xs[2 * i], b = xs[2 * i + 1]; v4u o; o.x = pk2(a.x, a.y); o.y = pk2(a.z, a.w); o.z = pk2(b.x, b.y); o.w = pk2(b.z, b.w); xd[i] = o; } }
    { LAS float* scr = (LAS float*)(c.lds + c.wave * 8704);
      constexpr int I_WIN = 16 * 144, I_WB = 8 * 32, I_WO = 16 * 32, I_ALL = I_WIN + I_WB + I_WO;
      for (int it = c.bid * NWAVES + c.wave; it < I_ALL; it += c.G * NWAVES) {
        int r = it;
        if (r < I_WIN) { SrcWin s_{c.w_in}; transpose_item(c, scr, s_, (bf16*)(c.ws + WS_WIN), 1024, (r % 16) * 64, (r / 16) * 32); continue; } r -= I_WIN;
        if (r < I_WB) { SrcPlain s_{c.w_b, 1024}; transpose_item(c, scr, s_, (bf16*)(c.ws + WS_WB), 512, (r % 8) * 64, (r / 8) * 32); continue; } r -= I_WB;
        { SrcPlain s_{c.w_out, 1024}; transpose_item(c, scr, s_, (bf16*)(c.ws + WS_WO), 1024, (r % 16) * 64, (r / 16) * 32); }
      } }
    __syncthreads();
    { LAS float* tile = (LAS float*)c.lds; LAS float* Us = tile + 64 * 65; LAS float* As = Us + 64 * 65;
      for (int tI = c.bid; tI < 256; tI += c.G) { const int k0 = (tI & 15) * 64, n0 = (tI >> 4) * 64, h = k0 >> 7;
        const int r = c.tid >> 6, cc = c.tid & 63;
#pragma unroll
        for (int pI = 0; pI < 8; ++pI) { const int kk = pI * 8 + r; Us[kk * 65 + cc] = c.w_uv[(size_t)(k0 + kk) * 64 + cc]; As[kk * 65 + cc] = c.w_a[(size_t)(h * 64 + kk) * 1024 + n0 + cc]; }
        __syncthreads();
#pragma unroll
        for (int pI = 0; pI < 8; ++pI) { const int kk = pI * 8 + r; float a = 0.f;
#pragma unroll 16
            for (int d = 0; d < 64; ++d) a += Us[kk * 65 + d] * As[d * 65 + cc];
            tile[kk * 65 + cc] = a; }
        __syncthreads();
        const int nl = c.tid >> 3, kc = c.tid & 7; v4u o;
        o.x = pk2(tile[(8 * kc + 0) * 65 + nl], tile[(8 * kc + 1) * 65 + nl]); o.y = pk2(tile[(8 * kc + 2) * 65 + nl], tile[(8 * kc + 3) * 65 + nl]);
        o.z = pk2(tile[(8 * kc + 4) * 65 + nl], tile[(8 * kc + 5) * 65 + nl]); o.w = pk2(tile[(8 * kc + 6) * 65 + nl], tile[(8 * kc + 7) * 65 + nl]);
        *(v4u*)((bf16*)(c.ws + WS_WC) + (size_t)(n0 + nl) * 1024 + k0 + 8 * kc) = o;
        __syncthreads(); } }
    for (int i = c.bid * NTHR + c.tid; i < 48 * 1024; i += c.G * NTHR) { const int o = i >> 10, k = i & 1023;
        const float v = o < 32 ? c.w_router[(size_t)k * 32 + o] : (o < 36 ? c.w_group[(size_t)k * 4 + (o - 32)] : 0.f);
        const unsigned hi = f2bf(v); const float rem = v - bf2f(hi);
        ((bf16*)(c.ws + WS_WRT))[i] = (bf16)hi; ((bf16*)(c.ws + WS_WRT))[48 * 1024 + i] = (bf16)f2bf(rem); }
    if (c.bid == 0) { for (int i = c.tid; i < 129 * 8; i += NTHR) { const int d = i >> 3, h = i & 7; const int b = (int)t5_bias_bucket(d);
            ((float*)(c.ws + WS_BIAS))[i] = c.rel_bias[b * 16 + h]; ((float*)(c.ws + WS_BIAS) + 129 * 8)[i] = c.rel_bias[b * 16 + 8 + h]; } }
}


__device__ __forceinline__ void p_rmsnorm(const Ctx& c) {
    const int gw = c.bid * NWAVES + c.wave, NGW = c.G * NWAVES, l15 = c.lane & 15, g4 = c.lane >> 4;
    const f32x4 g0 = *(const f32x4*)(c.kv_g + 8 * l15), g1 = *(const f32x4*)(c.kv_g + 8 * l15 + 4);
    for (int r = 4 * gw + g4; r < NTOK; r += 4 * NGW) {
        const float* src = (const float*)(c.ws + WS_CKVRAW) + (size_t)r * 128 + 8 * l15;
        const f32x4 a = *(const f32x4*)src, b = *(const f32x4*)(src + 4);
        float ss = (a.x * a.x + a.y * a.y) + (a.z * a.z + a.w * a.w) + (b.x * b.x + b.y * b.y) + (b.z * b.z + b.w * b.w);
        ss += DPP_F(ss, 0xB1); ss += DPP_F(ss, 0x4E); ss += DPP_F(ss, 0x141); ss += DPP_F(ss, 0x140);
        const float rs = 1.0f / sqrtf(ss * (1.0f / 128.0f) + RMS_EPS);
        v4u o; o.x = pk2(a.x * rs * g0.x, a.y * rs * g0.y); o.y = pk2(a.z * rs * g0.z, a.w * rs * g0.w); o.z = pk2(b.x * rs * g1.x, b.y * rs * g1.y); o.w = pk2(b.z * rs * g1.z, b.w * rs * g1.w);
        *(v4u*)((bf16*)(c.ws + WS_CKV) + (size_t)r * 128 + 8 * l15) = o;
    }
}


typedef float f32x16 __attribute__((ext_vector_type(16)));
typedef short s16x8 __attribute__((ext_vector_type(8)));
__device__ __forceinline__ float half_min(float v) {
    v = fminf(v, DPP_F(v, 0xB1)); v = fminf(v, DPP_F(v, 0x4E)); v = fminf(v, DPP_F(v, 0x141)); v = fminf(v, DPP_F(v, 0x140)); return x16_min(v); }
__device__ __forceinline__ float half_max(float v) {
    v = fmaxf(v, DPP_F(v, 0xB1)); v = fmaxf(v, DPP_F(v, 0x4E)); v = fmaxf(v, DPP_F(v, 0x141)); v = fmaxf(v, DPP_F(v, 0x140)); return x16_max(v); }
__device__ __forceinline__ int half_sum(int v) {
    v += DPP_I(v, 0xB1); v += DPP_I(v, 0x4E); v += DPP_I(v, 0x141); v += DPP_I(v, 0x140); return x16_sumi(v); }
struct P2B { s16x8 b[8]; };
__device__ __forceinline__ P2B p2_ld4(const LAS unsigned char* kb_, int tb) { P2B r;
#pragma unroll
    for (int u = 0; u < 4; ++u) { r.b[2 * u] = *(const LAS s16x8*)(kb_ + (tb + u) * 2048); r.b[2 * u + 1] = *(const LAS s16x8*)(kb_ + (tb + u) * 2048 + 1024); }
    return r; }
__device__ __forceinline__ float p2_relu(float x) { const int xi = __builtin_bit_cast(int, x); return __builtin_bit_cast(float, xi > 0 ? xi : 0); }
__device__ __forceinline__ float p2_wsum(const f32x4 a, const f32x4 w) {
    float p = fmaf(w.x, p2_relu(a[0]), 0.f); p = fmaf(w.y, p2_relu(a[1]), p); p = fmaf(w.z, p2_relu(a[2]), p); return fmaf(w.w, p2_relu(a[3]), p); }
__device__ __forceinline__ void p2_score4(const P2B& B, const s16x8 a0, const s16x8 a1, const f32x4 wq, float& r0, float& r1) {
    f32x4 acc[4];
#pragma unroll
    for (int u = 0; u < 4; ++u) { const f32x4 z = {0.f, 0.f, 0.f, 0.f}; acc[u] = __builtin_amdgcn_mfma_f32_16x16x32_bf16(a0, B.b[2 * u], z, 0, 0, 0); }
#pragma unroll
    for (int u = 0; u < 4; ++u) acc[u] = __builtin_amdgcn_mfma_f32_16x16x32_bf16(a1, B.b[2 * u + 1], acc[u], 0, 0, 0);
    const float p0 = p2_wsum(acc[0], wq), p1 = p2_wsum(acc[1], wq), p2 = p2_wsum(acc[2], wq), p3 = p2_wsum(acc[3], wq);
    { auto s_ = __builtin_amdgcn_permlane16_swap(__builtin_bit_cast(unsigned, p0), __builtin_bit_cast(unsigned, p1), false, false); const unsigned x_ = s_[0], y_ = s_[1];
      r0 = __builtin_bit_cast(float, x_) + __builtin_bit_cast(float, y_); }
    { auto s_ = __builtin_amdgcn_permlane16_swap(__builtin_bit_cast(unsigned, p2), __builtin_bit_cast(unsigned, p3), false, false); const unsigned x_ = s_[0], y_ = s_[1];
      r1 = __builtin_bit_cast(float, x_) + __builtin_bit_cast(float, y_); }
}
__device__ __forceinline__ void p2_unit(const Ctx& c, int b, int blk, int item, int item2) {
    LAS unsigned char* kst = c.lds;
    const int lane = c.lane, wv = c.wave, r = lane & 31, hh = lane >> 5, g4 = lane >> 4, c16 = lane & 15;
    const int t0 = blk * 16 + 2 * wv, n0 = b * SEQ + t0, ntile = blk + 1, nst = (ntile + 15) >> 4;
    const unsigned char* ksrc = c.ws + WS_KIDX + (size_t)(b * 128) * 2048;
#define P2_ISSUE(st) do { _Pragma("unroll") for (int _j = 0; _j < 4; ++_j) \
        __builtin_amdgcn_global_load_lds((const unsigned*)(ksrc + (size_t)(st) * 32768 + (_j * 512 + c.tid) * 16), (LAS unsigned*)(kst + ((st) & 1) * 32768 + (_j * 512 + wv * 64) * 16), 16, 0, 0); } while (0)
    P2_ISSUE(0);
    s16x8 af[2];
    { const bf16* qp = (const bf16*)(c.ws + WS_QIDX) + (size_t)(n0 + (c16 >> 3)) * 512 + (c16 & 7) * 64 + 8 * g4;
      af[0] = *(const s16x8*)qp; af[1] = *(const s16x8*)(qp + 32); }
    const f32x4 wq = *(const f32x4*)((const float*)(c.ws + WS_WIDX) + (size_t)(n0 + hh) * 8 + 4 * (g4 & 1));
    asm volatile("" :: "v"(af[0]), "v"(af[1]), "v"(wq));
    float sc0[64];
#pragma unroll
    for (int i = 0; i < 64; ++i) sc0[i] = -INFINITY;
    const int lim0 = 2 * wv + hh;
    const int lastst = blk >> 4;
    const int limt = (blk - (g4 & 1)) - ((c16 <= lim0) ? 0 : 1);
#pragma unroll
    for (int st = 0; st < 8; ++st) {
        if (st <= lastst) {
            if (st < lastst) { P2_ISSUE(st + 1); asm volatile("s_waitcnt vmcnt(4)" ::: "memory"); }
            else asm volatile("s_waitcnt vmcnt(0)" ::: "memory");
            __builtin_amdgcn_s_barrier();
            const LAS unsigned char* kb_ = kst + (st & 1) * 32768 + lane * 16;
            if (st < lastst) {
                P2B Ba = p2_ld4(kb_, 0), Bb = p2_ld4(kb_, 4);
                p2_score4(Ba, af[0], af[1], wq, sc0[st * 8 + 0], sc0[st * 8 + 1]); __builtin_amdgcn_sched_barrier(0);
                Ba = p2_ld4(kb_, 8);
                p2_score4(Bb, af[0], af[1], wq, sc0[st * 8 + 2], sc0[st * 8 + 3]); __builtin_amdgcn_sched_barrier(0);
                Bb = p2_ld4(kb_, 12);
                p2_score4(Ba, af[0], af[1], wq, sc0[st * 8 + 4], sc0[st * 8 + 5]); __builtin_amdgcn_sched_barrier(0);
                p2_score4(Bb, af[0], af[1], wq, sc0[st * 8 + 6], sc0[st * 8 + 7]);
            } else {
#pragma unroll
                for (int g = 0; g < 4; ++g) if (st * 16 + 4 * g <= blk) {
                    const P2B B = p2_ld4(kb_, 4 * g);
                    float r0, r1; p2_score4(B, af[0], af[1], wq, r0, r1);
                    sc0[st * 8 + 2 * g] = (st * 16 + 4 * g <= limt) ? r0 : -INFINITY;
                    sc0[st * 8 + 2 * g + 1] = (st * 16 + 4 * g + 2 <= limt) ? r1 : -INFINITY;
                    __builtin_amdgcn_sched_barrier(0);
                }
            }
            asm volatile("s_waitcnt lgkmcnt(0)" ::: "memory");
            __builtin_amdgcn_s_barrier();
        }
    }
#undef P2_ISSUE
    f32x4 tv[8];
    LAS float* iscr = (LAS float*)(c.lds + (wv < 7 ? 65536 + wv * 8448 : 133120));
    if (item >= 0) ex_item_load(c, item, tv);
    const int nreg = (ntile + 1) >> 1;
    float thr0 = -INFINITY; int quota0 = 0;
    if (blk >= 16) {
#define P2_COUNT_NEG(EXPR, OUT) do { unsigned sa_ = 0u, sb_ = 0u; \
        _Pragma("unroll") for (int g = 0; g < 4; ++g) if (nreg > 16 * g) { \
            _Pragma("unroll") for (int i = 16 * g; i < 16 * g + 16; ++i) { const float s_ = sc0[i]; const unsigned tb_ = __builtin_bit_cast(unsigned, (EXPR)); \
                if (g < 2) sa_ = __builtin_amdgcn_alignbit(sa_, tb_, 31); else sb_ = __builtin_amdgcn_alignbit(sb_, tb_, 31); } } \
        OUT = half_sum(__builtin_popcount(sa_) + __builtin_popcount(sb_)); } while (0)
        const int ntot = t0 + hh + 1;
        float mx0 = -INFINITY;
#pragma unroll
        for (int g = 0; g < 4; ++g) if (nreg > 16 * g) {
#pragma unroll
            for (int i = 16 * g; i < 16 * g + 16; ++i) mx0 = fmaxf(mx0, sc0[i]); }
        mx0 = half_max(mx0);
        int cneg, cp; P2_COUNT_NEG(s_, cneg); P2_COUNT_NEG(0.f - s_, cp);
        const int cn = 32 * ((nreg + 15) & ~15) - cneg;
        float lo0 = 0.f, hi0 = 0.f; int chi0 = 0, clo0 = KSEL + 1; bool done0 = false, eg0 = false;
        if (cp <= KSEL && cn >= KSEL) { done0 = true; thr0 = 0.f; quota0 = KSEL - cp; }
        else if (cp > KSEL) { lo0 = 0.f; clo0 = cp; hi0 = mx0 + fabsf(mx0) * 1e-6f + 1e-30f; chi0 = 0; }
        else { hi0 = 0.f; chi0 = cn; clo0 = ntot; }
        if (__builtin_amdgcn_ballot_w64(!done0 && cp <= KSEL) != 0ull) {
            float mn0 = INFINITY;
#pragma unroll
            for (int g = 0; g < 4; ++g) if (nreg > 16 * g) {
#pragma unroll
                for (int i = 16 * g; i < 16 * g + 16; ++i) mn0 = fminf(mn0, sc0[i] == -INFINITY ? INFINITY : sc0[i]); }
            mn0 = half_min(mn0);
            if (!done0 && cp <= KSEL) lo0 = mn0;
        }
        float wl0 = 1.f, wh0 = 1.f; int side0 = 0;
        for (int it = 0; it < 400; ++it) {
            if (!done0 && chi0 == KSEL - 1) { done0 = true; eg0 = true; }
            if (__builtin_amdgcn_ballot_w64(!done0) == 0ull) break;
            const float half_ = 0.5f * (lo0 + hi0);
            const float fl_ = ((float)(clo0 - KSEL) + 0.5f) * wl0, fh_ = ((float)(KSEL - chi0) - 0.5f) * wh0;
            const float mi = lo0 + (hi0 - lo0) * (fl_ / (fl_ + fh_));
            const float mid0 = (it < 48 && mi > lo0 && mi < hi0) ? mi : half_;
            int cb; P2_COUNT_NEG(s_ - mid0, cb);
            const int c0 = 32 * ((nreg + 15) & ~15) - cb;
            if (!done0) { if (c0 == KSEL) { done0 = true; thr0 = mid0; quota0 = KSEL; } else if (mid0 <= lo0 || mid0 >= hi0) { done0 = true; thr0 = lo0; quota0 = KSEL - chi0; }
                else if (c0 > KSEL) { lo0 = mid0; clo0 = c0; wh0 = side0 > 0 ? wh0 * 0.5f : 1.f; wl0 = 1.f; side0 = 1; }
                else { hi0 = mid0; chi0 = c0; wl0 = side0 < 0 ? wl0 * 0.5f : 1.f; wh0 = 1.f; side0 = -1; } }
        }
        if (!done0) { thr0 = lo0; quota0 = KSEL - chi0; }
        if (__builtin_amdgcn_ballot_w64(eg0) != 0ull) {
            float m_ = -INFINITY;
#pragma unroll
            for (int g = 0; g < 4; ++g) if (nreg > 16 * g) {
#pragma unroll
                for (int i = 16 * g; i < 16 * g + 16; ++i) m_ = fmaxf(m_, sc0[i] < hi0 ? sc0[i] : -INFINITY); }
            m_ = half_max(m_);
            if (eg0) { thr0 = m_; quota0 = 1; }
        }
#undef P2_COUNT_NEG
    }
    if (item >= 0) ex_item_finish(c, iscr, item, tv);
    if (item2 >= 0) ex_item_load(c, item2, tv);
    unsigned short* selp0 = (unsigned short*)(c.ws + WS_SEL) + (size_t)(n0 + hh) * KSEL;
    int base0 = 0, eq0 = 0; const unsigned ltm = (1u << r) - 1u;
#pragma unroll
    for (int g = 0; g < 4; ++g) if (nreg > 16 * g) {
#pragma unroll
        for (int i = 16 * g; i < 16 * g + 16; ++i) {
            bool sel_ = sc0[i] > thr0; const bool pe = sc0[i] == thr0; const unsigned long long me = __builtin_amdgcn_ballot_w64(pe);
            if (me) { const unsigned mh = hh ? (unsigned)(me >> 32) : (unsigned)me; sel_ = sel_ || (pe && (eq0 + __builtin_popcount(mh & ltm) < quota0)); eq0 += __builtin_popcount(mh); }
            const unsigned long long ms = __builtin_amdgcn_ballot_w64(sel_); const unsigned mh2 = hh ? (unsigned)(ms >> 32) : (unsigned)ms;
            const int pos = base0 + __builtin_popcount(mh2 & ltm); if (sel_ && pos < KSEL) selp0[pos] = (unsigned short)(32 * i + r); base0 += __builtin_popcount(mh2);
        } }
    if (item2 >= 0) ex_item_finish(c, iscr, item2, tv);
}
__device__ __forceinline__ void p2_indexer_topk(const Ctx& c) {
    for (int pu = c.bid; pu < 256; pu += c.G) {
        const int b = pu >> 5, j = pu & 31;
#pragma unroll 1
        for (int q = 0; q < 4; ++q) p2_unit(c, b, q == 0 ? j : (q == 1 ? 63 - j : (q == 2 ? 64 + j : 127 - j)), c.G == 256 ? q * 2048 + c.bid * NWAVES + c.wave : -1, (c.G == 256 && q < 2) ? (4 + q) * 2048 + c.bid * NWAVES + c.wave : -1);
    }
}


typedef short s16x4 __attribute__((ext_vector_type(4)));
constexpr int DSA_WS_OFF = 131072 + 2048;
constexpr int DSA_BIAS_OFF = 131072 + 2048 + 10240;
__device__ __forceinline__ void p3a_dsa(const Ctx& c) {
    const int lane = c.lane, wv = c.wave, l15 = lane & 15, g4 = lane >> 4;
    LAS unsigned char* kvb = c.lds + wv * 16384;
    LAS unsigned char* wsb = c.lds + DSA_WS_OFF + wv * 1280;
    LAS float* biasL = (LAS float*)(c.lds + DSA_BIAS_OFF);
    for (int i = c.tid; i < 129 * 8; i += NTHR) biasL[i] = ((const float*)(c.ws + WS_BIAS))[i];
    __syncthreads();
    const int prow = (l15 & 3) | ((l15 & 4) << 1) | ((l15 & 8) >> 1);
    const int rowx = ((prow & 3) << 2) | (prow >> 2);
    const unsigned qk_off = (unsigned)(256 * prow + 16 * (g4 ^ (rowx & 3))), qk_sx = (unsigned)(rowx >> 2);
    const int grow = 8 * (g4 & 1) + 4 * (g4 >> 1);
    const int trow = grow + (l15 >> 2), trx = ((trow & 3) << 2) | ((trow >> 2) & 3);
    const unsigned tr_off = (unsigned)(256 * trow + 16 * (((lane & 3) >> 1) ^ (trx & 1)) + 8 * (lane & 1)), tr_mx = (unsigned)(trx >> 1);
    const bf16* ckv = (const bf16*)(c.ws + WS_CKV);
    const float bfar = biasL[128 * 8 + (l15 & 7)];
    float bmax = 0.f;
    for (int d = 0; d <= 128; ++d) bmax = fmaxf(bmax, fabsf(biasL[d * 8 + (l15 & 7)]));
    const float kvmax = 11.313708499f * 1.004f * wave_max(fmaxf(fabsf(c.kv_g[2 * lane]), fabsf(c.kv_g[2 * lane + 1])));
    unsigned trm[8];
#pragma unroll
    for (int m = 0; m < 8; ++m) trm[m] = tr_off + 32u * ((unsigned)m ^ tr_mx);
    const int gw = c.bid * NWAVES + wv, NGW = c.G * NWAVES;
    const int eit0 = (c.G == 256 ? P0_EXPERT_ITEMS : 0) + gw;
    if (wv < 4) for (int eit = eit0; eit < P0_EXPERT_ITEMS; eit += NGW) p0_expert_item(c, (LAS float*)kvb, eit);
    asm volatile("s_waitcnt lgkmcnt(0)" ::: "memory");
#define DSA_LOADQ(n_, raw_, qf_) do { raw_ = *(const v2u*)((const unsigned short*)(c.ws + WS_SEL) + (size_t)(n_) * KSEL + 4 * lane); \
        const s16x8* qp_ = (const s16x8*)((const bf16*)(c.ws + WS_QLAT) + (size_t)(n_) * 1024 + (l15 & 7) * 128 + 8 * g4); \
        _Pragma("unroll") for (int s_ = 0; s_ < 4; ++s_) qf_[s_] = qp_[4 * s_]; } while (0)
#define DSA_PREP(n_, raw_, qf_, sl_, t_, cnt_, nch_, nfar_, mref_) do { t_ = (n_) & 2047; cnt_ = (t_ + 1 < KSEL) ? t_ + 1 : KSEL; nch_ = (cnt_ + 31) >> 5; \
        { const int i0 = 4 * lane, lim = t_ - 128; \
          raw_.x = (i0 < cnt_ ? (raw_.x & 0xffffu) : 0u) | (i0 + 1 < cnt_ ? (raw_.x & 0xffff0000u) : 0u); raw_.y = (i0 + 2 < cnt_ ? (raw_.y & 0xffffu) : 0u) | (i0 + 3 < cnt_ ? (raw_.y & 0xffff0000u) : 0u); \
          *(LAS v2u*)(wsb + (sl_) * 512 + 8 * lane) = raw_; \
          const int e0 = (i0 < cnt_ && (int)(raw_.x & 0xffffu) <= lim) ? 1 : 0, e1 = (i0 + 1 < cnt_ && (int)(raw_.x >> 16) <= lim) ? 1 : 0, e2 = (i0 + 2 < cnt_ && (int)(raw_.y & 0xffffu) <= lim) ? 1 : 0, e3 = (i0 + 3 < cnt_ && (int)(raw_.y >> 16) <= lim) ? 1 : 0; \
          int nf = e0 + e1 + e2 + e3; nf += DPP_I(nf, 0xB1); nf += DPP_I(nf, 0x4E); nf += DPP_I(nf, 0x141); nf += DPP_I(nf, 0x140); nf = x16_sumi(nf); { unsigned xa, xb; swap32((unsigned)nf, xa, xb); nf = (int)(xa + xb); } \
          nfar_ = __builtin_amdgcn_readfirstlane(nf) >> 5; } \
        { float q2 = 0.f; \
          _Pragma("unroll") for (int s_ = 0; s_ < 4; ++s_) { if (l15 >= 8) qf_[s_] = (s16x8){0, 0, 0, 0, 0, 0, 0, 0}; \
              _Pragma("unroll") for (int e = 0; e < 8; ++e) { const float qv = bf2f((unsigned)(unsigned short)qf_[s_][e]); q2 += qv * qv; } } \
          q2 = x16_sum(q2); q2 = x32_sum(q2); mref_ = sqrtf(q2) * kvmax + bmax; } } while (0)
#define DSA_ISSUE(ch_, bi_, k8_, sl_, n_, t_, cnt_, nfar_) do { const bf16* ckb_ = ckv + (size_t)((n_) >> 11) * SEQ * 128; \
            _Pragma("unroll") for (int u = 0; u < 8; ++u) { const unsigned kw = u < 2 ? k8_.x : (u < 4 ? k8_.y : (u < 6 ? k8_.z : k8_.w)); const unsigned key = (u & 1) ? (kw >> 16) : (kw & 0xffffu); \
                const int chl = l15 ^ ((g4 << 2) | (u & 3)); \
                __builtin_amdgcn_global_load_lds((const unsigned*)((const char*)ckb_ + (size_t)(unsigned)(key * 256u + (unsigned)chl * 16u)), (LAS unsigned*)(kvb + (bi_) * 8192 + u * 1024), 16, 0, 0); } \
            if ((ch_) >= (nfar_) && lane < 32) { const int kap = 32 * (ch_) + 8 * (lane & 3) + (lane >> 2); const int key = *(const LAS unsigned short*)(wsb + (sl_) * 512 + 2 * kap); int dd = (t_) - key; dd = dd > 128 ? 128 : dd; dd = kap < (cnt_) ? dd : 255; \
                *(LAS unsigned short*)(wsb + 1024 + (bi_) * 64 + 2 * lane) = (unsigned short)dd; } } while (0)
    const bool mixq = (NGW == SEQ);
#define DSA_QIDX(i_) (mixq ? ((i_) * SEQ + ((gw + 293 * (i_)) & (SEQ - 1))) : (gw + (i_) * NGW))
    const int nq = mixq ? BATCH : (NTOK - gw + NGW - 1) / NGW;
    int qi = 0, n = DSA_QIDX(0), sl = 0, b0 = 0, t = 0, cnt = 0, nch = 0, nfar = 0; float Mref = 0.f;
    s16x8 qf[4]; v2u rawn; s16x8 qfn[4];
    if (nq > 0) { v2u raw0; DSA_LOADQ(n, raw0, qf); DSA_PREP(n, raw0, qf, 0, t, cnt, nch, nfar, Mref);
        asm volatile("s_waitcnt lgkmcnt(0)" ::: "memory");
        const v4u k80 = *(const LAS v4u*)(wsb + (8 * g4) * 2); DSA_ISSUE(0, 0, k80, 0, n, t, cnt, nfar); }
    for (; qi < nq; ++qi) {
        const bool has_next = qi + 1 < nq; const int nn = has_next ? DSA_QIDX(qi + 1) : n;
        if (has_next) DSA_LOADQ(nn, rawn, qfn);
        int tn = 0, cntn = 0, nchn = 0, nfarn = 0; float Mrefn = 0.f;
        f32x4 O[8];
#pragma unroll
        for (int m = 0; m < 8; ++m) O[m] = (f32x4){0.f, 0.f, 0.f, 0.f};
        float l_run = 0.f;
        v4u k8n = *(const LAS v4u*)(wsb + sl * 512 + (32 * (nch > 1 ? 1 : 0) + 8 * g4) * 2);
        for (int ch = 0; ch < nch; ++ch) {
            const int bi = (b0 + ch) & 1;
            asm volatile("s_waitcnt lgkmcnt(0)" ::: "memory");
            if (ch + 1 < nch) { const v4u k8 = k8n; k8n = *(const LAS v4u*)(wsb + sl * 512 + (32 * (ch + 2 < 8 ? ch + 2 : 7) + 8 * g4) * 2);
                DSA_ISSUE(ch + 1, bi ^ 1, k8, sl, n, t, cnt, nfar); asm volatile("s_waitcnt vmcnt(8)" ::: "memory"); }
            else if (has_next) { DSA_PREP(nn, rawn, qfn, sl ^ 1, tn, cntn, nchn, nfarn, Mrefn);
                asm volatile("s_waitcnt lgkmcnt(0)" ::: "memory");
                const v4u k8 = *(const LAS v4u*)(wsb + (sl ^ 1) * 512 + (8 * g4) * 2);
                DSA_ISSUE(0, bi ^ 1, k8, sl ^ 1, nn, tn, cntn, nfarn); asm volatile("s_waitcnt vmcnt(8)" ::: "memory"); }
            else asm volatile("s_waitcnt vmcnt(0)" ::: "memory");
            const LAS unsigned char* kb_ = kvb + bi * 8192;
            f32x4 S[2];
#pragma unroll
            for (int T = 0; T < 2; ++T) { f32x4 a4 = {0.f, 0.f, 0.f, 0.f};
#pragma unroll
                for (int s_ = 0; s_ < 4; ++s_) { const s16x8 a = *(const LAS s16x8*)(kb_ + qk_off + 4096 * T + 64 * ((unsigned)s_ ^ qk_sx)); a4 = __builtin_amdgcn_mfma_f32_16x16x32_bf16(a, qf[s_], a4, 0, 0, 0); }
                S[T] = a4; }
            if (ch < nfar) {
#pragma unroll
                for (int T = 0; T < 2; ++T)
#pragma unroll
                    for (int r_ = 0; r_ < 4; ++r_) S[T][r_] = S[T][r_] + (bfar - Mref);
            } else
#pragma unroll
            for (int T = 0; T < 2; ++T) { const v2u d4 = *(const LAS v2u*)(wsb + 1024 + bi * 64 + 2 * (16 * T + grow));
#pragma unroll
                for (int r_ = 0; r_ < 4; ++r_) { const unsigned dw = r_ < 2 ? d4.x : d4.y; const unsigned dd = (r_ & 1) ? (dw >> 16) : (dw & 0xffffu);
                    const float bsv = biasL[(dd > 128u ? 128u : dd) * 8 + (l15 & 7)]; S[T][r_] = (dd == 255u) ? -INFINITY : S[T][r_] + (bsv - Mref); } }
#pragma unroll
            for (int T = 0; T < 2; ++T)
#pragma unroll
                for (int r_ = 0; r_ < 4; ++r_) { const float pv = __expf(S[T][r_]); S[T][r_] = pv; l_run += pv; }
            s16x8 P;
            { const unsigned p0 = cvt_pk(S[0][0], S[0][1]), p1 = cvt_pk(S[0][2], S[0][3]), p2 = cvt_pk(S[1][0], S[1][1]), p3 = cvt_pk(S[1][2], S[1][3]);
              const v4u pw_ = {p0, p1, p2, p3}; P = __builtin_bit_cast(s16x8, pw_); }
            { const unsigned kba = (unsigned)(size_t)kb_; s16x4 ta[8], tb[8];
#pragma unroll
              for (int m = 0; m < 8; ++m) { const unsigned ad = kba + trm[m];
                  asm volatile("ds_read_b64_tr_b16 %0, %1" : "=v"(ta[m]) : "v"(ad) : "memory"); asm volatile("ds_read_b64_tr_b16 %0, %1 offset:4096" : "=v"(tb[m]) : "v"(ad) : "memory"); }
              asm volatile("s_waitcnt lgkmcnt(8)" ::: "memory"); __builtin_amdgcn_sched_barrier(0);
#pragma unroll
              for (int m = 0; m < 4; ++m) O[m] = __builtin_amdgcn_mfma_f32_16x16x32_bf16(__builtin_shufflevector(ta[m], tb[m], 0, 1, 2, 3, 4, 5, 6, 7), P, O[m], 0, 0, 0);
              asm volatile("s_waitcnt lgkmcnt(0)" ::: "memory"); __builtin_amdgcn_sched_barrier(0);
#pragma unroll
              for (int m = 4; m < 8; ++m) O[m] = __builtin_amdgcn_mfma_f32_16x16x32_bf16(__builtin_shufflevector(ta[m], tb[m], 0, 1, 2, 3, 4, 5, 6, 7), P, O[m], 0, 0, 0); }
        }
        l_run = x16_sum(l_run); l_run = x32_sum(l_run);
        const float inv = 1.0f / fmaxf(l_run, 1e-37f);
        { LAS unsigned char* stg = kvb + ((b0 + nch - 1) & 1) * 8192;
          if (l15 < 8) {
#pragma unroll
              for (int m = 0; m < 8; ++m) *(LAS v2u*)(stg + (l15 * 128 + 16 * m + 4 * g4) * 2) = (v2u){cvt_pk(O[m][0] * inv, O[m][1] * inv), cvt_pk(O[m][2] * inv, O[m][3] * inv)}; }
          asm volatile("s_waitcnt lgkmcnt(0)" ::: "memory");
          const v4u oa = *(const LAS v4u*)(stg + lane * 16), ob = *(const LAS v4u*)(stg + 1024 + lane * 16);
          bf16* op = (bf16*)(c.ws + WS_XB) + (size_t)n * 1024 + lane * 8;
          *(v4u*)op = oa; *(v4u*)(op + 512) = ob; }
        b0 = (b0 + nch) & 1; sl ^= 1; t = tn; cnt = cntn; nch = nchn; nfar = nfarn; Mref = Mrefn; n = nn;
#pragma unroll
        for (int s_ = 0; s_ < 4; ++s_) qf[s_] = qfn[s_];
    }
#undef DSA_QIDX
#undef DSA_LOADQ
#undef DSA_PREP
#undef DSA_ISSUE
    asm volatile("s_waitcnt vmcnt(0) lgkmcnt(0)" ::: "memory");
    if (wv >= 4) for (int eit = eit0; eit < P0_EXPERT_ITEMS; eit += NGW) p0_expert_item(c, (LAS float*)kvb, eit);
    __syncthreads();
}

__device__ __forceinline__ void p3b_swa(const Ctx& c) {
    const int lane = c.lane, wv = c.wave, l15 = lane & 15, g4 = lane >> 4, g = wv & 3, hq = wv >> 2;
    LAS float* biasL = (LAS float*)(c.lds + DSA_BIAS_OFF);
    __syncthreads();
    for (int i = c.tid; i < 128 * 8; i += NTHR) biasL[i] = ((const float*)(c.ws + WS_BIAS) + 129 * 8)[i];
    __syncthreads();
    const unsigned kr_off = (unsigned)(128 * l15), kr_x = (unsigned)(l15 & 7);
    const int vrow = 4 * g4 + (l15 >> 2); const unsigned vr_x = (unsigned)(vrow & 7), vp1 = (unsigned)((lane & 3) >> 1);
    const unsigned vr_off = (unsigned)(128 * vrow + 8 * (lane & 1));
    for (int unit = c.bid; unit < 256; unit += c.G) {
        const int b = unit >> 5, qb = (unit >> 1) & 15, kvh = unit & 1, head = kvh * 4 + g;
        __syncthreads();
#pragma unroll
        for (int j = 0; j < 4; ++j) { const int piece = wv * 4 + j, row = 8 * piece + (lane >> 3), chunk = (lane & 7) ^ (row & 7); int key = (qb - 1) * 128 + row; key = key < 0 ? 0 : key;
            const size_t so = ((size_t)(b * SEQ + key) * 128 + kvh * 64 + chunk * 8);
            __builtin_amdgcn_global_load_lds((const unsigned*)((const bf16*)(c.ws + WS_KB) + so), (LAS unsigned*)(c.lds + piece * 1024), 16, 0, 0);
            __builtin_amdgcn_global_load_lds((const unsigned*)((const bf16*)(c.ws + WS_VB) + so), (LAS unsigned*)(c.lds + 32768 + piece * 1024), 16, 0, 0); }
        float bt[9][4];
#pragma unroll
        for (int ta = 0; ta < 9; ++ta)
#pragma unroll
            for (int r_ = 0; r_ < 4; ++r_) { const int dist = 128 + l15 - 16 * ta - 4 * g4 - r_; bt[ta][r_] = (dist >= 0 && dist < 128) ? biasL[dist * 8 + head] : -INFINITY; }
        const float sink = c.sinks[head];
        asm volatile("s_waitcnt vmcnt(0)" ::: "memory");
        __syncthreads();
#pragma unroll 1
        for (int jj = 0; jj < 4; ++jj) {
            const int j = 4 * hq + jj; const size_t nrow = (size_t)(b * SEQ + qb * 128 + 16 * j + l15);
            bf16* qrow = (bf16*)(c.ws + WS_QB) + nrow * 512 + head * 64;
            const s16x8 q0 = *(const s16x8*)(qrow + 8 * g4), q1 = *(const s16x8*)(qrow + 32 + 8 * g4);
            f32x4 S[9]; float mx = sink;
#pragma unroll
            for (int ta = 0; ta < 9; ++ta) { const int kt = j + ta; const LAS unsigned char* kp = c.lds + kr_off + 2048 * kt;
                f32x4 a4 = {0.f, 0.f, 0.f, 0.f};
                a4 = __builtin_amdgcn_mfma_f32_16x16x32_bf16(*(const LAS s16x8*)(kp + 16 * ((unsigned)g4 ^ kr_x)), q0, a4, 0, 0, 0);
                a4 = __builtin_amdgcn_mfma_f32_16x16x32_bf16(*(const LAS s16x8*)(kp + 16 * ((unsigned)(4 + g4) ^ kr_x)), q1, a4, 0, 0, 0);
                const bool dead = (qb == 0 && kt < 8);
#pragma unroll
                for (int r_ = 0; r_ < 4; ++r_) { const float sv = dead ? -INFINITY : a4[r_] + bt[ta][r_]; a4[r_] = sv; mx = fmaxf(mx, sv); }
                S[ta] = a4; }
            mx = x16_max(mx); mx = x32_max(mx);
            float ps = 0.f;
#pragma unroll
            for (int ta = 0; ta < 9; ++ta)
#pragma unroll
                for (int r_ = 0; r_ < 4; ++r_) { const float pv = __expf(S[ta][r_] - mx); S[ta][r_] = pv; ps += pv; }
            ps = x16_sum(ps); ps = x32_sum(ps);
            const float inv = 1.0f / (ps + __expf(sink - mx));
            f32x4 O[4];
#pragma unroll
            for (int m = 0; m < 4; ++m) O[m] = (f32x4){0.f, 0.f, 0.f, 0.f};
#pragma unroll
            for (int pp = 0; pp < 5; ++pp) {
                const int ta = 2 * pp, tb = 2 * pp + 1;
                v4u pw_; pw_.x = cvt_pk(S[ta][0] * inv, S[ta][1] * inv); pw_.y = cvt_pk(S[ta][2] * inv, S[ta][3] * inv);
                if (tb < 9) { pw_.z = cvt_pk(S[tb < 9 ? tb : 0][0] * inv, S[tb < 9 ? tb : 0][1] * inv); pw_.w = cvt_pk(S[tb < 9 ? tb : 0][2] * inv, S[tb < 9 ? tb : 0][3] * inv); } else { pw_.z = 0u; pw_.w = 0u; }
                const s16x8 P = __builtin_bit_cast(s16x8, pw_);
                const LAS unsigned char* va = c.lds + 32768 + vr_off + 2048 * (j + ta); const LAS unsigned char* vb_ = c.lds + 32768 + vr_off + 2048 * (j + (tb < 9 ? tb : ta));
#pragma unroll
                for (int m = 0; m < 4; ++m) { const unsigned co = 16u * ((unsigned)(2 * m + vp1) ^ vr_x);
                    const s16x4 a0 = __builtin_amdgcn_ds_read_tr16_b64_v4i16((LAS s16x4*)(va + co)), a1 = __builtin_amdgcn_ds_read_tr16_b64_v4i16((LAS s16x4*)(vb_ + co));
                    O[m] = __builtin_amdgcn_mfma_f32_16x16x32_bf16(__builtin_shufflevector(a0, a1, 0, 1, 2, 3, 4, 5, 6, 7), P, O[m], 0, 0, 0); }
            }
#pragma unroll
            for (int m = 0; m < 4; ++m) *(v2u*)(qrow + 16 * m + 4 * g4) = (v2u){cvt_pk(O[m][0], O[m][1]), cvt_pk(O[m][2], O[m][3])};
        }
    }
    __syncthreads();
}

__device__ __forceinline__ void p6_ln_router(const Ctx& c, bf16* x1b) {
    const int lane = c.lane, wv = c.wave, l15 = lane & 15, g4 = lane >> 4;
    LAS unsigned char* XH = c.lds; LAS unsigned char* XL = c.lds + 32768;
    LAS float* PL = (LAS float*)(c.lds + 65536);
    LAS float* LG = (LAS float*)(c.lds + 65536 + 24576);
    const bf16* WH = (const bf16*)(c.ws + WS_WRT); const bf16* WL = WH + 48 * 1024;
    LAS unsigned* PEX = (LAS unsigned*)(c.lds + 65536 + 24576 + 4096);
    LAS unsigned* EB = PEX + 128;
    int nbase = 0;
    s16x8 wbh[4][3], wbl[4][3];
#pragma unroll
    for (int s_ = 0; s_ < 4; ++s_)
#pragma unroll
        for (int nt = 0; nt < 3; ++nt) { const size_t wo = (size_t)(16 * nt + l15) * 1024 + 128 * wv + 32 * s_ + 8 * g4; wbh[s_][nt] = *(const s16x8*)(WH + wo); wbl[s_][nt] = *(const s16x8*)(WL + wo); }
    v2u vn[2][4];
    const bf16* h1b = (const bf16*)(c.ws + WS_H1B);
    if (c.bid < NTOK / 16) {
#pragma unroll
        for (int q = 0; q < 2; ++q)
#pragma unroll
            for (int j = 0; j < 4; ++j) vn[q][j] = ((const v2u*)(h1b + (size_t)(c.bid * 16 + 2 * wv + q) * D) + lane)[64 * j]; }
    for (int u = c.bid; u < NTOK / 16; u += c.G) {
        __syncthreads();
#pragma unroll
        for (int q = 0; q < 2; ++q) { const int tk = 2 * wv + q, n = u * 16 + tk;
            f32x4 v[4]; float s = 0.f;
#pragma unroll
            for (int j = 0; j < 4; ++j) { v[j] = (f32x4){bflo(vn[q][j].x), bfhi(vn[q][j].x), bflo(vn[q][j].y), bfhi(vn[q][j].y)}; s += (v[j].x + v[j].y) + (v[j].z + v[j].w); }
            const float mean = wave_sum(s) * (1.f / D); float s2 = 0.f;
#pragma unroll
            for (int j = 0; j < 4; ++j) { v[j] = v[j] - mean; s2 += (v[j].x * v[j].x + v[j].y * v[j].y) + (v[j].z * v[j].z + v[j].w * v[j].w); }
            const float rstd = 1.f / sqrtf(wave_sum(s2) * (1.f / D) + LN_EPS);
#pragma unroll
            for (int j = 0; j < 4; ++j) { const int k0 = 4 * lane + 256 * j;
                const f32x4 g = *(const f32x4*)(c.ln1_g + k0), bb = *(const f32x4*)(c.ln1_b + k0);
                const f32x4 y = v[j] * rstd * g + bb;
                const unsigned h01 = pk2(y.x, y.y), h23 = pk2(y.z, y.w);
                *(v2u*)(x1b + (size_t)n * D + k0) = (v2u){h01, h23};
                const unsigned l01 = pk2(y.x - bflo(h01), y.y - bfhi(h01)), l23 = pk2(y.z - bflo(h23), y.w - bfhi(h23));
                const unsigned off = (unsigned)(tk * 2048 + ((((lane >> 1) + 32 * j) ^ tk) << 4) + 8 * (lane & 1));
                *(LAS v2u*)(XH + off) = (v2u){h01, h23}; *(LAS v2u*)(XL + off) = (v2u){l01, l23}; } }
        if (u + c.G < NTOK / 16) {
#pragma unroll
            for (int q = 0; q < 2; ++q)
#pragma unroll
                for (int j = 0; j < 4; ++j) vn[q][j] = ((const v2u*)(h1b + (size_t)((u + c.G) * 16 + 2 * wv + q) * D) + lane)[64 * j]; }
        __syncthreads();
        { f32x4 acc[3];
#pragma unroll
          for (int nt = 0; nt < 3; ++nt) acc[nt] = (f32x4){0.f, 0.f, 0.f, 0.f};
#pragma unroll
          for (int s_ = 0; s_ < 4; ++s_) { const int chunk = 4 * (4 * wv + s_) + g4; const unsigned off = (unsigned)(l15 * 2048 + ((chunk ^ l15) << 4));
              const s16x8 ah = *(const LAS s16x8*)(XH + off), al = *(const LAS s16x8*)(XL + off);
#pragma unroll
              for (int nt = 0; nt < 3; ++nt) { const s16x8 bh = wbh[s_][nt], bl = wbl[s_][nt];
                  acc[nt] = __builtin_amdgcn_mfma_f32_16x16x32_bf16(al, bl, acc[nt], 0, 0, 0); acc[nt] = __builtin_amdgcn_mfma_f32_16x16x32_bf16(al, bh, acc[nt], 0, 0, 0);
                  acc[nt] = __builtin_amdgcn_mfma_f32_16x16x32_bf16(ah, bl, acc[nt], 0, 0, 0); acc[nt] = __builtin_amdgcn_mfma_f32_16x16x32_bf16(ah, bh, acc[nt], 0, 0, 0); } }
#pragma unroll
          for (int nt = 0; nt < 3; ++nt)
#pragma unroll
              for (int r_ = 0; r_ < 4; ++r_) PL[(wv * 16 + 4 * g4 + r_) * 48 + 16 * nt + l15] = acc[nt][r_]; }
        __syncthreads();
        for (int i = c.tid; i < 16 * 48; i += NTHR) { float a = 0.f;
#pragma unroll
            for (int w = 0; w < 8; ++w) a += PL[w * 768 + i];
            const int o = i % 48; a += o < 32 ? c.b_router[o] : (o < 36 ? c.b_group[o - 32] : 0.f);
            LG[i] = a; }
        __syncthreads();
        if (c.tid < 16) { const int n = u * 16 + c.tid; const LAS float* lg = LG + c.tid * 48; const int nloc = nbase + 2 * c.tid;
            int gs = 0; float gm = lg[32];
            for (int o = 1; o < 4; ++o) { const float v = lg[32 + o]; if (v > gm) { gm = v; gs = o; } }
            float gsum = 0.f;
            for (int o = 0; o < 4; ++o) gsum += __expf(lg[32 + o] - gm);
            const float gw_ = 1.0f / gsum;
            int i1 = 0; float m1 = lg[gs * 8];
            for (int o = 1; o < 8; ++o) { const float v = lg[gs * 8 + o]; if (v > m1) { m1 = v; i1 = o; } }
            int i2 = -1; float m2 = -INFINITY;
            for (int o = 0; o < 8; ++o) { const float v = lg[gs * 8 + o]; if (o != i1 && v > m2) { m2 = v; i2 = o; } }
            const float e2 = __expf(m2 - m1), w1 = gw_ / (1.0f + e2), w2 = gw_ * e2 / (1.0f + e2);
            const int ex1 = gs * 8 + i1, ex2 = gs * 8 + i2;
            ((unsigned*)(c.ws + WS_PE))[2 * n] = ex1; ((unsigned*)(c.ws + WS_PE))[2 * n + 1] = ex2; ((float*)(c.ws + WS_PW))[2 * n] = w1; ((float*)(c.ws + WS_PW))[2 * n + 1] = w2;
            PEX[nloc] = (unsigned)ex1 | ((unsigned)(2 * n) << 8); PEX[nloc + 1] = (unsigned)ex2 | ((unsigned)(2 * n + 1) << 8); }
        nbase += 32;
        if (nbase == 128 || u + c.G >= NTOK / 16) {
            __syncthreads();
            if (c.tid < 32) { unsigned cntE = 0; for (int j = 0; j < nbase; ++j) cntE += ((PEX[j] & 0xffu) == (unsigned)c.tid) ? 1u : 0u;
                EB[c.tid] = cntE ? atomicAdd(c.ctl + CW_CNT + c.tid, cntE) : 0u; }
            __syncthreads();
            if (c.tid < nbase) { const unsigned rec = PEX[c.tid], e = rec & 0xffu; unsigned rk = 0; for (int j = 0; j < c.tid; ++j) rk += ((PEX[j] & 0xffu) == e) ? 1u : 0u;
                ((unsigned*)(c.ws + WS_LIST))[(size_t)e * 32768 + EB[e] + rk] = rec >> 8; }
            nbase = 0;
        }
    }
    __syncthreads();
}


__device__ __forceinline__ void p9_ln2(const Ctx& c) {
    const int gw = c.bid * NWAVES + c.wave, NGW = c.G * NWAVES;
    v2u xn[4], san[4], sbn[4];
#define P9_LOAD(n_) do { _Pragma("unroll") for (int j = 0; j < 4; ++j) { const int k0 = 4 * c.lane + 256 * j; xn[j] = *(const v2u*)((const bf16*)(c.ws + WS_XB) + (size_t)(n_) * D + k0); \
            san[j] = *(const v2u*)((const bf16*)(c.ws + WS_SLOT) + (size_t)(2 * (n_)) * D + k0); sbn[j] = *(const v2u*)((const bf16*)(c.ws + WS_SLOT) + (size_t)(2 * (n_) + 1) * D + k0); } } while (0)
    if (gw < NTOK) P9_LOAD(gw);
    for (int n = gw; n < NTOK; n += NGW) {
        f32x4* row = (f32x4*)(c.out + (size_t)n * D) + c.lane;
        f32x4 v[4]; float s = 0.f;
#pragma unroll
        for (int j = 0; j < 4; ++j) { f32x4 y;
            y.x = bflo(xn[j].x) * ALPHA + (bflo(san[j].x) + bflo(sbn[j].x)); y.y = bfhi(xn[j].x) * ALPHA + (bfhi(san[j].x) + bfhi(sbn[j].x));
            y.z = bflo(xn[j].y) * ALPHA + (bflo(san[j].y) + bflo(sbn[j].y)); y.w = bfhi(xn[j].y) * ALPHA + (bfhi(san[j].y) + bfhi(sbn[j].y));
            v[j] = y; s += (y.x + y.y) + (y.z + y.w); }
        if (n + NGW < NTOK) P9_LOAD(n + NGW);
        const float mean = wave_sum(s) * (1.f / D); float s2 = 0.f;
#pragma unroll
        for (int j = 0; j < 4; ++j) { v[j] = v[j] - mean; s2 += (v[j].x * v[j].x + v[j].y * v[j].y) + (v[j].z * v[j].z + v[j].w * v[j].w); }
        const float rstd = 1.f / sqrtf(wave_sum(s2) * (1.f / D) + LN_EPS);
#pragma unroll
        for (int j = 0; j < 4; ++j) { const int k0 = 4 * c.lane + 256 * j; const f32x4 g = *(const f32x4*)(c.ln2_g + k0), bb = *(const f32x4*)(c.ln2_b + k0); row[64 * j] = v[j] * rstd * g + bb; }
    }
#undef P9_LOAD
}

namespace pg8 {
typedef short bf16x8 __attribute__((ext_vector_type(8)));
constexpr int BM = 256, BK = 64, HALF = 128, HTB = HALF * BK * 2, STAGE_BYTES = 8 * HTB, NXCD = 8, WGM = 8;
__host__ __device__ __forceinline__ int lds_byte(int r, int c) { const int st = (r >> 4) * 2 + (c >> 5), rr = r & 15, cc = c & 31, ob = rr * 64 + cc * 2; return st * 1024 + (ob ^ (((ob >> 9) & 1) << 5)); }
__host__ __device__ __forceinline__ void stage_rc(int b, int& R, int& C) { const int st = b / 1024, sb = b % 1024, swz = sb ^ (((sb >> 9) & 1) << 5); R = (st >> 1) * 16 + swz / 64; C = (st & 1) * 32 + (swz % 64) / 2; }
__host__ __device__ __forceinline__ int perm32(int rho) { const int n = rho >> 4, i = rho & 15; return 8 * (i >> 2) + 4 * n + (i & 3); }
__device__ __forceinline__ unsigned cvt_pk_bf16(float lo, float hi) { unsigned r; asm volatile("v_cvt_pk_bf16_f32 %0, %1, %2" : "=v"(r) : "v"(lo), "v"(hi)); return r; }

struct Unit { int pm, pn, pb, aux; };

struct StaticOrder {
    int nM, nN, nwg, G, c;
    __device__ void init(int M, int N, int G_, int c_) { nM = M / BM; nN = N / BM; nwg = nM * nN; G = G_; c = c_; }
    __device__ bool next(int i, Unit& u) const {
        const long L = (long)i * G + c; if (L >= nwg) return false;
        int wgid = (int)L; { const int q = nwg / NXCD, r = nwg % NXCD, xcd = wgid % NXCD, off = wgid / NXCD; wgid = (xcd < r ? xcd * (q + 1) : r * (q + 1) + (xcd - r) * q) + off; }
        const int nig = WGM * nN, gid = wgid / nig, fm = gid * WGM, gsz = (nM - fm) < WGM ? (nM - fm) : WGM;
        u.pm = fm + ((wgid % nig) % gsz); u.pn = (wgid % nig) / gsz; u.pb = u.pn; u.aux = 0; return true;
    }
    __device__ __forceinline__ void a_ready(const Unit&) const {}
    __device__ __forceinline__ void done(const Unit&) const {}
};
struct DenseProb {
    static constexpr bool GATHER = false;
    const bf16* A; const bf16* Bt; int K;
    __device__ __forceinline__ const char* a_base(const Unit& u) const { return (const char*)A + (size_t)u.pm * 256 * K * 2; }
    __device__ __forceinline__ const char* b_base(const Unit& u) const { return (const char*)Bt + (size_t)u.pb * 256 * K * 2; }
    __device__ __forceinline__ void a_offs(const Unit&, int R0, int C0, int R1, int C1, unsigned (&o)[2][2]) const {
        o[0][0] = (unsigned)(R0 * K + C0) * 2u; o[0][1] = (unsigned)(R1 * K + C1) * 2u; o[1][0] = o[0][0] + (unsigned)(HALF * K * 2); o[1][1] = o[0][1] + (unsigned)(HALF * K * 2); }
};

template <class Prob, class Epi, class Sched>
__device__ __forceinline__ void gemm_phase(LAS unsigned char* lds, const Prob& P, const Sched& S, const Epi& E) {
    const int tid = threadIdx.x, wid = __builtin_amdgcn_readfirstlane(tid >> 6), lane = tid & 63, wr = wid >> 2, wc = wid & 3, fr = lane & 15, fq = lane >> 4;
    const int K = P.K, nt = K / BK;
    int sR[2], sC[2];
    unsigned offB[2][2], offA[2][2];
#pragma unroll
    for (int i = 0; i < 2; ++i) { stage_rc(tid * 16 + i * 8192, sR[i], sC[i]); const int Rb = Epi::PERM ? ((sR[i] & ~31) + perm32(sR[i] & 31)) : sR[i];
        offB[0][i] = (unsigned)(Rb * K + sC[i]) * 2u; offB[1][i] = offB[0][i] + (unsigned)(HALF * K * 2); }
    const size_t kstep = (size_t)(BK * 2);
    const unsigned ldsw = (unsigned)wid * 1024u;
    const int aoff = lds_byte(wr * 64 + fr, fq * 8), boff = lds_byte(wc * 32 + fr, fq * 8);
#define PG8_SA(b, h) (((b) * 2 + (h)) * HTB)
#define PG8_SB(b, h) ((4 + (b) * 2 + (h)) * HTB)
#define PG8_STAGE(bufoff, gbase, offs) do { _Pragma("unroll") for (int _i = 0; _i < 2; ++_i) \
        __builtin_amdgcn_global_load_lds((const unsigned*)((gbase) + (offs)[_i]), (LAS unsigned*)(lds + (bufoff) + ldsw + _i * 8192), 16, 0, 0); } while (0)
#define PG8_STA(b, h, tau) PG8_STAGE(PG8_SA(b, h), sA + (size_t)(tau) * kstep, offA[h])
#define PG8_STB(b, h, tau) PG8_STAGE(PG8_SB(b, h), sB + (size_t)(tau) * kstep, offB[h])
#define PG8_LDA(dst, b, h) do { _Pragma("unroll") for (int m = 0; m < 4; ++m) _Pragma("unroll") for (int k = 0; k < 2; ++k) dst[m][k] = *(const LAS bf16x8*)(lds + PG8_SA(b, h) + aoff + m * 2048 + k * 1024); } while (0)
#define PG8_LDB(dst, b, h) do { _Pragma("unroll") for (int n = 0; n < 2; ++n) _Pragma("unroll") for (int k = 0; k < 2; ++k) dst[n][k] = *(const LAS bf16x8*)(lds + PG8_SB(b, h) + boff + n * 2048 + k * 1024); } while (0)
#define PG8_MMA(ai, bj, At, Bt) do { __builtin_amdgcn_s_setprio(1); _Pragma("unroll") for (int m = 0; m < 4; ++m) _Pragma("unroll") for (int n = 0; n < 2; ++n) _Pragma("unroll") for (int k = 0; k < 2; ++k) \
        acc[ai][bj][m][n] = __builtin_amdgcn_mfma_f32_16x16x32_bf16(Bt[n][k], At[m][k], acc[ai][bj][m][n], 0, 0, 0); __builtin_amdgcn_s_setprio(0); } while (0)
#define PG8_WAIT_V(n) asm volatile("s_waitcnt vmcnt(" #n ")" ::: "memory")
#define PG8_WAIT_L(n) asm volatile("s_waitcnt lgkmcnt(" #n ")" ::: "memory")
#define PG8_BAR __builtin_amdgcn_s_barrier()
#define PG8_SCHED __builtin_amdgcn_sched_barrier(0)
    Unit cur, nxt; int ui = 0;
    if (!S.next(0, cur)) return;
    f32x4 acc[2][2][4][2];
#pragma unroll
    for (int a = 0; a < 2; ++a)
#pragma unroll
        for (int b = 0; b < 2; ++b)
#pragma unroll
            for (int m = 0; m < 4; ++m)
#pragma unroll
                for (int n = 0; n < 2; ++n) acc[a][b][m][n] = (f32x4){0.f, 0.f, 0.f, 0.f};
    bf16x8 At[4][2], B0[2][2], B1[2][2];
    const char* sA = P.a_base(cur); const char* sB = P.b_base(cur);
    S.a_ready(cur);
    P.a_offs(cur, sR[0], sC[0], sR[1], sC[1], offA);
    PG8_STB(0, 0, 0); PG8_STB(0, 1, 0); PG8_STA(0, 0, 0); PG8_STA(0, 1, 0);
    if (wr == 1) PG8_BAR;
    PG8_WAIT_V(2); PG8_BAR;
    PG8_STB(1, 0, 1); PG8_STA(1, 0, 1); PG8_STB(1, 1, 1);
    PG8_WAIT_V(6); PG8_BAR;
    for (;;) {
        const bool has_next = S.next(ui + 1, nxt);
        unsigned nOffA[2][2];
        if (Prob::GATHER) { if (has_next) P.a_offs(nxt, sR[0], sC[0], sR[1], sC[1], nOffA); else {
#pragma unroll
            for (int h = 0; h < 2; ++h)
#pragma unroll
                for (int i = 0; i < 2; ++i) nOffA[h][i] = offA[h][i]; } }
        const char* nA = has_next ? P.a_base(nxt) : sA; const char* nB = has_next ? P.b_base(nxt) : sB;
        for (int t = 0; t < nt; t += 2) {
            const bool last = (t == nt - 2);
            if (last && has_next) S.a_ready(nxt);
            PG8_LDB(B0, 0, 0); PG8_LDB(B1, 0, 1); PG8_SCHED; PG8_LDA(At, 0, 0); PG8_STA(1, 1, t + 1);
            PG8_WAIT_V(8); PG8_WAIT_L(0); PG8_BAR; PG8_MMA(0, 0, At, B0); PG8_MMA(0, 1, At, B1); PG8_BAR; PG8_SCHED;
            if (last) {
                sA = nA - (size_t)nt * kstep; sB = nB - (size_t)nt * kstep;
                if (Prob::GATHER) {
#pragma unroll
                    for (int h = 0; h < 2; ++h)
#pragma unroll
                        for (int i = 0; i < 2; ++i) offA[h][i] = nOffA[h][i]; }
            }
            PG8_LDA(At, 0, 1); PG8_STB(0, 0, t + 2); PG8_STB(0, 1, t + 2); PG8_STA(0, 0, t + 2);
            PG8_WAIT_V(8); PG8_WAIT_L(0); PG8_BAR; PG8_MMA(1, 0, At, B0); PG8_MMA(1, 1, At, B1); PG8_BAR; PG8_SCHED;
            PG8_LDB(B0, 1, 0); PG8_LDB(B1, 1, 1); PG8_SCHED; PG8_LDA(At, 1, 0); PG8_STA(0, 1, t + 2);
            PG8_WAIT_V(8); PG8_WAIT_L(0); PG8_BAR; PG8_MMA(0, 0, At, B0); PG8_MMA(0, 1, At, B1); PG8_BAR; PG8_SCHED;
            PG8_LDA(At, 1, 1); PG8_STB(1, 0, t + 3); PG8_STB(1, 1, t + 3); PG8_STA(1, 0, t + 3);
            PG8_WAIT_V(8); PG8_WAIT_L(0); PG8_BAR; PG8_MMA(1, 0, At, B0); PG8_MMA(1, 1, At, B1); PG8_BAR; PG8_SCHED;
        }
        if (wr == 0) PG8_BAR;
        E(acc, cur, wr, wc, fr, fq); S.done(cur);
        if (!has_next) break;
#pragma unroll
        for (int a = 0; a < 2; ++a)
#pragma unroll
            for (int b = 0; b < 2; ++b)
#pragma unroll
                for (int m = 0; m < 4; ++m)
#pragma unroll
                    for (int n = 0; n < 2; ++n) acc[a][b][m][n] = (f32x4){0.f, 0.f, 0.f, 0.f};
        cur = nxt; ++ui; sA = nA; sB = nB;
        if (wr == 1) PG8_BAR;
    }
    PG8_WAIT_V(0);
    PG8_BAR;
#undef PG8_SA
#undef PG8_SB
#undef PG8_STAGE
#undef PG8_STA
#undef PG8_STB
#undef PG8_LDA
#undef PG8_LDB
#undef PG8_MMA
#undef PG8_WAIT_V
#undef PG8_WAIT_L
#undef PG8_BAR
#undef PG8_SCHED
}

template <class Epi, class Sched>
__device__ __forceinline__ void gemm_phase_dual(LAS unsigned char* lds, const bf16* A1, const bf16* Bt1, int K1, const bf16* A2, const bf16* Bt2, int K2, const Sched& S, const Epi& E) {
    const int tid = threadIdx.x, wid = __builtin_amdgcn_readfirstlane(tid >> 6), lane = tid & 63, wr = wid >> 2, wc = wid & 3, fr = lane & 15, fq = lane >> 4;
    const int nt1 = K1 / BK, nt = (K1 + K2) / BK;
    unsigned offB1[2][2], offA1[2][2]; const unsigned dK2 = (unsigned)(2 * (K2 - K1));
#pragma unroll
    for (int i = 0; i < 2; ++i) { int R, C; stage_rc(tid * 16 + i * 8192, R, C); const int Rb = (R & ~31) + perm32(R & 31);
        offA1[0][i] = (unsigned)(R * K1 + C) * 2u; offA1[1][i] = offA1[0][i] + (unsigned)(HALF * K1 * 2); offB1[0][i] = (unsigned)(Rb * K1 + C) * 2u; offB1[1][i] = offB1[0][i] + (unsigned)(HALF * K1 * 2); }
    const size_t kstep = (size_t)(BK * 2);
    const unsigned ldsw = (unsigned)wid * 1024u;
    const int aoff = lds_byte(wr * 64 + fr, fq * 8), boff = lds_byte(wc * 32 + fr, fq * 8);
#define PG8_SA(b, h) (((b) * 2 + (h)) * HTB)
#define PG8_SB(b, h) ((4 + (b) * 2 + (h)) * HTB)
#define PG8_STX(bufoff, tau, g1, g2, o1, o2) do { const int _t = (tau); const bool _s2 = _t >= nt1; const long long _d = _s2 ? (long long)((g2) - (g1)) - (long long)nt1 * (long long)kstep : 0ll; const char* _g = (g1) + (size_t)_t * kstep + _d; \
        _Pragma("unroll") for (int _i = 0; _i < 2; ++_i) { const unsigned _o = (o1)[_i] + (_s2 ? ((o1)[_i] >> 11) * dK2 : 0u); \
        __builtin_amdgcn_global_load_lds((const unsigned*)(_g + _o), (LAS unsigned*)(lds + (bufoff) + ldsw + _i * 8192), 16, 0, 0); } } while (0)
#define PG8_STA(b, h, tau) PG8_STX(PG8_SA(b, h), tau, sA1, sA2, offA1[h], 0)
#define PG8_STB(b, h, tau) PG8_STX(PG8_SB(b, h), tau, sB1, sB2, offB1[h], 0)
#define PG8_LDA(dst, b, h) do { _Pragma("unroll") for (int m = 0; m < 4; ++m) _Pragma("unroll") for (int k = 0; k < 2; ++k) dst[m][k] = *(const LAS bf16x8*)(lds + PG8_SA(b, h) + aoff + m * 2048 + k * 1024); } while (0)
#define PG8_LDB(dst, b, h) do { _Pragma("unroll") for (int n = 0; n < 2; ++n) _Pragma("unroll") for (int k = 0; k < 2; ++k) dst[n][k] = *(const LAS bf16x8*)(lds + PG8_SB(b, h) + boff + n * 2048 + k * 1024); } while (0)
#define PG8_MMA(ai, bj, At, Bt) do { __builtin_amdgcn_s_setprio(1); _Pragma("unroll") for (int m = 0; m < 4; ++m) _Pragma("unroll") for (int n = 0; n < 2; ++n) _Pragma("unroll") for (int k = 0; k < 2; ++k) \
        acc[ai][bj][m][n] = __builtin_amdgcn_mfma_f32_16x16x32_bf16(Bt[n][k], At[m][k], acc[ai][bj][m][n], 0, 0, 0); __builtin_amdgcn_s_setprio(0); } while (0)
#define PG8_WAIT_V(n) asm volatile("s_waitcnt vmcnt(" #n ")" ::: "memory")
#define PG8_WAIT_L(n) asm volatile("s_waitcnt lgkmcnt(" #n ")" ::: "memory")
#define PG8_BAR __builtin_amdgcn_s_barrier()
#define PG8_SCHED __builtin_amdgcn_sched_barrier(0)
    Unit cur, nxt; int ui = 0;
    if (!S.next(0, cur)) return;
    f32x4 acc[2][2][4][2];
#pragma unroll
    for (int a = 0; a < 2; ++a)
#pragma unroll
        for (int b = 0; b < 2; ++b)
#pragma unroll
            for (int m = 0; m < 4; ++m)
#pragma unroll
                for (int n = 0; n < 2; ++n) acc[a][b][m][n] = (f32x4){0.f, 0.f, 0.f, 0.f};
    bf16x8 At[4][2], B0[2][2], B1[2][2];
    const char* sA1 = (const char*)A1 + (size_t)cur.pm * 256 * K1 * 2; const char* sB1 = (const char*)Bt1 + (size_t)cur.pn * 256 * K1 * 2;
    const char* sA2 = (const char*)A2 + (size_t)cur.pm * 256 * K2 * 2; const char* sB2 = (const char*)Bt2 + (size_t)cur.pn * 256 * K2 * 2;
    PG8_STB(0, 0, 0); PG8_STB(0, 1, 0); PG8_STA(0, 0, 0); PG8_STA(0, 1, 0);
    if (wr == 1) PG8_BAR;
    PG8_WAIT_V(2); PG8_BAR;
    PG8_STB(1, 0, 1); PG8_STA(1, 0, 1); PG8_STB(1, 1, 1);
    PG8_WAIT_V(6); PG8_BAR;
    for (;;) {
        const bool has_next = S.next(ui + 1, nxt);
        const int npm = has_next ? nxt.pm : cur.pm, npn = has_next ? nxt.pn : cur.pn;
        const char* nA1 = (const char*)A1 + (size_t)npm * 256 * K1 * 2; const char* nB1 = (const char*)Bt1 + (size_t)npn * 256 * K1 * 2;
        const char* nA2 = (const char*)A2 + (size_t)npm * 256 * K2 * 2; const char* nB2 = (const char*)Bt2 + (size_t)npn * 256 * K2 * 2;
        for (int t = 0; t < nt; t += 2) {
            const bool last = (t == nt - 2);
            const int t2 = last ? 0 : t + 2, t3 = last ? 1 : t + 3;
            if (t == nt1) { E.mid(acc, cur, wr, wc, fr, fq); PG8_SCHED; }
            PG8_LDB(B0, 0, 0); PG8_LDB(B1, 0, 1); PG8_SCHED; PG8_LDA(At, 0, 0); PG8_STA(1, 1, t + 1);
            PG8_WAIT_V(8); PG8_WAIT_L(0); PG8_BAR; PG8_MMA(0, 0, At, B0); PG8_MMA(0, 1, At, B1); PG8_BAR; PG8_SCHED;
            if (last) { sA1 = nA1; sB1 = nB1; sA2 = nA2; sB2 = nB2; }
            PG8_LDA(At, 0, 1); PG8_STB(0, 0, t2); PG8_STB(0, 1, t2); PG8_STA(0, 0, t2);
            PG8_WAIT_V(8); PG8_WAIT_L(0); PG8_BAR; PG8_MMA(1, 0, At, B0); PG8_MMA(1, 1, At, B1); PG8_BAR; PG8_SCHED;
            PG8_LDB(B0, 1, 0); PG8_LDB(B1, 1, 1); PG8_SCHED; PG8_LDA(At, 1, 0); PG8_STA(0, 1, t2);
            PG8_WAIT_V(8); PG8_WAIT_L(0); PG8_BAR; PG8_MMA(0, 0, At, B0); PG8_MMA(0, 1, At, B1); PG8_BAR; PG8_SCHED;
            PG8_LDA(At, 1, 1); PG8_STB(1, 0, t3); PG8_STB(1, 1, t3); PG8_STA(1, 0, t3);
            PG8_WAIT_V(8); PG8_WAIT_L(0); PG8_BAR; PG8_MMA(1, 0, At, B0); PG8_MMA(1, 1, At, B1); PG8_BAR; PG8_SCHED;
        }
        if (wr == 0) PG8_BAR;
        E(acc, cur, wr, wc, fr, fq);
        if (!has_next) break;
#pragma unroll
        for (int a = 0; a < 2; ++a)
#pragma unroll
            for (int b = 0; b < 2; ++b)
#pragma unroll
                for (int m = 0; m < 4; ++m)
#pragma unroll
                    for (int n = 0; n < 2; ++n) acc[a][b][m][n] = (f32x4){0.f, 0.f, 0.f, 0.f};
        cur = nxt; ++ui;
        if (wr == 1) PG8_BAR;
    }
    PG8_WAIT_V(0);
    PG8_BAR;
#undef PG8_SA
#undef PG8_SB
#undef PG8_STX
#undef PG8_STA
#undef PG8_STB
#undef PG8_LDA
#undef PG8_LDB
#undef PG8_MMA
#undef PG8_WAIT_V
#undef PG8_WAIT_L
#undef PG8_BAR
#undef PG8_SCHED
}
__device__ __forceinline__ v4u pack8(f32x4 v0, f32x4 v1) { v4u w; w.x = cvt_pk_bf16(v0[0], v0[1]); w.y = cvt_pk_bf16(v0[2], v0[3]); w.z = cvt_pk_bf16(v1[0], v1[1]); w.w = cvt_pk_bf16(v1[2], v1[3]); return w; }
__device__ __forceinline__ float sigm(float v) { return __builtin_amdgcn_rcpf(1.0f + __expf(-v)); }

struct EpiMergedDual {
    static constexpr bool PERM = true;
    const bf16* ga; const bf16* gb; bf16* merged;
    __device__ __forceinline__ void mid(f32x4 (&acc)[2][2][4][2], const Unit& u, int wr, int wc, int fr, int fq) const {
        int row0 = u.pm * BM + wr * 64 + fr; const int col0 = u.pn * BM + wc * 32 + 8 * fq;
        asm volatile("" : "+v"(row0));
#pragma unroll
        for (int ai = 0; ai < 2; ++ai)
#pragma unroll
            for (int m = 0; m < 4; ++m) { const size_t o = (size_t)(row0 + ai * HALF + m * 16) * 1024 + col0;
#pragma unroll
                for (int bj = 0; bj < 2; ++bj) { const v4u a = *(const v4u*)(ga + o + bj * HALF), b = *(const v4u*)(gb + o + bj * HALF);
                    f32x4 r0 = {bflo(a.x) * __builtin_amdgcn_rcpf(bflo(b.x)), bfhi(a.x) * __builtin_amdgcn_rcpf(bfhi(b.x)), bflo(a.y) * __builtin_amdgcn_rcpf(bflo(b.y)), bfhi(a.y) * __builtin_amdgcn_rcpf(bfhi(b.y))};
                    f32x4 r1 = {bflo(a.z) * __builtin_amdgcn_rcpf(bflo(b.z)), bfhi(a.z) * __builtin_amdgcn_rcpf(bfhi(b.z)), bflo(a.w) * __builtin_amdgcn_rcpf(bflo(b.w)), bfhi(a.w) * __builtin_amdgcn_rcpf(bfhi(b.w))};
                    acc[ai][bj][m][0] = acc[ai][bj][m][0] * r0; acc[ai][bj][m][1] = acc[ai][bj][m][1] * r1; }
                asm volatile("" ::: "memory"); }
    }
    __device__ __forceinline__ void operator()(const f32x4 (&acc)[2][2][4][2], const Unit& u, int wr, int wc, int fr, int fq) const {
        int row0 = u.pm * BM + wr * 64 + fr; const int col0 = u.pn * BM + wc * 32 + 8 * fq;
        asm volatile("" : "+v"(row0));
#pragma unroll
        for (int ai = 0; ai < 2; ++ai)
#pragma unroll
            for (int m = 0; m < 4; ++m) { const size_t o = (size_t)(row0 + ai * HALF + m * 16) * 1024 + col0;
#pragma unroll
                for (int bj = 0; bj < 2; ++bj) { const v4u g = *(const v4u*)(gb + o + bj * HALF);
                    f32x4 g0 = {bflo(g.x), bfhi(g.x), bflo(g.y), bfhi(g.y)}, g1 = {bflo(g.z), bfhi(g.z), bflo(g.w), bfhi(g.w)};
                    *(v4u*)(merged + o + bj * HALF) = pack8(g0 * acc[ai][bj][m][0], g1 * acc[ai][bj][m][1]); } }
    }
};
struct EpiProj {
    static constexpr bool PERM = true;
    unsigned char* ws;
    __device__ __forceinline__ void operator()(const f32x4 (&acc)[2][2][4][2], const Unit& u, int wr, int wc, int fr, int fq) const {
        const int row0 = u.pm * BM + wr * 64 + fr, cw = wc * 32 + 8 * fq, pn = u.pn;
        if (pn == 4) {
#pragma unroll
            for (int ai = 0; ai < 2; ++ai)
#pragma unroll
                for (int m = 0; m < 4; ++m) { const size_t row = (size_t)(row0 + ai * HALF + m * 16);
                    float* cr = (float*)(ws + WS_CKVRAW) + row * 128 + cw; *(f32x4*)cr = acc[ai][0][m][0]; *(f32x4*)(cr + 4) = acc[ai][0][m][1];
                    if (cw < 64) *(v4u*)((bf16*)(ws + WS_KIDX) + ((((row >> 4) * 8 + (cw >> 3)) * 16 + (row & 15)) << 3)) = pack8(acc[ai][1][m][0], acc[ai][1][m][1]);
                    else if (cw == 64) { float* wr_ = (float*)(ws + WS_WIDX) + row * 8; *(f32x4*)wr_ = acc[ai][1][m][0] * IDXW_SCALE; *(f32x4*)(wr_ + 4) = acc[ai][1][m][1] * IDXW_SCALE; } }
            return;
        }
        bf16* base; int ld, c0; float sc = 1.f; bool sg = false;
        if (pn < 4) { base = (bf16*)(ws + WS_QLAT); ld = 1024; c0 = pn * 256; sc = ATT_SCALE; }
        else if (pn < 7) { base = (bf16*)(ws + WS_QIDX); ld = 512; c0 = (pn - 5) * 256; }
        else if (pn < 9) { base = (bf16*)(ws + WS_QB); ld = 512; c0 = (pn - 7) * 256; sc = 0.125f; }
        else if (pn == 9) { base = (bf16*)(ws + WS_KB); ld = 128; c0 = 0; }
        else if (pn < 14) { base = (bf16*)(ws + WS_GA); ld = 1024; c0 = (pn - 10) * 256; sg = true; }
        else { base = (bf16*)(ws + WS_GB); ld = 1024; c0 = (pn - 14) * 256; sg = true; }
        const size_t bjstep = (pn == 9) ? (size_t)(WS_VB - WS_KB) / 2 : (size_t)HALF;
#pragma unroll
        for (int ai = 0; ai < 2; ++ai)
#pragma unroll
            for (int m = 0; m < 4; ++m) { bf16* rowp = base + (size_t)(row0 + ai * HALF + m * 16) * ld + c0 + cw;
#pragma unroll
                for (int bj = 0; bj < 2; ++bj) { f32x4 v0 = acc[ai][bj][m][0], v1 = acc[ai][bj][m][1];
                    if (sg) {
#pragma unroll
                        for (int j = 0; j < 4; ++j) { v0[j] = sigm(v0[j]); v1[j] = sigm(v1[j]); } }
                    else { v0 = v0 * sc; v1 = v1 * sc; }
                    *(v4u*)(rowp + bj * bjstep) = pack8(v0, v1); } }
    }
};
struct EpiWoutM {
    static constexpr bool PERM = true;
    const float* x; bf16* h1b;
    __device__ __forceinline__ void operator()(const f32x4 (&acc)[2][2][4][2], const Unit& u, int wr, int wc, int fr, int fq) const {
        const int row0 = u.pm * BM + wr * 64 + fr, col0 = u.pn * BM + wc * 32 + 8 * fq;
#pragma unroll
        for (int ai = 0; ai < 2; ++ai)
#pragma unroll
            for (int m = 0; m < 4; ++m) { const size_t o = (size_t)(row0 + ai * HALF + m * 16) * 1024 + col0;
#pragma unroll
                for (int bj = 0; bj < 2; ++bj) { const f32x4 x0 = *(const f32x4*)(x + o + bj * HALF), x1 = *(const f32x4*)(x + o + bj * HALF + 4);
                    *(v4u*)(h1b + o + bj * HALF) = pack8(x0 * ALPHA + acc[ai][bj][m][0], x1 * ALPHA + acc[ai][bj][m][1]); } }
    }
};
constexpr int MOE_TB_OFF = 131072 + 1024;
constexpr int CW_RDY = 16384;
constexpr int CW_TMO = 8;
struct MoeOrder {
    const LAS int* tb; int npn, G, c; unsigned* ctl;
    __device__ bool next(int i, Unit& u) const {
        const int L = i * G + c; if (L >= tb[32] * npn) return false;
        const int rt = L / npn, pn = L - rt * npn; int e = 0;
        for (int j = 1; j < 32; ++j) e = (tb[j] <= rt) ? j : e;
        u.pm = rt; u.pn = pn; u.pb = e * npn + pn; u.aux = e; return true;
    }
    __device__ __forceinline__ void a_ready(const Unit&) const {}
    __device__ __forceinline__ void done(const Unit& u) const {
        asm volatile("s_waitcnt vmcnt(0)" ::: "memory");
        if ((threadIdx.x & 63) == 0) __hip_atomic_fetch_add(ctl + CW_RDY + 64 * u.pm, 1u, __ATOMIC_RELAXED, __HIP_MEMORY_SCOPE_AGENT);
    }
};
struct MoeDownOrder {
    const LAS int* tb; int G, c; unsigned* ctl;
    __device__ bool next(int i, Unit& u) const {
        const int nT = tb[32], nD = 4 * nT; int R = 2 * nT - G; R = R < 0 ? 0 : (R > G ? G : R);
        int L;
        if (c >= R) { L = (i < 4) ? i * (G - R) + (c - R) : 4 * (G - R) + (i - 4) * G + c; }
        else { L = 4 * (G - R) + i * G + c; }
        if (L >= nD) return false;
        const int rt = L >> 2, pn = L & 3; int e = 0;
        for (int j = 1; j < 32; ++j) e = (tb[j] <= rt) ? j : e;
        u.pm = rt; u.pn = pn; u.pb = e * 4 + pn; u.aux = e; return true;
    }
    __device__ __forceinline__ void a_ready(const Unit& u) const {
        if (threadIdx.x < 64) {
            unsigned* w = ctl + CW_RDY + 64 * u.pm; unsigned sp = 0;
            while ((unsigned)__builtin_amdgcn_readfirstlane(__hip_atomic_load(w, __ATOMIC_RELAXED, __HIP_MEMORY_SCOPE_AGENT)) < 16u) {
                __builtin_amdgcn_s_sleep(2);
                if ((++sp & 1023u) == 0u) { if (__hip_atomic_load(ctl + CW_TMO, __ATOMIC_RELAXED, __HIP_MEMORY_SCOPE_AGENT) != 0u) break;
                    if (sp > (1u << 22)) { __hip_atomic_store(ctl + CW_TMO, 1u, __ATOMIC_RELAXED, __HIP_MEMORY_SCOPE_AGENT); break; } } }
            __builtin_amdgcn_fence(__ATOMIC_ACQUIRE, "agent");
            asm volatile("s_waitcnt vmcnt(0)" ::: "memory");
        }
        asm volatile("" ::: "memory"); __builtin_amdgcn_s_barrier(); asm volatile("" ::: "memory");
    }
    __device__ __forceinline__ void done(const Unit&) const {}
};
struct GatherProb {
    static constexpr bool GATHER = true;
    const bf16* A; const bf16* Bt; int K; const LAS int* tb; const unsigned* list;
    __device__ __forceinline__ const char* a_base(const Unit&) const { return (const char*)A; }
    __device__ __forceinline__ const char* b_base(const Unit& u) const { return (const char*)Bt + (size_t)u.pb * 256 * K * 2; }
    __device__ __forceinline__ void a_offs(const Unit& u, int R0, int C0, int R1, int C1, unsigned (&o)[2][2]) const {
        const int e = u.aux, lbase = (u.pm - tb[e]) * 256, cnt = tb[64 + e];
        const unsigned* le = list + (size_t)e * 32768;
#pragma unroll
        for (int h = 0; h < 2; ++h) { const int l0 = lbase + h * HALF + R0, l1 = lbase + h * HALF + R1;
            const unsigned t0 = l0 < cnt ? (le[l0] >> 1) : 0u, t1 = l1 < cnt ? (le[l1] >> 1) : 0u;
            o[h][0] = (t0 * (unsigned)K + (unsigned)C0) * 2u; o[h][1] = (t1 * (unsigned)K + (unsigned)C1) * 2u; }
    }
};
struct EpiGU {
    static constexpr bool PERM = true;
    bf16* hbuf;
    __device__ __forceinline__ void operator()(const f32x4 (&acc)[2][2][4][2], const Unit& u, int wr, int wc, int fr, int fq) const {
        const int row0 = u.pm * BM + wr * 64 + fr, col0 = u.pn * HALF + wc * 32 + 8 * fq;
#pragma unroll
        for (int ai = 0; ai < 2; ++ai)
#pragma unroll
            for (int m = 0; m < 4; ++m) { f32x4 h0, h1;
#pragma unroll
                for (int j = 0; j < 4; ++j) { const float g0 = acc[ai][0][m][0][j], g1 = acc[ai][0][m][1][j];
                    h0[j] = g0 * sigm(g0) * acc[ai][1][m][0][j]; h1[j] = g1 * sigm(g1) * acc[ai][1][m][1][j]; }
                { const v4u hv = pack8(h0, h1); bf16* hp = hbuf + (size_t)(row0 + ai * HALF + m * 16) * 256 + col0;
                  asm volatile("global_store_dwordx4 %0, %1, off sc1\n\ts_nop 1" :: "v"(hp), "v"(hv) : "memory"); } }
    }
};
struct EpiDown {
    static constexpr bool PERM = true;
    bf16* slot; const LAS int* tb; const unsigned* list; const float* pw;
    __device__ __forceinline__ void operator()(const f32x4 (&acc)[2][2][4][2], const Unit& u, int wr, int wc, int fr, int fq) const {
        const int e = u.aux, lbase = (u.pm - tb[e]) * 256 + wr * 64 + fr, cnt = tb[64 + e], col0 = u.pn * BM + wc * 32 + 8 * fq;
        const unsigned* le = list + (size_t)e * 32768;
#pragma unroll
        for (int ai = 0; ai < 2; ++ai)
#pragma unroll
            for (int m = 0; m < 4; ++m) { const int l = lbase + ai * HALF + m * 16;
                if (l < cnt) { const unsigned pair = le[l]; const float w = pw[pair]; bf16* rowp = slot + (size_t)pair * 1024 + col0;
#pragma unroll
                    for (int bj = 0; bj < 2; ++bj) *(v4u*)(rowp + bj * HALF) = pack8(acc[ai][bj][m][0] * w, acc[ai][bj][m][1] * w); } }
    }
};
}

struct Args { const float* in[20]; float* out; unsigned char* ws; int ph_lo, ph_hi; };
__global__ void __launch_bounds__(NTHR, 2) fwd_kernel(Args args) {
    extern __shared__ __attribute__((aligned(16))) unsigned char lds_raw[];
    Ctx c;
    c.lds = (LAS unsigned char*)lds_raw;
    c.tid = threadIdx.x; c.lane = c.tid & 63; c.wave = __builtin_amdgcn_readfirstlane(c.tid >> 6); c.bid = blockIdx.x; c.G = gridDim.x;
    c.x = args.in[0]; c.w_in = args.in[1]; c.kv_g = args.in[2]; c.w_uv = args.in[3]; c.w_a = args.in[4]; c.sinks = args.in[5]; c.w_b = args.in[6]; c.w_out = args.in[7]; c.rel_bias = args.in[8];
    c.ln1_g = args.in[9]; c.ln1_b = args.in[10]; c.w_group = args.in[11]; c.b_group = args.in[12]; c.w_router = args.in[13]; c.b_router = args.in[14]; c.w_gate = args.in[15]; c.w_up = args.in[16]; c.w_down = args.in[17];
    c.ln2_g = args.in[18]; c.ln2_b = args.in[19]; c.out = args.out; c.ws = args.ws; unsigned char* ws = args.ws;
    c.ctl = (unsigned*)(ws + WS_CTL);
    volatile LAS unsigned* MISC = (volatile LAS unsigned*)(c.lds + MISC_OFF);
    if (c.tid < 32) MISC[c.tid] = 0u;
    __syncthreads();
    XcdBarrier bar; bar.bar = c.ctl + CW_BAR; bar.x = 0; bar.st = nullptr;
    if (MK_N_LAUNCHES == 1) bar = xcd_barrier_post(c.ctl + CW_BAR, MISC + 8);
    const int lo = args.ph_lo, hi = args.ph_hi;
#define IN(k) (lo <= (k) && (k) < hi)
#define SEAM(k) do { if (IN(k) && IN((k) + 1)) xcd_barrier(bar); } while (0)
    bf16* merged = ((bf16*)(c.ws + WS_QLAT)); bf16* x1b = ((bf16*)(c.ws + WS_XB));

    if (IN(0)) { p0_prologue(c); } SEAM(0);
    if (IN(1)) { pg8::DenseProb P{(const bf16*)(c.ws + WS_XB), (const bf16*)(c.ws + WS_WIN), 1024}; pg8::StaticOrder S; S.init(NTOK, NPROJ, c.G, c.bid); pg8::EpiProj E{c.ws};
        pg8::gemm_phase(c.lds, P, S, E); } SEAM(1);
    if (IN(2)) { p_rmsnorm(c); __syncthreads(); p2_indexer_topk(c); } SEAM(2);
    if (IN(3)) { p3a_dsa(c); p3b_swa(c); } SEAM(3);
    if (IN(4)) { pg8::StaticOrder S; S.init(NTOK, 1024, c.G, c.bid); pg8::EpiMergedDual E{(const bf16*)(c.ws + WS_GA), (const bf16*)(c.ws + WS_GB), merged};
        pg8::gemm_phase_dual(c.lds, (const bf16*)(c.ws + WS_XB), (const bf16*)(c.ws + WS_WC), 1024, (const bf16*)(c.ws + WS_QB), (const bf16*)(c.ws + WS_WB), 512, S, E); } SEAM(4);
    if (IN(5)) { pg8::DenseProb P{(const bf16*)merged, (const bf16*)(c.ws + WS_WO), 1024}; pg8::StaticOrder S; S.init(NTOK, 1024, c.G, c.bid); pg8::EpiWoutM E{c.x, (bf16*)(c.ws + WS_H1B)};
        pg8::gemm_phase(c.lds, P, S, E); } SEAM(5);
    if (IN(6)) { p6_ln_router(c, x1b); } SEAM(6);
    LAS int* tb = (LAS int*)(c.lds + pg8::MOE_TB_OFF);
    if (IN(7) || IN(8)) {
        if (c.tid < 32) tb[64 + c.tid] = (int)__hip_atomic_load(c.ctl + CW_CNT + c.tid, __ATOMIC_RELAXED, __HIP_MEMORY_SCOPE_AGENT);
        __syncthreads();
        if (c.tid == 0) { int a = 0; for (int e = 0; e < 32; ++e) { tb[e] = a; a += (tb[64 + e] + 255) >> 8; } tb[32] = a; }
        __syncthreads();
    }
    if (IN(7)) { pg8::GatherProb P{(const bf16*)x1b, (const bf16*)(c.ws + WS_WGU), 1024, tb, (const unsigned*)(c.ws + WS_LIST)}; pg8::MoeOrder S{tb, 2, c.G, c.bid, c.ctl}; pg8::EpiGU E{(bf16*)(c.ws + WS_QLAT)};
        pg8::gemm_phase(c.lds, P, S, E); }
    if (MK_N_LAUNCHES != 1) SEAM(7);
    if (IN(8)) { pg8::DenseProb P{(const bf16*)(c.ws + WS_QLAT), (const bf16*)(c.ws + WS_WD), 256}; pg8::MoeDownOrder S{tb, c.G, c.bid, c.ctl};
        pg8::EpiDown E{(bf16*)(c.ws + WS_SLOT), tb, (const unsigned*)(c.ws + WS_LIST), (const float*)(c.ws + WS_PW)};
        pg8::gemm_phase(c.lds, P, S, E); } SEAM(8);
    if (IN(9)) { p9_ln2(c); }
#undef IN
#undef SEAM
}

extern "C" void kernel_launch(void* const* d_in, const int* in_sizes, int n_in, void* d_out, int out_size, void* d_ws, size_t ws_size, hipStream_t stream) {
    static int grid = 0;
    if (grid == 0) {
        if (n_in != 20 || out_size != NTOK * D || ws_size < WS_END) { fprintf(stderr, "kernel_launch: unexpected shapes (n_in %d out %d ws %zu)\n", n_in, out_size, ws_size); grid = -1; return; }
        int dev = 0, cus = 0, per_cu = 0;
        if (hipGetDevice(&dev) != hipSuccess || hipDeviceGetAttribute(&cus, hipDeviceAttributeMultiprocessorCount, dev) != hipSuccess) { grid = -1; return; }
        if (hipFuncSetAttribute((const void*)fwd_kernel, hipFuncAttributeMaxDynamicSharedMemorySize, LDS_BYTES) != hipSuccess) { fprintf(stderr, "kernel_launch: hipFuncSetAttribute failed\n"); grid = -1; return; }
        if (hipOccupancyMaxActiveBlocksPerMultiprocessor(&per_cu, (const void*)fwd_kernel, NTHR, LDS_BYTES) != hipSuccess || per_cu < 1) { fprintf(stderr, "kernel_launch: occupancy query says %d\n", per_cu); }
        (void)hipGetLastError();
        grid = cus;
    }
    if (grid < 0) return;
    if (hipMemsetAsync((char*)d_ws + WS_CTL, 0, CTL_ZERO_BYTES, stream) != hipSuccess) return;
    Args a{};
    for (int i = 0; i < 20; ++i) a.in[i] = (const float*)d_in[i];
    a.out = (float*)d_out; a.ws = (unsigned char*)d_ws;
    if (MK_N_LAUNCHES == 1) { a.ph_lo = 0; a.ph_hi = NPHASE; hipLaunchKernelGGL(fwd_kernel, dim3(grid), dim3(NTHR), LDS_BYTES, stream, a); }
    else { for (int p = 0; p < NPHASE; ++p) { a.ph_lo = p; a.ph_hi = p + 1; hipLaunchKernelGGL(fwd_kernel, dim3(grid), dim3(NTHR), LDS_BYTES, stream, a); } }
}
```

```cpp
#include <hip/hip_runtime.h>
#include <cstdio>
#include <cstdint>

#ifndef MK_N_LAUNCHES
#define MK_N_LAUNCHES 1
#endif

constexpr int D = 1024, BATCH = 8, SEQ = 2048, NTOK = BATCH * SEQ;
constexpr int A_HEADS = 8, A_LAT = 128, IDX_HEADS = 8, IDX_DIM = 64, KSEL = 256;
constexpr int B_HEADS = 8, B_HD = 64, WINDOW = 128;
constexpr int NEXP = 32, EPG = 8, NGRP = 4, DEXP = 256;
constexpr int IN_WIDTH = 4552, NPROJ = 4608;
constexpr float ALPHA = 1.189207115002721f;
constexpr float LN_EPS = 1e-5f, RMS_EPS = 1e-6f;
constexpr float ATT_SCALE = 0.08838834764831845f;
constexpr float IDXW_SCALE = 0.125f * 0.35355339059327373f;
constexpr int NPHASE = 10;

constexpr size_t MiB = 1u << 20;
constexpr size_t WS_CTL = 0, CTL_ZERO_BYTES = 128 * 1024;
constexpr size_t WS_WIN = 1 * MiB;
constexpr size_t WS_SEL = 1 * MiB;
constexpr size_t WS_WC = 10 * MiB;
constexpr size_t WS_WB = 12 * MiB;
constexpr size_t WS_WO = 13 * MiB;
constexpr size_t WS_WIDX = 15 * MiB;
constexpr size_t WS_BIAS = 16 * MiB;
constexpr size_t WS_PE = 16 * MiB + 64 * 1024;
constexpr size_t WS_PW = 16 * MiB + 256 * 1024;
constexpr size_t WS_WGU = 17 * MiB;
constexpr size_t WS_WD = 49 * MiB;
constexpr size_t WS_XB = 65 * MiB;
constexpr size_t WS_QLAT = 97 * MiB;
constexpr size_t WS_CKV = 129 * MiB;
constexpr size_t WS_KIDX = 133 * MiB;
constexpr size_t WS_QIDX = 135 * MiB;
constexpr size_t WS_QB = 151 * MiB;
constexpr size_t WS_KB = 167 * MiB;
constexpr size_t WS_VB = 171 * MiB;
constexpr size_t WS_GA = 175 * MiB;
constexpr size_t WS_GB = 207 * MiB;
constexpr size_t WS_H1B = WS_GB;
constexpr size_t WS_CKVRAW = 239 * MiB;
constexpr size_t WS_LIST = 247 * MiB;
constexpr size_t WS_SLOT = 129 * MiB;
constexpr size_t WS_END = 252 * MiB;
constexpr int CW_CNT = 64;
constexpr int CW_BAR = 4096;

constexpr int NWAVES = 8, NTHR = 512;
constexpr int LDS_BYTES = 155648;
constexpr int MISC_OFF = 131072 + 320;

#define GAS __attribute__((address_space(1)))
#define LAS __attribute__((address_space(3)))
typedef unsigned short bf16;
typedef unsigned v4u __attribute__((ext_vector_type(4)));
typedef unsigned v2u __attribute__((ext_vector_type(2)));
typedef float f32x4 __attribute__((ext_vector_type(4)));

__device__ __forceinline__ float bf2f(unsigned v) { return __builtin_bit_cast(float, v << 16); }
__device__ __forceinline__ float bflo(unsigned v) { return __builtin_bit_cast(float, v << 16); }
__device__ __forceinline__ float bfhi(unsigned v) { return __builtin_bit_cast(float, v & 0xffff0000u); }
__device__ __forceinline__ unsigned f2bf(float f) { unsigned u = __builtin_bit_cast(unsigned, f); return (u + 0x7fffu + ((u >> 16) & 1u)) >> 16; }
__device__ __forceinline__ unsigned cvt_pk(float lo, float hi) { unsigned r; asm volatile("v_cvt_pk_bf16_f32 %0, %1, %2" : "=v"(r) : "v"(lo), "v"(hi)); return r; }
__device__ __forceinline__ unsigned pk2(float lo, float hi) { return f2bf(lo) | (f2bf(hi) << 16); }
__device__ __forceinline__ float wave_sum(float v) {
#pragma unroll
    for (int o = 1; o < 64; o <<= 1) v += __shfl_xor(v, o);
    return v;
}
__device__ __forceinline__ float wave_max(float v) {
#pragma unroll
    for (int o = 1; o < 64; o <<= 1) v = fmaxf(v, __shfl_xor(v, o));
    return v;
}

typedef unsigned u2v __attribute__((ext_vector_type(2)));
#define DPP_I(v, ctrl) __builtin_amdgcn_update_dpp(0, (v), (ctrl), 0xf, 0xf, true)
#define DPP_F(v, ctrl) __builtin_bit_cast(float, __builtin_amdgcn_update_dpp(0, __builtin_bit_cast(int, (v)), (ctrl), 0xf, 0xf, true))
__device__ __forceinline__ void swap16(unsigned a, unsigned& x, unsigned& y) { auto r = __builtin_amdgcn_permlane16_swap(a, a, false, false); x = r[0]; y = r[1]; }
__device__ __forceinline__ void swap32(unsigned a, unsigned& x, unsigned& y) { auto r = __builtin_amdgcn_permlane32_swap(a, a, false, false); x = r[0]; y = r[1]; }
__device__ __forceinline__ float x16_sum(float v) { unsigned x, y; swap16(__builtin_bit_cast(unsigned, v), x, y); return __builtin_bit_cast(float, x) + __builtin_bit_cast(float, y); }
__device__ __forceinline__ float x16_max(float v) { unsigned x, y; swap16(__builtin_bit_cast(unsigned, v), x, y); return fmaxf(__builtin_bit_cast(float, x), __builtin_bit_cast(float, y)); }
__device__ __forceinline__ float x16_min(float v) { unsigned x, y; swap16(__builtin_bit_cast(unsigned, v), x, y); return fminf(__builtin_bit_cast(float, x), __builtin_bit_cast(float, y)); }
__device__ __forceinline__ int x16_sumi(int v) { unsigned x, y; swap16((unsigned)v, x, y); return (int)(x + y); }
__device__ __forceinline__ float x32_sum(float v) { unsigned x, y; swap32(__builtin_bit_cast(unsigned, v), x, y); return __builtin_bit_cast(float, x) + __builtin_bit_cast(float, y); }
__device__ __forceinline__ float x32_max(float v) { unsigned x, y; swap32(__builtin_bit_cast(unsigned, v), x, y); return fmaxf(__builtin_bit_cast(float, x), __builtin_bit_cast(float, y)); }

#define XB_TMO      128
#define XB_XCNT(j)  (256  + 64 * (j))
#define XB_XSUB(j)  (1280 + 64 * (j))
#define XB_XGEN(j)  (2304 + 64 * (j))
#define XB_TOP      3328
#define XB_TOPGEN   3392
#define XCD_BAR_WORDS 3456
#define XB_SPIN_CAP (1u << 22)

__device__ __forceinline__ unsigned xb_ld(unsigned* p)              { return __hip_atomic_load(p, __ATOMIC_RELAXED, __HIP_MEMORY_SCOPE_AGENT); }
__device__ __forceinline__ unsigned xb_add(unsigned* p, unsigned v) { return __hip_atomic_fetch_add(p, v, __ATOMIC_RELAXED, __HIP_MEMORY_SCOPE_AGENT); }
__device__ __forceinline__ unsigned xb_xcc_id() { return (unsigned)__builtin_amdgcn_s_getreg((3 << 11) | 20) & 0xFu; }
#define XB_SPIN(cond, bar) do { unsigned _sp = 0; while (cond) { __builtin_amdgcn_s_sleep(1); \
    if ((++_sp & 255u) == 0u) { if (xb_ld(&(bar)[XB_TMO])) break; if (_sp > XB_SPIN_CAP) { atomicAdd(&(bar)[XB_TMO], 1u); break; } } } } while (0)

struct XcdBarrier { unsigned* bar; unsigned x; volatile LAS unsigned* st; };

__device__ __forceinline__ XcdBarrier xcd_barrier_post(unsigned* bar, volatile LAS unsigned* st) {
    XcdBarrier b; b.bar = bar; b.x = xb_xcc_id(); b.st = st;
    if (threadIdx.x == 0) (void)xb_add(&bar[XB_XCNT(b.x)], 1u);
    return b;
}
__device__ __forceinline__ void xcd_barrier_complete(unsigned* bar, unsigned x, unsigned& nloc, unsigned& nx) {
    const unsigned G = gridDim.x * gridDim.y * gridDim.z;
    unsigned sum, cnt, mine, sp = 0u;
    for (;;) {
        sum = 0u; cnt = 0u; mine = 0u;
#pragma unroll
        for (unsigned j = 0; j < 16; ++j) { const unsigned c = xb_ld(&bar[XB_XCNT(j)]); sum += c; cnt += (c > 0u) ? 1u : 0u; mine = (j == x) ? c : mine; }
        if (sum == G) break;
        __builtin_amdgcn_s_sleep(1);
        if ((++sp & 255u) == 0u) { if (xb_ld(&bar[XB_TMO])) break; if (sp > XB_SPIN_CAP) { atomicAdd(&bar[XB_TMO], 1u); break; } }
    }
    nloc = mine > 0u ? mine : 1u; nx = cnt > 0u ? cnt : 1u;
}
__device__ __forceinline__ void xcd_barrier(const XcdBarrier& b) {
    asm volatile("s_waitcnt vmcnt(0)" ::: "memory");
    __syncthreads();
    if (threadIdx.x == 0) {
        unsigned* bar = b.bar;
        __builtin_amdgcn_s_waitcnt(0);
        unsigned nloc = b.st[0], nx = b.st[1];
        if (nloc == 0u) { xcd_barrier_complete(bar, b.x, nloc, nx); b.st[0] = nloc; b.st[1] = nx; }
        const unsigned old = xb_add(&bar[XB_XSUB(b.x)], 1u);
        const unsigned gen = old / nloc;
        if (old + 1u == (gen + 1u) * nloc) {
            __builtin_amdgcn_fence(__ATOMIC_RELEASE, "agent");
            asm volatile("s_waitcnt vmcnt(0)" ::: "memory");
            const unsigned og = xb_add(&bar[XB_TOP], 1u);
            const unsigned tg = og / nx;
            if (og + 1u == (tg + 1u) * nx) xb_add(&bar[XB_TOPGEN], 1u);
            else XB_SPIN(xb_ld(&bar[XB_TOPGEN]) == tg, bar);
            __builtin_amdgcn_fence(__ATOMIC_ACQUIRE, "agent");
            xb_add(&bar[XB_XGEN(b.x)], 1u);
            asm volatile("s_waitcnt vmcnt(0)" ::: "memory");
        } else {
            XB_SPIN(xb_ld(&bar[XB_XGEN(b.x)]) == gen, bar);
            __builtin_amdgcn_fence(__ATOMIC_ACQUIRE, "agent");
            asm volatile("s_waitcnt vmcnt(0)" ::: "memory");
        }
    }
    __syncthreads();
}

struct Ctx {
    const float *x, *w_in, *kv_g, *w_uv, *w_a, *sinks, *w_b, *w_out, *rel_bias, *ln1_g, *ln1_b, *w_group, *b_group, *w_router, *b_router, *w_gate, *w_up, *w_down, *ln2_g, *ln2_b;
    float* out;
    unsigned char* ws;
    unsigned* ctl;
    __device__ __forceinline__ bf16* P(size_t off) const { return (bf16*)(ws + off); }
    LAS unsigned char* lds;
    int tid, lane, wave, bid, G;
};

__device__ __forceinline__ int proj_src_col(int j) {
    if (j < 1024) return j;
    if (j < 1152) return j;
    if (j < 1216) return 1664 + (j - 1152);
    if (j < 1224) return 1728 + (j - 1216);
    if (j < 1280) return -1;
    if (j < 1792) return 1152 + (j - 1280);
    if (j < 2304) return 1736 + (j - 1792);
    if (j < 2432) return 2248 + (j - 2304);
    if (j < 2560) return 2376 + (j - 2432);
    if (j < 3584) return 2504 + (j - 2560);
    return 3528 + (j - 3584);
}
__device__ __forceinline__ float sigmoidf_(float v) { return 1.0f / (1.0f + __expf(-v)); }

template <class Src> __device__ __forceinline__ void titem_load(const Ctx& c, const Src& src, int k0, int n0, f32x4 (&tv)[8]) {
    const int kr = c.lane >> 3, n4 = (c.lane & 7) * 4;
#pragma unroll
    for (int i = 0; i < 8; ++i) tv[i] = src.v4(k0 + 8 * i + kr, n0 + n4);
}
__device__ __forceinline__ void titem_finish(const Ctx& c, LAS float* scr, const f32x4 (&tv)[8], bf16* dst, int dstK, int k0, int n0) {
    const int lane = c.lane, kr = lane >> 3, n4 = (lane & 7) * 4;
#pragma unroll
    for (int i = 0; i < 8; ++i) { LAS float* d = scr + (8 * i + kr) * 33 + n4; d[0] = tv[i].x; d[1] = tv[i].y; d[2] = tv[i].z; d[3] = tv[i].w; }
    asm volatile("s_waitcnt lgkmcnt(0)" ::: "memory");
    const int cc = lane & 7;
#pragma unroll
    for (int j = 0; j < 4; ++j) { const int n = (lane >> 3) + 8 * j; const LAS float* q = scr + (8 * cc) * 33 + n;
        v4u o; o.x = pk2(q[0 * 33], q[1 * 33]); o.y = pk2(q[2 * 33], q[3 * 33]); o.z = pk2(q[4 * 33], q[5 * 33]); o.w = pk2(q[6 * 33], q[7 * 33]);
        *(v4u*)(dst + (size_t)(n0 + n) * dstK + k0 + 8 * cc) = o; }
    asm volatile("s_waitcnt lgkmcnt(0)" ::: "memory");
}
template <class Src> __device__ __forceinline__ void transpose_item(const Ctx& c, LAS float* scr, const Src& src, bf16* dst, int dstK, int k0, int n0) {
    f32x4 tv[8]; titem_load(c, src, k0, n0, tv); titem_finish(c, scr, tv, dst, dstK, k0, n0);
}
struct SrcWin { const float* w; __device__ __forceinline__ f32x4 v4(int k, int n) const { const int s = proj_src_col(n); return s < 0 ? (f32x4){0.f, 0.f, 0.f, 0.f} : *(const f32x4*)(w + (size_t)k * IN_WIDTH + s); } };
struct SrcPlain { const float* w; int N; __device__ __forceinline__ f32x4 v4(int k, int n) const { return *(const f32x4*)(w + (size_t)k * N + n); } };
struct SrcShift { const float* w; int N; int shift; __device__ __forceinline__ f32x4 v4(int k, int n) const { return *(const f32x4*)(w + (size_t)k * N + n + shift); } };

__device__ __forceinline__ float t5_bias_bucket(int dist) {
    if (dist < 16) return (float)dist;
    int b = 16 + (int)(logf((float)dist / 16.0f) / logf(8.0f) * 16.0f);
    return (float)(b < 31 ? b : 31);
}
constexpr int P0_EXPERT_ITEMS = 32 * 256 + 32 * 128;
__device__ __forceinline__ void p0_expert_item(const Ctx& c, LAS float* scr, int r) {
    constexpr int I_GU = 32 * 256;
    if (r < I_GU) { const int e = r / 256, q = r % 256, n0 = (q / 16) * 32, half = (n0 >> 7) & 1, col0 = (n0 >> 8) * 128 + (n0 & 127);
        if (half) { SrcShift s_{c.w_up + (size_t)e * 1024 * 256, DEXP, col0 - n0}; transpose_item(c, scr, s_, (bf16*)(c.ws + WS_WGU) + (size_t)e * 512 * 1024, 1024, (q % 16) * 64, n0); }
        else { SrcShift s_{c.w_gate + (size_t)e * 1024 * 256, DEXP, col0 - n0}; transpose_item(c, scr, s_, (bf16*)(c.ws + WS_WGU) + (size_t)e * 512 * 1024, 1024, (q % 16) * 64, n0); }
        return; }
    r -= I_GU;
    { const int e = r / 128, q = r % 128; SrcPlain s_{c.w_down + (size_t)e * 256 * 1024, 1024};
        transpose_item(c, scr, s_, (bf16*)(c.ws + WS_WD) + (size_t)e * 1024 * 256, 256, (q % 4) * 64, (q / 4) * 32); }
}
__device__ __forceinline__ void ex_item_load(const Ctx& c, int r, f32x4 (&tv)[8]) {
    constexpr int I_GU = 32 * 256;
    const float* base; int ld;
    if (r < I_GU) { const int e = r / 256, q = r % 256, n0 = (q / 16) * 32, half = (n0 >> 7) & 1, col0 = (n0 >> 8) * 128 + (n0 & 127);
        base = (half ? c.w_up : c.w_gate) + (size_t)e * 1024 * 256 + (size_t)((q % 16) * 64) * DEXP + col0; ld = DEXP; }
    else { r -= I_GU; const int e = r / 128, q = r % 128; base = c.w_down + (size_t)e * 256 * 1024 + (size_t)((q % 4) * 64) * 1024 + (q / 4) * 32; ld = 1024; }
    const float* pl = base + (size_t)(c.lane >> 3) * ld + (c.lane & 7) * 4;
#pragma unroll
    for (int i = 0; i < 8; ++i) tv[i] = *(const f32x4*)(pl + (size_t)(8 * i) * ld);
}
__device__ __forceinline__ void ex_item_finish(const Ctx& c, LAS float* scr, int r, const f32x4 (&tv)[8]) {
    constexpr int I_GU = 32 * 256;
    if (r < I_GU) { const int e = r / 256, q = r % 256; titem_finish(c, scr, tv, (bf16*)(c.ws + WS_WGU) + (size_t)e * 512 * 1024, 1024, (q % 16) * 64, (q / 16) * 32); }
    else { r -= I_GU; const int e = r / 128, q = r % 128; titem_finish(c, scr, tv, (bf16*)(c.ws + WS_WD) + (size_t)e * 1024 * 256, 256, (q % 4) * 64, (q / 4) * 32); }
}
constexpr size_t WS_WRT = 16 * MiB + 512 * 1024;
__device__ __forceinline__ void p0_prologue(const Ctx& c) {
    { const size_t n8 = (size_t)NTOK * D / 8; const f32x4* xs = (const f32x4*)c.x; v4u* xd = (v4u*)((bf16*)(c.ws + WS_XB));
      const size_t st = (size_t)c.G * NTHR;
      size_t i = (size_t)c.bid * NTHR + c.tid;
      for (; i + 3 * st < n8; i += 4 * st) { f32x4 a[4], b[4];
#pragma unroll
          for (int u = 0; u < 4; ++u) { a[u] = xs[2 * (i + u * st)]; b[u] = xs[2 * (i + u * st) + 1]; }
#pragma unroll
          for (int u = 0; u < 4; ++u) { v4u o; o.x = pk2(a[u].x, a[u].y); o.y = pk2(a[u].z, a[u].w); o.z = pk2(b[u].x, b[u].y); o.w = pk2(b[u].z, b[u].w); xd[i + u * st] = o; } }
      for (; i < n8; i += st) { const f32x4 a = xs[2 * i], b = xs[2 * i + 1]; v4u o; o.x = pk2(a.x, a.y); o.y = pk2(a.z, a.w); o.z = pk2(b.x, b.y); o.w = pk2(b.z, b.w); xd[i] = o; } }
    { LAS float* scr = (LAS float*)(c.lds + c.wave * 8704);
      constexpr int I_WIN = 16 * 144, I_WB = 8 * 32, I_WO = 16 * 32, I_ALL = I_WIN + I_WB + I_WO;
      for (int it = c.bid * NWAVES + c.wave; it < I_ALL; it += c.G * NWAVES) {
        int r = it;
        if (r < I_WIN) { SrcWin s_{c.w_in}; transpose_item(c, scr, s_, (bf16*)(c.ws + WS_WIN), 1024, (r % 16) * 64, (r / 16) * 32); continue; } r -= I_WIN;
        if (r < I_WB) { SrcPlain s_{c.w_b, 1024}; transpose_item(c, scr, s_, (bf16*)(c.ws + WS_WB), 512, (r % 8) * 64, (r / 8) * 32); continue; } r -= I_WB;
        { SrcPlain s_{c.w_out, 1024}; transpose_item(c, scr, s_, (bf16*)(c.ws + WS_WO), 1024, (r % 16) * 64, (r / 16) * 32); }
      } }
    __syncthreads();
    { LAS float* tile = (LAS float*)c.lds; LAS float* Us = tile + 64 * 65; LAS float* As = Us + 64 * 65;
      for (int tI = c.bid; tI < 256; tI += c.G) { const int k0 = (tI & 15) * 64, n0 = (tI >> 4) * 64, h = k0 >> 7;
        const int r = c.tid >> 6, cc = c.tid & 63;
#pragma unroll
        for (int pI = 0; pI < 8; ++pI) { const int kk = pI * 8 + r; Us[kk * 65 + cc] = c.w_uv[(size_t)(k0 + kk) * 64 + cc]; As[kk * 65 + cc] = c.w_a[(size_t)(h * 64 + kk) * 1024 + n0 + cc]; }
        __syncthreads();
#pragma unroll
        for (int pI = 0; pI < 8; ++pI) { const int kk = pI * 8 + r; float a = 0.f;
#pragma unroll 16
            for (int d = 0; d < 64; ++d) a += Us[kk * 65 + d] * As[d * 65 + cc];
            tile[kk * 65 + cc] = a; }
        __syncthreads();
        const int nl = c.tid >> 3, kc = c.tid & 7; v4u o;
        o.x = pk2(tile[(8 * kc + 0) * 65 + nl], tile[(8 * kc + 1) * 65 + nl]); o.y = pk2(tile[(8 * kc + 2) * 65 + nl], tile[(8 * kc + 3) * 65 + nl]);
        o.z = pk2(tile[(8 * kc + 4) * 65 + nl], tile[(8 * kc + 5) * 65 + nl]); o.w = pk2(tile[(8 * kc + 6) * 65 + nl], tile[(8 * kc + 7) * 65 + nl]);
        *(v4u*)((bf16*)(c.ws + WS_WC) + (size_t)(n0 + nl) * 1024 + k0 + 8 * kc) = o;
        __syncthreads(); } }
    for (int i = c.bid * NTHR + c.tid; i < 48 * 1024; i += c.G * NTHR) { const int o = i >> 10, k = i & 1023;
        const float v = o < 32 ? c.w_router[(size_t)k * 32 + o] : (o < 36 ? c.w_group[(size_t)k * 4 + (o - 32)] : 0.f);
        const unsigned hi = f2bf(v); const float rem = v - bf2f(hi);
        ((bf16*)(c.ws + WS_WRT))[i] = (bf16)hi; ((bf16*)(c.ws + WS_WRT))[48 * 1024 + i] = (bf16)f2bf(rem); }
    if (c.bid == 0) { for (int i = c.tid; i < 129 * 8; i += NTHR) { const int d = i >> 3, h = i & 7; const int b = (int)t5_bias_bucket(d);
            ((float*)(c.ws + WS_BIAS))[i] = c.rel_bias[b * 16 + h]; ((float*)(c.ws + WS_BIAS) + 129 * 8)[i] = c.rel_bias[b * 16 + 8 + h]; } }
}


__device__ __forceinline__ void p_rmsnorm(const Ctx& c) {
    const int gw = c.bid * NWAVES + c.wave, NGW = c.G * NWAVES, l15 = c.lane & 15, g4 = c.lane >> 4;
    const f32x4 g0 = *(const f32x4*)(c.kv_g + 8 * l15), g1 = *(const f32x4*)(c.kv_g + 8 * l15 + 4);
    for (int r = 4 * gw + g4; r < NTOK; r += 4 * NGW) {
        const float* src = (const float*)(c.ws + WS_CKVRAW) + (size_t)r * 128 + 8 * l15;
        const f32x4 a = *(const f32x4*)src, b = *(const f32x4*)(src + 4);
        float ss = (a.x * a.x + a.y * a.y) + (a.z * a.z + a.w * a.w) + (b.x * b.x + b.y * b.y) + (b.z * b.z + b.w * b.w);
        ss += DPP_F(ss, 0xB1); ss += DPP_F(ss, 0x4E); ss += DPP_F(ss, 0x141); ss += DPP_F(ss, 0x140);
        const float rs = 1.0f / sqrtf(ss * (1.0f / 128.0f) + RMS_EPS);
        v4u o; o.x = pk2(a.x * rs * g0.x, a.y * rs * g0.y); o.y = pk2(a.z * rs * g0.z, a.w * rs * g0.w); o.z = pk2(b.x * rs * g1.x, b.y * rs * g1.y); o.w = pk2(b.z * rs * g1.z, b.w * rs * g1.w);
        *(v4u*)((bf16*)(c.ws + WS_CKV) + (size_t)r * 128 + 8 * l15) = o;
    }
}


typedef float f32x16 __attribute__((ext_vector_type(16)));
typedef short s16x8 __attribute__((ext_vector_type(8)));
__device__ __forceinline__ float half_min(float v) {
    v = fminf(v, DPP_F(v, 0xB1)); v = fminf(v, DPP_F(v, 0x4E)); v = fminf(v, DPP_F(v, 0x141)); v = fminf(v, DPP_F(v, 0x140)); return x16_min(v); }
__device__ __forceinline__ float half_max(float v) {
    v = fmaxf(v, DPP_F(v, 0xB1)); v = fmaxf(v, DPP_F(v, 0x4E)); v = fmaxf(v, DPP_F(v, 0x141)); v = fmaxf(v, DPP_F(v, 0x140)); return x16_max(v); }
__device__ __forceinline__ int half_sum(int v) {
    v += DPP_I(v, 0xB1); v += DPP_I(v, 0x4E); v += DPP_I(v, 0x141); v += DPP_I(v, 0x140); return x16_sumi(v); }
struct P2B { s16x8 b[8]; };
__device__ __forceinline__ P2B p2_ld4(const LAS unsigned char* kb_, int tb) { P2B r;
#pragma unroll
    for (int u = 0; u < 4; ++u) { r.b[2 * u] = *(const LAS s16x8*)(kb_ + (tb + u) * 2048); r.b[2 * u + 1] = *(const LAS s16x8*)(kb_ + (tb + u) * 2048 + 1024); }
    return r; }
__device__ __forceinline__ float p2_relu(float x) { const int xi = __builtin_bit_cast(int, x); return __builtin_bit_cast(float, xi > 0 ? xi : 0); }
__device__ __forceinline__ float p2_wsum(const f32x4 a, const f32x4 w) {
    float p = fmaf(w.x, p2_relu(a[0]), 0.f); p = fmaf(w.y, p2_relu(a[1]), p); p = fmaf(w.z, p2_relu(a[2]), p); return fmaf(w.w, p2_relu(a[3]), p); }
__device__ __forceinline__ void p2_score4(const P2B& B, const s16x8 a0, const s16x8 a1, const f32x4 wq, float& r0, float& r1) {
    f32x4 acc[4];
#pragma unroll
    for (int u = 0; u < 4; ++u) { const f32x4 z = {0.f, 0.f, 0.f, 0.f}; acc[u] = __builtin_amdgcn_mfma_f32_16x16x32_bf16(a0, B.b[2 * u], z, 0, 0, 0); }
#pragma unroll
    for (int u = 0; u < 4; ++u) acc[u] = __builtin_amdgcn_mfma_f32_16x16x32_bf16(a1, B.b[2 * u + 1], acc[u], 0, 0, 0);
    const float p0 = p2_wsum(acc[0], wq), p1 = p2_wsum(acc[1], wq), p2 = p2_wsum(acc[2], wq), p3 = p2_wsum(acc[3], wq);
    { auto s_ = __builtin_amdgcn_permlane16_swap(__builtin_bit_cast(unsigned, p0), __builtin_bit_cast(unsigned, p1), false, false); const unsigned x_ = s_[0], y_ = s_[1];
      r0 = __builtin_bit_cast(float, x_) + __builtin_bit_cast(float, y_); }
    { auto s_ = __builtin_amdgcn_permlane16_swap(__builtin_bit_cast(unsigned, p2), __builtin_bit_cast(unsigned, p3), false, false); const unsigned x_ = s_[0], y_ = s_[1];
      r1 = __builtin_bit_cast(float, x_) + __builtin_bit_cast(float, y_); }
}
__device__ __forceinline__ void p2_unit(const Ctx& c, int b, int blk, int item, int item2) {
    LAS unsigned char* kst = c.lds;
    const int lane = c.lane, wv = c.wave, r = lane & 31, hh = lane >> 5, g4 = lane >> 4, c16 = lane & 15;
    const int t0 = blk * 16 + 2 * wv, n0 = b * SEQ + t0, ntile = blk + 1, nst = (ntile + 15) >> 4;
    const unsigned char* ksrc = c.ws + WS_KIDX + (size_t)(b * 128) * 2048;
#define P2_ISSUE(st) do { _Pragma("unroll") for (int _j = 0; _j < 4; ++_j) \
        __builtin_amdgcn_global_load_lds((const unsigned*)(ksrc + (size_t)(st) * 32768 + (_j * 512 + c.tid) * 16), (LAS unsigned*)(kst + ((st) & 1) * 32768 + (_j * 512 + wv * 64) * 16), 16, 0, 0); } while (0)
    P2_ISSUE(0);
    s16x8 af[2];
    { const bf16* qp = (const bf16*)(c.ws + WS_QIDX) + (size_t)(n0 + (c16 >> 3)) * 512 + (c16 & 7) * 64 + 8 * g4;
      af[0] = *(const s16x8*)qp; af[1] = *(const s16x8*)(qp + 32); }
    const f32x4 wq = *(const f32x4*)((const float*)(c.ws + WS_WIDX) + (size_t)(n0 + hh) * 8 + 4 * (g4 & 1));
    asm volatile("" :: "v"(af[0]), "v"(af[1]), "v"(wq));
    float sc0[64];
#pragma unroll
    for (int i = 0; i < 64; ++i) sc0[i] = -INFINITY;
    const int lim0 = 2 * wv + hh;
    const int lastst = blk >> 4;
    const int limt = (blk - (g4 & 1)) - ((c16 <= lim0) ? 0 : 1);
#pragma unroll
    for (int st = 0; st < 8; ++st) {
        if (st <= lastst) {
            if (st < lastst) { P2_ISSUE(st + 1); asm volatile("s_waitcnt vmcnt(4)" ::: "memory"); }
            else asm volatile("s_waitcnt vmcnt(0)" ::: "memory");
            __builtin_amdgcn_s_barrier();
            const LAS unsigned char* kb_ = kst + (st & 1) * 32768 + lane * 16;
            if (st < lastst) {
                P2B Ba = p2_ld4(kb_, 0), Bb = p2_ld4(kb_, 4);
                p2_score4(Ba, af[0], af[1], wq, sc0[st * 8 + 0], sc0[st * 8 + 1]); __builtin_amdgcn_sched_barrier(0);
                Ba = p2_ld4(kb_, 8);
                p2_score4(Bb, af[0], af[1], wq, sc0[st * 8 + 2], sc0[st * 8 + 3]); __builtin_amdgcn_sched_barrier(0);
                Bb = p2_ld4(kb_, 12);
                p2_score4(Ba, af[0], af[1], wq, sc0[st * 8 + 4], sc0[st * 8 + 5]); __builtin_amdgcn_sched_barrier(0);
                p2_score4(Bb, af[0], af[1], wq, sc0[st * 8 + 6], sc0[st * 8 + 7]);
            } else {
#pragma unroll
                for (int g = 0; g < 4; ++g) if (st * 16 + 4 * g <= blk) {
                    const P2B B = p2_ld4(kb_, 4 * g);
                    float r0, r1; p2_score4(B, af[0], af[1], wq, r0, r1);
                    sc0[st * 8 + 2 * g] = (st * 16 + 4 * g <= limt) ? r0 : -INFINITY;
                    sc0[st * 8 + 2 * g + 1] = (st * 16 + 4 * g + 2 <= limt) ? r1 : -INFINITY;
                    __builtin_amdgcn_sched_barrier(0);
                }
            }
            asm volatile("s_waitcnt lgkmcnt(0)" ::: "memory");
            __builtin_amdgcn_s_barrier();
        }
    }
#undef P2_ISSUE
    f32x4 tv[8];
    LAS float* iscr = (LAS float*)(c.lds + (wv < 7 ? 65536 + wv * 8448 : 133120));
    if (item >= 0) ex_item_load(c, item, tv);
    const int nreg = (ntile + 1) >> 1;
    float thr0 = -INFINITY; int quota0 = 0;
    if (blk >= 16) {
#define P2_COUNT_NEG(EXPR, OUT) do { unsigned sa_ = 0u, sb_ = 0u; \
        _Pragma("unroll") for (int g = 0; g < 4; ++g) if (nreg > 16 * g) { \
            _Pragma("unroll") for (int i = 16 * g; i < 16 * g + 16; ++i) { const float s_ = sc0[i]; const unsigned tb_ = __builtin_bit_cast(unsigned, (EXPR)); \
                if (g < 2) sa_ = __builtin_amdgcn_alignbit(sa_, tb_, 31); else sb_ = __builtin_amdgcn_alignbit(sb_, tb_, 31); } } \
        OUT = half_sum(__builtin_popcount(sa_) + __builtin_popcount(sb_)); } while (0)
        const int ntot = t0 + hh + 1;
        float mx0 = -INFINITY;
#pragma unroll
        for (int g = 0; g < 4; ++g) if (nreg > 16 * g) {
#pragma unroll
            for (int i = 16 * g; i < 16 * g + 16; ++i) mx0 = fmaxf(mx0, sc0[i]); }
        mx0 = half_max(mx0);
        int cneg, cp; P2_COUNT_NEG(s_, cneg); P2_COUNT_NEG(0.f - s_, cp);
        const int cn = 32 * ((nreg + 15) & ~15) - cneg;
        float lo0 = 0.f, hi0 = 0.f; int chi0 = 0, clo0 = KSEL + 1; bool done0 = false, eg0 = false;
        if (cp <= KSEL && cn >= KSEL) { done0 = true; thr0 = 0.f; quota0 = KSEL - cp; }
        else if (cp > KSEL) { lo0 = 0.f; clo0 = cp; hi0 = mx0 + fabsf(mx0) * 1e-6f + 1e-30f; chi0 = 0; }
        else { hi0 = 0.f; chi0 = cn; clo0 = ntot; }
        if (__builtin_amdgcn_ballot_w64(!done0 && cp <= KSEL) != 0ull) {
            float mn0 = INFINITY;
#pragma unroll
            for (int g = 0; g < 4; ++g) if (nreg > 16 * g) {
#pragma unroll
                for (int i = 16 * g; i < 16 * g + 16; ++i) mn0 = fminf(mn0, sc0[i] == -INFINITY ? INFINITY : sc0[i]); }
            mn0 = half_min(mn0);
            if (!done0 && cp <= KSEL) lo0 = mn0;
        }
        float wl0 = 1.f, wh0 = 1.f; int side0 = 0;
        for (int it = 0; it < 400; ++it) {
            if (!done0 && chi0 == KSEL - 1) { done0 = true; eg0 = true; }
            if (__builtin_amdgcn_ballot_w64(!done0) == 0ull) break;
            const float half_ = 0.5f * (lo0 + hi0);
            const float fl_ = ((float)(clo0 - KSEL) + 0.5f) * wl0, fh_ = ((float)(KSEL - chi0) - 0.5f) * wh0;
            const float mi = lo0 + (hi0 - lo0) * (fl_ / (fl_ + fh_));
            const float mid0 = (it < 48 && mi > lo0 && mi < hi0) ? mi : half_;
            int cb; P2_COUNT_NEG(s_ - mid0, cb);
            const int c0 = 32 * ((nreg + 15) & ~15) - cb;
            if (!done0) { if (c0 == KSEL) { done0 = true; thr0 = mid0; quota0 = KSEL; } else if (mid0 <= lo0 || mid0 >= hi0) { done0 = true; thr0 = lo0; quota0 = KSEL - chi0; }
                else if (c0 > KSEL) { lo0 = mid0; clo0 = c0; wh0 = side0 > 0 ? wh0 * 0.5f : 1.f; wl0 = 1.f; side0 = 1; }
                else { hi0 = mid0; chi0 = c0; wl0 = side0 < 0 ? wl0 * 0.5f : 1.f; wh0 = 1.f; side0 = -1; } }
        }
        if (!done0) { thr0 = lo0; quota0 = KSEL - chi0; }
        if (__builtin_amdgcn_ballot_w64(eg0) != 0ull) {
            float m_ = -INFINITY;
#pragma unroll
            for (int g = 0; g < 4; ++g) if (nreg > 16 * g) {
#pragma unroll
                for (int i = 16 * g; i < 16 * g + 16; ++i) m_ = fmaxf(m_, sc0[i] < hi0 ? sc0[i] : -INFINITY); }
            m_ = half_max(m_);
            if (eg0) { thr0 = m_; quota0 = 1; }
        }
#undef P2_COUNT_NEG
    }
    if (item >= 0) ex_item_finish(c, iscr, item, tv);
    if (item2 >= 0) ex_item_load(c, item2, tv);
    unsigned short* selp0 = (unsigned short*)(c.ws + WS_SEL) + (size_t)(n0 + hh) * KSEL;
    int base0 = 0, eq0 = 0; const unsigned ltm = (1u << r) - 1u;
#pragma unroll
    for (int g = 0; g < 4; ++g) if (nreg > 16 * g) {
#pragma unroll
        for (int i = 16 * g; i < 16 * g + 16; ++i) {
            bool sel_ = sc0[i] > thr0; const bool pe = sc0[i] == thr0; const unsigned long long me = __builtin_amdgcn_ballot_w64(pe);
            if (me) { const unsigned mh = hh ? (unsigned)(me >> 32) : (unsigned)me; sel_ = sel_ || (pe && (eq0 + __builtin_popcount(mh & ltm) < quota0)); eq0 += __builtin_popcount(mh); }
            const unsigned long long ms = __builtin_amdgcn_ballot_w64(sel_); const unsigned mh2 = hh ? (unsigned)(ms >> 32) : (unsigned)ms;
            const int pos = base0 + __builtin_popcount(mh2 & ltm); if (sel_ && pos < KSEL) selp0[pos] = (unsigned short)(32 * i + r); base0 += __builtin_popcount(mh2);
        } }
    if (item2 >= 0) ex_item_finish(c, iscr, item2, tv);
}
__device__ __forceinline__ void p2_indexer_topk(const Ctx& c) {
    for (int pu = c.bid; pu < 256; pu += c.G) {
        const int b = pu >> 5, j = pu & 31;
#pragma unroll 1
        for (int q = 0; q < 4; ++q) p2_unit(c, b, q == 0 ? j : (q == 1 ? 63 - j : (q == 2 ? 64 + j : 127 - j)), c.G == 256 ? q * 2048 + c.bid * NWAVES + c.wave : -1, (c.G == 256 && q < 2) ? (4 + q) * 2048 + c.bid * NWAVES + c.wave : -1);
    }
}


typedef short s16x4 __attribute__((ext_vector_type(4)));
constexpr int DSA_WS_OFF = 131072 + 2048;
constexpr int DSA_BIAS_OFF = 131072 + 2048 + 10240;
__device__ __forceinline__ void p3a_dsa(const Ctx& c) {
    const int lane = c.lane, wv = c.wave, l15 = lane & 15, g4 = lane >> 4;
    LAS unsigned char* kvb = c.lds + wv * 16384;
    LAS unsigned char* wsb = c.lds + DSA_WS_OFF + wv * 1280;
    LAS float* biasL = (LAS float*)(c.lds + DSA_BIAS_OFF);
    for (int i = c.tid; i < 129 * 8; i += NTHR) biasL[i] = ((const float*)(c.ws + WS_BIAS))[i];
    __syncthreads();
    const int prow = (l15 & 3) | ((l15 & 4) << 1) | ((l15 & 8) >> 1);
    const int rowx = ((prow & 3) << 2) | (prow >> 2);
    const unsigned qk_off = (unsigned)(256 * prow + 16 * (g4 ^ (rowx & 3))), qk_sx = (unsigned)(rowx >> 2);
    const int grow = 8 * (g4 & 1) + 4 * (g4 >> 1);
    const int trow = grow + (l15 >> 2), trx = ((trow & 3) << 2) | ((trow >> 2) & 3);
    const unsigned tr_off = (unsigned)(256 * trow + 16 * (((lane & 3) >> 1) ^ (trx & 1)) + 8 * (lane & 1)), tr_mx = (unsigned)(trx >> 1);
    const bf16* ckv = (const bf16*)(c.ws + WS_CKV);
    const float bfar = biasL[128 * 8 + (l15 & 7)];
    float bmax = 0.f;
    for (int d = 0; d <= 128; ++d) bmax = fmaxf(bmax, fabsf(biasL[d * 8 + (l15 & 7)]));
    const float kvmax = 11.313708499f * 1.004f * wave_max(fmaxf(fabsf(c.kv_g[2 * lane]), fabsf(c.kv_g[2 * lane + 1])));
    unsigned trm[8];
#pragma unroll
    for (int m = 0; m < 8; ++m) trm[m] = tr_off + 32u * ((unsigned)m ^ tr_mx);
    const int gw = c.bid * NWAVES + wv, NGW = c.G * NWAVES;
    const int eit0 = (c.G == 256 ? P0_EXPERT_ITEMS : 0) + gw;
    if (wv < 4) for (int eit = eit0; eit < P0_EXPERT_ITEMS; eit += NGW) p0_expert_item(c, (LAS float*)kvb, eit);
    asm volatile("s_waitcnt lgkmcnt(0)" ::: "memory");
#define DSA_LOADQ(n_, raw_, qf_) do { raw_ = *(const v2u*)((const unsigned short*)(c.ws + WS_SEL) + (size_t)(n_) * KSEL + 4 * lane); \
        const s16x8* qp_ = (const s16x8*)((const bf16*)(c.ws + WS_QLAT) + (size_t)(n_) * 1024 + (l15 & 7) * 128 + 8 * g4); \
        _Pragma("unroll") for (int s_ = 0; s_ < 4; ++s_) qf_[s_] = qp_[4 * s_]; } while (0)
#define DSA_PREP(n_, raw_, qf_, sl_, t_, cnt_, nch_, nfar_, mref_) do { t_ = (n_) & 2047; cnt_ = (t_ + 1 < KSEL) ? t_ + 1 : KSEL; nch_ = (cnt_ + 31) >> 5; \
        { const int i0 = 4 * lane, lim = t_ - 128; \
          raw_.x = (i0 < cnt_ ? (raw_.x & 0xffffu) : 0u) | (i0 + 1 < cnt_ ? (raw_.x & 0xffff0000u) : 0u); raw_.y = (i0 + 2 < cnt_ ? (raw_.y & 0xffffu) : 0u) | (i0 + 3 < cnt_ ? (raw_.y & 0xffff0000u) : 0u); \
          *(LAS v2u*)(wsb + (sl_) * 512 + 8 * lane) = raw_; \
          const int e0 = (i0 < cnt_ && (int)(raw_.x & 0xffffu) <= lim) ? 1 : 0, e1 = (i0 + 1 < cnt_ && (int)(raw_.x >> 16) <= lim) ? 1 : 0, e2 = (i0 + 2 < cnt_ && (int)(raw_.y & 0xffffu) <= lim) ? 1 : 0, e3 = (i0 + 3 < cnt_ && (int)(raw_.y >> 16) <= lim) ? 1 : 0; \
          int nf = e0 + e1 + e2 + e3; nf += DPP_I(nf, 0xB1); nf += DPP_I(nf, 0x4E); nf += DPP_I(nf, 0x141); nf += DPP_I(nf, 0x140); nf = x16_sumi(nf); { unsigned xa, xb; swap32((unsigned)nf, xa, xb); nf = (int)(xa + xb); } \
          nfar_ = __builtin_amdgcn_readfirstlane(nf) >> 5; } \
        { float q2 = 0.f; \
          _Pragma("unroll") for (int s_ = 0; s_ < 4; ++s_) { if (l15 >= 8) qf_[s_] = (s16x8){0, 0, 0, 0, 0, 0, 0, 0}; \
              _Pragma("unroll") for (int e = 0; e < 8; ++e) { const float qv = bf2f((unsigned)(unsigned short)qf_[s_][e]); q2 += qv * qv; } } \
          q2 = x16_sum(q2); q2 = x32_sum(q2); mref_ = sqrtf(q2) * kvmax + bmax; } } while (0)
#define DSA_ISSUE(ch_, bi_, k8_, sl_, n_, t_, cnt_, nfar_) do { const bf16* ckb_ = ckv + (size_t)((n_) >> 11) * SEQ * 128; \
            _Pragma("unroll") for (int u = 0; u < 8; ++u) { const unsigned kw = u < 2 ? k8_.x : (u < 4 ? k8_.y : (u < 6 ? k8_.z : k8_.w)); const unsigned key = (u & 1) ? (kw >> 16) : (kw & 0xffffu); \
                const int chl = l15 ^ ((g4 << 2) | (u & 3)); \
                __builtin_amdgcn_global_load_lds((const unsigned*)((const char*)ckb_ + (size_t)(unsigned)(key * 256u + (unsigned)chl * 16u)), (LAS unsigned*)(kvb + (bi_) * 8192 + u * 1024), 16, 0, 0); } \
            if ((ch_) >= (nfar_) && lane < 32) { const int kap = 32 * (ch_) + 8 * (lane & 3) + (lane >> 2); const int key = *(const LAS unsigned short*)(wsb + (sl_) * 512 + 2 * kap); int dd = (t_) - key; dd = dd > 128 ? 128 : dd; dd = kap < (cnt_) ? dd : 255; \
                *(LAS unsigned short*)(wsb + 1024 + (bi_) * 64 + 2 * lane) = (unsigned short)dd; } } while (0)
    const bool mixq = (NGW == SEQ);
#define DSA_QIDX(i_) (mixq ? ((i_) * SEQ + ((gw + 293 * (i_)) & (SEQ - 1))) : (gw + (i_) * NGW))
    const int nq = mixq ? BATCH : (NTOK - gw + NGW - 1) / NGW;
    int qi = 0, n = DSA_QIDX(0), sl = 0, b0 = 0, t = 0, cnt = 0, nch = 0, nfar = 0; float Mref = 0.f;
    s16x8 qf[4]; v2u rawn; s16x8 qfn[4];
    if (nq > 0) { v2u raw0; DSA_LOADQ(n, raw0, qf); DSA_PREP(n, raw0, qf, 0, t, cnt, nch, nfar, Mref);
        asm volatile("s_waitcnt lgkmcnt(0)" ::: "memory");
        const v4u k80 = *(const LAS v4u*)(wsb + (8 * g4) * 2); DSA_ISSUE(0, 0, k80, 0, n, t, cnt, nfar); }
    for (; qi < nq; ++qi) {
        const bool has_next = qi + 1 < nq; const int nn = has_next ? DSA_QIDX(qi + 1) : n;
        if (has_next) DSA_LOADQ(nn, rawn, qfn);
        int tn = 0, cntn = 0, nchn = 0, nfarn = 0; float Mrefn = 0.f;
        f32x4 O[8];
#pragma unroll
        for (int m = 0; m < 8; ++m) O[m] = (f32x4){0.f, 0.f, 0.f, 0.f};
        float l_run = 0.f;
        v4u k8n = *(const LAS v4u*)(wsb + sl * 512 + (32 * (nch > 1 ? 1 : 0) + 8 * g4) * 2);
        for (int ch = 0; ch < nch; ++ch) {
            const int bi = (b0 + ch) & 1;
            asm volatile("s_waitcnt lgkmcnt(0)" ::: "memory");
            if (ch + 1 < nch) { const v4u k8 = k8n; k8n = *(const LAS v4u*)(wsb + sl * 512 + (32 * (ch + 2 < 8 ? ch + 2 : 7) + 8 * g4) * 2);
                DSA_ISSUE(ch + 1, bi ^ 1, k8, sl, n, t, cnt, nfar); asm volatile("s_waitcnt vmcnt(8)" ::: "memory"); }
            else if (has_next) { DSA_PREP(nn, rawn, qfn, sl ^ 1, tn, cntn, nchn, nfarn, Mrefn);
                asm volatile("s_waitcnt lgkmcnt(0)" ::: "memory");
                const v4u k8 = *(const LAS v4u*)(wsb + (sl ^ 1) * 512 + (8 * g4) * 2);
                DSA_ISSUE(0, bi ^ 1, k8, sl ^ 1, nn, tn, cntn, nfarn); asm volatile("s_waitcnt vmcnt(8)" ::: "memory"); }
            else asm volatile("s_waitcnt vmcnt(0)" ::: "memory");
            const LAS unsigned char* kb_ = kvb + bi * 8192;
            f32x4 S[2];
#pragma unroll
            for (int T = 0; T < 2; ++T) { f32x4 a4 = {0.f, 0.f, 0.f, 0.f};
#pragma unroll
                for (int s_ = 0; s_ < 4; ++s_) { const s16x8 a = *(const LAS s16x8*)(kb_ + qk_off + 4096 * T + 64 * ((unsigned)s_ ^ qk_sx)); a4 = __builtin_amdgcn_mfma_f32_16x16x32_bf16(a, qf[s_], a4, 0, 0, 0); }
                S[T] = a4; }
            if (ch < nfar) {
#pragma unroll
                for (int T = 0; T < 2; ++T)
#pragma unroll
                    for (int r_ = 0; r_ < 4; ++r_) S[T][r_] = S[T][r_] + (bfar - Mref);
            } else
#pragma unroll
            for (int T = 0; T < 2; ++T) { const v2u d4 = *(const LAS v2u*)(wsb + 1024 + bi * 64 + 2 * (16 * T + grow));
#pragma unroll
                for (int r_ = 0; r_ < 4; ++r_) { const unsigned dw = r_ < 2 ? d4.x : d4.y; const unsigned dd = (r_ & 1) ? (dw >> 16) : (dw & 0xffffu);
                    const float bsv = biasL[(dd > 128u ? 128u : dd) * 8 + (l15 & 7)]; S[T][r_] = (dd == 255u) ? -INFINITY : S[T][r_] + (bsv - Mref); } }
#pragma unroll
            for (int T = 0; T < 2; ++T)
#pragma unroll
                for (int r_ = 0; r_ < 4; ++r_) { const float pv = __expf(S[T][r_]); S[T][r_] = pv; l_run += pv; }
            s16x8 P;
            { const unsigned p0 = cvt_pk(S[0][0], S[0][1]), p1 = cvt_pk(S[0][2], S[0][3]), p2 = cvt_pk(S[1][0], S[1][1]), p3 = cvt_pk(S[1][2], S[1][3]);
              const v4u pw_ = {p0, p1, p2, p3}; P = __builtin_bit_cast(s16x8, pw_); }
            { const unsigned kba = (unsigned)(size_t)kb_; s16x4 ta[8], tb[8];
#pragma unroll
              for (int m = 0; m < 8; ++m) { const unsigned ad = kba + trm[m];
                  asm volatile("ds_read_b64_tr_b16 %0, %1" : "=v"(ta[m]) : "v"(ad) : "memory"); asm volatile("ds_read_b64_tr_b16 %0, %1 offset:4096" : "=v"(tb[m]) : "v"(ad) : "memory"); }
              asm volatile("s_waitcnt lgkmcnt(8)" ::: "memory"); __builtin_amdgcn_sched_barrier(0);
#pragma unroll
              for (int m = 0; m < 4; ++m) O[m] = __builtin_amdgcn_mfma_f32_16x16x32_bf16(__builtin_shufflevector(ta[m], tb[m], 0, 1, 2, 3, 4, 5, 6, 7), P, O[m], 0, 0, 0);
              asm volatile("s_waitcnt lgkmcnt(0)" ::: "memory"); __builtin_amdgcn_sched_barrier(0);
#pragma unroll
              for (int m = 4; m < 8; ++m) O[m] = __builtin_amdgcn_mfma_f32_16x16x32_bf16(__builtin_shufflevector(ta[m], tb[m], 0, 1, 2, 3, 4, 5, 6, 7), P, O[m], 0, 0, 0); }
        }
        l_run = x16_sum(l_run); l_run = x32_sum(l_run);
        const float inv = 1.0f / fmaxf(l_run, 1e-37f);
        { LAS unsigned char* stg = kvb + ((b0 + nch - 1) & 1) * 8192;
          if (l15 < 8) {
#pragma unroll
              for (int m = 0; m < 8; ++m) *(LAS v2u*)(stg + (l15 * 128 + 16 * m + 4 * g4) * 2) = (v2u){cvt_pk(O[m][0] * inv, O[m][1] * inv), cvt_pk(O[m][2] * inv, O[m][3] * inv)}; }
          asm volatile("s_waitcnt lgkmcnt(0)" ::: "memory");
          const v4u oa = *(const LAS v4u*)(stg + lane * 16), ob = *(const LAS v4u*)(stg + 1024 + lane * 16);
          bf16* op = (bf16*)(c.ws + WS_XB) + (size_t)n * 1024 + lane * 8;
          *(v4u*)op = oa; *(v4u*)(op + 512) = ob; }
        b0 = (b0 + nch) & 1; sl ^= 1; t = tn; cnt = cntn; nch = nchn; nfar = nfarn; Mref = Mrefn; n = nn;
#pragma unroll
        for (int s_ = 0; s_ < 4; ++s_) qf[s_] = qfn[s_];
    }
#undef DSA_QIDX
#undef DSA_LOADQ
#undef DSA_PREP
#undef DSA_ISSUE
    asm volatile("s_waitcnt vmcnt(0) lgkmcnt(0)" ::: "memory");
    if (wv >= 4) for (int eit = eit0; eit < P0_EXPERT_ITEMS; eit += NGW) p0_expert_item(c, (LAS float*)kvb, eit);
    __syncthreads();
}

__device__ __forceinline__ void p3b_swa(const Ctx& c) {
    const int lane = c.lane, wv = c.wave, l15 = lane & 15, g4 = lane >> 4, g = wv & 3, hq = wv >> 2;
    LAS float* biasL = (LAS float*)(c.lds + DSA_BIAS_OFF);
    __syncthreads();
    for (int i = c.tid; i < 128 * 8; i += NTHR) biasL[i] = ((const float*)(c.ws + WS_BIAS) + 129 * 8)[i];
    __syncthreads();
    const unsigned kr_off = (unsigned)(128 * l15), kr_x = (unsigned)(l15 & 7);
    const int vrow = 4 * g4 + (l15 >> 2); const unsigned vr_x = (unsigned)(vrow & 7), vp1 = (unsigned)((lane & 3) >> 1);
    const unsigned vr_off = (unsigned)(128 * vrow + 8 * (lane & 1));
    for (int unit = c.bid; unit < 256; unit += c.G) {
        const int b = unit >> 5, qb = (unit >> 1) & 15, kvh = unit & 1, head = kvh * 4 + g;
        __syncthreads();
#pragma unroll
        for (int j = 0; j < 4; ++j) { const int piece = wv * 4 + j, row = 8 * piece + (lane >> 3), chunk = (lane & 7) ^ (row & 7); int key = (qb - 1) * 128 + row; key = key < 0 ? 0 : key;
            const size_t so = ((size_t)(b * SEQ + key) * 128 + kvh * 64 + chunk * 8);
            __builtin_amdgcn_global_load_lds((const unsigned*)((const bf16*)(c.ws + WS_KB) + so), (LAS unsigned*)(c.lds + piece * 1024), 16, 0, 0);
            __builtin_amdgcn_global_load_lds((const unsigned*)((const bf16*)(c.ws + WS_VB) + so), (LAS unsigned*)(c.lds + 32768 + piece * 1024), 16, 0, 0); }
        float bt[9][4];
#pragma unroll
        for (int ta = 0; ta < 9; ++ta)
#pragma unroll
            for (int r_ = 0; r_ < 4; ++r_) { const int dist = 128 + l15 - 16 * ta - 4 * g4 - r_; bt[ta][r_] = (dist >= 0 && dist < 128) ? biasL[dist * 8 + head] : -INFINITY; }
        const float sink = c.sinks[head];
        asm volatile("s_waitcnt vmcnt(0)" ::: "memory");
        __syncthreads();
#pragma unroll 1
        for (int jj = 0; jj < 4; ++jj) {
            const int j = 4 * hq + jj; const size_t nrow = (size_t)(b * SEQ + qb * 128 + 16 * j + l15);
            bf16* qrow = (bf16*)(c.ws + WS_QB) + nrow * 512 + head * 64;
            const s16x8 q0 = *(const s16x8*)(qrow + 8 * g4), q1 = *(const s16x8*)(qrow + 32 + 8 * g4);
            f32x4 S[9]; float mx = sink;
#pragma unroll
            for (int ta = 0; ta < 9; ++ta) { const int kt = j + ta; const LAS unsigned char* kp = c.lds + kr_off + 2048 * kt;
                f32x4 a4 = {0.f, 0.f, 0.f, 0.f};
                a4 = __builtin_amdgcn_mfma_f32_16x16x32_bf16(*(const LAS s16x8*)(kp + 16 * ((unsigned)g4 ^ kr_x)), q0, a4, 0, 0, 0);
                a4 = __builtin_amdgcn_mfma_f32_16x16x32_bf16(*(const LAS s16x8*)(kp + 16 * ((unsigned)(4 + g4) ^ kr_x)), q1, a4, 0, 0, 0);
                const bool dead = (qb == 0 && kt < 8);
#pragma unroll
                for (int r_ = 0; r_ < 4; ++r_) { const float sv = dead ? -INFINITY : a4[r_] + bt[ta][r_]; a4[r_] = sv; mx = fmaxf(mx, sv); }
                S[ta] = a4; }
            mx = x16_max(mx); mx = x32_max(mx);
            float ps = 0.f;
#pragma unroll
            for (int ta = 0; ta < 9; ++ta)
#pragma unroll
                for (int r_ = 0; r_ < 4; ++r_) { const float pv = __expf(S[ta][r_] - mx); S[ta][r_] = pv; ps += pv; }
            ps = x16_sum(ps); ps = x32_sum(ps);
            const float inv = 1.0f / (ps + __expf(sink - mx));
            f32x4 O[4];
#pragma unroll
            for (int m = 0; m < 4; ++m) O[m] = (f32x4){0.f, 0.f, 0.f, 0.f};
#pragma unroll
            for (int pp = 0; pp < 5; ++pp) {
                const int ta = 2 * pp, tb = 2 * pp + 1;
                v4u pw_; pw_.x = cvt_pk(S[ta][0] * inv, S[ta][1] * inv); pw_.y = cvt_pk(S[ta][2] * inv, S[ta][3] * inv);
                if (tb < 9) { pw_.z = cvt_pk(S[tb < 9 ? tb : 0][0] * inv, S[tb < 9 ? tb : 0][1] * inv); pw_.w = cvt_pk(S[tb < 9 ? tb : 0][2] * inv, S[tb < 9 ? tb : 0][3] * inv); } else { pw_.z = 0u; pw_.w = 0u; }
                const s16x8 P = __builtin_bit_cast(s16x8, pw_);
                const LAS unsigned char* va = c.lds + 32768 + vr_off + 2048 * (j + ta); const LAS unsigned char* vb_ = c.lds + 32768 + vr_off + 2048 * (j + (tb < 9 ? tb : ta));
#pragma unroll
                for (int m = 0; m < 4; ++m) { const unsigned co = 16u * ((unsigned)(2 * m + vp1) ^ vr_x);
                    const s16x4 a0 = __builtin_amdgcn_ds_read_tr16_b64_v4i16((LAS s16x4*)(va + co)), a1 = __builtin_amdgcn_ds_read_tr16_b64_v4i16((LAS s16x4*)(vb_ + co));
                    O[m] = __builtin_amdgcn_mfma_f32_16x16x32_bf16(__builtin_shufflevector(a0, a1, 0, 1, 2, 3, 4, 5, 6, 7), P, O[m], 0, 0, 0); }
            }
#pragma unroll
            for (int m = 0; m < 4; ++m) *(v2u*)(qrow + 16 * m + 4 * g4) = (v2u){cvt_pk(O[m][0], O[m][1]), cvt_pk(O[m][2], O[m][3])};
        }
    }
    __syncthreads();
}

__device__ __forceinline__ void p6_ln_router(const Ctx& c, bf16* x1b) {
    const int lane = c.lane, wv = c.wave, l15 = lane & 15, g4 = lane >> 4;
    LAS unsigned char* XH = c.lds; LAS unsigned char* XL = c.lds + 32768;
    LAS float* PL = (LAS float*)(c.lds + 65536);
    LAS float* LG = (LAS float*)(c.lds + 65536 + 24576);
    const bf16* WH = (const bf16*)(c.ws + WS_WRT); const bf16* WL = WH + 48 * 1024;
    LAS unsigned* PEX = (LAS unsigned*)(c.lds + 65536 + 24576 + 4096);
    LAS unsigned* EB = PEX + 128;
    int nbase = 0;
    s16x8 wbh[4][3], wbl[4][3];
#pragma unroll
    for (int s_ = 0; s_ < 4; ++s_)
#pragma unroll
        for (int nt = 0; nt < 3; ++nt) { const size_t wo = (size_t)(16 * nt + l15) * 1024 + 128 * wv + 32 * s_ + 8 * g4; wbh[s_][nt] = *(const s16x8*)(WH + wo); wbl[s_][nt] = *(const s16x8*)(WL + wo); }
    v2u vn[2][4];
    const bf16* h1b = (const bf16*)(c.ws + WS_H1B);
    if (c.bid < NTOK / 16) {
#pragma unroll
        for (int q = 0; q < 2; ++q)
#pragma unroll
            for (int j = 0; j < 4; ++j) vn[q][j] = ((const v2u*)(h1b + (size_t)(c.bid * 16 + 2 * wv + q) * D) + lane)[64 * j]; }
    for (int u = c.bid; u < NTOK / 16; u += c.G) {
        __syncthreads();
#pragma unroll
        for (int q = 0; q < 2; ++q) { const int tk = 2 * wv + q, n = u * 16 + tk;
            f32x4 v[4]; float s = 0.f;
#pragma unroll
            for (int j = 0; j < 4; ++j) { v[j] = (f32x4){bflo(vn[q][j].x), bfhi(vn[q][j].x), bflo(vn[q][j].y), bfhi(vn[q][j].y)}; s += (v[j].x + v[j].y) + (v[j].z + v[j].w); }
            const float mean = wave_sum(s) * (1.f / D); float s2 = 0.f;
#pragma unroll
            for (int j = 0; j < 4; ++j) { v[j] = v[j] - mean; s2 += (v[j].x * v[j].x + v[j].y * v[j].y) + (v[j].z * v[j].z + v[j].w * v[j].w); }
            const float rstd = 1.f / sqrtf(wave_sum(s2) * (1.f / D) + LN_EPS);
#pragma unroll
            for (int j = 0; j < 4; ++j) { const int k0 = 4 * lane + 256 * j;
                const f32x4 g = *(const f32x4*)(c.ln1_g + k0), bb = *(const f32x4*)(c.ln1_b + k0);
                const f32x4 y = v[j] * rstd * g + bb;
                const unsigned h01 = pk2(y.x, y.y), h23 = pk2(y.z, y.w);
                *(v2u*)(x1b + (size_t)n * D + k0) = (v2u){h01, h23};
                const unsigned l01 = pk2(y.x - bflo(h01), y.y - bfhi(h01)), l23 = pk2(y.z - bflo(h23), y.w - bfhi(h23));
                const unsigned off = (unsigned)(tk * 2048 + ((((lane >> 1) + 32 * j) ^ tk) << 4) + 8 * (lane & 1));
                *(LAS v2u*)(XH + off) = (v2u){h01, h23}; *(LAS v2u*)(XL + off) = (v2u){l01, l23}; } }
        if (u + c.G < NTOK / 16) {
#pragma unroll
            for (int q = 0; q < 2; ++q)
#pragma unroll
                for (int j = 0; j < 4; ++j) vn[q][j] = ((const v2u*)(h1b + (size_t)((u + c.G) * 16 + 2 * wv + q) * D) + lane)[64 * j]; }
        __syncthreads();
        { f32x4 acc[3];
#pragma unroll
          for (int nt = 0; nt < 3; ++nt) acc[nt] = (f32x4){0.f, 0.f, 0.f, 0.f};
#pragma unroll
          for (int s_ = 0; s_ < 4; ++s_) { const int chunk = 4 * (4 * wv + s_) + g4; const unsigned off = (unsigned)(l15 * 2048 + ((chunk ^ l15) << 4));
              const s16x8 ah = *(const LAS s16x8*)(XH + off), al = *(const LAS s16x8*)(XL + off);
#pragma unroll
              for (int nt = 0; nt < 3; ++nt) { const s16x8 bh = wbh[s_][nt], bl = wbl[s_][nt];
                  acc[nt] = __builtin_amdgcn_mfma_f32_16x16x32_bf16(al, bl, acc[nt], 0, 0, 0); acc[nt] = __builtin_amdgcn_mfma_f32_16x16x32_bf16(al, bh, acc[nt], 0, 0, 0);
                  acc[nt] = __builtin_amdgcn_mfma_f32_16x16x32_bf16(ah, bl, acc[nt], 0, 0, 0); acc[nt] = __builtin_amdgcn_mfma_f32_16x16x32_bf16(ah, bh, acc[nt], 0, 0, 0); } }
#pragma unroll
          for (int nt = 0; nt < 3; ++nt)
#pragma unroll
              for (int r_ = 0; r_ < 4; ++r_) PL[(wv * 16 + 4 * g4 + r_) * 48 + 16 * nt + l15] = acc[nt][r_]; }
        __syncthreads();
        for (int i = c.tid; i < 16 * 48; i += NTHR) { float a = 0.f;
#pragma unroll
            for (int w = 0; w < 8; ++w) a += PL[w * 768 + i];
            const int o = i % 48; a += o < 32 ? c.b_router[o] : (o < 36 ? c.b_group[o - 32] : 0.f);
            LG[i] = a; }
        __syncthreads();
        if (c.tid < 16) { const int n = u * 16 + c.tid; const LAS float* lg = LG + c.tid * 48; const int nloc = nbase + 2 * c.tid;
            int gs = 0; float gm = lg[32];
            for (int o = 1; o < 4; ++o) { const float v = lg[32 + o]; if (v > gm) { gm = v; gs = o; } }
            float gsum = 0.f;
            for (int o = 0; o < 4; ++o) gsum += __expf(lg[32 + o] - gm);
            const float gw_ = 1.0f / gsum;
            int i1 = 0; float m1 = lg[gs * 8];
            for (int o = 1; o < 8; ++o) { const float v = lg[gs * 8 + o]; if (v > m1) { m1 = v; i1 = o; } }
            int i2 = -1; float m2 = -INFINITY;
            for (int o = 0; o < 8; ++o) { const float v = lg[gs * 8 + o]; if (o != i1 && v > m2) { m2 = v; i2 = o; } }
            const float e2 = __expf(m2 - m1), w1 = gw_ / (1.0f + e2), w2 = gw_ * e2 / (1.0f + e2);
            const int ex1 = gs * 8 + i1, ex2 = gs * 8 + i2;
            ((unsigned*)(c.ws + WS_PE))[2 * n] = ex1; ((unsigned*)(c.ws + WS_PE))[2 * n + 1] = ex2; ((float*)(c.ws + WS_PW))[2 * n] = w1; ((float*)(c.ws + WS_PW))[2 * n + 1] = w2;
            PEX[nloc] = (unsigned)ex1 | ((unsigned)(2 * n) << 8); PEX[nloc + 1] = (unsigned)ex2 | ((unsigned)(2 * n + 1) << 8); }
        nbase += 32;
        if (nbase == 128 || u + c.G >= NTOK / 16) {
            __syncthreads();
            if (c.tid < 32) { unsigned cntE = 0; for (int j = 0; j < nbase; ++j) cntE += ((PEX[j] & 0xffu) == (unsigned)c.tid) ? 1u : 0u;
                EB[c.tid] = cntE ? atomicAdd(c.ctl + CW_CNT + c.tid, cntE) : 0u; }
            __syncthreads();
            if (c.tid < nbase) { const unsigned rec = PEX[c.tid], e = rec & 0xffu; unsigned rk = 0; for (int j = 0; j < c.tid; ++j) rk += ((PEX[j] & 0xffu) == e) ? 1u : 0u;
                ((unsigned*)(c.ws + WS_LIST))[(size_t)e * 32768 + EB[e] + rk] = rec >> 8; }
            nbase = 0;
        }
    }
    __syncthreads();
}


__device__ __forceinline__ void p9_ln2(const Ctx& c) {
    const int gw = c.bid * NWAVES + c.wave, NGW = c.G * NWAVES;
    v2u xn[4], san[4], sbn[4];
#define P9_LOAD(n_) do { _Pragma("unroll") for (int j = 0; j < 4; ++j) { const int k0 = 4 * c.lane + 256 * j; xn[j] = *(const v2u*)((const bf16*)(c.ws + WS_XB) + (size_t)(n_) * D + k0); \
            san[j] = *(const v2u*)((const bf16*)(c.ws + WS_SLOT) + (size_t)(2 * (n_)) * D + k0); sbn[j] = *(const v2u*)((const bf16*)(c.ws + WS_SLOT) + (size_t)(2 * (n_) + 1) * D + k0); } } while (0)
    if (gw < NTOK) P9_LOAD(gw);
    for (int n = gw; n < NTOK; n += NGW) {
        f32x4* row = (f32x4*)(c.out + (size_t)n * D) + c.lane;
        f32x4 v[4]; float s = 0.f;
#pragma unroll
        for (int j = 0; j < 4; ++j) { f32x4 y;
            y.x = bflo(xn[j].x) * ALPHA + (bflo(san[j].x) + bflo(sbn[j].x)); y.y = bfhi(xn[j].x) * ALPHA + (bfhi(san[j].x) + bfhi(sbn[j].x));
            y.z = bflo(xn[j].y) * ALPHA + (bflo(san[j].y) + bflo(sbn[j].y)); y.w = bfhi(xn[j].y) * ALPHA + (bfhi(san[j].y) + bfhi(sbn[j].y));
            v[j] = y; s += (y.x + y.y) + (y.z + y.w); }
        if (n + NGW < NTOK) P9_LOAD(n + NGW);
        const float mean = wave_sum(s) * (1.f / D); float s2 = 0.f;
#pragma unroll
        for (int j = 0; j < 4; ++j) { v[j] = v[j] - mean; s2 += (v[j].x * v[j].x + v[j].y * v[j].y) + (v[j].z * v[j].z + v[j].w * v[j].w); }
        const float rstd = 1.f / sqrtf(wave_sum(s2) * (1.f / D) + LN_EPS);
#pragma unroll
        for (int j = 0; j < 4; ++j) { const int k0 = 4 * c.lane + 256 * j; const f32x4 g = *(const f32x4*)(c.ln2_g + k0), bb = *(const f32x4*)(c.ln2_b + k0); row[64 * j] = v[j] * rstd * g + bb; }
    }
#undef P9_LOAD
}

namespace pg8 {
typedef short bf16x8 __attribute__((ext_vector_type(8)));
constexpr int BM = 256, BK = 64, HALF = 128, HTB = HALF * BK * 2, STAGE_BYTES = 8 * HTB, NXCD = 8, WGM = 8;
__host__ __device__ __forceinline__ int lds_byte(int r, int c) { const int st = (r >> 4) * 2 + (c >> 5), rr = r & 15, cc = c & 31, ob = rr * 64 + cc * 2; return st * 1024 + (ob ^ (((ob >> 9) & 1) << 5)); }
__host__ __device__ __forceinline__ void stage_rc(int b, int& R, int& C) { const int st = b / 1024, sb = b % 1024, swz = sb ^ (((sb >> 9) & 1) << 5); R = (st >> 1) * 16 + swz / 64; C = (st & 1) * 32 + (swz % 64) / 2; }
__host__ __device__ __forceinline__ int perm32(int rho) { const int n = rho >> 4, i = rho & 15; return 8 * (i >> 2) + 4 * n + (i & 3); }
__device__ __forceinline__ unsigned cvt_pk_bf16(float lo, float hi) { unsigned r; asm volatile("v_cvt_pk_bf16_f32 %0, %1, %2" : "=v"(r) : "v"(lo), "v"(hi)); return r; }

struct Unit { int pm, pn, pb, aux, half; };

struct StaticOrder {
    static constexpr bool HALF_SKIP = false;
    int nM, nN, nwg, G, c;
    __device__ void init(int M, int N, int G_, int c_) { nM = M / BM; nN = N / BM; nwg = nM * nN; G = G_; c = c_; }
    __device__ bool next(int i, Unit& u) const {
        const long L = (long)i * G + c; if (L >= nwg) return false;
        int wgid = (int)L; { const int q = nwg / NXCD, r = nwg % NXCD, xcd = wgid % NXCD, off = wgid / NXCD; wgid = (xcd < r ? xcd * (q + 1) : r * (q + 1) + (xcd - r) * q) + off; }
        const int nig = WGM * nN, gid = wgid / nig, fm = gid * WGM, gsz = (nM - fm) < WGM ? (nM - fm) : WGM;
        u.pm = fm + ((wgid % nig) % gsz); u.pn = (wgid % nig) / gsz; u.pb = u.pn; u.aux = 0; u.half = 0; return true;
    }
    __device__ __forceinline__ void a_ready(const Unit&) const {}
    __device__ __forceinline__ void done(const Unit&) const {}
};
struct DenseProb {
    static constexpr bool GATHER = false;
    const bf16* A; const bf16* Bt; int K;
    __device__ __forceinline__ const char* a_base(const Unit& u) const { return (const char*)A + (size_t)u.pm * 256 * K * 2; }
    __device__ __forceinline__ const char* b_base(const Unit& u) const { return (const char*)Bt + (size_t)u.pb * 256 * K * 2; }
    __device__ __forceinline__ void a_offs(const Unit&, int R0, int C0, int R1, int C1, unsigned (&o)[2][2]) const {
        o[0][0] = (unsigned)(R0 * K + C0) * 2u; o[0][1] = (unsigned)(R1 * K + C1) * 2u; o[1][0] = o[0][0] + (unsigned)(HALF * K * 2); o[1][1] = o[0][1] + (unsigned)(HALF * K * 2); }
};

template <class Prob, class Epi, class Sched>
__device__ __forceinline__ void gemm_phase(LAS unsigned char* lds, const Prob& P, const Sched& S, const Epi& E) {
    const int tid = threadIdx.x, wid = __builtin_amdgcn_readfirstlane(tid >> 6), lane = tid & 63, wr = wid >> 2, wc = wid & 3, fr = lane & 15, fq = lane >> 4;
    const int K = P.K, nt = K / BK;
    int sR[2], sC[2];
    unsigned offB0[2], offA[2][2];
#pragma unroll
    for (int i = 0; i < 2; ++i) { stage_rc(tid * 16 + i * 8192, sR[i], sC[i]); const int Rb = Epi::PERM ? ((sR[i] & ~31) + perm32(sR[i] & 31)) : sR[i];
        offB0[i] = (unsigned)(Rb * K + sC[i]) * 2u; }
    const size_t hstepB = (size_t)HALF * K * 2;
    const size_t kstep = (size_t)(BK * 2);
    const unsigned ldsw = (unsigned)wid * 1024u;
    const int aoff = lds_byte(wr * 64 + fr, fq * 8), boff = lds_byte(wc * 32 + fr, fq * 8);
#define PG8_SA(b, h) (((b) * 2 + (h)) * HTB)
#define PG8_SB(b, h) ((4 + (b) * 2 + (h)) * HTB)
#define PG8_STAGE(bufoff, gbase, offs) do { _Pragma("unroll") for (int _i = 0; _i < 2; ++_i) \
        __builtin_amdgcn_global_load_lds((const unsigned*)((gbase) + (offs)[_i]), (LAS unsigned*)(lds + (bufoff) + ldsw + _i * 8192), 16, 0, 0); } while (0)
#define PG8_STA(b, h, tau) PG8_STAGE(PG8_SA(b, h), sA + (size_t)(tau) * kstep, offA[h])
#define PG8_STB(b, h, tau) PG8_STAGE(PG8_SB(b, h), sB + (size_t)(tau) * kstep + (h) * hstepB, offB0)
#define PG8_LDA(dst, b, h) do { _Pragma("unroll") for (int m = 0; m < 4; ++m) _Pragma("unroll") for (int k = 0; k < 2; ++k) dst[m][k] = *(const LAS bf16x8*)(lds + PG8_SA(b, h) + aoff + m * 2048 + k * 1024); } while (0)
#define PG8_LDB(dst, b, h) do { _Pragma("unroll") for (int n = 0; n < 2; ++n) _Pragma("unroll") for (int k = 0; k < 2; ++k) dst[n][k] = *(const LAS bf16x8*)(lds + PG8_SB(b, h) + boff + n * 2048 + k * 1024); } while (0)
#define PG8_MMA(ai, bj, At, Bt) do { __builtin_amdgcn_s_setprio(1); _Pragma("unroll") for (int m = 0; m < 4; ++m) _Pragma("unroll") for (int n = 0; n < 2; ++n) _Pragma("unroll") for (int k = 0; k < 2; ++k) \
        acc[ai][bj][m][n] = __builtin_amdgcn_mfma_f32_16x16x32_bf16(Bt[n][k], At[m][k], acc[ai][bj][m][n], 0, 0, 0); __builtin_amdgcn_s_setprio(0); } while (0)
#define PG8_WAIT_V(n) asm volatile("s_waitcnt vmcnt(" #n ")" ::: "memory")
#define PG8_WAIT_L(n) asm volatile("s_waitcnt lgkmcnt(" #n ")" ::: "memory")
#define PG8_BAR __builtin_amdgcn_s_barrier()
#define PG8_SCHED __builtin_amdgcn_sched_barrier(0)
    Unit cur, nxt; int ui = 0;
    if (!S.next(0, cur)) return;
    f32x4 acc[2][2][4][2];
#pragma unroll
    for (int a = 0; a < 2; ++a)
#pragma unroll
        for (int b = 0; b < 2; ++b)
#pragma unroll
            for (int m = 0; m < 4; ++m)
#pragma unroll
                for (int n = 0; n < 2; ++n) acc[a][b][m][n] = (f32x4){0.f, 0.f, 0.f, 0.f};
    bf16x8 At[4][2], B0[2][2], B1[2][2];
    const char* sA = P.a_base(cur); const char* sB = P.b_base(cur);
    S.a_ready(cur);
    P.a_offs(cur, sR[0], sC[0], sR[1], sC[1], offA);
    PG8_STB(0, 0, 0); PG8_STB(0, 1, 0); PG8_STA(0, 0, 0); PG8_STA(0, 1, 0);
    if (wr == 1) PG8_BAR;
    PG8_WAIT_V(2); PG8_BAR;
    PG8_STB(1, 0, 1); PG8_STA(1, 0, 1); PG8_STB(1, 1, 1);
    PG8_WAIT_V(6); PG8_BAR;
    for (;;) {
        const bool has_next = S.next(ui + 1, nxt);
        const char* nA = has_next ? P.a_base(nxt) : sA; const char* nB = has_next ? P.b_base(nxt) : sB;
        const bool skip1 = Sched::HALF_SKIP && cur.half != 0;
        for (int t = 0; t < nt; t += 2) {
            const bool last = (t == nt - 2);
            if (last && has_next) S.a_ready(nxt);
            PG8_LDB(B0, 0, 0); PG8_LDB(B1, 0, 1); PG8_SCHED; PG8_LDA(At, 0, 0); PG8_STA(1, 1, t + 1);
            PG8_WAIT_V(8); PG8_WAIT_L(0); PG8_BAR; PG8_MMA(0, 0, At, B0); PG8_MMA(0, 1, At, B1); PG8_BAR; PG8_SCHED;
            if (last) {
                sA = nA - (size_t)nt * kstep; sB = nB - (size_t)nt * kstep;
                if (Prob::GATHER) { if (has_next) P.a_offs(nxt, sR[0], sC[0], sR[1], sC[1], offA); }
            }
            if (!skip1) PG8_LDA(At, 0, 1); PG8_STB(0, 0, t + 2); PG8_STB(0, 1, t + 2); PG8_STA(0, 0, t + 2);
            PG8_WAIT_V(8); PG8_WAIT_L(0); PG8_BAR; if (!skip1) { PG8_MMA(1, 0, At, B0); PG8_MMA(1, 1, At, B1); } PG8_BAR; PG8_SCHED;
            PG8_LDB(B0, 1, 0); PG8_LDB(B1, 1, 1); PG8_SCHED; PG8_LDA(At, 1, 0); PG8_STA(0, 1, t + 2);
            PG8_WAIT_V(8); PG8_WAIT_L(0); PG8_BAR; PG8_MMA(0, 0, At, B0); PG8_MMA(0, 1, At, B1); PG8_BAR; PG8_SCHED;
            if (!skip1) PG8_LDA(At, 1, 1); PG8_STB(1, 0, t + 3); PG8_STB(1, 1, t + 3); PG8_STA(1, 0, t + 3);
            PG8_WAIT_V(8); PG8_WAIT_L(0); PG8_BAR; if (!skip1) { PG8_MMA(1, 0, At, B0); PG8_MMA(1, 1, At, B1); } PG8_BAR; PG8_SCHED;
        }
        if (wr == 0) PG8_BAR;
        E(acc, cur, wr, wc, fr, fq); S.done(cur);
        if (!has_next) break;
#pragma unroll
        for (int a = 0; a < 2; ++a)
#pragma unroll
            for (int b = 0; b < 2; ++b)
#pragma unroll
                for (int m = 0; m < 4; ++m)
#pragma unroll
                    for (int n = 0; n < 2; ++n) acc[a][b][m][n] = (f32x4){0.f, 0.f, 0.f, 0.f};
        cur = nxt; ++ui; sA = nA; sB = nB;
        if (wr == 1) PG8_BAR;
    }
    PG8_WAIT_V(0);
    PG8_BAR;
#undef PG8_SA
#undef PG8_SB
#undef PG8_STAGE
#undef PG8_STA
#undef PG8_STB
#undef PG8_LDA
#undef PG8_LDB
#undef PG8_MMA
#undef PG8_WAIT_V
#undef PG8_WAIT_L
#undef PG8_BAR
#undef PG8_SCHED
}

template <class Epi, class Sched>
__device__ __forceinline__ void gemm_phase_dual(LAS unsigned char* lds, const bf16* A1, const bf16* Bt1, int K1, const bf16* A2, const bf16* Bt2, int K2, const Sched& S, const Epi& E) {
    const int tid = threadIdx.x, wid = __builtin_amdgcn_readfirstlane(tid >> 6), lane = tid & 63, wr = wid >> 2, wc = wid & 3, fr = lane & 15, fq = lane >> 4;
    const int nt1 = K1 / BK, nt = (K1 + K2) / BK;
    unsigned offB1[2][2], offA1[2][2]; const unsigned dK2 = (unsigned)(2 * (K2 - K1));
#pragma unroll
    for (int i = 0; i < 2; ++i) { int R, C; stage_rc(tid * 16 + i * 8192, R, C); const int Rb = (R & ~31) + perm32(R & 31);
        offA1[0][i] = (unsigned)(R * K1 + C) * 2u; offA1[1][i] = offA1[0][i] + (unsigned)(HALF * K1 * 2); offB1[0][i] = (unsigned)(Rb * K1 + C) * 2u; offB1[1][i] = offB1[0][i] + (unsigned)(HALF * K1 * 2); }
    const size_t kstep = (size_t)(BK * 2);
    const unsigned ldsw = (unsigned)wid * 1024u;
    const int aoff = lds_byte(wr * 64 + fr, fq * 8), boff = lds_byte(wc * 32 + fr, fq * 8);
#define PG8_SA(b, h) (((b) * 2 + (h)) * HTB)
#define PG8_SB(b, h) ((4 + (b) * 2 + (h)) * HTB)
#define PG8_STX(bufoff, tau, g1, g2, o1, o2) do { const int _t = (tau); const bool _s2 = _t >= nt1; const long long _d = _s2 ? (long long)((g2) - (g1)) - (long long)nt1 * (long long)kstep : 0ll; const char* _g = (g1) + (size_t)_t * kstep + _d; \
        _Pragma("unroll") for (int _i = 0; _i < 2; ++_i) { const unsigned _o = (o1)[_i] + (_s2 ? ((o1)[_i] >> 11) * dK2 : 0u); \
        __builtin_amdgcn_global_load_lds((const unsigned*)(_g + _o), (LAS unsigned*)(lds + (bufoff) + ldsw + _i * 8192), 16, 0, 0); } } while (0)
#define PG8_STA(b, h, tau) PG8_STX(PG8_SA(b, h), tau, sA1, sA2, offA1[h], 0)
#define PG8_STB(b, h, tau) PG8_STX(PG8_SB(b, h), tau, sB1, sB2, offB1[h], 0)
#define PG8_LDA(dst, b, h) do { _Pragma("unroll") for (int m = 0; m < 4; ++m) _Pragma("unroll") for (int k = 0; k < 2; ++k) dst[m][k] = *(const LAS bf16x8*)(lds + PG8_SA(b, h) + aoff + m * 2048 + k * 1024); } while (0)
#define PG8_LDB(dst, b, h) do { _Pragma("unroll") for (int n = 0; n < 2; ++n) _Pragma("unroll") for (int k = 0; k < 2; ++k) dst[n][k] = *(const LAS bf16x8*)(lds + PG8_SB(b, h) + boff + n * 2048 + k * 1024); } while (0)
#define PG8_MMA(ai, bj, At, Bt) do { __builtin_amdgcn_s_setprio(1); _Pragma("unroll") for (int m = 0; m < 4; ++m) _Pragma("unroll") for (int n = 0; n < 2; ++n) _Pragma("unroll") for (int k = 0; k < 2; ++k) \
        acc[ai][bj][m][n] = __builtin_amdgcn_mfma_f32_16x16x32_bf16(Bt[n][k], At[m][k], acc[ai][bj][m][n], 0, 0, 0); __builtin_amdgcn_s_setprio(0); } while (0)
#define PG8_WAIT_V(n) asm volatile("s_waitcnt vmcnt(" #n ")" ::: "memory")
#define PG8_WAIT_L(n) asm volatile("s_waitcnt lgkmcnt(" #n ")" ::: "memory")
#define PG8_BAR __builtin_amdgcn_s_barrier()
#define PG8_SCHED __builtin_amdgcn_sched_barrier(0)
    Unit cur, nxt; int ui = 0;
    if (!S.next(0, cur)) return;
    f32x4 acc[2][2][4][2];
#pragma unroll
    for (int a = 0; a < 2; ++a)
#pragma unroll
        for (int b = 0; b < 2; ++b)
#pragma unroll
            for (int m = 0; m < 4; ++m)
#pragma unroll
                for (int n = 0; n < 2; ++n) acc[a][b][m][n] = (f32x4){0.f, 0.f, 0.f, 0.f};
    bf16x8 At[4][2], B0[2][2], B1[2][2];
    const char* sA1 = (const char*)A1 + (size_t)cur.pm * 256 * K1 * 2; const char* sB1 = (const char*)Bt1 + (size_t)cur.pn * 256 * K1 * 2;
    const char* sA2 = (const char*)A2 + (size_t)cur.pm * 256 * K2 * 2; const char* sB2 = (const char*)Bt2 + (size_t)cur.pn * 256 * K2 * 2;
    PG8_STB(0, 0, 0); PG8_STB(0, 1, 0); PG8_STA(0, 0, 0); PG8_STA(0, 1, 0);
    if (wr == 1) PG8_BAR;
    PG8_WAIT_V(2); PG8_BAR;
    PG8_STB(1, 0, 1); PG8_STA(1, 0, 1); PG8_STB(1, 1, 1);
    PG8_WAIT_V(6); PG8_BAR;
    for (;;) {
        const bool has_next = S.next(ui + 1, nxt);
        const int npm = has_next ? nxt.pm : cur.pm, npn = has_next ? nxt.pn : cur.pn;
        const char* nA1 = (const char*)A1 + (size_t)npm * 256 * K1 * 2; const char* nB1 = (const char*)Bt1 + (size_t)npn * 256 * K1 * 2;
        const char* nA2 = (const char*)A2 + (size_t)npm * 256 * K2 * 2; const char* nB2 = (const char*)Bt2 + (size_t)npn * 256 * K2 * 2;
        for (int t = 0; t < nt; t += 2) {
            const bool last = (t == nt - 2);
            const int t2 = last ? 0 : t + 2, t3 = last ? 1 : t + 3;
            if (t == nt1) { E.mid(acc, cur, wr, wc, fr, fq); PG8_SCHED; }
            PG8_LDB(B0, 0, 0); PG8_LDB(B1, 0, 1); PG8_SCHED; PG8_LDA(At, 0, 0); PG8_STA(1, 1, t + 1);
            PG8_WAIT_V(8); PG8_WAIT_L(0); PG8_BAR; PG8_MMA(0, 0, At, B0); PG8_MMA(0, 1, At, B1); PG8_BAR; PG8_SCHED;
            if (last) { sA1 = nA1; sB1 = nB1; sA2 = nA2; sB2 = nB2; }
            PG8_LDA(At, 0, 1); PG8_STB(0, 0, t2); PG8_STB(0, 1, t2); PG8_STA(0, 0, t2);
            PG8_WAIT_V(8); PG8_WAIT_L(0); PG8_BAR; PG8_MMA(1, 0, At, B0); PG8_MMA(1, 1, At, B1); PG8_BAR; PG8_SCHED;
            PG8_LDB(B0, 1, 0); PG8_LDB(B1, 1, 1); PG8_SCHED; PG8_LDA(At, 1, 0); PG8_STA(0, 1, t2);
            PG8_WAIT_V(8); PG8_WAIT_L(0); PG8_BAR; PG8_MMA(0, 0, At, B0); PG8_MMA(0, 1, At, B1); PG8_BAR; PG8_SCHED;
            PG8_LDA(At, 1, 1); PG8_STB(1, 0, t3); PG8_STB(1, 1, t3); PG8_STA(1, 0, t3);
            PG8_WAIT_V(8); PG8_WAIT_L(0); PG8_BAR; PG8_MMA(1, 0, At, B0); PG8_MMA(1, 1, At, B1); PG8_BAR; PG8_SCHED;
        }
        if (wr == 0) PG8_BAR;
        E(acc, cur, wr, wc, fr, fq);
        if (!has_next) break;
#pragma unroll
        for (int a = 0; a < 2; ++a)
#pragma unroll
            for (int b = 0; b < 2; ++b)
#pragma unroll
                for (int m = 0; m < 4; ++m)
#pragma unroll
                    for (int n = 0; n < 2; ++n) acc[a][b][m][n] = (f32x4){0.f, 0.f, 0.f, 0.f};
        cur = nxt; ++ui;
        if (wr == 1) PG8_BAR;
    }
    PG8_WAIT_V(0);
    PG8_BAR;
#undef PG8_SA
#undef PG8_SB
#undef PG8_STX
#undef PG8_STA
#undef PG8_STB
#undef PG8_LDA
#undef PG8_LDB
#undef PG8_MMA
#undef PG8_WAIT_V
#undef PG8_WAIT_L
#undef PG8_BAR
#undef PG8_SCHED
}
__device__ __forceinline__ v4u pack8(f32x4 v0, f32x4 v1) { v4u w; w.x = cvt_pk_bf16(v0[0], v0[1]); w.y = cvt_pk_bf16(v0[2], v0[3]); w.z = cvt_pk_bf16(v1[0], v1[1]); w.w = cvt_pk_bf16(v1[2], v1[3]); return w; }
__device__ __forceinline__ float sigm(float v) { return __builtin_amdgcn_rcpf(1.0f + __expf(-v)); }

struct EpiMergedDual {
    static constexpr bool PERM = true;
    const bf16* ga; const bf16* gb; bf16* merged;
    __device__ __forceinline__ void mid(f32x4 (&acc)[2][2][4][2], const Unit& u, int wr, int wc, int fr, int fq) const {
        int row0 = u.pm * BM + wr * 64 + fr; const int col0 = u.pn * BM + wc * 32 + 8 * fq;
        asm volatile("" : "+v"(row0));
#pragma unroll
        for (int ai = 0; ai < 2; ++ai)
#pragma unroll
            for (int m = 0; m < 4; ++m) { const size_t o = (size_t)(row0 + ai * HALF + m * 16) * 1024 + col0;
#pragma unroll
                for (int bj = 0; bj < 2; ++bj) { const v4u a = *(const v4u*)(ga + o + bj * HALF), b = *(const v4u*)(gb + o + bj * HALF);
                    f32x4 r0 = {bflo(a.x) * __builtin_amdgcn_rcpf(bflo(b.x)), bfhi(a.x) * __builtin_amdgcn_rcpf(bfhi(b.x)), bflo(a.y) * __builtin_amdgcn_rcpf(bflo(b.y)), bfhi(a.y) * __builtin_amdgcn_rcpf(bfhi(b.y))};
                    f32x4 r1 = {bflo(a.z) * __builtin_amdgcn_rcpf(bflo(b.z)), bfhi(a.z) * __builtin_amdgcn_rcpf(bfhi(b.z)), bflo(a.w) * __builtin_amdgcn_rcpf(bflo(b.w)), bfhi(a.w) * __builtin_amdgcn_rcpf(bfhi(b.w))};
                    acc[ai][bj][m][0] = acc[ai][bj][m][0] * r0; acc[ai][bj][m][1] = acc[ai][bj][m][1] * r1; }
                asm volatile("" ::: "memory"); }
    }
    __device__ __forceinline__ void operator()(const f32x4 (&acc)[2][2][4][2], const Unit& u, int wr, int wc, int fr, int fq) const {
        int row0 = u.pm * BM + wr * 64 + fr; const int col0 = u.pn * BM + wc * 32 + 8 * fq;
        asm volatile("" : "+v"(row0));
#pragma unroll
        for (int ai = 0; ai < 2; ++ai)
#pragma unroll
            for (int m = 0; m < 4; ++m) { const size_t o = (size_t)(row0 + ai * HALF + m * 16) * 1024 + col0;
#pragma unroll
                for (int bj = 0; bj < 2; ++bj) { const v4u g = *(const v4u*)(gb + o + bj * HALF);
                    f32x4 g0 = {bflo(g.x), bfhi(g.x), bflo(g.y), bfhi(g.y)}, g1 = {bflo(g.z), bfhi(g.z), bflo(g.w), bfhi(g.w)};
                    *(v4u*)(merged + o + bj * HALF) = pack8(g0 * acc[ai][bj][m][0], g1 * acc[ai][bj][m][1]); } }
    }
};
struct EpiProj {
    static constexpr bool PERM = true;
    unsigned char* ws;
    __device__ __forceinline__ void operator()(const f32x4 (&acc)[2][2][4][2], const Unit& u, int wr, int wc, int fr, int fq) const {
        const int row0 = u.pm * BM + wr * 64 + fr, cw = wc * 32 + 8 * fq, pn = u.pn;
        if (pn == 4) {
#pragma unroll
            for (int ai = 0; ai < 2; ++ai)
#pragma unroll
                for (int m = 0; m < 4; ++m) { const size_t row = (size_t)(row0 + ai * HALF + m * 16);
                    float* cr = (float*)(ws + WS_CKVRAW) + row * 128 + cw; *(f32x4*)cr = acc[ai][0][m][0]; *(f32x4*)(cr + 4) = acc[ai][0][m][1];
                    if (cw < 64) *(v4u*)((bf16*)(ws + WS_KIDX) + ((((row >> 4) * 8 + (cw >> 3)) * 16 + (row & 15)) << 3)) = pack8(acc[ai][1][m][0], acc[ai][1][m][1]);
                    else if (cw == 64) { float* wr_ = (float*)(ws + WS_WIDX) + row * 8; *(f32x4*)wr_ = acc[ai][1][m][0] * IDXW_SCALE; *(f32x4*)(wr_ + 4) = acc[ai][1][m][1] * IDXW_SCALE; } }
            return;
        }
        bf16* base; int ld, c0; float sc = 1.f; bool sg = false;
        if (pn < 4) { base = (bf16*)(ws + WS_QLAT); ld = 1024; c0 = pn * 256; sc = ATT_SCALE; }
        else if (pn < 7) { base = (bf16*)(ws + WS_QIDX); ld = 512; c0 = (pn - 5) * 256; }
        else if (pn < 9) { base = (bf16*)(ws + WS_QB); ld = 512; c0 = (pn - 7) * 256; sc = 0.125f; }
        else if (pn == 9) { base = (bf16*)(ws + WS_KB); ld = 128; c0 = 0; }
        else if (pn < 14) { base = (bf16*)(ws + WS_GA); ld = 1024; c0 = (pn - 10) * 256; sg = true; }
        else { base = (bf16*)(ws + WS_GB); ld = 1024; c0 = (pn - 14) * 256; sg = true; }
        const size_t bjstep = (pn == 9) ? (size_t)(WS_VB - WS_KB) / 2 : (size_t)HALF;
#pragma unroll
        for (int ai = 0; ai < 2; ++ai)
#pragma unroll
            for (int m = 0; m < 4; ++m) { bf16* rowp = base + (size_t)(row0 + ai * HALF + m * 16) * ld + c0 + cw;
#pragma unroll
                for (int bj = 0; bj < 2; ++bj) { f32x4 v0 = acc[ai][bj][m][0], v1 = acc[ai][bj][m][1];
                    if (sg) {
#pragma unroll
                        for (int j = 0; j < 4; ++j) { v0[j] = sigm(v0[j]); v1[j] = sigm(v1[j]); } }
                    else { v0 = v0 * sc; v1 = v1 * sc; }
                    *(v4u*)(rowp + bj * bjstep) = pack8(v0, v1); } }
    }
};
struct EpiWoutM {
    static constexpr bool PERM = true;
    const float* x; bf16* h1b;
    __device__ __forceinline__ void operator()(const f32x4 (&acc)[2][2][4][2], const Unit& u, int wr, int wc, int fr, int fq) const {
        const int row0 = u.pm * BM + wr * 64 + fr, col0 = u.pn * BM + wc * 32 + 8 * fq;
#pragma unroll
        for (int ai = 0; ai < 2; ++ai)
#pragma unroll
            for (int m = 0; m < 4; ++m) { const size_t o = (size_t)(row0 + ai * HALF + m * 16) * 1024 + col0;
#pragma unroll
                for (int bj = 0; bj < 2; ++bj) { const f32x4 x0 = *(const f32x4*)(x + o + bj * HALF), x1 = *(const f32x4*)(x + o + bj * HALF + 4);
                    *(v4u*)(h1b + o + bj * HALF) = pack8(x0 * ALPHA + acc[ai][bj][m][0], x1 * ALPHA + acc[ai][bj][m][1]); } }
    }
};
constexpr int MOE_TB_OFF = 131072 + 1024;
constexpr int CW_RDY = 16384;
constexpr int CW_TMO = 8;
struct MoeOrder {
    static constexpr bool HALF_SKIP = true;
    const LAS int* tb; int npn, G, c; unsigned* ctl;
    __device__ bool next(int i, Unit& u) const {
        const int L = i * G + c; if (L >= tb[32] * npn) return false;
        const int p = L / npn, pn = L - p * npn, rt = tb[128 + p]; int e = 0;
        for (int j = 1; j < 32; ++j) e = (tb[j] <= rt) ? j : e;
        u.pm = rt; u.pn = pn; u.pb = e * npn + pn; u.aux = e; u.half = p >= tb[33] ? 1 : 0; return true;
    }
    __device__ __forceinline__ void a_ready(const Unit&) const {}
    __device__ __forceinline__ void done(const Unit& u) const {
        asm volatile("s_waitcnt vmcnt(0)" ::: "memory");
        if ((threadIdx.x & 63) == 0) __hip_atomic_fetch_add(ctl + CW_RDY + 64 * u.pm, 1u, __ATOMIC_RELAXED, __HIP_MEMORY_SCOPE_AGENT);
    }
};
struct MoeDownOrder {
    static constexpr bool HALF_SKIP = false;
    const LAS int* tb; int G, c; unsigned* ctl;
    __device__ bool next(int i, Unit& u) const {
        const int nT = tb[32], nD = 4 * nT; int R = 2 * nT - G; R = R < 0 ? 0 : (R > G ? G : R);
        int L;
        if (c >= R) { L = (i < 4) ? i * (G - R) + (c - R) : 4 * (G - R) + (i - 4) * G + c; }
        else { L = 4 * (G - R) + i * G + c; }
        if (L >= nD) return false;
        const int p = L >> 2, pn = L & 3, rt = tb[128 + p]; int e = 0;
        for (int j = 1; j < 32; ++j) e = (tb[j] <= rt) ? j : e;
        u.pm = rt; u.pn = pn; u.pb = e * 4 + pn; u.aux = e; u.half = p >= tb[33] ? 1 : 0; return true;
    }
    __device__ __forceinline__ void a_ready(const Unit& u) const {
        if (threadIdx.x < 64) {
            unsigned* w = ctl + CW_RDY + 64 * u.pm; unsigned sp = 0;
            while ((unsigned)__builtin_amdgcn_readfirstlane(__hip_atomic_load(w, __ATOMIC_RELAXED, __HIP_MEMORY_SCOPE_AGENT)) < 16u) {
                __builtin_amdgcn_s_sleep(2);
                if ((++sp & 1023u) == 0u) { if (__hip_atomic_load(ctl + CW_TMO, __ATOMIC_RELAXED, __HIP_MEMORY_SCOPE_AGENT) != 0u) break;
                    if (sp > (1u << 22)) { __hip_atomic_store(ctl + CW_TMO, 1u, __ATOMIC_RELAXED, __HIP_MEMORY_SCOPE_AGENT); break; } } }
            __builtin_amdgcn_fence(__ATOMIC_ACQUIRE, "agent");
            asm volatile("s_waitcnt vmcnt(0)" ::: "memory");
        }
        asm volatile("" ::: "memory"); __builtin_amdgcn_s_barrier(); asm volatile("" ::: "memory");
    }
    __device__ __forceinline__ void done(const Unit&) const {}
};
struct GatherProb {
    static constexpr bool GATHER = true;
    const bf16* A; const bf16* Bt; int K; const LAS int* tb; const unsigned* list;
    __device__ __forceinline__ const char* a_base(const Unit&) const { return (const char*)A; }
    __device__ __forceinline__ const char* b_base(const Unit& u) const { return (const char*)Bt + (size_t)u.pb * 256 * K * 2; }
    __device__ __forceinline__ void a_offs(const Unit& u, int R0, int C0, int R1, int C1, unsigned (&o)[2][2]) const {
        const int e = u.aux, lbase = (u.pm - tb[e]) * 256, cnt = tb[64 + e];
        const unsigned* le = list + (size_t)e * 32768;
#pragma unroll
        for (int h = 0; h < 2; ++h) { const int l0 = lbase + h * HALF + R0, l1 = lbase + h * HALF + R1;
            const unsigned t0 = le[l0 < cnt ? l0 : 0] >> 1, t1 = le[l1 < cnt ? l1 : 0] >> 1;
            o[h][0] = (t0 * (unsigned)K + (unsigned)C0) * 2u; o[h][1] = (t1 * (unsigned)K + (unsigned)C1) * 2u; }
    }
};
struct EpiGU {
    static constexpr bool PERM = true;
    bf16* hbuf;
    __device__ __forceinline__ void operator()(const f32x4 (&acc)[2][2][4][2], const Unit& u, int wr, int wc, int fr, int fq) const {
        const int row0 = u.pm * BM + wr * 64 + fr, col0 = u.pn * HALF + wc * 32 + 8 * fq;
#pragma unroll
        for (int ai = 0; ai < 2; ++ai) if (ai == 0 || !u.half)
#pragma unroll
            for (int m = 0; m < 4; ++m) { f32x4 h0, h1;
#pragma unroll
                for (int j = 0; j < 4; ++j) { const float g0 = acc[ai][0][m][0][j], g1 = acc[ai][0][m][1][j];
                    h0[j] = g0 * sigm(g0) * acc[ai][1][m][0][j]; h1[j] = g1 * sigm(g1) * acc[ai][1][m][1][j]; }
                { const v4u hv = pack8(h0, h1); bf16* hp = hbuf + (size_t)(row0 + ai * HALF + m * 16) * 256 + col0;
                  asm volatile("global_store_dwordx4 %0, %1, off sc1\n\ts_nop 1" :: "v"(hp), "v"(hv) : "memory"); } }
    }
};
struct EpiDown {
    static constexpr bool PERM = true;
    bf16* slot; const LAS int* tb; const unsigned* list; const float* pw;
    __device__ __forceinline__ void operator()(const f32x4 (&acc)[2][2][4][2], const Unit& u, int wr, int wc, int fr, int fq) const {
        const int e = u.aux, lbase = (u.pm - tb[e]) * 256 + wr * 64 + fr, cnt = tb[64 + e], col0 = u.pn * BM + wc * 32 + 8 * fq;
        const unsigned* le = list + (size_t)e * 32768;
        unsigned pr[2][4]; float w[2][4];
#pragma unroll
        for (int ai = 0; ai < 2; ++ai)
#pragma unroll
            for (int m = 0; m < 4; ++m) { const int l = lbase + ai * HALF + m * 16; pr[ai][m] = le[l < cnt ? l : 0]; }
#pragma unroll
        for (int ai = 0; ai < 2; ++ai)
#pragma unroll
            for (int m = 0; m < 4; ++m) w[ai][m] = pw[pr[ai][m]];
#pragma unroll
        for (int ai = 0; ai < 2; ++ai)
#pragma unroll
            for (int m = 0; m < 4; ++m) { const int l = lbase + ai * HALF + m * 16;
                if (l < cnt) { bf16* rowp = slot + (size_t)pr[ai][m] * 1024 + col0;
#pragma unroll
                    for (int bj = 0; bj < 2; ++bj) *(v4u*)(rowp + bj * HALF) = pack8(acc[ai][bj][m][0] * w[ai][m], acc[ai][bj][m][1] * w[ai][m]); } }
    }
};
}

struct Args { const float* in[20]; float* out; unsigned char* ws; int ph_lo, ph_hi; };
__global__ void __launch_bounds__(NTHR, 2) fwd_kernel(Args args) {
    extern __shared__ __attribute__((aligned(16))) unsigned char lds_raw[];
    Ctx c;
    c.lds = (LAS unsigned char*)lds_raw;
    c.tid = threadIdx.x; c.lane = c.tid & 63; c.wave = __builtin_amdgcn_readfirstlane(c.tid >> 6); c.bid = blockIdx.x; c.G = gridDim.x;
    c.x = args.in[0]; c.w_in = args.in[1]; c.kv_g = args.in[2]; c.w_uv = args.in[3]; c.w_a = args.in[4]; c.sinks = args.in[5]; c.w_b = args.in[6]; c.w_out = args.in[7]; c.rel_bias = args.in[8];
    c.ln1_g = args.in[9]; c.ln1_b = args.in[10]; c.w_group = args.in[11]; c.b_group = args.in[12]; c.w_router = args.in[13]; c.b_router = args.in[14]; c.w_gate = args.in[15]; c.w_up = args.in[16]; c.w_down = args.in[17];
    c.ln2_g = args.in[18]; c.ln2_b = args.in[19]; c.out = args.out; c.ws = args.ws; unsigned char* ws = args.ws;
    c.ctl = (unsigned*)(ws + WS_CTL);
    volatile LAS unsigned* MISC = (volatile LAS unsigned*)(c.lds + MISC_OFF);
    if (c.tid < 32) MISC[c.tid] = 0u;
    __syncthreads();
    XcdBarrier bar; bar.bar = c.ctl + CW_BAR; bar.x = 0; bar.st = nullptr;
    if (MK_N_LAUNCHES == 1) bar = xcd_barrier_post(c.ctl + CW_BAR, MISC + 8);
    const int lo = args.ph_lo, hi = args.ph_hi;
#define IN(k) (lo <= (k) && (k) < hi)
#define SEAM(k) do { if (IN(k) && IN((k) + 1)) xcd_barrier(bar); } while (0)
    bf16* merged = ((bf16*)(c.ws + WS_QLAT)); bf16* x1b = ((bf16*)(c.ws + WS_XB));

    if (IN(0)) { p0_prologue(c); } SEAM(0);
    if (IN(1)) { pg8::DenseProb P{(const bf16*)(c.ws + WS_XB), (const bf16*)(c.ws + WS_WIN), 1024}; pg8::StaticOrder S; S.init(NTOK, NPROJ, c.G, c.bid); pg8::EpiProj E{c.ws};
        pg8::gemm_phase(c.lds, P, S, E); } SEAM(1);
    if (IN(2)) { p_rmsnorm(c); __syncthreads(); p2_indexer_topk(c); } SEAM(2);
    if (IN(3)) { p3a_dsa(c); p3b_swa(c); } SEAM(3);
    if (IN(4)) { pg8::StaticOrder S; S.init(NTOK, 1024, c.G, c.bid); pg8::EpiMergedDual E{(const bf16*)(c.ws + WS_GA), (const bf16*)(c.ws + WS_GB), merged};
        pg8::gemm_phase_dual(c.lds, (const bf16*)(c.ws + WS_XB), (const bf16*)(c.ws + WS_WC), 1024, (const bf16*)(c.ws + WS_QB), (const bf16*)(c.ws + WS_WB), 512, S, E); } SEAM(4);
    if (IN(5)) { pg8::DenseProb P{(const bf16*)merged, (const bf16*)(c.ws + WS_WO), 1024}; pg8::StaticOrder S; S.init(NTOK, 1024, c.G, c.bid); pg8::EpiWoutM E{c.x, (bf16*)(c.ws + WS_H1B)};
        pg8::gemm_phase(c.lds, P, S, E); } SEAM(5);
    if (IN(6)) { p6_ln_router(c, x1b); } SEAM(6);
    LAS int* tb = (LAS int*)(c.lds + pg8::MOE_TB_OFF);
    if (IN(7) || IN(8)) {
        if (c.tid < 32) { const int e = c.tid, cnt = (int)__hip_atomic_load(c.ctl + CW_CNT + e, __ATOMIC_RELAXED, __HIP_MEMORY_SCOPE_AGENT);
            const int ne = (cnt + 255) >> 8, hh_ = (ne > 0 && cnt - (ne - 1) * 256 <= 128) ? 1 : 0, nfe = ne - hh_;
            int a = ne, f = nfe, h = hh_;
#pragma unroll
            for (int d = 1; d < 32; d <<= 1) { const int ta = __shfl_up(a, d, 32), tf = __shfl_up(f, d, 32), th = __shfl_up(h, d, 32); if (e >= d) { a += ta; f += tf; h += th; } }
            const int nT = __shfl(a, 31, 32), nF = __shfl(f, 31, 32), tbe = a - ne;
            tb[e] = tbe; tb[64 + e] = cnt;
            for (int k = 0; k < nfe; ++k) tb[128 + (f - nfe) + k] = tbe + k;
            if (hh_) tb[128 + nF + h - 1] = tbe + ne - 1;
            if (e == 0) { tb[32] = nT; tb[33] = nF; } }
        __syncthreads();
    }
    if (IN(7)) { pg8::GatherProb P{(const bf16*)x1b, (const bf16*)(c.ws + WS_WGU), 1024, tb, (const unsigned*)(c.ws + WS_LIST)}; pg8::MoeOrder S{tb, 2, c.G, c.bid, c.ctl}; pg8::EpiGU E{(bf16*)(c.ws + WS_QLAT)};
        pg8::gemm_phase(c.lds, P, S, E); }
    if (MK_N_LAUNCHES != 1) SEAM(7);
    if (IN(8)) { pg8::DenseProb P{(const bf16*)(c.ws + WS_QLAT), (const bf16*)(c.ws + WS_WD), 256}; pg8::MoeDownOrder S{tb, c.G, c.bid, c.ctl};
        pg8::EpiDown E{(bf16*)(c.ws + WS_SLOT), tb, (const unsigned*)(c.ws + WS_LIST), (const float*)(c.ws + WS_PW)};
        pg8::gemm_phase(c.lds, P, S, E); } SEAM(8);
    if (IN(9)) { p9_ln2(c); }
#undef IN
#undef SEAM
}

extern "C" void kernel_launch(void* const* d_in, const int* in_sizes, int n_in, void* d_out, int out_size, void* d_ws, size_t ws_size, hipStream_t stream) {
    static int grid = 0;
    if (grid == 0) {
        if (n_in != 20 || out_size != NTOK * D || ws_size < WS_END) { fprintf(stderr, "kernel_launch: unexpected shapes (n_in %d out %d ws %zu)\n", n_in, out_size, ws_size); grid = -1; return; }
        int dev = 0, cus = 0, per_cu = 0;
        if (hipGetDevice(&dev) != hipSuccess || hipDeviceGetAttribute(&cus, hipDeviceAttributeMultiprocessorCount, dev) != hipSuccess) { grid = -1; return; }
        if (hipFuncSetAttribute((const void*)fwd_kernel, hipFuncAttributeMaxDynamicSharedMemorySize, LDS_BYTES) != hipSuccess) { fprintf(stderr, "kernel_launch: hipFuncSetAttribute failed\n"); grid = -1; return; }
        if (hipOccupancyMaxActiveBlocksPerMultiprocessor(&per_cu, (const void*)fwd_kernel, NTHR, LDS_BYTES) != hipSuccess || per_cu < 1) { fprintf(stderr, "kernel_launch: occupancy query says %d\n", per_cu); }
        (void)hipGetLastError();
        grid = cus;
    }
    if (grid < 0) return;
    if (hipMemsetAsync((char*)d_ws + WS_CTL, 0, CTL_ZERO_BYTES, stream) != hipSuccess) return;
    Args a{};
    for (int i = 0; i < 20; ++i) a.in[i] = (const float*)d_in[i];
    a.out = (float*)d_out; a.ws = (unsigned char*)d_ws;
    if (MK_N_LAUNCHES == 1) { a.ph_lo = 0; a.ph_hi = NPHASE; hipLaunchKernelGGL(fwd_kernel, dim3(grid), dim3(NTHR), LDS_BYTES, stream, a); }
    else { for (int p = 0; p < NPHASE; ++p) { a.ph_lo = p; a.ph_hi = p + 1; hipLaunchKernelGGL(fwd_kernel, dim3(grid), dim3(NTHR), LDS_BYTES, stream, a); } }
}
```

```cpp
#include <hip/hip_runtime.h>
#include <cstdio>
#include <cstdint>

#ifndef MK_N_LAUNCHES
#define MK_N_LAUNCHES 1
#endif

constexpr int D = 1024, BATCH = 8, SEQ = 2048, NTOK = BATCH * SEQ;
constexpr int A_HEADS = 8, A_LAT = 128, IDX_HEADS = 8, IDX_DIM = 64, KSEL = 256;
constexpr int B_HEADS = 8, B_HD = 64, WINDOW = 128;
constexpr int NEXP = 32, EPG = 8, NGRP = 4, DEXP = 256;
constexpr int IN_WIDTH = 4552, NPROJ = 4608;
constexpr float ALPHA = 1.189207115002721f;
constexpr float LN_EPS = 1e-5f, RMS_EPS = 1e-6f;
constexpr float ATT_SCALE = 0.08838834764831845f;
constexpr float IDXW_SCALE = 0.125f * 0.35355339059327373f;
constexpr int NPHASE = 10;

constexpr size_t MiB = 1u << 20;
constexpr size_t WS_CTL = 0, CTL_ZERO_BYTES = 128 * 1024;
constexpr size_t WS_WIN = 1 * MiB;
constexpr size_t WS_SEL = 247 * MiB;
constexpr size_t WS_WC = 10 * MiB;
constexpr size_t WS_WB = 12 * MiB;
constexpr size_t WS_WO = 13 * MiB;
constexpr size_t WS_WIDX = 15 * MiB;
constexpr size_t WS_BIAS = 16 * MiB;
constexpr size_t WS_WGU = 17 * MiB;
constexpr size_t WS_WD = 49 * MiB;
constexpr size_t WS_XB = 65 * MiB;
constexpr size_t WS_QLAT = 97 * MiB;
constexpr size_t WS_CKV = 129 * MiB;
constexpr size_t WS_KIDX = 133 * MiB;
constexpr size_t WS_QIDX = 135 * MiB;
constexpr size_t WS_QB = 151 * MiB;
constexpr size_t WS_KB = 167 * MiB;
constexpr size_t WS_VB = 171 * MiB;
constexpr size_t WS_GA = 175 * MiB;
constexpr size_t WS_GB = 207 * MiB;
constexpr size_t WS_H1B = WS_GB;
constexpr size_t WS_CKVRAW = 239 * MiB;
constexpr size_t WS_LIST = 1 * MiB;
constexpr size_t WS_SLOT = 129 * MiB;
constexpr size_t WS_END = 255 * MiB;
constexpr int CW_CNT = 64;
constexpr int CW_TMO_P2 = 9;
constexpr int CW_P1D = 1536;
constexpr int CW_RMS = 1600;
constexpr int CW_P1S = 1024;
constexpr int CW_BAR = 4096;

constexpr int NWAVES = 8, NTHR = 512;
constexpr int LDS_BYTES = 155648;
constexpr int MISC_OFF = 131072 + 320;

#define GAS __attribute__((address_space(1)))
#define LAS __attribute__((address_space(3)))
typedef unsigned short bf16;
typedef unsigned v4u __attribute__((ext_vector_type(4)));
typedef unsigned v2u __attribute__((ext_vector_type(2)));
typedef float f32x4 __attribute__((ext_vector_type(4)));

__device__ __forceinline__ float bf2f(unsigned v) { return __builtin_bit_cast(float, v << 16); }
__device__ __forceinline__ float bflo(unsigned v) { return __builtin_bit_cast(float, v << 16); }
__device__ __forceinline__ float bfhi(unsigned v) { return __builtin_bit_cast(float, v & 0xffff0000u); }
__device__ __forceinline__ unsigned f2bf(float f) { unsigned u = __builtin_bit_cast(unsigned, f); return (u + 0x7fffu + ((u >> 16) & 1u)) >> 16; }
__device__ __forceinline__ unsigned cvt_pk(float lo, float hi) { unsigned r; asm volatile("v_cvt_pk_bf16_f32 %0, %1, %2" : "=v"(r) : "v"(lo), "v"(hi)); return r; }
__device__ __forceinline__ unsigned pk2(float lo, float hi) { return f2bf(lo) | (f2bf(hi) << 16); }
__device__ __forceinline__ float wave_sum(float v) {
#pragma unroll
    for (int o = 1; o < 64; o <<= 1) v += __shfl_xor(v, o);
    return v;
}
__device__ __forceinline__ float wave_max(float v) {
#pragma unroll
    for (int o = 1; o < 64; o <<= 1) v = fmaxf(v, __shfl_xor(v, o));
    return v;
}

typedef unsigned u2v __attribute__((ext_vector_type(2)));
#define DPP_I(v, ctrl) __builtin_amdgcn_update_dpp(0, (v), (ctrl), 0xf, 0xf, true)
#define DPP_F(v, ctrl) __builtin_bit_cast(float, __builtin_amdgcn_update_dpp(0, __builtin_bit_cast(int, (v)), (ctrl), 0xf, 0xf, true))
__device__ __forceinline__ void swap16(unsigned a, unsigned& x, unsigned& y) { auto r = __builtin_amdgcn_permlane16_swap(a, a, false, false); x = r[0]; y = r[1]; }
__device__ __forceinline__ void swap32(unsigned a, unsigned& x, unsigned& y) { auto r = __builtin_amdgcn_permlane32_swap(a, a, false, false); x = r[0]; y = r[1]; }
__device__ __forceinline__ float x16_sum(float v) { unsigned x, y; swap16(__builtin_bit_cast(unsigned, v), x, y); return __builtin_bit_cast(float, x) + __builtin_bit_cast(float, y); }
__device__ __forceinline__ float x16_max(float v) { unsigned x, y; swap16(__builtin_bit_cast(unsigned, v), x, y); return fmaxf(__builtin_bit_cast(float, x), __builtin_bit_cast(float, y)); }
__device__ __forceinline__ float x16_min(float v) { unsigned x, y; swap16(__builtin_bit_cast(unsigned, v), x, y); return fminf(__builtin_bit_cast(float, x), __builtin_bit_cast(float, y)); }
__device__ __forceinline__ int x16_sumi(int v) { unsigned x, y; swap16((unsigned)v, x, y); return (int)(x + y); }
__device__ __forceinline__ float x32_sum(float v) { unsigned x, y; swap32(__builtin_bit_cast(unsigned, v), x, y); return __builtin_bit_cast(float, x) + __builtin_bit_cast(float, y); }
__device__ __forceinline__ float x32_max(float v) { unsigned x, y; swap32(__builtin_bit_cast(unsigned, v), x, y); return fmaxf(__builtin_bit_cast(float, x), __builtin_bit_cast(float, y)); }

#define XB_TMO      128
#define XB_XCNT(j)  (256  + 64 * (j))
#define XB_XSUB(j)  (1280 + 64 * (j))
#define XB_XGEN(j)  (2304 + 64 * (j))
#define XB_TOP      3328
#define XB_TOPGEN   3392
#define XCD_BAR_WORDS 3456
#define XB_SPIN_CAP (1u << 22)

__device__ __forceinline__ unsigned xb_ld(unsigned* p)              { return __hip_atomic_load(p, __ATOMIC_RELAXED, __HIP_MEMORY_SCOPE_AGENT); }
__device__ __forceinline__ unsigned xb_add(unsigned* p, unsigned v) { return __hip_atomic_fetch_add(p, v, __ATOMIC_RELAXED, __HIP_MEMORY_SCOPE_AGENT); }
__device__ __forceinline__ unsigned xb_xcc_id() { return (unsigned)__builtin_amdgcn_s_getreg((3 << 11) | 20) & 0xFu; }
#define XB_SPIN(cond, bar) do { unsigned _sp = 0; while (cond) { __builtin_amdgcn_s_sleep(1); \
    if ((++_sp & 255u) == 0u) { if (xb_ld(&(bar)[XB_TMO])) break; if (_sp > XB_SPIN_CAP) { atomicAdd(&(bar)[XB_TMO], 1u); break; } } } } while (0)

struct XcdBarrier { unsigned* bar; unsigned x; volatile LAS unsigned* st; };

__device__ __forceinline__ XcdBarrier xcd_barrier_post(unsigned* bar, volatile LAS unsigned* st) {
    XcdBarrier b; b.bar = bar; b.x = xb_xcc_id(); b.st = st;
    if (threadIdx.x == 0) (void)xb_add(&bar[XB_XCNT(b.x)], 1u);
    return b;
}
__device__ __forceinline__ void xcd_barrier_complete(unsigned* bar, unsigned x, unsigned& nloc, unsigned& nx) {
    const unsigned G = gridDim.x * gridDim.y * gridDim.z;
    unsigned sum, cnt, mine, sp = 0u;
    for (;;) {
        sum = 0u; cnt = 0u; mine = 0u;
#pragma unroll
        for (unsigned j = 0; j < 16; ++j) { const unsigned c = xb_ld(&bar[XB_XCNT(j)]); sum += c; cnt += (c > 0u) ? 1u : 0u; mine = (j == x) ? c : mine; }
        if (sum == G) break;
        __builtin_amdgcn_s_sleep(1);
        if ((++sp & 255u) == 0u) { if (xb_ld(&bar[XB_TMO])) break; if (sp > XB_SPIN_CAP) { atomicAdd(&bar[XB_TMO], 1u); break; } }
    }
    nloc = mine > 0u ? mine : 1u; nx = cnt > 0u ? cnt : 1u;
}
__device__ __forceinline__ void xcd_barrier(const XcdBarrier& b) {
    asm volatile("s_waitcnt vmcnt(0)" ::: "memory");
    __syncthreads();
    if (threadIdx.x == 0) {
        unsigned* bar = b.bar;
        __builtin_amdgcn_s_waitcnt(0);
        unsigned nloc = b.st[0], nx = b.st[1];
        if (nloc == 0u) { xcd_barrier_complete(bar, b.x, nloc, nx); b.st[0] = nloc; b.st[1] = nx; }
        const unsigned old = xb_add(&bar[XB_XSUB(b.x)], 1u);
        const unsigned gen = old / nloc;
        if (old + 1u == (gen + 1u) * nloc) {
            __builtin_amdgcn_fence(__ATOMIC_RELEASE, "agent");
            asm volatile("s_waitcnt vmcnt(0)" ::: "memory");
            const unsigned og = xb_add(&bar[XB_TOP], 1u);
            const unsigned tg = og / nx;
            if (og + 1u == (tg + 1u) * nx) xb_add(&bar[XB_TOPGEN], 1u);
            else XB_SPIN(xb_ld(&bar[XB_TOPGEN]) == tg, bar);
            __builtin_amdgcn_fence(__ATOMIC_ACQUIRE, "agent");
            xb_add(&bar[XB_XGEN(b.x)], 1u);
            asm volatile("s_waitcnt vmcnt(0)" ::: "memory");
        } else {
            XB_SPIN(xb_ld(&bar[XB_XGEN(b.x)]) == gen, bar);
            __builtin_amdgcn_fence(__ATOMIC_ACQUIRE, "agent");
            asm volatile("s_waitcnt vmcnt(0)" ::: "memory");
        }
    }
    __syncthreads();
}

struct Ctx {
    const float *x, *w_in, *kv_g, *w_uv, *w_a, *sinks, *w_b, *w_out, *rel_bias, *ln1_g, *ln1_b, *w_group, *b_group, *w_router, *b_router, *w_gate, *w_up, *w_down, *ln2_g, *ln2_b;
    float* out;
    unsigned char* ws;
    unsigned* ctl;
    __device__ __forceinline__ bf16* P(size_t off) const { return (bf16*)(ws + off); }
    LAS unsigned char* lds;
    int tid, lane, wave, bid, G;
};

__device__ __forceinline__ int proj_src_col(int j) {
    if (j < 1024) return j;
    if (j < 1152) return j;
    if (j < 1216) return 1664 + (j - 1152);
    if (j < 1224) return 1728 + (j - 1216);
    if (j < 1280) return -1;
    if (j < 1792) return 1152 + (j - 1280);
    if (j < 2304) return 1736 + (j - 1792);
    if (j < 2432) return 2248 + (j - 2304);
    if (j < 2560) return 2376 + (j - 2432);
    { const int jj = j - 2560, k = jj >> 8, w = jj & 255;
      return w < 128 ? 2504 + 128 * k + w : 3528 + 128 * k + (w - 128); }
}
__device__ __forceinline__ float sigmoidf_(float v) { return 1.0f / (1.0f + __expf(-v)); }

template <class Src> __device__ __forceinline__ void titem_load(const Ctx& c, const Src& src, int k0, int n0, f32x4 (&tv)[8]) {
    const int kr = c.lane >> 3, n4 = (c.lane & 7) * 4;
#pragma unroll
    for (int i = 0; i < 8; ++i) tv[i] = src.v4(k0 + 8 * i + kr, n0 + n4);
}
__device__ __forceinline__ void titem_finish(const Ctx& c, LAS float* scr, const f32x4 (&tv)[8], bf16* dst, int dstK, int k0, int n0) {
    const int lane = c.lane, kr = lane >> 3, n4 = (lane & 7) * 4;
#pragma unroll
    for (int i = 0; i < 8; ++i) { LAS float* d = scr + (8 * i + kr) * 33 + n4; d[0] = tv[i].x; d[1] = tv[i].y; d[2] = tv[i].z; d[3] = tv[i].w; }
    asm volatile("s_waitcnt lgkmcnt(0)" ::: "memory");
    const int cc = lane & 7;
#pragma unroll
    for (int j = 0; j < 4; ++j) { const int n = (lane >> 3) + 8 * j; const LAS float* q = scr + (8 * cc) * 33 + n;
        v4u o; o.x = pk2(q[0 * 33], q[1 * 33]); o.y = pk2(q[2 * 33], q[3 * 33]); o.z = pk2(q[4 * 33], q[5 * 33]); o.w = pk2(q[6 * 33], q[7 * 33]);
        *(v4u*)(dst + (size_t)(n0 + n) * dstK + k0 + 8 * cc) = o; }
    asm volatile("s_waitcnt lgkmcnt(0)" ::: "memory");
}
template <class Src> __device__ __forceinline__ void transpose_item(const Ctx& c, LAS float* scr, const Src& src, bf16* dst, int dstK, int k0, int n0) {
    f32x4 tv[8]; titem_load(c, src, k0, n0, tv); titem_finish(c, scr, tv, dst, dstK, k0, n0);
}
struct SrcWin { const float* w; __device__ __forceinline__ f32x4 v4(int k, int n) const { const int s = proj_src_col(n); return s < 0 ? (f32x4){0.f, 0.f, 0.f, 0.f} : *(const f32x4*)(w + (size_t)k * IN_WIDTH + s); } };
struct SrcPlain { const float* w; int N; __device__ __forceinline__ f32x4 v4(int k, int n) const { return *(const f32x4*)(w + (size_t)k * N + n); } };
struct SrcShift { const float* w; int N; int shift; __device__ __forceinline__ f32x4 v4(int k, int n) const { return *(const f32x4*)(w + (size_t)k * N + n + shift); } };

__device__ __forceinline__ float t5_bias_bucket(int dist) {
    if (dist < 16) return (float)dist;
    int b = 16 + (int)(logf((float)dist / 16.0f) / logf(8.0f) * 16.0f);
    return (float)(b < 31 ? b : 31);
}
constexpr int P0_EXPERT_ITEMS = 32 * 256 + 32 * 128;
__device__ __forceinline__ void p0_expert_item(const Ctx& c, LAS float* scr, int r) {
    constexpr int I_GU = 32 * 256;
    if (r < I_GU) { const int e = r / 256, q = r % 256, n0 = (q / 16) * 32, half = (n0 >> 7) & 1, col0 = (n0 >> 8) * 128 + (n0 & 127);
        if (half) { SrcShift s_{c.w_up + (size_t)e * 1024 * 256, DEXP, col0 - n0}; transpose_item(c, scr, s_, (bf16*)(c.ws + WS_WGU) + (size_t)e * 512 * 1024, 1024, (q % 16) * 64, n0); }
        else { SrcShift s_{c.w_gate + (size_t)e * 1024 * 256, DEXP, col0 - n0}; transpose_item(c, scr, s_, (bf16*)(c.ws + WS_WGU) + (size_t)e * 512 * 1024, 1024, (q % 16) * 64, n0); }
        return; }
    r -= I_GU;
    { const int e = r / 128, q = r % 128; SrcPlain s_{c.w_down + (size_t)e * 256 * 1024, 1024};
        transpose_item(c, scr, s_, (bf16*)(c.ws + WS_WD) + (size_t)e * 1024 * 256, 256, (q % 4) * 64, (q / 4) * 32); }
}
__device__ __forceinline__ void ex_item_load(const Ctx& c, int r, f32x4 (&tv)[8]) {
    constexpr int I_GU = 32 * 256;
    const float* base; int ld;
    if (r < I_GU) { const int e = r / 256, q = r % 256, n0 = (q / 16) * 32, half = (n0 >> 7) & 1, col0 = (n0 >> 8) * 128 + (n0 & 127);
        base = (half ? c.w_up : c.w_gate) + (size_t)e * 1024 * 256 + (size_t)((q % 16) * 64) * DEXP + col0; ld = DEXP; }
    else { r -= I_GU; const int e = r / 128, q = r % 128; base = c.w_down + (size_t)e * 256 * 1024 + (size_t)((q % 4) * 64) * 1024 + (q / 4) * 32; ld = 1024; }
    const float* pl = base + (size_t)(c.lane >> 3) * ld + (c.lane & 7) * 4;
#pragma unroll
    for (int i = 0; i < 8; ++i) tv[i] = *(const f32x4*)(pl + (size_t)(8 * i) * ld);
}
__device__ __forceinline__ void ex_item_finish(const Ctx& c, LAS float* scr, int r, const f32x4 (&tv)[8]) {
    constexpr int I_GU = 32 * 256;
    if (r < I_GU) { const int e = r / 256, q = r % 256; titem_finish(c, scr, tv, (bf16*)(c.ws + WS_WGU) + (size_t)e * 512 * 1024, 1024, (q % 16) * 64, (q / 16) * 32); }
    else { r -= I_GU; const int e = r / 128, q = r % 128; titem_finish(c, scr, tv, (bf16*)(c.ws + WS_WD) + (size_t)e * 1024 * 256, 256, (q % 4) * 64, (q / 4) * 32); }
}
constexpr size_t WS_WRT = 16 * MiB + 512 * 1024;
__device__ __forceinline__ void p0_prologue(const Ctx& c) {
    { const size_t n8 = (size_t)NTOK * D / 8; const f32x4* xs = (const f32x4*)c.x; v4u* xd = (v4u*)((bf16*)(c.ws + WS_XB));
      const size_t st = (size_t)c.G * NTHR;
      size_t i = (size_t)c.bid * NTHR + c.tid;
      for (; i + 3 * st < n8; i += 4 * st) { f32x4 a[4], b[4];
#pragma unroll
          for (int u = 0; u < 4; ++u) { a[u] = xs[2 * (i + u * st)]; b[u] = xs[2 * (i + u * st) + 1]; }
#pragma unroll
          for (int u = 0; u < 4; ++u) { v4u o; o.x = pk2(a[u].x, a[u].y); o.y = pk2(a[u].z, a[u].w); o.z = pk2(b[u].x, b[u].y); o.w = pk2(b[u].z, b[u].w); xd[i + u * st] = o; } }
      for (; i < n8; i += st) { const f32x4 a = xs[2 * i], b = xs[2 * i + 1]; v4u o; o.x = pk2(a.x, a.y); o.y = pk2(a.z, a.w); o.z = pk2(b.x, b.y); o.w = pk2(b.z, b.w); xd[i] = o; } }
    { LAS float* scr = (LAS float*)(c.lds + c.wave * 8704);
      constexpr int I_WIN = 16 * 144, I_WB = 8 * 32, I_WO = 16 * 32, I_ALL = I_WIN + I_WB + I_WO;
      for (int it = c.bid * NWAVES + c.wave; it < I_ALL; it += c.G * NWAVES) {
        int r = it;
        if (r < I_WIN) { SrcWin s_{c.w_in}; transpose_item(c, scr, s_, (bf16*)(c.ws + WS_WIN), 1024, (r % 16) * 64, (r / 16) * 32); continue; } r -= I_WIN;
        if (r < I_WB) { SrcPlain s_{c.w_b, 1024}; transpose_item(c, scr, s_, (bf16*)(c.ws + WS_WB), 512, (r % 8) * 64, (r / 8) * 32); continue; } r -= I_WB;
        { SrcPlain s_{c.w_out, 1024}; transpose_item(c, scr, s_, (bf16*)(c.ws + WS_WO), 1024, (r % 16) * 64, (r / 16) * 32); }
      } }
    __syncthreads();
    { LAS float* tile = (LAS float*)c.lds; LAS float* Us = tile + 64 * 65; LAS float* As = Us + 64 * 65;
      for (int tI = c.bid; tI < 256; tI += c.G) { const int k0 = (tI & 15) * 64, n0 = (tI >> 4) * 64, h = k0 >> 7;
        const int r = c.tid >> 6, cc = c.tid & 63;
#pragma unroll
        for (int pI = 0; pI < 8; ++pI) { const int kk = pI * 8 + r; Us[kk * 65 + cc] = c.w_uv[(size_t)(k0 + kk) * 64 + cc]; As[kk * 65 + cc] = c.w_a[(size_t)(h * 64 + kk) * 1024 + n0 + cc]; }
        __syncthreads();
        { float a8[8];
#pragma unroll
          for (int pI = 0; pI < 8; ++pI) a8[pI] = 0.f;
#pragma unroll 8
          for (int d = 0; d < 64; ++d) { const float asv = As[d * 65 + cc];
#pragma unroll
              for (int pI = 0; pI < 8; ++pI) a8[pI] += Us[(pI * 8 + r) * 65 + d] * asv; }
#pragma unroll
          for (int pI = 0; pI < 8; ++pI) tile[(pI * 8 + r) * 65 + cc] = a8[pI]; }
        __syncthreads();
        const int nl = c.tid >> 3, kc = c.tid & 7; v4u o;
        o.x = pk2(tile[(8 * kc + 0) * 65 + nl], tile[(8 * kc + 1) * 65 + nl]); o.y = pk2(tile[(8 * kc + 2) * 65 + nl], tile[(8 * kc + 3) * 65 + nl]);
        o.z = pk2(tile[(8 * kc + 4) * 65 + nl], tile[(8 * kc + 5) * 65 + nl]); o.w = pk2(tile[(8 * kc + 6) * 65 + nl], tile[(8 * kc + 7) * 65 + nl]);
        *(v4u*)((bf16*)(c.ws + WS_WC) + (size_t)(n0 + nl) * 1024 + k0 + 8 * kc) = o;
        __syncthreads(); } }
    for (int i = c.bid * NTHR + c.tid; i < 48 * 1024; i += c.G * NTHR) { const int o = i >> 10, k = i & 1023;
        const float v = o < 32 ? c.w_router[(size_t)k * 32 + o] : (o < 36 ? c.w_group[(size_t)k * 4 + (o - 32)] : 0.f);
        const unsigned hi = f2bf(v); const float rem = v - bf2f(hi);
        ((bf16*)(c.ws + WS_WRT))[i] = (bf16)hi; ((bf16*)(c.ws + WS_WRT))[48 * 1024 + i] = (bf16)f2bf(rem); }
    for (int i = c.bid * NTHR + c.tid; i < 129 * 8; i += c.G * NTHR) { const int d = i >> 3, h = i & 7; const int b = (int)t5_bias_bucket(d);
        ((float*)(c.ws + WS_BIAS))[i] = c.rel_bias[b * 16 + h]; ((float*)(c.ws + WS_BIAS) + 129 * 8)[i] = c.rel_bias[b * 16 + 8 + h]; }
}


__device__ __forceinline__ void st16_sc1(void* p, v4u v) { asm volatile("global_store_dwordx4 %0, %1, off sc1\n\ts_nop 1" :: "v"(p), "v"(v) : "memory"); }
__device__ __forceinline__ void st16_sc1(void* p, f32x4 v) { st16_sc1(p, __builtin_bit_cast(v4u, v)); }
__device__ __forceinline__ void st8_sc1(void* p, v2u v) { asm volatile("global_store_dwordx2 %0, %1, off sc1\n\ts_nop 1" :: "v"(p), "v"(v) : "memory"); }
__device__ __forceinline__ void wave_publish(const Ctx& c, unsigned* w) { asm volatile("s_waitcnt vmcnt(0)" ::: "memory"); if (c.lane == 0) __hip_atomic_fetch_add(w, 1u, __ATOMIC_RELAXED, __HIP_MEMORY_SCOPE_AGENT); }
__device__ __forceinline__ void p_rmsnorm(const Ctx& c, int b, int slot, int nslot) {
    const int l15 = c.lane & 15, g4 = c.lane >> 4;
    const f32x4 g0 = *(const f32x4*)(c.kv_g + 8 * l15), g1 = *(const f32x4*)(c.kv_g + 8 * l15 + 4);
    for (int rr = 4 * (slot * NWAVES + c.wave) + g4; rr < SEQ; rr += 4 * nslot * NWAVES) { const int r = b * SEQ + rr;
        const float* src = (const float*)(c.ws + WS_CKVRAW) + (size_t)r * 128 + 8 * l15;
        const f32x4 a = *(const f32x4*)src, b_ = *(const f32x4*)(src + 4);
        float ss = (a.x * a.x + a.y * a.y) + (a.z * a.z + a.w * a.w) + (b_.x * b_.x + b_.y * b_.y) + (b_.z * b_.z + b_.w * b_.w);
        ss += DPP_F(ss, 0xB1); ss += DPP_F(ss, 0x4E); ss += DPP_F(ss, 0x141); ss += DPP_F(ss, 0x140);
        const float rs = 1.0f / sqrtf(ss * (1.0f / 128.0f) + RMS_EPS);
        v4u o; o.x = pk2(a.x * rs * g0.x, a.y * rs * g0.y); o.y = pk2(a.z * rs * g0.z, a.w * rs * g0.w); o.z = pk2(b_.x * rs * g1.x, b_.y * rs * g1.y); o.w = pk2(b_.z * rs * g1.z, b_.w * rs * g1.w);
        st16_sc1((bf16*)(c.ws + WS_CKV) + (size_t)r * 128 + 8 * l15, o);
    }
}


typedef float f32x16 __attribute__((ext_vector_type(16)));
typedef float f32x2 __attribute__((ext_vector_type(2)));
typedef short s16x8 __attribute__((ext_vector_type(8)));
__device__ __forceinline__ float half_min(float v) {
    v = fminf(v, DPP_F(v, 0xB1)); v = fminf(v, DPP_F(v, 0x4E)); v = fminf(v, DPP_F(v, 0x141)); v = fminf(v, DPP_F(v, 0x140)); return x16_min(v); }
__device__ __forceinline__ float half_max(float v) {
    v = fmaxf(v, DPP_F(v, 0xB1)); v = fmaxf(v, DPP_F(v, 0x4E)); v = fmaxf(v, DPP_F(v, 0x141)); v = fmaxf(v, DPP_F(v, 0x140)); return x16_max(v); }
__device__ __forceinline__ int half_sum(int v) {
    v += DPP_I(v, 0xB1); v += DPP_I(v, 0x4E); v += DPP_I(v, 0x141); v += DPP_I(v, 0x140); return x16_sumi(v); }
struct P2B { s16x8 b[8]; };
__device__ __forceinline__ P2B p2_ld4(const LAS unsigned char* kb_, int tb) { P2B r;
#pragma unroll
    for (int u = 0; u < 4; ++u) { r.b[2 * u] = *(const LAS s16x8*)(kb_ + (tb + u) * 2048); r.b[2 * u + 1] = *(const LAS s16x8*)(kb_ + (tb + u) * 2048 + 1024); }
    return r; }
__device__ __forceinline__ float p2_relu(float x) { const int xi = __builtin_bit_cast(int, x); return __builtin_bit_cast(float, xi > 0 ? xi : 0); }
__device__ __forceinline__ float p2_wsum(const f32x4 a, const f32x4 w) {
    float p = fmaf(w.x, p2_relu(a[0]), 0.f); p = fmaf(w.y, p2_relu(a[1]), p); p = fmaf(w.z, p2_relu(a[2]), p); return fmaf(w.w, p2_relu(a[3]), p); }
__device__ __forceinline__ void p2_score4(const P2B& B, const s16x8 a0, const s16x8 a1, const f32x4 wq, float& r0, float& r1) {
    f32x4 acc[4];
#pragma unroll
    for (int u = 0; u < 4; ++u) { const f32x4 z = {0.f, 0.f, 0.f, 0.f}; acc[u] = __builtin_amdgcn_mfma_f32_16x16x32_bf16(a0, B.b[2 * u], z, 0, 0, 0); }
#pragma unroll
    for (int u = 0; u < 4; ++u) acc[u] = __builtin_amdgcn_mfma_f32_16x16x32_bf16(a1, B.b[2 * u + 1], acc[u], 0, 0, 0);
    const float p0 = p2_wsum(acc[0], wq), p1 = p2_wsum(acc[1], wq), p2 = p2_wsum(acc[2], wq), p3 = p2_wsum(acc[3], wq);
    { auto s_ = __builtin_amdgcn_permlane16_swap(__builtin_bit_cast(unsigned, p0), __builtin_bit_cast(unsigned, p1), false, false); const unsigned x_ = s_[0], y_ = s_[1];
      r0 = __builtin_bit_cast(float, x_) + __builtin_bit_cast(float, y_); }
    { auto s_ = __builtin_amdgcn_permlane16_swap(__builtin_bit_cast(unsigned, p2), __builtin_bit_cast(unsigned, p3), false, false); const unsigned x_ = s_[0], y_ = s_[1];
      r1 = __builtin_bit_cast(float, x_) + __builtin_bit_cast(float, y_); }
}
__device__ __forceinline__ void p2_unit(const Ctx& c, int b, int blk, int item, int item2) {
    LAS unsigned char* kst = c.lds;
    const int lane = c.lane, wv = c.wave, r = lane & 31, hh = lane >> 5, g4 = lane >> 4, c16 = lane & 15;
    const int t0 = blk * 16 + 2 * wv, n0 = b * SEQ + t0, ntile = blk + 1, nst = (ntile + 15) >> 4;
    const unsigned char* ksrc = c.ws + WS_KIDX + (size_t)(b * 128) * 2048;
    const unsigned ktoff = (unsigned)c.tid * 16u;
#define P2_ISSUE(st) do { unsigned _to = ktoff; asm volatile("" : "+v"(_to));        \
        _Pragma("unroll") for (int _j = 0; _j < 4; ++_j) \
        __builtin_amdgcn_global_load_lds((const unsigned*)((ksrc + (size_t)(st) * 32768 + _j * 8192) + _to), (LAS unsigned*)(kst + ((st) & 1) * 32768 + (_j * 512 + wv * 64) * 16), 16, 0, 0); } while (0)
    P2_ISSUE(0);
    s16x8 af[2];
    { const bf16* qp = (const bf16*)(c.ws + WS_QIDX) + (size_t)(n0 + (c16 >> 3)) * 512 + (c16 & 7) * 64 + 8 * g4;
      af[0] = *(const s16x8*)qp; af[1] = *(const s16x8*)(qp + 32); }
    const f32x4 wq = *(const f32x4*)((const float*)(c.ws + WS_WIDX) + (size_t)(n0 + hh) * 8 + 4 * (g4 & 1));
    asm volatile("" :: "v"(af[0]), "v"(af[1]), "v"(wq));
    float sc0[64];
#pragma unroll
    for (int i = 0; i < 64; ++i) sc0[i] = -INFINITY;
    const int lim0 = 2 * wv + hh;
    const int lastst = blk >> 4;
    const int limt = (blk - (g4 & 1)) - ((c16 <= lim0) ? 0 : 1);
#pragma unroll
    for (int st = 0; st < 8; ++st) {
        if (st <= lastst) {
            if (st < lastst) { P2_ISSUE(st + 1); asm volatile("s_waitcnt vmcnt(4)" ::: "memory"); }
            else asm volatile("s_waitcnt vmcnt(0)" ::: "memory");
            __builtin_amdgcn_s_barrier();
            const LAS unsigned char* kb_ = kst + (st & 1) * 32768 + lane * 16;
            if (st < lastst) {
                P2B Ba = p2_ld4(kb_, 0), Bb = p2_ld4(kb_, 4);
                p2_score4(Ba, af[0], af[1], wq, sc0[st * 8 + 0], sc0[st * 8 + 1]); __builtin_amdgcn_sched_barrier(0);
                Ba = p2_ld4(kb_, 8);
                p2_score4(Bb, af[0], af[1], wq, sc0[st * 8 + 2], sc0[st * 8 + 3]); __builtin_amdgcn_sched_barrier(0);
                Bb = p2_ld4(kb_, 12);
                p2_score4(Ba, af[0], af[1], wq, sc0[st * 8 + 4], sc0[st * 8 + 5]); __builtin_amdgcn_sched_barrier(0);
                p2_score4(Bb, af[0], af[1], wq, sc0[st * 8 + 6], sc0[st * 8 + 7]);
            } else {
#pragma unroll
                for (int g = 0; g < 4; ++g) if (st * 16 + 4 * g <= blk) {
                    const P2B B = p2_ld4(kb_, 4 * g);
                    float r0, r1; p2_score4(B, af[0], af[1], wq, r0, r1);
                    sc0[st * 8 + 2 * g] = (st * 16 + 4 * g <= limt) ? r0 : -INFINITY;
                    sc0[st * 8 + 2 * g + 1] = (st * 16 + 4 * g + 2 <= limt) ? r1 : -INFINITY;
                    __builtin_amdgcn_sched_barrier(0);
                }
            }
            asm volatile("s_waitcnt lgkmcnt(0)" ::: "memory");
            __builtin_amdgcn_s_barrier();
        }
    }
#undef P2_ISSUE
    f32x4 tv[8];
    LAS float* iscr = (LAS float*)(c.lds + (wv < 7 ? 65536 + wv * 8448 : 133120));
    if (item >= 0) ex_item_load(c, item, tv);
    const int nreg = (ntile + 1) >> 1;
    float thr0 = -INFINITY; int quota0 = 0;
    if (blk >= 16) {
#define P2_COUNT_NEG(EXPR, OUT) do { unsigned sa_ = 0u, sb_ = 0u; \
        _Pragma("unroll") for (int g = 0; g < 4; ++g) if (nreg > 16 * g) { \
            _Pragma("unroll") for (int i = 16 * g; i < 16 * g + 16; ++i) { const float s_ = sc0[i]; const unsigned tb_ = __builtin_bit_cast(unsigned, (EXPR)); \
                if (g < 2) sa_ = __builtin_amdgcn_alignbit(sa_, tb_, 31); else sb_ = __builtin_amdgcn_alignbit(sb_, tb_, 31); } } \
        OUT = half_sum(__builtin_popcount(sa_) + __builtin_popcount(sb_)); } while (0)
#define P2_COUNT_NEG2(MID, OUT) do { unsigned sa_ = 0u, sb_ = 0u; const f32x2 m2_ = {(MID), (MID)}; \
        _Pragma("unroll") for (int g = 0; g < 4; ++g) if (nreg > 16 * g) { \
            _Pragma("unroll") for (int i = 16 * g; i < 16 * g + 16; i += 4) { const f32x2 p_ = {sc0[i], sc0[i + 1]}, q_ = {sc0[i + 2], sc0[i + 3]}; const f32x2 d_ = p_ - m2_, e_ = q_ - m2_;     \
                const float dx_ = d_.x, dy_ = d_.y, ex_ = e_.x, ey_ = e_.y;     \
                const unsigned t0_ = __builtin_bit_cast(unsigned, dx_), t1_ = __builtin_bit_cast(unsigned, dy_), t2_ = __builtin_bit_cast(unsigned, ex_), t3_ = __builtin_bit_cast(unsigned, ey_); \
                if (g < 2) { sa_ = __builtin_amdgcn_alignbit(sa_, t0_, 31); sa_ = __builtin_amdgcn_alignbit(sa_, t1_, 31); sa_ = __builtin_amdgcn_alignbit(sa_, t2_, 31); sa_ = __builtin_amdgcn_alignbit(sa_, t3_, 31); } \
                else { sb_ = __builtin_amdgcn_alignbit(sb_, t0_, 31); sb_ = __builtin_amdgcn_alignbit(sb_, t1_, 31); sb_ = __builtin_amdgcn_alignbit(sb_, t2_, 31); sb_ = __builtin_amdgcn_alignbit(sb_, t3_, 31); } } } \
        OUT = half_sum(__builtin_popcount(sa_) + __builtin_popcount(sb_)); } while (0)
        const int ntot = t0 + hh + 1;
        float mx0 = -INFINITY;
#pragma unroll
        for (int g = 0; g < 4; ++g) if (nreg > 16 * g) {
#pragma unroll
            for (int i = 16 * g; i < 16 * g + 16; ++i) mx0 = fmaxf(mx0, sc0[i]); }
        mx0 = half_max(mx0);
        int cneg, cp; P2_COUNT_NEG(s_, cneg); P2_COUNT_NEG(0.f - s_, cp);
        const int cn = 32 * ((nreg + 15) & ~15) - cneg;
        float lo0 = 0.f, hi0 = 0.f; int chi0 = 0, clo0 = KSEL + 1; bool done0 = false, eg0 = false;
        if (cp <= KSEL && cn >= KSEL) { done0 = true; thr0 = 0.f; quota0 = KSEL - cp; }
        else if (cp > KSEL) { lo0 = 0.f; clo0 = cp; hi0 = mx0 + fabsf(mx0) * 1e-6f + 1e-30f; chi0 = 0; }
        else { hi0 = 0.f; chi0 = cn; clo0 = ntot; }
        if (__builtin_amdgcn_ballot_w64(!done0 && cp <= KSEL) != 0ull) {
            float mn0 = INFINITY;
#pragma unroll
            for (int g = 0; g < 4; ++g) if (nreg > 16 * g) {
#pragma unroll
                for (int i = 16 * g; i < 16 * g + 16; ++i) mn0 = fminf(mn0, sc0[i] == -INFINITY ? INFINITY : sc0[i]); }
            mn0 = half_min(mn0);
            if (!done0 && cp <= KSEL) lo0 = mn0;
        }
        float wl0 = 1.f, wh0 = 1.f; int side0 = 0;
        for (int it = 0; it < 400; ++it) {
            if (!done0 && chi0 == KSEL - 1) { done0 = true; eg0 = true; }
            if (__builtin_amdgcn_ballot_w64(!done0) == 0ull) break;
            const float half_ = 0.5f * (lo0 + hi0);
            const float fl_ = ((float)(clo0 - KSEL) + 0.5f) * wl0, fh_ = ((float)(KSEL - chi0) - 0.5f) * wh0;
            const float mi = lo0 + (hi0 - lo0) * (fl_ / (fl_ + fh_));
            const float mid0 = (it < 48 && mi > lo0 && mi < hi0) ? mi : half_;
            int cb; P2_COUNT_NEG2(mid0, cb);
            const int c0 = 32 * ((nreg + 15) & ~15) - cb;
            if (!done0) { if (c0 == KSEL) { done0 = true; thr0 = mid0; quota0 = KSEL; } else if (mid0 <= lo0 || mid0 >= hi0) { done0 = true; thr0 = lo0; quota0 = KSEL - chi0; }
                else if (c0 > KSEL) { lo0 = mid0; clo0 = c0; wh0 = side0 > 0 ? wh0 * 0.5f : 1.f; wl0 = 1.f; side0 = 1; }
                else { hi0 = mid0; chi0 = c0; wl0 = side0 < 0 ? wl0 * 0.5f : 1.f; wh0 = 1.f; side0 = -1; } }
        }
        if (!done0) { thr0 = lo0; quota0 = KSEL - chi0; }
        if (__builtin_amdgcn_ballot_w64(eg0) != 0ull) {
            float m_ = -INFINITY;
#pragma unroll
            for (int g = 0; g < 4; ++g) if (nreg > 16 * g) {
#pragma unroll
                for (int i = 16 * g; i < 16 * g + 16; ++i) m_ = fmaxf(m_, sc0[i] < hi0 ? sc0[i] : -INFINITY); }
            m_ = half_max(m_);
            if (eg0) { thr0 = m_; quota0 = 1; }
        }
#undef P2_COUNT_NEG
#undef P2_COUNT_NEG2
    }
    if (item >= 0) ex_item_finish(c, iscr, item, tv);
    if (item2 >= 0) ex_item_load(c, item2, tv);
    unsigned short* selp0 = (unsigned short*)(c.ws + WS_SEL) + (size_t)(n0 + hh) * KSEL;
    int base0 = 0, eq0 = 0; const unsigned ltm = (1u << r) - 1u;
#pragma unroll
    for (int g = 0; g < 4; ++g) if (nreg > 16 * g) {
#pragma unroll
        for (int i = 16 * g; i < 16 * g + 16; ++i) {
            bool sel_ = sc0[i] > thr0; const bool pe = sc0[i] == thr0; const unsigned long long me = __builtin_amdgcn_ballot_w64(pe);
            if (me) { const unsigned mh = hh ? (unsigned)(me >> 32) : (unsigned)me; sel_ = sel_ || (pe && (eq0 + __builtin_popcount(mh & ltm) < quota0)); eq0 += __builtin_popcount(mh); }
            const unsigned long long ms = __builtin_amdgcn_ballot_w64(sel_); const unsigned mh2 = hh ? (unsigned)(ms >> 32) : (unsigned)ms;
            const int pos = base0 + __builtin_popcount(mh2 & ltm); if (sel_ && pos < KSEL) selp0[pos] = (unsigned short)(32 * i + r); base0 += __builtin_popcount(mh2);
        } }
    if (item2 >= 0) ex_item_finish(c, iscr, item2, tv);
}
__device__ __forceinline__ void p2_wait_batch(const Ctx& c, int b) {
    if (c.tid == 0) { unsigned* w = c.ctl + CW_P1S + 64 * b; unsigned sp = 0;
        while (__hip_atomic_load(w, __ATOMIC_RELAXED, __HIP_MEMORY_SCOPE_AGENT) < 48u * NWAVES) { __builtin_amdgcn_s_sleep(2);
            if ((++sp & 1023u) == 0u) { if (__hip_atomic_load(c.ctl + CW_TMO_P2, __ATOMIC_RELAXED, __HIP_MEMORY_SCOPE_AGENT) != 0u) break;
                if (sp > (1u << 22)) { __hip_atomic_store(c.ctl + CW_TMO_P2, 1u, __ATOMIC_RELAXED, __HIP_MEMORY_SCOPE_AGENT); break; } } }
        __builtin_amdgcn_fence(__ATOMIC_ACQUIRE, "agent");
        asm volatile("s_waitcnt vmcnt(0)" ::: "memory"); }
    __syncthreads();
}
__device__ __forceinline__ void p3b_swa(const Ctx& c, int u0, int ustep, int uend);
__device__ __forceinline__ int p2_blk_fast(int slot, int q) { const int i = slot & 15;
    return slot < 16 ? (q == 0 ? 96 + i : (q == 1 ? 64 + (15 - i) : (q == 2 ? 32 + i : 16 + (15 - i)))) : (q == 0 ? 112 + i : (q == 1 ? 80 + (15 - i) : (q == 2 ? 48 + i : 15 - i))); }
__device__ __forceinline__ void wg_publish(const Ctx& c, unsigned* w) {
    asm volatile("s_waitcnt vmcnt(0)" ::: "memory");
    __syncthreads();
    if (c.tid == 0) { __builtin_amdgcn_fence(__ATOMIC_RELEASE, "agent"); asm volatile("s_waitcnt vmcnt(0)" ::: "memory"); __hip_atomic_fetch_add(w, 1u, __ATOMIC_RELAXED, __HIP_MEMORY_SCOPE_AGENT); }
}
__device__ __forceinline__ void wg_wait(const Ctx& c, unsigned* w, unsigned n) {
    if (c.tid == 0) { unsigned sp = 0;
        while (__hip_atomic_load(w, __ATOMIC_RELAXED, __HIP_MEMORY_SCOPE_AGENT) < n) { __builtin_amdgcn_s_sleep(2);
            if ((++sp & 1023u) == 0u) { if (__hip_atomic_load(c.ctl + CW_TMO_P2, __ATOMIC_RELAXED, __HIP_MEMORY_SCOPE_AGENT) != 0u) break;
                if (sp > (1u << 22)) { __hip_atomic_store(c.ctl + CW_TMO_P2, 1u, __ATOMIC_RELAXED, __HIP_MEMORY_SCOPE_AGENT); break; } } }
        __builtin_amdgcn_fence(__ATOMIC_ACQUIRE, "agent");
        asm volatile("s_waitcnt vmcnt(0)" ::: "memory"); }
    __syncthreads();
}
__device__ __forceinline__ void p2_indexer_topk(const Ctx& c) {
    const bool fast = c.G == 256; const int gw = c.bid * NWAVES + c.wave;
    if (fast) { p2_wait_batch(c, c.bid & 7);
        if (c.bid >= 128) { const int u0 = (c.bid & 7) * 32 + 2 * ((c.bid >> 3) - 16); p3b_swa(c, u0, 1, u0 + 2); }
        p_rmsnorm(c, c.bid & 7, c.bid >> 3, 32); wave_publish(c, c.ctl + CW_RMS + 64 * (c.bid & 7)); }
    else { for (int b = 0; b < BATCH; ++b) p2_wait_batch(c, b); for (int b = 0; b < BATCH; ++b) p_rmsnorm(c, b, c.bid, c.G); }
    for (int pu = c.bid; pu < 256; pu += c.G) {
        const int b = fast ? (pu & 7) : (pu >> 5), slot = pu >> 3, j = pu & 31, i = slot & 15;
        const int nu = 4;
#pragma unroll 1
        for (int q = 0; q < nu; ++q) {
            int blk, it1 = -1, it2 = -1;
            if (!fast) blk = q == 0 ? j : (q == 1 ? 63 - j : (q == 2 ? 64 + j : 127 - j));
            else { blk = p2_blk_fast(slot, q); it1 = q * 2048 + gw; it2 = q < 2 ? (4 + q) * 2048 + gw : -1; }
            p2_unit(c, b, blk, it1, it2);
        }
    }
}


typedef short s16x4 __attribute__((ext_vector_type(4)));
constexpr int DSA_WS_OFF = 131072 + 2048;
constexpr int DSA_BIAS_OFF = 131072 + 2048 + 10240;
__device__ __forceinline__ void p3a_dsa(const Ctx& c) {
    int tid_o = c.tid; asm volatile("" : "+v"(tid_o));
    const int lane = tid_o & 63, wv = c.wave, l15 = lane & 15, g4 = lane >> 4;
    LAS unsigned char* kvb = c.lds + wv * 16384;
    LAS unsigned char* wsb = c.lds + DSA_WS_OFF + wv * 1280;
    LAS float* biasL = (LAS float*)(c.lds + DSA_BIAS_OFF);
    for (int i = c.tid; i < 129 * 8; i += NTHR) biasL[i] = ((const float*)(c.ws + WS_BIAS))[i] * 1.4426950408889634f;
    __syncthreads();
    const int prow = (l15 & 3) | ((l15 & 4) << 1) | ((l15 & 8) >> 1);
    const int rowx = ((prow & 3) << 2) | (prow >> 2);
    const unsigned qk_off = (unsigned)(256 * prow + 16 * (g4 ^ (rowx & 3))), qk_sx = (unsigned)(rowx >> 2);
    const int grow = 8 * (g4 & 1) + 4 * (g4 >> 1);
    const int trow = grow + (l15 >> 2), trx = ((trow & 3) << 2) | ((trow >> 2) & 3);
    const unsigned tr_off = (unsigned)(256 * trow + 16 * (((lane & 3) >> 1) ^ (trx & 1)) + 8 * (lane & 1)), tr_mx = (unsigned)(trx >> 1);
    const bf16* ckv = (const bf16*)(c.ws + WS_CKV);
    const float bfar = biasL[128 * 8 + (l15 & 7)];
    float bmax = 0.f;
    for (int d = 0; d <= 128; ++d) bmax = fmaxf(bmax, fabsf(biasL[d * 8 + (l15 & 7)]));
    const float kvmax = 11.313708499f * 1.004f * wave_max(fmaxf(fabsf(c.kv_g[2 * lane]), fabsf(c.kv_g[2 * lane + 1])));
    unsigned trm[8];
#pragma unroll
    for (int m = 0; m < 8; ++m) trm[m] = tr_off + 32u * ((unsigned)m ^ tr_mx);
    const int gw = c.bid * NWAVES + wv, NGW = c.G * NWAVES;
    const int eit0 = (c.G == 256 ? P0_EXPERT_ITEMS : 0) + gw;
    if (wv < 4) for (int eit = eit0; eit < P0_EXPERT_ITEMS; eit += NGW) p0_expert_item(c, (LAS float*)kvb, eit);
    asm volatile("s_waitcnt lgkmcnt(0)" ::: "memory");
#define DSA_LOADQ(n_, raw_, qf_) do { raw_ = *(const v2u*)((const unsigned short*)(c.ws + WS_SEL) + (size_t)(n_) * KSEL + 4 * lane); \
        const s16x8* qp_ = (const s16x8*)((const bf16*)(c.ws + WS_QLAT) + (size_t)(n_) * 1024 + (l15 & 7) * 128 + 8 * g4); \
        _Pragma("unroll") for (int s_ = 0; s_ < 4; ++s_) qf_[s_] = qp_[4 * s_]; } while (0)
#define DSA_PREP(n_, raw_, qf_, sl_, t_, cnt_, nch_, nfar_, mref_) do { t_ = (n_) & 2047; cnt_ = (t_ + 1 < KSEL) ? t_ + 1 : KSEL; nch_ = (cnt_ + 31) >> 5; \
        { const int i0 = 4 * lane, lim = t_ - 128; \
          raw_.x = (i0 < cnt_ ? (raw_.x & 0xffffu) : 0u) | (i0 + 1 < cnt_ ? (raw_.x & 0xffff0000u) : 0u); raw_.y = (i0 + 2 < cnt_ ? (raw_.y & 0xffffu) : 0u) | (i0 + 3 < cnt_ ? (raw_.y & 0xffff0000u) : 0u); \
          *(LAS v2u*)(wsb + (sl_) * 512 + 8 * lane) = raw_; \
          const int e0 = (i0 < cnt_ && (int)(raw_.x & 0xffffu) <= lim) ? 1 : 0, e1 = (i0 + 1 < cnt_ && (int)(raw_.x >> 16) <= lim) ? 1 : 0, e2 = (i0 + 2 < cnt_ && (int)(raw_.y & 0xffffu) <= lim) ? 1 : 0, e3 = (i0 + 3 < cnt_ && (int)(raw_.y >> 16) <= lim) ? 1 : 0; \
          int nf = e0 + e1 + e2 + e3; nf += DPP_I(nf, 0xB1); nf += DPP_I(nf, 0x4E); nf += DPP_I(nf, 0x141); nf += DPP_I(nf, 0x140); nf = x16_sumi(nf); { unsigned xa, xb; swap32((unsigned)nf, xa, xb); nf = (int)(xa + xb); } \
          nfar_ = __builtin_amdgcn_readfirstlane(nf) >> 5; } \
        { float q2 = 0.f; \
          _Pragma("unroll") for (int s_ = 0; s_ < 4; ++s_) { if (l15 >= 8) qf_[s_] = (s16x8){0, 0, 0, 0, 0, 0, 0, 0}; \
              _Pragma("unroll") for (int e = 0; e < 8; ++e) { const float qv = bf2f((unsigned)(unsigned short)qf_[s_][e]); q2 += qv * qv; } } \
          q2 = x16_sum(q2); q2 = x32_sum(q2); mref_ = sqrtf(q2) * (kvmax * 1.4426950408889634f) + bmax; } } while (0)
#define DSA_ISSUE(ch_, bi_, k8_, sl_, n_, t_, cnt_, nfar_) do { const bf16* ckb_ = ckv + (size_t)((n_) >> 11) * SEQ * 128; \
            _Pragma("unroll") for (int u = 0; u < 8; ++u) { const unsigned kw = u < 2 ? k8_.x : (u < 4 ? k8_.y : (u < 6 ? k8_.z : k8_.w)); const unsigned key = (u & 1) ? (kw >> 16) : (kw & 0xffffu); \
                const int chl = l15 ^ ((g4 << 2) | (u & 3)); \
                __builtin_amdgcn_global_load_lds((const unsigned*)((const char*)ckb_ + (size_t)(unsigned)(key * 256u + (unsigned)chl * 16u)), (LAS unsigned*)(kvb + (bi_) * 8192 + u * 1024), 16, 0, 0); } \
            if ((ch_) >= (nfar_) && lane < 32) { const int kap = 32 * (ch_) + 8 * (lane & 3) + (lane >> 2); const int key = *(const LAS unsigned short*)(wsb + (sl_) * 512 + 2 * kap); int dd = (t_) - key; dd = dd > 128 ? 128 : dd; dd = kap < (cnt_) ? dd : 255; \
                *(LAS unsigned short*)(wsb + 1024 + (bi_) * 64 + 2 * lane) = (unsigned short)dd; } } while (0)
    const bool mixq = (NGW == SEQ);
#define DSA_QIDX(i_) (mixq ? ((c.bid & 7) * SEQ + p2_blk_fast(c.bid >> 3, (i_) >> 1) * 16 + 2 * wv + ((i_) & 1)) : (gw + (i_) * NGW))
    const int nq = mixq ? 8 : (NTOK - gw + NGW - 1) / NGW;
    int qi = 0, n = DSA_QIDX(0), sl = 0, b0 = 0, t = 0, cnt = 0, nch = 0, nfar = 0; float Mref = 0.f;
    s16x8 qf[4]; v2u rawn; s16x8 qfn[4];
    if (nq > 0) { v2u raw0; DSA_LOADQ(n, raw0, qf); DSA_PREP(n, raw0, qf, 0, t, cnt, nch, nfar, Mref);
        asm volatile("s_waitcnt lgkmcnt(0)" ::: "memory");
        const v4u k80 = *(const LAS v4u*)(wsb + (8 * g4) * 2); DSA_ISSUE(0, 0, k80, 0, n, t, cnt, nfar); }
    for (; qi < nq; ++qi) {
        const bool has_next = qi + 1 < nq; const int nn = has_next ? DSA_QIDX(qi + 1) : n;
        if (has_next) DSA_LOADQ(nn, rawn, qfn);
        int tn = 0, cntn = 0, nchn = 0, nfarn = 0; float Mrefn = 0.f;
        f32x4 O[8];
#pragma unroll
        for (int m = 0; m < 8; ++m) O[m] = (f32x4){0.f, 0.f, 0.f, 0.f};
        float l_run = 0.f;
        v4u k8n = *(const LAS v4u*)(wsb + sl * 512 + (32 * (nch > 1 ? 1 : 0) + 8 * g4) * 2);
        for (int ch = 0; ch < nch; ++ch) {
            const int bi = (b0 + ch) & 1;
            asm volatile("s_waitcnt lgkmcnt(0)" ::: "memory");
            if (ch + 1 < nch) { const v4u k8 = k8n; k8n = *(const LAS v4u*)(wsb + sl * 512 + (32 * (ch + 2 < 8 ? ch + 2 : 7) + 8 * g4) * 2);
                DSA_ISSUE(ch + 1, bi ^ 1, k8, sl, n, t, cnt, nfar); asm volatile("s_waitcnt vmcnt(8)" ::: "memory"); }
            else if (has_next) { DSA_PREP(nn, rawn, qfn, sl ^ 1, tn, cntn, nchn, nfarn, Mrefn);
                asm volatile("s_waitcnt lgkmcnt(0)" ::: "memory");
                const v4u k8 = *(const LAS v4u*)(wsb + (sl ^ 1) * 512 + (8 * g4) * 2);
                DSA_ISSUE(0, bi ^ 1, k8, sl ^ 1, nn, tn, cntn, nfarn); asm volatile("s_waitcnt vmcnt(8)" ::: "memory"); }
            else asm volatile("s_waitcnt vmcnt(0)" ::: "memory");
            const LAS unsigned char* kb_ = kvb + bi * 8192;
            f32x4 S[2];
            { s16x8 ka[2][4];
#pragma unroll
              for (int T = 0; T < 2; ++T)
#pragma unroll
                  for (int s_ = 0; s_ < 4; ++s_) ka[T][s_] = *(const LAS s16x8*)(kb_ + qk_off + 4096 * T + 64 * ((unsigned)s_ ^ qk_sx));
              __builtin_amdgcn_sched_barrier(0);
              f32x4 a0 = {0.f, 0.f, 0.f, 0.f}, a1 = {0.f, 0.f, 0.f, 0.f};
#pragma unroll
              for (int s_ = 0; s_ < 4; ++s_) { a0 = __builtin_amdgcn_mfma_f32_16x16x32_bf16(ka[0][s_], qf[s_], a0, 0, 0, 0); a1 = __builtin_amdgcn_mfma_f32_16x16x32_bf16(ka[1][s_], qf[s_], a1, 0, 0, 0); }
              S[0] = a0; S[1] = a1; }
            if (ch < nfar) {
#pragma unroll
                for (int T = 0; T < 2; ++T)
#pragma unroll
                    for (int r_ = 0; r_ < 4; ++r_) S[T][r_] = fmaf(S[T][r_], 1.4426950408889634f, bfar - Mref);
            } else { float bsv[2][4]; unsigned ddv[2][4];
#pragma unroll
                for (int T = 0; T < 2; ++T) { const v2u d4 = *(const LAS v2u*)(wsb + 1024 + bi * 64 + 2 * (16 * T + grow));
#pragma unroll
                    for (int r_ = 0; r_ < 4; ++r_) { const unsigned dw = r_ < 2 ? d4.x : d4.y; const unsigned dd = (r_ & 1) ? (dw >> 16) : (dw & 0xffffu);
                        ddv[T][r_] = dd; bsv[T][r_] = biasL[(dd > 128u ? 128u : dd) * 8 + (l15 & 7)]; } }
                asm volatile("" : "+v"(bsv[0][0]), "+v"(bsv[0][1]), "+v"(bsv[0][2]), "+v"(bsv[0][3]), "+v"(bsv[1][0]), "+v"(bsv[1][1]), "+v"(bsv[1][2]), "+v"(bsv[1][3]));
#pragma unroll
                for (int T = 0; T < 2; ++T)
#pragma unroll
                    for (int r_ = 0; r_ < 4; ++r_) S[T][r_] = (ddv[T][r_] == 255u) ? -INFINITY : fmaf(S[T][r_], 1.4426950408889634f, bsv[T][r_] - Mref); }
#pragma unroll
            for (int T = 0; T < 2; ++T)
#pragma unroll
                for (int r_ = 0; r_ < 4; ++r_) { const float pv = __builtin_amdgcn_exp2f(S[T][r_]); S[T][r_] = pv; l_run += pv; }
            s16x8 P;
            { const unsigned p0 = cvt_pk(S[0][0], S[0][1]), p1 = cvt_pk(S[0][2], S[0][3]), p2 = cvt_pk(S[1][0], S[1][1]), p3 = cvt_pk(S[1][2], S[1][3]);
              const v4u pw_ = {p0, p1, p2, p3}; P = __builtin_bit_cast(s16x8, pw_); }
            { const unsigned kba = (unsigned)(size_t)kb_; s16x4 ta[8], tb[8];
#pragma unroll
              for (int m = 0; m < 8; ++m) { const unsigned ad = kba + trm[m];
                  asm volatile("ds_read_b64_tr_b16 %0, %1" : "=v"(ta[m]) : "v"(ad) : "memory"); asm volatile("ds_read_b64_tr_b16 %0, %1 offset:4096" : "=v"(tb[m]) : "v"(ad) : "memory"); }
              asm volatile("s_waitcnt lgkmcnt(8)" ::: "memory"); __builtin_amdgcn_sched_barrier(0);
#pragma unroll
              for (int m = 0; m < 4; ++m) O[m] = __builtin_amdgcn_mfma_f32_16x16x32_bf16(__builtin_shufflevector(ta[m], tb[m], 0, 1, 2, 3, 4, 5, 6, 7), P, O[m], 0, 0, 0);
              asm volatile("s_waitcnt lgkmcnt(0)" ::: "memory"); __builtin_amdgcn_sched_barrier(0);
#pragma unroll
              for (int m = 4; m < 8; ++m) O[m] = __builtin_amdgcn_mfma_f32_16x16x32_bf16(__builtin_shufflevector(ta[m], tb[m], 0, 1, 2, 3, 4, 5, 6, 7), P, O[m], 0, 0, 0); }
        }
        l_run = x16_sum(l_run); l_run = x32_sum(l_run);
        const float inv = __builtin_amdgcn_rcpf(fmaxf(l_run, 1e-37f));
        { LAS unsigned char* stg = kvb + ((b0 + nch - 1) & 1) * 8192;
          if (l15 < 8) {
#pragma unroll
              for (int m = 0; m < 8; ++m) *(LAS v2u*)(stg + (l15 * 128 + 16 * m + 4 * g4) * 2) = (v2u){cvt_pk(O[m][0] * inv, O[m][1] * inv), cvt_pk(O[m][2] * inv, O[m][3] * inv)}; }
          asm volatile("s_waitcnt lgkmcnt(0)" ::: "memory");
          const v4u oa = *(const LAS v4u*)(stg + lane * 16), ob = *(const LAS v4u*)(stg + 1024 + lane * 16);
          bf16* op = (bf16*)(c.ws + WS_XB) + (size_t)n * 1024 + lane * 8;
          st16_sc1(op, oa); st16_sc1(op + 512, ob); }
        b0 = (b0 + nch) & 1; sl ^= 1; t = tn; cnt = cntn; nch = nchn; nfar = nfarn; Mref = Mrefn; n = nn;
#pragma unroll
        for (int s_ = 0; s_ < 4; ++s_) qf[s_] = qfn[s_];
    }
#undef DSA_QIDX
#undef DSA_LOADQ
#undef DSA_PREP
#undef DSA_ISSUE
    asm volatile("s_waitcnt vmcnt(0) lgkmcnt(0)" ::: "memory");
    if (MK_N_LAUNCHES == 1 && c.G == 256 && lane == 0) {
#pragma unroll
        for (int q = 0; q < 4; ++q) __hip_atomic_fetch_add(c.ctl + 26624 + 64 * ((c.bid & 7) * 8 + (p2_blk_fast(c.bid >> 3, q) >> 4)), 1u, __ATOMIC_RELAXED, __HIP_MEMORY_SCOPE_AGENT); }
    if (wv >= 4) for (int eit = eit0; eit < P0_EXPERT_ITEMS; eit += NGW) p0_expert_item(c, (LAS float*)kvb, eit);
    __syncthreads();
}

__device__ __forceinline__ void p3b_swa(const Ctx& c, int u0, int ustep, int uend) {
    int tid_o = c.tid; asm volatile("" : "+v"(tid_o));
    const int lane = tid_o & 63, wv = c.wave, l15 = lane & 15, g4 = lane >> 4, g = wv & 3, hq = wv >> 2;
    LAS float* biasL = (LAS float*)(c.lds + DSA_BIAS_OFF);
    __syncthreads();
    for (int i = c.tid; i < 128 * 8; i += NTHR) biasL[i] = ((const float*)(c.ws + WS_BIAS) + 129 * 8)[i];
    __syncthreads();
    const unsigned kr_off = (unsigned)(128 * l15), kr_x = (unsigned)(l15 & 7);
    const int vrow = 4 * g4 + (l15 >> 2); const unsigned vr_x = (unsigned)(vrow & 7), vp1 = (unsigned)((lane & 3) >> 1);
    const unsigned vr_off = (unsigned)(128 * vrow + 8 * (lane & 1));
    for (int unit = u0; unit < uend; unit += ustep) {
        const int b = unit >> 5, qb = (unit >> 1) & 15, kvh = unit & 1, head = kvh * 4 + g;
        __syncthreads();
#pragma unroll
        for (int j = 0; j < 4; ++j) { const int piece = wv * 4 + j, row = 8 * piece + (lane >> 3), chunk = (lane & 7) ^ (row & 7); int key = (qb - 1) * 128 + row; key = key < 0 ? 0 : key;
            const size_t so = ((size_t)(b * SEQ + key) * 128 + kvh * 64 + chunk * 8);
            __builtin_amdgcn_global_load_lds((const unsigned*)((const bf16*)(c.ws + WS_KB) + so), (LAS unsigned*)(c.lds + piece * 1024), 16, 0, 0);
            __builtin_amdgcn_global_load_lds((const unsigned*)((const bf16*)(c.ws + WS_VB) + so), (LAS unsigned*)(c.lds + 32768 + piece * 1024), 16, 0, 0); }
        float bt[9][4];
#pragma unroll
        for (int ta = 0; ta < 9; ++ta)
#pragma unroll
            for (int r_ = 0; r_ < 4; ++r_) { const int dist = 128 + l15 - 16 * ta - 4 * g4 - r_; bt[ta][r_] = (dist >= 0 && dist < 128) ? biasL[dist * 8 + head] : -INFINITY; }
        const float sink = c.sinks[head];
        asm volatile("s_waitcnt vmcnt(0)" ::: "memory");
        __syncthreads();
        s16x8 q0, q1;
#pragma unroll 1
        for (int jj = 0; jj < 4; ++jj) {
            const int j = 4 * hq + jj; const size_t nrow = (size_t)(b * SEQ + qb * 128 + 16 * j + l15);
            bf16* qrow = (bf16*)(c.ws + WS_QB) + nrow * 512 + head * 64;
            q0 = *(const s16x8*)(qrow + 8 * g4); q1 = *(const s16x8*)(qrow + 32 + 8 * g4);
            s16x8 kf[9][2];
#pragma unroll
            for (int ta = 0; ta < 9; ++ta) { const LAS unsigned char* kp = c.lds + kr_off + 2048 * (j + ta);
                kf[ta][0] = *(const LAS s16x8*)(kp + 16 * ((unsigned)g4 ^ kr_x)); kf[ta][1] = *(const LAS s16x8*)(kp + 16 * ((unsigned)(4 + g4) ^ kr_x)); }
            __builtin_amdgcn_sched_barrier(0);
            f32x4 S[9]; float mx = sink;
#pragma unroll
            for (int ta = 0; ta < 9; ++ta) { const int kt = j + ta;
                f32x4 a4 = {0.f, 0.f, 0.f, 0.f};
                a4 = __builtin_amdgcn_mfma_f32_16x16x32_bf16(kf[ta][0], q0, a4, 0, 0, 0);
                a4 = __builtin_amdgcn_mfma_f32_16x16x32_bf16(kf[ta][1], q1, a4, 0, 0, 0);
                const bool dead = (qb == 0 && kt < 8);
#pragma unroll
                for (int r_ = 0; r_ < 4; ++r_) { const float sv = dead ? -INFINITY : a4[r_] + bt[ta][r_]; a4[r_] = sv; mx = fmaxf(mx, sv); }
                S[ta] = a4; }
            mx = x16_max(mx); mx = x32_max(mx);
            float ps = 0.f;
#pragma unroll
            for (int ta = 0; ta < 9; ++ta)
#pragma unroll
                for (int r_ = 0; r_ < 4; ++r_) { const float pv = __expf(S[ta][r_] - mx); S[ta][r_] = pv; ps += pv; }
            ps = x16_sum(ps); ps = x32_sum(ps);
            const float inv = 1.0f / (ps + __expf(sink - mx));
            f32x4 O[4];
#pragma unroll
            for (int m = 0; m < 4; ++m) O[m] = (f32x4){0.f, 0.f, 0.f, 0.f};
#pragma unroll
            for (int pp = 0; pp < 5; ++pp) {
                const int ta = 2 * pp, tb = 2 * pp + 1;
                v4u pw_; pw_.x = cvt_pk(S[ta][0] * inv, S[ta][1] * inv); pw_.y = cvt_pk(S[ta][2] * inv, S[ta][3] * inv);
                if (tb < 9) { pw_.z = cvt_pk(S[tb < 9 ? tb : 0][0] * inv, S[tb < 9 ? tb : 0][1] * inv); pw_.w = cvt_pk(S[tb < 9 ? tb : 0][2] * inv, S[tb < 9 ? tb : 0][3] * inv); } else { pw_.z = 0u; pw_.w = 0u; }
                const s16x8 P = __builtin_bit_cast(s16x8, pw_);
                const LAS unsigned char* va = c.lds + 32768 + vr_off + 2048 * (j + ta); const LAS unsigned char* vb_ = c.lds + 32768 + vr_off + 2048 * (j + (tb < 9 ? tb : ta));
#pragma unroll
                for (int m = 0; m < 4; ++m) { const unsigned co = 16u * ((unsigned)(2 * m + vp1) ^ vr_x);
                    const s16x4 a0 = __builtin_amdgcn_ds_read_tr16_b64_v4i16((LAS s16x4*)(va + co)), a1 = __builtin_amdgcn_ds_read_tr16_b64_v4i16((LAS s16x4*)(vb_ + co));
                    O[m] = __builtin_amdgcn_mfma_f32_16x16x32_bf16(__builtin_shufflevector(a0, a1, 0, 1, 2, 3, 4, 5, 6, 7), P, O[m], 0, 0, 0); }
            }
#pragma unroll
            for (int m = 0; m < 4; ++m) st8_sc1(qrow + 16 * m + 4 * g4, (v2u){cvt_pk(O[m][0], O[m][1]), cvt_pk(O[m][2], O[m][3])});
        }
    }
    __syncthreads();
}

__device__ __forceinline__ void p6_ln_router(const Ctx& c, bf16* x1b, const XcdBarrier bar, const bool seam) {
    int tid_o = c.tid; asm volatile("" : "+v"(tid_o));
    const int lane = tid_o & 63, wv = c.wave, l15 = lane & 15, g4 = lane >> 4;
    LAS unsigned char* XH = c.lds; LAS unsigned char* XL = c.lds + 32768;
    LAS float* PL = (LAS float*)(c.lds + 65536);
    LAS float* LG = (LAS float*)(c.lds + 65536 + 24576);
    const bf16* WH = (const bf16*)(c.ws + WS_WRT); const bf16* WL = WH + 48 * 1024;
    LAS unsigned* PEX = (LAS unsigned*)(c.lds + 65536 + 24576 + 4096);
    LAS unsigned* EB = PEX + 128;
    int nbase = 0;
    s16x8 wbh[4][3], wbl[4][3];
#pragma unroll
    for (int s_ = 0; s_ < 4; ++s_)
#pragma unroll
        for (int nt = 0; nt < 3; ++nt) { const size_t wo = (size_t)(16 * nt + l15) * 1024 + 128 * wv + 32 * s_ + 8 * g4; wbh[s_][nt] = *(const s16x8*)(WH + wo); wbl[s_][nt] = *(const s16x8*)(WL + wo); }
    LAS f32x4* G1 = (LAS f32x4*)(c.lds + 102400); LAS f32x4* B1 = G1 + 256;
    if (c.tid < 256) { G1[c.tid] = ((const f32x4*)c.ln1_g)[c.tid]; B1[c.tid] = ((const f32x4*)c.ln1_b)[c.tid]; }
    LAS unsigned* PEXW = EB + 192;
    LAS float* RB = (LAS float*)(EB + 128);
    if (c.tid < 48) RB[c.tid] = c.tid < 32 ? c.b_router[c.tid] : (c.tid < 36 ? c.b_group[c.tid - 32] : 0.f);
    if (c.tid < 32) EB[64 + c.tid] = 0u;
    if (seam) {
        if (MK_N_LAUNCHES == 1 && c.G == 256) {
            if (c.tid == 0) { unsigned sp = 0; unsigned* w = c.ctl + 26624 + 64 * (c.bid >> 4);
                for (;;) { const unsigned a0 = __hip_atomic_load(w, __ATOMIC_RELAXED, __HIP_MEMORY_SCOPE_AGENT), a1 = __hip_atomic_load(w + 64 * 16, __ATOMIC_RELAXED, __HIP_MEMORY_SCOPE_AGENT),
                                          a2 = __hip_atomic_load(w + 64 * 32, __ATOMIC_RELAXED, __HIP_MEMORY_SCOPE_AGENT), a3 = __hip_atomic_load(w + 64 * 48, __ATOMIC_RELAXED, __HIP_MEMORY_SCOPE_AGENT);
                    if (a0 >= 192u && a1 >= 192u && a2 >= 192u && a3 >= 192u) break;
                    __builtin_amdgcn_s_sleep(2);
                    if ((++sp & 1023u) == 0u) { if (__hip_atomic_load(c.ctl + CW_TMO_P2, __ATOMIC_RELAXED, __HIP_MEMORY_SCOPE_AGENT) != 0u) break;
                        if (sp > (1u << 22)) { __hip_atomic_store(c.ctl + CW_TMO_P2, 1u, __ATOMIC_RELAXED, __HIP_MEMORY_SCOPE_AGENT); break; } } }
                __builtin_amdgcn_fence(__ATOMIC_ACQUIRE, "agent");
                asm volatile("s_waitcnt vmcnt(0)" ::: "memory"); }
            __syncthreads();
        } else xcd_barrier(bar);
    }
    v4u vn[2][2];
    const bf16* h1b = (const bf16*)(c.ws + WS_H1B);
    if (c.bid < NTOK / 16) {
#pragma unroll
        for (int q = 0; q < 2; ++q)
#pragma unroll
            for (int h = 0; h < 2; ++h) vn[q][h] = *(const v4u*)(h1b + (size_t)(c.bid * 16 + 2 * wv + q) * D + 8 * lane + 512 * h); }
    for (int u = c.bid; u < NTOK / 16; u += c.G) {
        __syncthreads();
        f32x4 gv[4], bv[4];
#pragma unroll
        for (int h = 0; h < 2; ++h) { gv[2 * h] = G1[2 * lane + 128 * h]; gv[2 * h + 1] = G1[2 * lane + 128 * h + 1]; bv[2 * h] = B1[2 * lane + 128 * h]; bv[2 * h + 1] = B1[2 * lane + 128 * h + 1]; }
#pragma unroll
        for (int q = 0; q < 2; ++q) { const int tk = 2 * wv + q, n = u * 16 + tk;
            f32x4 v[4]; float s = 0.f;
#pragma unroll
            for (int h = 0; h < 2; ++h) { const v4u w_ = vn[q][h];
                v[2 * h] = (f32x4){bflo(w_.x), bfhi(w_.x), bflo(w_.y), bfhi(w_.y)}; v[2 * h + 1] = (f32x4){bflo(w_.z), bfhi(w_.z), bflo(w_.w), bfhi(w_.w)}; }
#pragma unroll
            for (int j = 0; j < 4; ++j) s += (v[j].x + v[j].y) + (v[j].z + v[j].w);
            const float mean = wave_sum(s) * (1.f / D); float s2 = 0.f;
#pragma unroll
            for (int j = 0; j < 4; ++j) { v[j] = v[j] - mean; s2 += (v[j].x * v[j].x + v[j].y * v[j].y) + (v[j].z * v[j].z + v[j].w * v[j].w); }
            const float rstd = 1.f / sqrtf(wave_sum(s2) * (1.f / D) + LN_EPS);
#pragma unroll
            for (int h = 0; h < 2; ++h) { const int k0 = 8 * lane + 512 * h;
                const f32x4 y0 = v[2 * h] * rstd * gv[2 * h] + bv[2 * h], y1 = v[2 * h + 1] * rstd * gv[2 * h + 1] + bv[2 * h + 1];
                const unsigned h01 = pk2(y0.x, y0.y), h23 = pk2(y0.z, y0.w), h45 = pk2(y1.x, y1.y), h67 = pk2(y1.z, y1.w);
                *(v4u*)(x1b + (size_t)n * D + k0) = (v4u){h01, h23, h45, h67};
                const unsigned l01 = pk2(y0.x - bflo(h01), y0.y - bfhi(h01)), l23 = pk2(y0.z - bflo(h23), y0.w - bfhi(h23)), l45 = pk2(y1.x - bflo(h45), y1.y - bfhi(h45)), l67 = pk2(y1.z - bflo(h67), y1.w - bfhi(h67));
                const unsigned off = (unsigned)(tk * 2048 + (((lane + 64 * h) ^ tk) << 4));
                *(LAS v4u*)(XH + off) = (v4u){h01, h23, h45, h67}; *(LAS v4u*)(XL + off) = (v4u){l01, l23, l45, l67}; } }
        if (u + c.G < NTOK / 16) {
#pragma unroll
            for (int q = 0; q < 2; ++q)
#pragma unroll
                for (int h = 0; h < 2; ++h) vn[q][h] = *(const v4u*)(h1b + (size_t)((u + c.G) * 16 + 2 * wv + q) * D + 8 * lane + 512 * h); }
        __syncthreads();
        { f32x4 acc[3];
#pragma unroll
          for (int nt = 0; nt < 3; ++nt) acc[nt] = (f32x4){0.f, 0.f, 0.f, 0.f};
          s16x8 ahv[4], alv[4];
#pragma unroll
          for (int s_ = 0; s_ < 4; ++s_) { const int chunk = 4 * (4 * wv + s_) + g4; const unsigned off = (unsigned)(l15 * 2048 + ((chunk ^ l15) << 4));
              ahv[s_] = *(const LAS s16x8*)(XH + off); alv[s_] = *(const LAS s16x8*)(XL + off); }
          __builtin_amdgcn_sched_barrier(0);
#pragma unroll
          for (int s_ = 0; s_ < 4; ++s_) { const s16x8 ah = ahv[s_], al = alv[s_];
#pragma unroll
              for (int nt = 0; nt < 3; ++nt) { const s16x8 bh = wbh[s_][nt], bl = wbl[s_][nt];
                  acc[nt] = __builtin_amdgcn_mfma_f32_16x16x32_bf16(al, bl, acc[nt], 0, 0, 0); acc[nt] = __builtin_amdgcn_mfma_f32_16x16x32_bf16(al, bh, acc[nt], 0, 0, 0);
                  acc[nt] = __builtin_amdgcn_mfma_f32_16x16x32_bf16(ah, bl, acc[nt], 0, 0, 0); acc[nt] = __builtin_amdgcn_mfma_f32_16x16x32_bf16(ah, bh, acc[nt], 0, 0, 0); } }
#pragma unroll
          for (int nt = 0; nt < 3; ++nt)
#pragma unroll
              for (int r_ = 0; r_ < 4; ++r_) PL[(wv * 16 + 4 * g4 + r_) * 48 + 16 * nt + l15] = acc[nt][r_]; }
        __syncthreads();
        for (int i = c.tid; i < 16 * 48; i += NTHR) { float a = 0.f;
#pragma unroll
            for (int w = 0; w < 8; ++w) a += PL[w * 768 + i];
            a += RB[i % 48];
            LG[i] = a; }
        __syncthreads();
        if (c.tid < 16) { const int n = u * 16 + c.tid; const LAS float* lg = LG + c.tid * 48; const int nloc = nbase + 2 * c.tid;
            int gs = 0; float gm = lg[32];
            for (int o = 1; o < 4; ++o) { const float v = lg[32 + o]; if (v > gm) { gm = v; gs = o; } }
            float gsum = 0.f;
            for (int o = 0; o < 4; ++o) gsum += __expf(lg[32 + o] - gm);
            const float gw_ = 1.0f / gsum;
            int i1 = 0; float m1 = lg[gs * 8];
            for (int o = 1; o < 8; ++o) { const float v = lg[gs * 8 + o]; if (v > m1) { m1 = v; i1 = o; } }
            int i2 = -1; float m2 = -INFINITY;
            for (int o = 0; o < 8; ++o) { const float v = lg[gs * 8 + o]; if (o != i1 && v > m2) { m2 = v; i2 = o; } }
            const float e2 = __expf(m2 - m1), w1 = gw_ / (1.0f + e2), w2 = gw_ * e2 / (1.0f + e2);
            const int ex1 = gs * 8 + i1, ex2 = gs * 8 + i2;
            PEX[nloc] = (unsigned)ex1 | ((unsigned)(2 * n) << 8); PEX[nloc + 1] = (unsigned)ex2 | ((unsigned)(2 * n + 1) << 8);
            PEXW[nloc] = __builtin_bit_cast(unsigned, w1); PEXW[nloc + 1] = __builtin_bit_cast(unsigned, w2); }
        nbase += 32;
        if (nbase == 128 || u + c.G >= NTOK / 16) {
            __syncthreads();
            unsigned rec = 0u, rk = 0u;
            if (c.tid < nbase) { rec = PEX[c.tid]; rk = __hip_atomic_fetch_add(&EB[64 + (rec & 0xffu)], 1u, __ATOMIC_RELAXED, __HIP_MEMORY_SCOPE_WORKGROUP); }
            __syncthreads();
            if (c.tid < 32) { const unsigned cntE = EB[64 + c.tid]; EB[c.tid] = cntE ? atomicAdd(c.ctl + CW_CNT + c.tid, cntE) : 0u; EB[64 + c.tid] = 0u; }
            __syncthreads();
            if (c.tid < nbase) { const unsigned e = rec & 0xffu; ((v2u*)(c.ws + WS_LIST))[(size_t)e * 32768 + EB[e] + rk] = (v2u){rec >> 8, PEXW[c.tid]}; }
            nbase = 0;
        }
    }
    __syncthreads();
}


__device__ __forceinline__ void p9_ln2(const Ctx& c, const XcdBarrier bar, const bool seam) {
    const int gw = c.bid * NWAVES + c.wave, NGW = c.G * NWAVES;
    int tid_o = c.tid; asm volatile("" : "+v"(tid_o)); const int lane = tid_o & 63;
    LAS f32x4* G2 = (LAS f32x4*)(c.lds + 102400); LAS f32x4* B2 = G2 + 256;
    __syncthreads();
    if (c.tid < 256) { G2[c.tid] = ((const f32x4*)c.ln2_g)[c.tid]; B2[c.tid] = ((const f32x4*)c.ln2_b)[c.tid]; }
    __syncthreads();
    f32x4 gv2[4], bv2[4];
#pragma unroll
    for (int h = 0; h < 2; ++h) { gv2[2 * h] = G2[2 * lane + 128 * h]; gv2[2 * h + 1] = G2[2 * lane + 128 * h + 1]; bv2[2 * h] = B2[2 * lane + 128 * h]; bv2[2 * h + 1] = B2[2 * lane + 128 * h + 1]; }
    v4u xn[2], san[2], sbn[2];
#define P9_LOAD(n_) do { _Pragma("unroll") for (int h = 0; h < 2; ++h) { const int k0 = 8 * lane + 512 * h; xn[h] = __builtin_nontemporal_load((const v4u*)((const bf16*)(c.ws + WS_XB) + (size_t)(n_) * D + k0)); \
            san[h] = __builtin_nontemporal_load((const v4u*)((const bf16*)(c.ws + WS_SLOT) + (size_t)(2 * (n_)) * D + k0)); sbn[h] = __builtin_nontemporal_load((const v4u*)((const bf16*)(c.ws + WS_SLOT) + (size_t)(2 * (n_) + 1) * D + k0)); } } while (0)
    if (gw < NTOK) {
#pragma unroll
        for (int h = 0; h < 2; ++h) xn[h] = *(const v4u*)((const bf16*)(c.ws + WS_XB) + (size_t)gw * D + 8 * lane + 512 * h); }
    if (seam) xcd_barrier(bar);
    if (gw < NTOK) {
#pragma unroll
        for (int h = 0; h < 2; ++h) { const int k0 = 8 * lane + 512 * h; san[h] = *(const v4u*)((const bf16*)(c.ws + WS_SLOT) + (size_t)(2 * gw) * D + k0); sbn[h] = *(const v4u*)((const bf16*)(c.ws + WS_SLOT) + (size_t)(2 * gw + 1) * D + k0); } }
    for (int n = gw; n < NTOK; n += NGW) {
        float* row = c.out + (size_t)n * D + 8 * lane;
        f32x4 v[4]; float s = 0.f;
#pragma unroll
        for (int h = 0; h < 2; ++h) {
#pragma unroll
            for (int q = 0; q < 2; ++q) { const unsigned x0 = q ? xn[h].z : xn[h].x, x1 = q ? xn[h].w : xn[h].y, a0 = q ? san[h].z : san[h].x, a1 = q ? san[h].w : san[h].y, b0 = q ? sbn[h].z : sbn[h].x, b1 = q ? sbn[h].w : sbn[h].y;
                f32x4 y;
                y.x = bflo(x0) * ALPHA + (bflo(a0) + bflo(b0)); y.y = bfhi(x0) * ALPHA + (bfhi(a0) + bfhi(b0));
                y.z = bflo(x1) * ALPHA + (bflo(a1) + bflo(b1)); y.w = bfhi(x1) * ALPHA + (bfhi(a1) + bfhi(b1));
                v[2 * h + q] = y; s += (y.x + y.y) + (y.z + y.w); } }
        if (n + NGW < NTOK) P9_LOAD(n + NGW);
        const float mean = wave_sum(s) * (1.f / D); float s2 = 0.f;
#pragma unroll
        for (int j = 0; j < 4; ++j) { v[j] = v[j] - mean; s2 += (v[j].x * v[j].x + v[j].y * v[j].y) + (v[j].z * v[j].z + v[j].w * v[j].w); }
        const float rstd = 1.f / sqrtf(wave_sum(s2) * (1.f / D) + LN_EPS);
#pragma unroll
        for (int h = 0; h < 2; ++h) { *(f32x4*)(row + 512 * h) = v[2 * h] * rstd * gv2[2 * h] + bv2[2 * h]; *(f32x4*)(row + 512 * h + 4) = v[2 * h + 1] * rstd * gv2[2 * h + 1] + bv2[2 * h + 1]; }
    }
#undef P9_LOAD
}

namespace pg8 {
typedef short bf16x8 __attribute__((ext_vector_type(8)));
constexpr int BM = 256, BK = 64, HALF = 128, HTB = HALF * BK * 2, STAGE_BYTES = 8 * HTB, NXCD = 8, WGM = 8;
__host__ __device__ __forceinline__ int lds_byte(int r, int c) { const int st = (r >> 4) * 2 + (c >> 5), rr = r & 15, cc = c & 31, ob = rr * 64 + cc * 2; return st * 1024 + (ob ^ (((ob >> 9) & 1) << 5)); }
__host__ __device__ __forceinline__ void stage_rc(int b, int& R, int& C) { const int st = b / 1024, sb = b % 1024, swz = sb ^ (((sb >> 9) & 1) << 5); R = (st >> 1) * 16 + swz / 64; C = (st & 1) * 32 + (swz % 64) / 2; }
__host__ __device__ __forceinline__ int perm32(int rho) { const int n = rho >> 4, i = rho & 15; return 8 * (i >> 2) + 4 * n + (i & 3); }
__device__ __forceinline__ unsigned cvt_pk_bf16(float lo, float hi) { unsigned r; asm volatile("v_cvt_pk_bf16_f32 %0, %1, %2" : "=v"(r) : "v"(lo), "v"(hi)); return r; }

struct Unit { int pm, pn, pb, aux, half; };

struct StaticOrder {
    static constexpr bool HALF_SKIP = false;
    int nM, nN, nwg, G, c;
    __device__ void init(int M, int N, int G_, int c_) { nM = M / BM; nN = N / BM; nwg = nM * nN; G = G_; c = c_; }
    __device__ __forceinline__ bool next(int i, Unit& u) const {
        const long L = (long)i * G + c; if (L >= nwg) return false;
        int wgid = (int)L; { const int q = nwg / NXCD, r = nwg % NXCD, xcd = wgid % NXCD, off = wgid / NXCD; wgid = (xcd < r ? xcd * (q + 1) : r * (q + 1) + (xcd - r) * q) + off; }
        const int nig = WGM * nN, gid = wgid / nig, fm = gid * WGM, gsz = (nM - fm) < WGM ? (nM - fm) : WGM;
        u.pm = fm + ((wgid % nig) % gsz); u.pn = (wgid % nig) / gsz; u.pb = u.pn; u.aux = 0; u.half = 0; return true;
    }
    __device__ __forceinline__ void a_ready(const Unit&) const {}
    __device__ __forceinline__ void done(const Unit&) const {}
};
constexpr int CW_PAN = 26624;
struct PanelOrder : StaticOrder {
    unsigned* ctl; unsigned need;
    __device__ __forceinline__ void a_ready(const Unit& u) const {
        if (need == 0u) return;
        if (threadIdx.x < 64) { unsigned* w = ctl + CW_PAN + 64 * u.pm; unsigned sp = 0;
            while ((unsigned)__builtin_amdgcn_readfirstlane(__hip_atomic_load(w, __ATOMIC_RELAXED, __HIP_MEMORY_SCOPE_AGENT)) < need) {
                __builtin_amdgcn_s_sleep(2);
                if ((++sp & 1023u) == 0u) { if (__hip_atomic_load(ctl + 8, __ATOMIC_RELAXED, __HIP_MEMORY_SCOPE_AGENT) != 0u) break;
                    if (sp > (1u << 22)) { __hip_atomic_store(ctl + 8, 1u, __ATOMIC_RELAXED, __HIP_MEMORY_SCOPE_AGENT); break; } } }
            __builtin_amdgcn_fence(__ATOMIC_ACQUIRE, "agent");
            asm volatile("s_waitcnt vmcnt(0)" ::: "memory"); }
        asm volatile("" ::: "memory"); __builtin_amdgcn_s_barrier(); asm volatile("" ::: "memory");
    }
};
struct ProjOrder {
    static constexpr bool HALF_SKIP = false;
    int G, c; unsigned* ctl;
    __device__ bool next(int i, Unit& u) const {
        const int L = i * G + c; if (L >= 64 * 18) return false;
        const int x = L & 7, off = L >> 3;
        if (off < 48) { u.pm = 8 * x + (off & 7); u.pn = 4 + (off >> 3); u.aux = 1; }
        else { const int w = off - 48, v = w >> 3; u.pm = 8 * x + (w & 7); u.pn = v < 4 ? v : v + 6; u.aux = 0; }
        u.pb = u.pn; u.half = 0; return true;
    }
    __device__ __forceinline__ void a_ready(const Unit&) const {}
    __device__ __forceinline__ void done(const Unit& u) const {
        if (u.aux) {
            asm volatile("s_waitcnt vmcnt(0)" ::: "memory");
            if ((threadIdx.x & 63) == 0) __hip_atomic_fetch_add(ctl + CW_P1S + 64 * (u.pm >> 3), 1u, __ATOMIC_RELAXED, __HIP_MEMORY_SCOPE_AGENT);
        }
    }
};
struct DenseProb {
    static constexpr bool GATHER = false;
    const bf16* A; const bf16* Bt; int K;
    __device__ __forceinline__ const char* a_base(const Unit& u) const { return (const char*)A + (size_t)u.pm * 256 * K * 2; }
    __device__ __forceinline__ const char* b_base(const Unit& u) const { return (const char*)Bt + (size_t)u.pb * 256 * K * 2; }
    __device__ __forceinline__ void a_offs(const Unit&, int R0, int C0, int R1, int C1, unsigned (&o)[2][2]) const {
        o[0][0] = (unsigned)(R0 * K + C0) * 2u; o[0][1] = (unsigned)(R1 * K + C1) * 2u; o[1][0] = o[0][0] + (unsigned)(HALF * K * 2); o[1][1] = o[0][1] + (unsigned)(HALF * K * 2); }
};

template <class Prob, class Epi, class Sched>
__device__ __forceinline__ void gemm_phase(LAS unsigned char* lds, const Prob& P, const Sched& S, const Epi& E) {
    const int tid = threadIdx.x, wid = __builtin_amdgcn_readfirstlane(tid >> 6), lane = tid & 63, wr = wid >> 2, wc = wid & 3, fr = lane & 15, fq = lane >> 4;
    const int K = P.K, nt = K / BK;
    int sR[2], sC[2];
    unsigned offB0[2], offA[2][2];
#pragma unroll
    for (int i = 0; i < 2; ++i) { stage_rc(tid * 16 + i * 8192, sR[i], sC[i]); const int Rb = Epi::PERM ? ((sR[i] & ~31) + perm32(sR[i] & 31)) : sR[i];
        offB0[i] = (unsigned)(Rb * K + sC[i]) * 2u; }
    const size_t hstepB = (size_t)HALF * K * 2;
    const size_t kstep = (size_t)(BK * 2);
    const unsigned ldsw = (unsigned)wid * 1024u;
    const int aoff = lds_byte(wr * 64 + fr, fq * 8), boff = lds_byte(wc * 32 + fr, fq * 8);
#define PG8_SA(b, h) (((b) * 2 + (h)) * HTB)
#define PG8_SB(b, h) ((4 + (b) * 2 + (h)) * HTB)
#define PG8_STAGE(bufoff, gbase, offs) do { _Pragma("unroll") for (int _i = 0; _i < 2; ++_i) \
        __builtin_amdgcn_global_load_lds((const unsigned*)((gbase) + (offs)[_i]), (LAS unsigned*)(lds + (bufoff) + ldsw + _i * 8192), 16, 0, 0); } while (0)
#define PG8_STA(b, h, tau) PG8_STAGE(PG8_SA(b, h), sA + (size_t)(tau) * kstep, offA[h])
#define PG8_STB(b, h, tau) PG8_STAGE(PG8_SB(b, h), sB + (size_t)(tau) * kstep + (h) * hstepB, offB0)
#define PG8_LDA(dst, b, h) do { _Pragma("unroll") for (int m = 0; m < 4; ++m) _Pragma("unroll") for (int k = 0; k < 2; ++k) dst[m][k] = *(const LAS bf16x8*)(lds + PG8_SA(b, h) + aoff + m * 2048 + k * 1024); } while (0)
#define PG8_LDB(dst, b, h) do { _Pragma("unroll") for (int n = 0; n < 2; ++n) _Pragma("unroll") for (int k = 0; k < 2; ++k) dst[n][k] = *(const LAS bf16x8*)(lds + PG8_SB(b, h) + boff + n * 2048 + k * 1024); } while (0)
#define PG8_MMA(ai, bj, At, Bt) do { __builtin_amdgcn_s_setprio(1); _Pragma("unroll") for (int m = 0; m < 4; ++m) _Pragma("unroll") for (int n = 0; n < 2; ++n) _Pragma("unroll") for (int k = 0; k < 2; ++k) \
        acc[ai][bj][m][n] = __builtin_amdgcn_mfma_f32_16x16x32_bf16(Bt[n][k], At[m][k], acc[ai][bj][m][n], 0, 0, 0); __builtin_amdgcn_s_setprio(0); } while (0)
#define PG8_WAIT_V(n) asm volatile("s_waitcnt vmcnt(" #n ")" ::: "memory")
#define PG8_WAIT_L(n) asm volatile("s_waitcnt lgkmcnt(" #n ")" ::: "memory")
#define PG8_BAR __builtin_amdgcn_s_barrier()
#define PG8_SCHED __builtin_amdgcn_sched_barrier(0)
    Unit cur, nxt; int ui = 0;
    if (!S.next(0, cur)) return;
    f32x4 acc[2][2][4][2];
#pragma unroll
    for (int a = 0; a < 2; ++a)
#pragma unroll
        for (int b = 0; b < 2; ++b)
#pragma unroll
            for (int m = 0; m < 4; ++m)
#pragma unroll
                for (int n = 0; n < 2; ++n) acc[a][b][m][n] = (f32x4){0.f, 0.f, 0.f, 0.f};
    bf16x8 At[4][2], B0[2][2], B1[2][2];
    const char* sA = P.a_base(cur); const char* sB = P.b_base(cur);
    S.a_ready(cur);
    P.a_offs(cur, sR[0], sC[0], sR[1], sC[1], offA);
    PG8_STB(0, 0, 0); PG8_STB(0, 1, 0); PG8_STA(0, 0, 0); PG8_STA(0, 1, 0);
    if (wr == 1) PG8_BAR;
    PG8_WAIT_V(2); PG8_BAR;
    PG8_STB(1, 0, 1); PG8_STA(1, 0, 1); PG8_STB(1, 1, 1);
    PG8_WAIT_V(6); PG8_BAR;
    for (;;) {
        const bool has_next = S.next(ui + 1, nxt);
        const char* nA = has_next ? P.a_base(nxt) : sA; const char* nB = has_next ? P.b_base(nxt) : sB;
        const bool skip1 = Sched::HALF_SKIP && cur.half != 0;
        for (int t = 0; t < nt; t += 2) {
            const bool last = (t == nt - 2);
            if (last && has_next) S.a_ready(nxt);
            PG8_LDB(B0, 0, 0); PG8_LDB(B1, 0, 1); PG8_SCHED; PG8_LDA(At, 0, 0); PG8_STA(1, 1, t + 1);
            PG8_WAIT_V(8); PG8_WAIT_L(0); PG8_BAR; PG8_MMA(0, 0, At, B0); PG8_MMA(0, 1, At, B1); PG8_BAR; PG8_SCHED;
            if (last) {
                sA = nA - (size_t)nt * kstep; sB = nB - (size_t)nt * kstep;
                if (Prob::GATHER) { if (has_next) P.a_offs(nxt, sR[0], sC[0], sR[1], sC[1], offA); }
            }
            if (!skip1) PG8_LDA(At, 0, 1); PG8_STB(0, 0, t + 2); PG8_STB(0, 1, t + 2); PG8_STA(0, 0, t + 2);
            PG8_WAIT_V(8); PG8_WAIT_L(0); PG8_BAR; if (!skip1) { PG8_MMA(1, 0, At, B0); PG8_MMA(1, 1, At, B1); } PG8_BAR; PG8_SCHED;
            PG8_LDB(B0, 1, 0); PG8_LDB(B1, 1, 1); PG8_SCHED; PG8_LDA(At, 1, 0); PG8_STA(0, 1, t + 2);
            PG8_WAIT_V(8); PG8_WAIT_L(0); PG8_BAR; PG8_MMA(0, 0, At, B0); PG8_MMA(0, 1, At, B1); PG8_BAR; PG8_SCHED;
            if (!skip1) PG8_LDA(At, 1, 1); PG8_STB(1, 0, t + 3); PG8_STB(1, 1, t + 3); PG8_STA(1, 0, t + 3);
            PG8_WAIT_V(8); PG8_WAIT_L(0); PG8_BAR; if (!skip1) { PG8_MMA(1, 0, At, B0); PG8_MMA(1, 1, At, B1); } PG8_BAR; PG8_SCHED;
        }
        if (wr == 0) PG8_BAR;
        E(acc, cur, wr, wc, fr, fq); S.done(cur);
        if (!has_next) break;
#pragma unroll
        for (int a = 0; a < 2; ++a)
#pragma unroll
            for (int b = 0; b < 2; ++b)
#pragma unroll
                for (int m = 0; m < 4; ++m)
#pragma unroll
                    for (int n = 0; n < 2; ++n) acc[a][b][m][n] = (f32x4){0.f, 0.f, 0.f, 0.f};
        cur = nxt; ++ui; sA = nA; sB = nB;
        if (wr == 1) PG8_BAR;
    }
    PG8_WAIT_V(0);
    PG8_BAR;
#undef PG8_SA
#undef PG8_SB
#undef PG8_STAGE
#undef PG8_STA
#undef PG8_STB
#undef PG8_LDA
#undef PG8_LDB
#undef PG8_MMA
#undef PG8_WAIT_V
#undef PG8_WAIT_L
#undef PG8_BAR
#undef PG8_SCHED
}

template <class Epi, class Sched>
__device__ __forceinline__ void gemm_phase_dual(LAS unsigned char* lds, const bf16* A1, const bf16* Bt1, int K1, const bf16* A2, const bf16* Bt2, int K2, const Sched& S, const Epi& E) {
    const int tid = threadIdx.x, wid = __builtin_amdgcn_readfirstlane(tid >> 6), lane = tid & 63, wr = wid >> 2, wc = wid & 3, fr = lane & 15, fq = lane >> 4;
    const int nt1 = K1 / BK, nt = (K1 + K2) / BK;
    unsigned offB1[2][2], offA1[2][2]; const unsigned dK2 = (unsigned)(2 * (K2 - K1));
#pragma unroll
    for (int i = 0; i < 2; ++i) { int R, C; stage_rc(tid * 16 + i * 8192, R, C); const int Rb = (R & ~31) + perm32(R & 31);
        offA1[0][i] = (unsigned)(R * K1 + C) * 2u; offA1[1][i] = offA1[0][i] + (unsigned)(HALF * K1 * 2); offB1[0][i] = (unsigned)(Rb * K1 + C) * 2u; offB1[1][i] = offB1[0][i] + (unsigned)(HALF * K1 * 2); }
    const size_t kstep = (size_t)(BK * 2);
    const unsigned ldsw = (unsigned)wid * 1024u;
    const int aoff = lds_byte(wr * 64 + fr, fq * 8), boff = lds_byte(wc * 32 + fr, fq * 8);
#define PG8_SA(b, h) (((b) * 2 + (h)) * HTB)
#define PG8_SB(b, h) ((4 + (b) * 2 + (h)) * HTB)
#define PG8_STX(bufoff, tau, g1, g2, o1, o2) do { const int _t = (tau); const bool _s2 = _t >= nt1; const long long _d = _s2 ? (long long)((g2) - (g1)) - (long long)nt1 * (long long)kstep : 0ll; const char* _g = (g1) + (size_t)_t * kstep + _d; \
        _Pragma("unroll") for (int _i = 0; _i < 2; ++_i) { const unsigned _o = (o1)[_i] + (_s2 ? ((o1)[_i] >> 11) * dK2 : 0u); \
        __builtin_amdgcn_global_load_lds((const unsigned*)(_g + _o), (LAS unsigned*)(lds + (bufoff) + ldsw + _i * 8192), 16, 0, 0); } } while (0)
#define PG8_STA(b, h, tau) PG8_STX(PG8_SA(b, h), tau, sA1, sA2, offA1[h], 0)
#define PG8_STB(b, h, tau) PG8_STX(PG8_SB(b, h), tau, sB1, sB2, offB1[h], 0)
#define PG8_LDA(dst, b, h) do { _Pragma("unroll") for (int m = 0; m < 4; ++m) _Pragma("unroll") for (int k = 0; k < 2; ++k) dst[m][k] = *(const LAS bf16x8*)(lds + PG8_SA(b, h) + aoff + m * 2048 + k * 1024); } while (0)
#define PG8_LDB(dst, b, h) do { _Pragma("unroll") for (int n = 0; n < 2; ++n) _Pragma("unroll") for (int k = 0; k < 2; ++k) dst[n][k] = *(const LAS bf16x8*)(lds + PG8_SB(b, h) + boff + n * 2048 + k * 1024); } while (0)
#define PG8_MMA(ai, bj, At, Bt) do { __builtin_amdgcn_s_setprio(1); _Pragma("unroll") for (int m = 0; m < 4; ++m) _Pragma("unroll") for (int n = 0; n < 2; ++n) _Pragma("unroll") for (int k = 0; k < 2; ++k) \
        acc[ai][bj][m][n] = __builtin_amdgcn_mfma_f32_16x16x32_bf16(Bt[n][k], At[m][k], acc[ai][bj][m][n], 0, 0, 0); __builtin_amdgcn_s_setprio(0); } while (0)
#define PG8_WAIT_V(n) asm volatile("s_waitcnt vmcnt(" #n ")" ::: "memory")
#define PG8_WAIT_L(n) asm volatile("s_waitcnt lgkmcnt(" #n ")" ::: "memory")
#define PG8_BAR __builtin_amdgcn_s_barrier()
#define PG8_SCHED __builtin_amdgcn_sched_barrier(0)
    Unit cur, nxt; int ui = 0;
    if (!S.next(0, cur)) return;
    f32x4 acc[2][2][4][2];
#pragma unroll
    for (int a = 0; a < 2; ++a)
#pragma unroll
        for (int b = 0; b < 2; ++b)
#pragma unroll
            for (int m = 0; m < 4; ++m)
#pragma unroll
                for (int n = 0; n < 2; ++n) acc[a][b][m][n] = (f32x4){0.f, 0.f, 0.f, 0.f};
    bf16x8 At[4][2], B0[2][2], B1[2][2];
    const char* sA1 = (const char*)A1 + (size_t)cur.pm * 256 * K1 * 2; const char* sB1 = (const char*)Bt1 + (size_t)cur.pn * 256 * K1 * 2;
    const char* sA2 = (const char*)A2 + (size_t)cur.pm * 256 * K2 * 2; const char* sB2 = (const char*)Bt2 + (size_t)cur.pn * 256 * K2 * 2;
    PG8_STB(0, 0, 0); PG8_STB(0, 1, 0); PG8_STA(0, 0, 0); PG8_STA(0, 1, 0);
    if (wr == 1) PG8_BAR;
    PG8_WAIT_V(2); PG8_BAR;
    PG8_STB(1, 0, 1); PG8_STA(1, 0, 1); PG8_STB(1, 1, 1);
    PG8_WAIT_V(6); PG8_BAR;
    for (;;) {
        const bool has_next = S.next(ui + 1, nxt);
        const int npm = has_next ? nxt.pm : cur.pm, npn = has_next ? nxt.pn : cur.pn;
        const char* nA1 = (const char*)A1 + (size_t)npm * 256 * K1 * 2; const char* nB1 = (const char*)Bt1 + (size_t)npn * 256 * K1 * 2;
        const char* nA2 = (const char*)A2 + (size_t)npm * 256 * K2 * 2; const char* nB2 = (const char*)Bt2 + (size_t)npn * 256 * K2 * 2;
        for (int t = 0; t < nt; t += 2) {
            const bool last = (t == nt - 2);
            const int t2 = last ? 0 : t + 2, t3 = last ? 1 : t + 3;
            if (t == nt1) { E.mid(acc, cur, wr, wc, fr, fq); PG8_SCHED; }
            PG8_LDB(B0, 0, 0); PG8_LDB(B1, 0, 1); PG8_SCHED; PG8_LDA(At, 0, 0); PG8_STA(1, 1, t + 1);
            PG8_WAIT_V(8); PG8_WAIT_L(0); PG8_BAR; PG8_MMA(0, 0, At, B0); PG8_MMA(0, 1, At, B1); PG8_BAR; PG8_SCHED;
            if (last) { sA1 = nA1; sB1 = nB1; sA2 = nA2; sB2 = nB2; }
            PG8_LDA(At, 0, 1); PG8_STB(0, 0, t2); PG8_STB(0, 1, t2); PG8_STA(0, 0, t2);
            PG8_WAIT_V(8); PG8_WAIT_L(0); PG8_BAR; PG8_MMA(1, 0, At, B0); PG8_MMA(1, 1, At, B1); PG8_BAR; PG8_SCHED;
            PG8_LDB(B0, 1, 0); PG8_LDB(B1, 1, 1); PG8_SCHED; PG8_LDA(At, 1, 0); PG8_STA(0, 1, t2);
            PG8_WAIT_V(8); PG8_WAIT_L(0); PG8_BAR; PG8_MMA(0, 0, At, B0); PG8_MMA(0, 1, At, B1); PG8_BAR; PG8_SCHED;
            PG8_LDA(At, 1, 1); PG8_STB(1, 0, t3); PG8_STB(1, 1, t3); PG8_STA(1, 0, t3);
            PG8_WAIT_V(8); PG8_WAIT_L(0); PG8_BAR; PG8_MMA(1, 0, At, B0); PG8_MMA(1, 1, At, B1); PG8_BAR; PG8_SCHED;
        }
        if (wr == 0) PG8_BAR;
        E(acc, cur, wr, wc, fr, fq);
        if (!has_next) break;
#pragma unroll
        for (int a = 0; a < 2; ++a)
#pragma unroll
            for (int b = 0; b < 2; ++b)
#pragma unroll
                for (int m = 0; m < 4; ++m)
#pragma unroll
                    for (int n = 0; n < 2; ++n) acc[a][b][m][n] = (f32x4){0.f, 0.f, 0.f, 0.f};
        cur = nxt; ++ui;
        if (wr == 1) PG8_BAR;
    }
    PG8_WAIT_V(0);
    PG8_BAR;
#undef PG8_SA
#undef PG8_SB
#undef PG8_STX
#undef PG8_STA
#undef PG8_STB
#undef PG8_LDA
#undef PG8_LDB
#undef PG8_MMA
#undef PG8_WAIT_V
#undef PG8_WAIT_L
#undef PG8_BAR
#undef PG8_SCHED
}
__device__ __forceinline__ v4u pack8(f32x4 v0, f32x4 v1) { v4u w; w.x = cvt_pk_bf16(v0[0], v0[1]); w.y = cvt_pk_bf16(v0[2], v0[3]); w.z = cvt_pk_bf16(v1[0], v1[1]); w.w = cvt_pk_bf16(v1[2], v1[3]); return w; }
__device__ __forceinline__ float sigm(float v) { return __builtin_amdgcn_rcpf(1.0f + __expf(-v)); }

struct EpiMergedDual {
    static constexpr bool PERM = true;
    const bf16* ga; const bf16* gb; bf16* merged;
    __device__ __forceinline__ void mid(f32x4 (&acc)[2][2][4][2], const Unit& u, int wr, int wc, int fr, int fq) const {
        int row0 = u.pm * BM + wr * 64 + fr; const int col0 = u.pn * BM + wc * 32 + 8 * fq;
        asm volatile("" : "+v"(row0));
#pragma unroll
        for (int ai = 0; ai < 2; ++ai) { v4u a[4][2];
#pragma unroll
            for (int m = 0; m < 4; ++m) { const size_t o = (size_t)(row0 + ai * HALF + m * 16) * 1024 + col0;
#pragma unroll
                for (int bj = 0; bj < 2; ++bj) a[m][bj] = *(const v4u*)(ga + o + bj * HALF); }
#pragma unroll
            for (int m = 0; m < 4; ++m)
#pragma unroll
                for (int bj = 0; bj < 2; ++bj) { const v4u a_ = a[m][bj];
                    const f32x4 r0 = {bflo(a_.x), bfhi(a_.x), bflo(a_.y), bfhi(a_.y)}, r1 = {bflo(a_.z), bfhi(a_.z), bflo(a_.w), bfhi(a_.w)};
                    acc[ai][bj][m][0] = acc[ai][bj][m][0] * r0; acc[ai][bj][m][1] = acc[ai][bj][m][1] * r1; }
            asm volatile("" ::: "memory"); }
    }
    __device__ __forceinline__ void operator()(const f32x4 (&acc)[2][2][4][2], const Unit& u, int wr, int wc, int fr, int fq) const {
        int row0 = u.pm * BM + wr * 64 + fr; const int col0 = u.pn * BM + wc * 32 + 8 * fq;
        asm volatile("" : "+v"(row0));
#pragma unroll
        for (int ai = 0; ai < 2; ++ai) { v4u g[4][2];
#pragma unroll
            for (int m = 0; m < 4; ++m) { const size_t o = (size_t)(row0 + ai * HALF + m * 16) * 1024 + col0;
#pragma unroll
                for (int bj = 0; bj < 2; ++bj) g[m][bj] = *(const v4u*)(gb + o + bj * HALF); }
#pragma unroll
            for (int m = 0; m < 4; ++m) { const size_t o = (size_t)(row0 + ai * HALF + m * 16) * 1024 + col0;
#pragma unroll
                for (int bj = 0; bj < 2; ++bj) { const v4u g_ = g[m][bj];
                    f32x4 g0 = {bflo(g_.x), bfhi(g_.x), bflo(g_.y), bfhi(g_.y)}, g1 = {bflo(g_.z), bfhi(g_.z), bflo(g_.w), bfhi(g_.w)};
                    st16_sc1(merged + o + bj * HALF, pack8(g0 * acc[ai][bj][m][0], g1 * acc[ai][bj][m][1])); } }
            asm volatile("" ::: "memory"); }
    }
};
struct EpiProj {
    static constexpr bool PERM = true;
    unsigned char* ws;
    __device__ __forceinline__ void operator()(const f32x4 (&acc)[2][2][4][2], const Unit& u, int wr, int wc, int fr, int fq) const {
        const int row0 = u.pm * BM + wr * 64 + fr, cw = wc * 32 + 8 * fq, pn = u.pn;
        if (pn == 4) {
#pragma unroll
            for (int ai = 0; ai < 2; ++ai)
#pragma unroll
                for (int m = 0; m < 4; ++m) { const size_t row = (size_t)(row0 + ai * HALF + m * 16);
                    float* cr = (float*)(ws + WS_CKVRAW) + row * 128 + cw; st16_sc1(cr, acc[ai][0][m][0]); st16_sc1(cr + 4, acc[ai][0][m][1]);
                    if (cw < 64) st16_sc1((bf16*)(ws + WS_KIDX) + ((((row >> 4) * 8 + (cw >> 3)) * 16 + (row & 15)) << 3), pack8(acc[ai][1][m][0], acc[ai][1][m][1]));
                    else if (cw == 64) { float* wr_ = (float*)(ws + WS_WIDX) + row * 8; st16_sc1(wr_, acc[ai][1][m][0] * IDXW_SCALE); st16_sc1(wr_ + 4, acc[ai][1][m][1] * IDXW_SCALE); } }
            return;
        }
        bf16* base; int ld, c0; float sc = 1.f;
        if (pn < 4) { base = (bf16*)(ws + WS_QLAT); ld = 1024; c0 = pn * 256; sc = ATT_SCALE; }
        else if (pn < 7) { base = (bf16*)(ws + WS_QIDX); ld = 512; c0 = (pn - 5) * 256; }
        else if (pn < 9) { base = (bf16*)(ws + WS_QB); ld = 512; c0 = (pn - 7) * 256; sc = 0.125f; }
        else if (pn == 9) { base = (bf16*)(ws + WS_KB); ld = 128; c0 = 0; }
        else {
#pragma unroll
            for (int ai = 0; ai < 2; ++ai)
#pragma unroll
                for (int m = 0; m < 4; ++m) { const size_t o = (size_t)(row0 + ai * HALF + m * 16) * 1024 + (pn - 10) * 128 + cw; f32x4 r0, r1, g0, g1;
#pragma unroll
                    for (int j = 0; j < 4; ++j) {
                        const float eb0 = 1.0f + __expf(-acc[ai][1][m][0][j]), eb1 = 1.0f + __expf(-acc[ai][1][m][1][j]);
                        g0[j] = __builtin_amdgcn_rcpf(eb0); g1[j] = __builtin_amdgcn_rcpf(eb1);
                        r0[j] = eb0 * __builtin_amdgcn_rcpf(1.0f + __expf(-acc[ai][0][m][0][j])); r1[j] = eb1 * __builtin_amdgcn_rcpf(1.0f + __expf(-acc[ai][0][m][1][j])); }
                    st16_sc1((bf16*)(ws + WS_GA) + o, pack8(r0, r1)); st16_sc1((bf16*)(ws + WS_GB) + o, pack8(g0, g1)); }
            return;
        }
        const size_t bjstep = (pn == 9) ? (size_t)(WS_VB - WS_KB) / 2 : (size_t)HALF;
#pragma unroll
        for (int ai = 0; ai < 2; ++ai)
#pragma unroll
            for (int m = 0; m < 4; ++m) { bf16* rowp = base + (size_t)(row0 + ai * HALF + m * 16) * ld + c0 + cw;
#pragma unroll
                for (int bj = 0; bj < 2; ++bj) { f32x4 v0 = acc[ai][bj][m][0], v1 = acc[ai][bj][m][1];
                    v0 = v0 * sc; v1 = v1 * sc;
                    st16_sc1(rowp + bj * bjstep, pack8(v0, v1)); } }
    }
};
struct EpiWoutM {
    static constexpr bool PERM = true;
    const float* x; bf16* h1b;
    __device__ __forceinline__ void operator()(const f32x4 (&acc)[2][2][4][2], const Unit& u, int wr, int wc, int fr, int fq) const {
        int row0 = u.pm * BM + wr * 64 + fr; const int col0 = u.pn * BM + wc * 32 + 8 * fq;
        asm volatile("" : "+v"(row0));
#pragma unroll
        for (int ai = 0; ai < 2; ++ai) { f32x4 xv[4][2][2];
#pragma unroll
            for (int m = 0; m < 4; ++m) { const size_t o = (size_t)(row0 + ai * HALF + m * 16) * 1024 + col0;
#pragma unroll
                for (int bj = 0; bj < 2; ++bj) { xv[m][bj][0] = *(const f32x4*)(x + o + bj * HALF); xv[m][bj][1] = *(const f32x4*)(x + o + bj * HALF + 4); } }
#pragma unroll
            for (int m = 0; m < 4; ++m) { const size_t o = (size_t)(row0 + ai * HALF + m * 16) * 1024 + col0;
#pragma unroll
                for (int bj = 0; bj < 2; ++bj) st16_sc1(h1b + o + bj * HALF, pack8(xv[m][bj][0] * ALPHA + acc[ai][bj][m][0], xv[m][bj][1] * ALPHA + acc[ai][bj][m][1])); }
            asm volatile("" ::: "memory"); }
    }
};
constexpr int MOE_TB_OFF = 131072 + 1024;
constexpr int CW_RDY = 16384;
constexpr int CW_TMO = 8;
struct MoeOrder {
    static constexpr bool HALF_SKIP = true;
    const LAS int* tb; int npn, G, c; unsigned* ctl;
    __device__ bool next(int i, Unit& u) const {
        const int L = i * G + c; if (L >= tb[32] * npn) return false;
        const int p = L / npn, pn = L - p * npn, rt = tb[128 + p]; int e = 0;
        for (int j = 1; j < 32; ++j) e = (tb[j] <= rt) ? j : e;
        u.pm = rt; u.pn = pn; u.pb = e * npn + pn; u.aux = e; u.half = p >= tb[33] ? 1 : 0; return true;
    }
    __device__ __forceinline__ void a_ready(const Unit&) const {}
    __device__ __forceinline__ void done(const Unit& u) const {
        asm volatile("s_waitcnt vmcnt(0)" ::: "memory");
        if ((threadIdx.x & 63) == 0) __hip_atomic_fetch_add(ctl + CW_RDY + 64 * u.pm, 1u, __ATOMIC_RELAXED, __HIP_MEMORY_SCOPE_AGENT);
    }
};
struct MoeDownOrder {
    static constexpr bool HALF_SKIP = false;
    const LAS int* tb; int G, c; unsigned* ctl;
    __device__ bool next(int i, Unit& u) const {
        const int nT = tb[32], nD = 4 * nT; int R = 2 * nT - G; R = R < 0 ? 0 : (R > G ? G : R);
        int L;
        if (c >= R) { L = (i < 4) ? i * (G - R) + (c - R) : 4 * (G - R) + (i - 4) * G + c; }
        else { L = 4 * (G - R) + i * G + c; }
        if (L >= nD) return false;
        const int p = L >> 2, pn = L & 3, rt = tb[128 + p]; int e = 0;
        for (int j = 1; j < 32; ++j) e = (tb[j] <= rt) ? j : e;
        u.pm = rt; u.pn = pn; u.pb = e * 4 + pn; u.aux = e; u.half = p >= tb[33] ? 1 : 0; return true;
    }
    __device__ __forceinline__ void a_ready(const Unit& u) const {
        if (threadIdx.x < 64) {
            unsigned* w = ctl + CW_RDY + 64 * u.pm; unsigned sp = 0;
            while ((unsigned)__builtin_amdgcn_readfirstlane(__hip_atomic_load(w, __ATOMIC_RELAXED, __HIP_MEMORY_SCOPE_AGENT)) < 16u) {
                __builtin_amdgcn_s_sleep(2);
                if ((++sp & 1023u) == 0u) { if (__hip_atomic_load(ctl + CW_TMO, __ATOMIC_RELAXED, __HIP_MEMORY_SCOPE_AGENT) != 0u) break;
                    if (sp > (1u << 22)) { __hip_atomic_store(ctl + CW_TMO, 1u, __ATOMIC_RELAXED, __HIP_MEMORY_SCOPE_AGENT); break; } } }
            __builtin_amdgcn_fence(__ATOMIC_ACQUIRE, "agent");
            asm volatile("s_waitcnt vmcnt(0)" ::: "memory");
        }
        asm volatile("" ::: "memory"); __builtin_amdgcn_s_barrier(); asm volatile("" ::: "memory");
    }
    __device__ __forceinline__ void done(const Unit&) const {}
};
struct GatherProb {
    static constexpr bool GATHER = true;
    const bf16* A; const bf16* Bt; int K; const LAS int* tb; const unsigned* list;
    __device__ __forceinline__ const char* a_base(const Unit&) const { return (const char*)A; }
    __device__ __forceinline__ const char* b_base(const Unit& u) const { return (const char*)Bt + (size_t)u.pb * 256 * K * 2; }
    __device__ __forceinline__ void a_offs(const Unit& u, int R0, int C0, int R1, int C1, unsigned (&o)[2][2]) const {
        const int e = u.aux, lbase = (u.pm - tb[e]) * 256, cnt = tb[64 + e];
        const unsigned* le = list + (size_t)e * 65536;
#pragma unroll
        for (int h = 0; h < 2; ++h) { const int l0 = lbase + h * HALF + R0, l1 = lbase + h * HALF + R1;
            const unsigned t0 = le[2 * (l0 < cnt ? l0 : 0)] >> 1, t1 = le[2 * (l1 < cnt ? l1 : 0)] >> 1;
            o[h][0] = (t0 * (unsigned)K + (unsigned)C0) * 2u; o[h][1] = (t1 * (unsigned)K + (unsigned)C1) * 2u; }
    }
};
struct EpiGU {
    static constexpr bool PERM = true;
    bf16* hbuf;
    __device__ __forceinline__ void operator()(const f32x4 (&acc)[2][2][4][2], const Unit& u, int wr, int wc, int fr, int fq) const {
        const int row0 = u.pm * BM + wr * 64 + fr, col0 = u.pn * HALF + wc * 32 + 8 * fq;
#pragma unroll
        for (int ai = 0; ai < 2; ++ai) if (ai == 0 || !u.half)
#pragma unroll
            for (int m = 0; m < 4; ++m) { f32x4 h0, h1;
#pragma unroll
                for (int j = 0; j < 4; ++j) { const float g0 = acc[ai][0][m][0][j], g1 = acc[ai][0][m][1][j];
                    h0[j] = g0 * sigm(g0) * acc[ai][1][m][0][j]; h1[j] = g1 * sigm(g1) * acc[ai][1][m][1][j]; }
                { const v4u hv = pack8(h0, h1); bf16* hp = hbuf + (size_t)(row0 + ai * HALF + m * 16) * 256 + col0;
                  asm volatile("global_store_dwordx4 %0, %1, off sc1\n\ts_nop 1" :: "v"(hp), "v"(hv) : "memory"); } }
    }
};
struct EpiDown {
    static constexpr bool PERM = true;
    bf16* slot; const LAS int* tb; const unsigned* list;
    __device__ __forceinline__ void operator()(const f32x4 (&acc)[2][2][4][2], const Unit& u, int wr, int wc, int fr, int fq) const {
        const int e = u.aux, lbase = (u.pm - tb[e]) * 256 + wr * 64 + fr, cnt = tb[64 + e], col0 = u.pn * BM + wc * 32 + 8 * fq;
        const v2u* le = (const v2u*)list + (size_t)e * 32768;
        unsigned pr[2][4]; float w[2][4];
#pragma unroll
        for (int ai = 0; ai < 2; ++ai)
#pragma unroll
            for (int m = 0; m < 4; ++m) { const int l = lbase + ai * HALF + m * 16; const v2u en = le[l < cnt ? l : 0]; const unsigned ex_ = en.x, ey_ = en.y; pr[ai][m] = ex_; w[ai][m] = __builtin_bit_cast(float, ey_); }
#pragma unroll
        for (int ai = 0; ai < 2; ++ai)
#pragma unroll
            for (int m = 0; m < 4; ++m) { const int l = lbase + ai * HALF + m * 16;
                if (l < cnt) { bf16* rowp = slot + (size_t)pr[ai][m] * 1024 + col0;
#pragma unroll
                    for (int bj = 0; bj < 2; ++bj) *(v4u*)(rowp + bj * HALF) = pack8(acc[ai][bj][m][0] * w[ai][m], acc[ai][bj][m][1] * w[ai][m]); } }
    }
};
}

struct Args { const float* in[20]; float* out; unsigned char* ws; int ph_lo, ph_hi; };
__global__ void __launch_bounds__(NTHR, 2) fwd_kernel(Args args) {
    extern __shared__ __attribute__((aligned(16))) unsigned char lds_raw[];
    Ctx c;
    c.lds = (LAS unsigned char*)lds_raw;
    c.tid = threadIdx.x; c.lane = c.tid & 63; c.wave = __builtin_amdgcn_readfirstlane(c.tid >> 6); c.bid = blockIdx.x; c.G = gridDim.x;
    c.x = args.in[0]; c.w_in = args.in[1]; c.kv_g = args.in[2]; c.w_uv = args.in[3]; c.w_a = args.in[4]; c.sinks = args.in[5]; c.w_b = args.in[6]; c.w_out = args.in[7]; c.rel_bias = args.in[8];
    c.ln1_g = args.in[9]; c.ln1_b = args.in[10]; c.w_group = args.in[11]; c.b_group = args.in[12]; c.w_router = args.in[13]; c.b_router = args.in[14]; c.w_gate = args.in[15]; c.w_up = args.in[16]; c.w_down = args.in[17];
    c.ln2_g = args.in[18]; c.ln2_b = args.in[19]; c.out = args.out; c.ws = args.ws; unsigned char* ws = args.ws;
    c.ctl = (unsigned*)(ws + WS_CTL);
    volatile LAS unsigned* MISC = (volatile LAS unsigned*)(c.lds + MISC_OFF);
    if (c.tid < 32) MISC[c.tid] = 0u;
    __syncthreads();
    XcdBarrier bar; bar.bar = c.ctl + CW_BAR; bar.x = 0; bar.st = nullptr;
    if (MK_N_LAUNCHES == 1) bar = xcd_barrier_post(c.ctl + CW_BAR, MISC + 8);
    const int lo = args.ph_lo, hi = args.ph_hi;
#define IN(k) (lo <= (k) && (k) < hi)
#define SEAM(k) do { if (IN(k) && IN((k) + 1)) xcd_barrier(bar); } while (0)
    bf16* merged = ((bf16*)(c.ws + WS_QLAT)); bf16* x1b = ((bf16*)(c.ws + WS_XB));

    if (IN(0)) { p0_prologue(c); } SEAM(0);
    if (IN(1)) { pg8::DenseProb P{(const bf16*)(c.ws + WS_XB), (const bf16*)(c.ws + WS_WIN), 1024}; pg8::ProjOrder S{c.G, c.bid, c.ctl}; pg8::EpiProj E{c.ws};
        pg8::gemm_phase(c.lds, P, S, E);
        if (MK_N_LAUNCHES == 1) wave_publish(c, c.ctl + CW_P1D); }
    if (MK_N_LAUNCHES != 1) SEAM(1);
    if (IN(2)) { p2_indexer_topk(c); }
    if (MK_N_LAUNCHES == 1 && c.G == 256) { wg_wait(c, c.ctl + CW_P1D, 256u * NWAVES); wg_wait(c, c.ctl + CW_RMS + 64 * (c.bid & 7), 32u * NWAVES); } else SEAM(2);
    if (IN(3)) { p3a_dsa(c); if (c.G != 256) p3b_swa(c, c.bid, c.G, 256); } if (!(MK_N_LAUNCHES == 1 && c.G == 256)) SEAM(3);
    if (IN(4)) { pg8::StaticOrder S; S.init(NTOK, 1024, c.G, c.bid); pg8::EpiMergedDual E{(const bf16*)(c.ws + WS_GA), (const bf16*)(c.ws + WS_GB), merged};
        if (MK_N_LAUNCHES == 1 && c.G == 256) { pg8::Unit u3; if (S.next(0, u3)) wg_wait(c, c.ctl + pg8::CW_PAN + 64 * u3.pm, 128u); }
        pg8::gemm_phase_dual(c.lds, (const bf16*)(c.ws + WS_XB), (const bf16*)(c.ws + WS_WC), 1024, (const bf16*)(c.ws + WS_QB), (const bf16*)(c.ws + WS_WB), 512, S, E);
        if (MK_N_LAUNCHES == 1 && c.G == 256) { pg8::Unit u4; if (S.next(0, u4)) wave_publish(c, c.ctl + pg8::CW_PAN + 64 * u4.pm); } }
    if (!(MK_N_LAUNCHES == 1 && c.G == 256)) SEAM(4);
    if (IN(5)) { pg8::DenseProb P{(const bf16*)merged, (const bf16*)(c.ws + WS_WO), 1024}; pg8::PanelOrder S; S.init(NTOK, 1024, c.G, c.bid); S.ctl = c.ctl; S.need = (MK_N_LAUNCHES == 1 && c.G == 256) ? 160u : 0u; pg8::EpiWoutM E{c.x, (bf16*)(c.ws + WS_H1B)};
        pg8::gemm_phase(c.lds, P, S, E);
        if (MK_N_LAUNCHES == 1 && c.G == 256) { pg8::Unit u5; if (S.next(0, u5)) wave_publish(c, c.ctl + pg8::CW_PAN + 64 * u5.pm); } }
    if (IN(6)) { p6_ln_router(c, x1b, bar, IN(5) && IN(6)); } else SEAM(5);
    SEAM(6);
    LAS int* tb = (LAS int*)(c.lds + pg8::MOE_TB_OFF);
    if (IN(7) || IN(8)) {
        if (c.tid < 32) { const int e = c.tid, cnt = (int)__hip_atomic_load(c.ctl + CW_CNT + e, __ATOMIC_RELAXED, __HIP_MEMORY_SCOPE_AGENT);
            const int ne = (cnt + 255) >> 8, hh_ = (ne > 0 && cnt - (ne - 1) * 256 <= 128) ? 1 : 0, nfe = ne - hh_;
            int a = ne, f = nfe, h = hh_;
#pragma unroll
            for (int d = 1; d < 32; d <<= 1) { const int ta = __shfl_up(a, d, 32), tf = __shfl_up(f, d, 32), th = __shfl_up(h, d, 32); if (e >= d) { a += ta; f += tf; h += th; } }
            const int nT = __shfl(a, 31, 32), nF = __shfl(f, 31, 32), tbe = a - ne;
            tb[e] = tbe; tb[64 + e] = cnt;
            for (int k = 0; k < nfe; ++k) tb[128 + (f - nfe) + k] = tbe + k;
            if (hh_) tb[128 + nF + h - 1] = tbe + ne - 1;
            if (e == 0) { tb[32] = nT; tb[33] = nF; } }
        __syncthreads();
    }
    if (IN(7)) { pg8::GatherProb P{(const bf16*)x1b, (const bf16*)(c.ws + WS_WGU), 1024, tb, (const unsigned*)(c.ws + WS_LIST)}; pg8::MoeOrder S{tb, 2, c.G, c.bid, c.ctl}; pg8::EpiGU E{(bf16*)(c.ws + WS_QLAT)};
        pg8::gemm_phase(c.lds, P, S, E); }
    if (MK_N_LAUNCHES != 1) SEAM(7);
    if (IN(8)) { pg8::DenseProb P{(const bf16*)(c.ws + WS_QLAT), (const bf16*)(c.ws + WS_WD), 256}; pg8::MoeDownOrder S{tb, c.G, c.bid, c.ctl};
        pg8::EpiDown E{(bf16*)(c.ws + WS_SLOT), tb, (const unsigned*)(c.ws + WS_LIST)};
        pg8::gemm_phase(c.lds, P, S, E); }
    if (IN(9)) { p9_ln2(c, bar, IN(8) && IN(9)); } else SEAM(8);
#undef IN
#undef SEAM
}

extern "C" void kernel_launch(void* const* d_in, const int* in_sizes, int n_in, void* d_out, int out_size, void* d_ws, size_t ws_size, hipStream_t stream) {
    static int grid = 0;
    if (grid == 0) {
        if (n_in != 20 || out_size != NTOK * D || ws_size < WS_END) { fprintf(stderr, "kernel_launch: unexpected shapes (n_in %d out %d ws %zu)\n", n_in, out_size, ws_size); grid = -1; return; }
        int dev = 0, cus = 0, per_cu = 0;
        if (hipGetDevice(&dev) != hipSuccess || hipDeviceGetAttribute(&cus, hipDeviceAttributeMultiprocessorCount, dev) != hipSuccess) { grid = -1; return; }
        if (hipFuncSetAttribute((const void*)fwd_kernel, hipFuncAttributeMaxDynamicSharedMemorySize, LDS_BYTES) != hipSuccess) { fprintf(stderr, "kernel_launch: hipFuncSetAttribute failed\n"); grid = -1; return; }
        if (hipOccupancyMaxActiveBlocksPerMultiprocessor(&per_cu, (const void*)fwd_kernel, NTHR, LDS_BYTES) != hipSuccess || per_cu < 1) { fprintf(stderr, "kernel_launch: occupancy query says %d\n", per_cu); }
        (void)hipGetLastError();
        grid = cus;
    }
    if (grid < 0) return;
    if (hipMemsetAsync((char*)d_ws + WS_CTL, 0, CTL_ZERO_BYTES, stream) != hipSuccess) return;
    Args a{};
    for (int i = 0; i < 20; ++i) a.in[i] = (const float*)d_in[i];
    a.out = (float*)d_out; a.ws = (unsigned char*)d_ws;
    if (MK_N_LAUNCHES == 1) { a.ph_lo = 0; a.ph_hi = NPHASE; hipLaunchKernelGGL(fwd_kernel, dim3(grid), dim3(NTHR), LDS_BYTES, stream, a); }
    else { for (int p = 0; p < NPHASE; ++p) { a.ph_lo = p; a.ph_hi = p + 1; hipLaunchKernelGGL(fwd_kernel, dim3(grid), dim3(NTHR), LDS_BYTES, stream, a); } }
}
```
